# Optimizing an MI355X kernel written in HIP

```python
import jax, jax.numpy as jnp
from jax import lax
import numpy as np

D_MODEL = 1024
BATCH = 1
SEQ = 16384
DEPTH = 4
DEC_BATCH = 32
DEC_SEQ = 16
PAST_LEN = 2048

CHUNK = 64
N_A = DEPTH // 2
N_B = DEPTH - N_A
CONV_W = 3
N_HEADS = 16
HEAD_DIM = 64
D_ATTN = N_HEADS * HEAD_DIM
D_FF = 4 * D_MODEL
Q_BLOCK = 128
RMS_EPS = 1e-6

kernel_name = "yoco_shortconv_fox_stream_step"


def rmsnorm(x, g):
    xf = x.astype(jnp.float32)
    y = xf * lax.rsqrt(jnp.mean(xf * xf, axis=-1, keepdims=True) + RMS_EPS)
    return (y * g.astype(jnp.float32)).astype(x.dtype)


def short_conv(h, state, w_in, w_conv, w_out):
    bcx = h @ w_in
    gb, gc, xv = jnp.split(bcx, 3, axis=-1)
    u = gc * xv
    L = u.shape[1]
    u_pad = jnp.concatenate([state.astype(u.dtype), u], axis=1)
    conv = sum(w_conv[i] * u_pad[:, i:i + L] for i in range(CONV_W))
    y = (gb * conv) @ w_out
    return y, u_pad[:, -(CONV_W - 1):]


def sq_relu_mlp(h, w_up, w_down):
    a = jax.nn.relu(h @ w_up)
    return (a * a) @ w_down


def fox_attend(q, k, v, c_q, c_k, q_pos, k_pos):
    s = jnp.einsum('bqhd,bkhd->bhqk', q, k).astype(jnp.float32) * (HEAD_DIM ** -0.5)
    bias = jnp.transpose(c_q, (0, 2, 1))[:, :, :, None] - jnp.transpose(c_k, (0, 2, 1))[:, :, None, :]
    mask = k_pos[None, :] <= q_pos[:, None]
    s = jnp.where(mask[None, None], s + bias, -jnp.inf)
    p = jax.nn.softmax(s, axis=-1)
    return jnp.einsum('bhqk,bkhd->bqhd', p.astype(v.dtype), v)


def setup_inputs(seed: int = 0) -> dict:
    key = jax.random.key(seed)
    ks = jax.random.split(key, 24)
    nrm = lambda k, shape, scale: jax.random.normal(k, shape, jnp.float32) * scale
    return {
        "x_prompt": nrm(ks[0], (BATCH, SEQ, D_MODEL), 1.0),
        "x_sample": nrm(ks[1], (DEC_BATCH, DEC_SEQ, D_MODEL), 1.0),
        "cache_k": nrm(ks[2], (DEC_BATCH, PAST_LEN, N_HEADS, HEAD_DIM), 1.0),
        "cache_v": nrm(ks[3], (DEC_BATCH, PAST_LEN, N_HEADS, HEAD_DIM), 1.0),
        "cache_logf": jax.nn.log_sigmoid(3.0 + nrm(ks[4], (DEC_BATCH, PAST_LEN, N_HEADS), 0.5)),
        "state_conv": nrm(ks[5], (N_A, DEC_BATCH, CONV_W - 1, D_MODEL), 1.0),
        "norm_mix": 1.0 + nrm(ks[6], (DEPTH, D_MODEL), 0.02),
        "norm_mlp": 1.0 + nrm(ks[7], (DEPTH, D_MODEL), 0.02),
        "conv_in": nrm(ks[8], (N_A, D_MODEL, 3 * D_MODEL), D_MODEL ** -0.5),
        "conv_w": nrm(ks[9], (N_A, CONV_W, D_MODEL), CONV_W ** -0.5),
        "conv_out": nrm(ks[10], (N_A, D_MODEL, D_MODEL), D_MODEL ** -0.5),
        "norm_kv": 1.0 + nrm(ks[11], (D_MODEL,), 0.02),
        "w_k": nrm(ks[12], (D_MODEL, D_ATTN), D_MODEL ** -0.5),
        "w_v": nrm(ks[13], (D_MODEL, D_ATTN), D_MODEL ** -0.5),
        "w_f": nrm(ks[14], (D_MODEL, N_HEADS), 0.1 * D_MODEL ** -0.5),
        "b_f": 3.0 + nrm(ks[15], (N_HEADS,), 0.5),
        "w_q": nrm(ks[16], (N_B, D_MODEL, D_ATTN), D_MODEL ** -0.5),
        "w_o": nrm(ks[17], (N_B, D_ATTN, D_MODEL), D_ATTN ** -0.5),
        "mlp_up": nrm(ks[18], (DEPTH, D_MODEL, D_FF), D_MODEL ** -0.5),
        "mlp_down": nrm(ks[19], (DEPTH, D_FF, D_MODEL), D_FF ** -0.5),
        "norm_final": 1.0 + nrm(ks[20], (D_MODEL,), 0.02),
    }


def reference(x_prompt, x_sample, cache_k, cache_v, cache_logf, state_conv,
              norm_mix, norm_mlp, conv_in, conv_w, conv_out,
              norm_kv, w_k, w_v, w_f, b_f, w_q, w_o,
              mlp_up, mlp_down, norm_final):

    def trunk(x, conv_state, past):
        bsz, L, _ = x.shape
        new_conv = []
        shared = None
        for l in range(DEPTH):
            h = rmsnorm(x, norm_mix[l])
            if l < N_A:
                y, st = short_conv(h, conv_state[l], conv_in[l], conv_w[l], conv_out[l])
                new_conv.append(st)
            else:
                j = l - N_A
                k_all, v_all, c_all, k_pos, q_off = shared
                q = (h @ w_q[j]).reshape(bsz, L, N_HEADS, HEAD_DIM)
                if past is None:
                    nb = L // Q_BLOCK
                    qb = jnp.transpose(q.reshape(bsz, nb, Q_BLOCK, N_HEADS, HEAD_DIM), (1, 0, 2, 3, 4))
                    cqb = jnp.transpose(c_all.reshape(bsz, nb, Q_BLOCK, N_HEADS), (1, 0, 2, 3))
                    posb = jnp.arange(L, dtype=jnp.int32).reshape(nb, Q_BLOCK)
                    ob = lax.map(lambda a: fox_attend(a[0], k_all, v_all, a[1], c_all, a[2], k_pos),
                                 (qb, cqb, posb))
                    attn = jnp.transpose(ob, (1, 0, 2, 3, 4)).reshape(bsz, L, D_ATTN)
                else:
                    q_pos = q_off + jnp.arange(L, dtype=jnp.int32)
                    attn = fox_attend(q, k_all, v_all, c_all[:, q_off:], c_all, q_pos, k_pos)
                    attn = attn.reshape(bsz, L, D_ATTN)
                y = attn @ w_o[j]
            x = x + y
            x = x + sq_relu_mlp(rmsnorm(x, norm_mlp[l]), mlp_up[l], mlp_down[l])
            if l == N_A - 1:
                hk = rmsnorm(x, norm_kv)
                k_new = (hk @ w_k).reshape(bsz, L, N_HEADS, HEAD_DIM)
                v_new = (hk @ w_v).reshape(bsz, L, N_HEADS, HEAD_DIM)
                logf_new = jax.nn.log_sigmoid((hk @ w_f + b_f).astype(jnp.float32))
                if past is None:
                    k_all, v_all, logf_all, q_off = k_new, v_new, logf_new, 0
                else:
                    k_p, v_p, lf_p = past
                    q_off = k_p.shape[1]
                    k_all = jnp.concatenate([k_p, k_new.astype(k_p.dtype)], axis=1)
                    v_all = jnp.concatenate([v_p, v_new.astype(v_p.dtype)], axis=1)
                    logf_all = jnp.concatenate([lf_p.astype(jnp.float32), logf_new], axis=1)
                c_all = jnp.cumsum(logf_all, axis=1)
                k_pos = jnp.arange(k_all.shape[1], dtype=jnp.int32)
                shared = (k_all, v_all, c_all, k_pos, q_off)
        return rmsnorm(x, norm_final), k_new, v_new, logf_new, jnp.stack(new_conv)

    conv0 = jnp.zeros((N_A, x_prompt.shape[0], CONV_W - 1, D_MODEL), x_prompt.dtype)
    y_prompt, k_prompt, v_prompt, logf_prompt, conv_prompt = trunk(x_prompt, conv0, None)
    y_sample, k_sample, v_sample, logf_sample, conv_sample = trunk(
        x_sample, state_conv, (cache_k, cache_v, cache_logf))
    return (y_prompt, y_sample, k_prompt, v_prompt, logf_prompt, conv_prompt,
            k_sample, v_sample, logf_sample, conv_sample)
```

```cpp
#include <hip/hip_runtime.h>
#include <hip/hip_cooperative_groups.h>
#include <cstdio>
#include <cstdint>
__device__ __forceinline__ int opaque_bid() { int b = (int)blockIdx.x; asm volatile("" : "+s"(b)); return b; }
__device__ __forceinline__ int opaque_tid() { int t = (int)threadIdx.x; asm volatile("" : "+v"(t)); return t; }
namespace pg8 {
#define PG8_LAS __attribute__((address_space(3)))
typedef unsigned short bf16_t;
typedef short bf16x8 __attribute__((ext_vector_type(8)));
typedef float f32x4 __attribute__((ext_vector_type(4)));
typedef unsigned u32x4 __attribute__((ext_vector_type(4)));
constexpr int BM = 256, BK = 64, HALF = 128, HTB = HALF * BK * 2  , STAGE_BYTES = 8 * HTB, NXCD = 8, WGM = 8;

__host__ __device__ __forceinline__ int lds_byte(int r, int c) { const int st = (r >> 4) * 2 + (c >> 5), rr = r & 15, cc = c & 31, ob = rr * 64 + cc * 2; return st * 1024 + (ob ^ (((ob >> 9) & 1) << 5)); }
__host__ __device__ __forceinline__ void stage_rc(int b, int& R, int& C) { const int st = b / 1024, sb = b % 1024, swz = sb ^ (((sb >> 9) & 1) << 5); R = (st >> 1) * 16 + swz / 64; C = (st & 1) * 32 + (swz % 64) / 2; }
__host__ __device__ __forceinline__ int perm32(int rho) { const int n = rho >> 4, i = rho & 15; return 8 * (i >> 2) + 4 * n + (i & 3); }

struct Unit { int pm, pn; };
struct Gemm { const bf16_t* A; const bf16_t* Bt; int M, N, K; };

struct StaticOrder {
    int nM, nN, nwg, G, c;
    __host__ __device__ void init(int M, int N, int G_, int c_) { nM = M / BM; nN = N / BM; nwg = nM * nN; G = G_; c = c_; }
    __host__ __device__ bool next(int i, Unit& u) const {
        const long L = (long)i * G + c; if (L >= nwg) return false;
        int wgid = (int)L; { const int q = nwg / NXCD, r = nwg % NXCD, xcd = wgid % NXCD, off = wgid / NXCD; wgid = (xcd < r ? xcd * (q + 1) : r * (q + 1) + (xcd - r) * q) + off; }
        const int nig = WGM * nN, gid = wgid / nig, fm = gid * WGM, gsz = (nM - fm) < WGM ? (nM - fm) : WGM;
        u.pm = fm + ((wgid % nig) % gsz); u.pn = (wgid % nig) / gsz; return true;
    }
    __device__ __forceinline__ void a_ready(const Unit&) const {}
    __device__ __forceinline__ void done(const Unit&) const {}
};

__device__ __forceinline__ unsigned cvt_pk_bf16(float lo, float hi) { unsigned r; asm volatile("v_cvt_pk_bf16_f32 %0, %1, %2" : "=v"(r) : "v"(lo), "v"(hi)); return r; }
typedef float f32x2 __attribute__((ext_vector_type(2)));
__device__ __forceinline__ f32x2 gelu_pk(f32x2 v) {
    const f32x2 av = __builtin_elementwise_abs(v), d = av * 0.2316418882f + 1.0f;
    f32x2 t; t.x = __builtin_amdgcn_rcpf(d.x); t.y = __builtin_amdgcn_rcpf(d.y);
    f32x2 q = t * 0.5307027145f + (-0.7265760135f); q = q * t + 0.7107068705f; q = q * t + (-0.142248368f); q = q * t + 0.127414796f; q = q * t;
    const f32x2 s = (v * v) * (-0.72134752044f);
    f32x2 e; e.x = __builtin_amdgcn_exp2f(s.x); e.y = __builtin_amdgcn_exp2f(s.y);
    const f32x2 m = v * (q * e), r = v - m;
    f32x2 o; o.x = v.x < 0.f ? m.x : r.x; o.y = v.y < 0.f ? m.y : r.y; return o;
}

template <int ACT  > struct EpiBf16 {
    static constexpr bool PERM = true, AFTER_DRAIN = false; static_assert(ACT == 0 || ACT == 1, "EpiBf16: ACT is 0 (none) or 1 (gelu_pk)");
    bf16_t* O; int ldc; const float* bias; int split_cols; size_t split_stride; float scale0;
    __device__ __forceinline__ void operator()(const f32x4 (&acc)[2][2][4][2], const Unit& u, int wr, int wc, int fr, int fq) const {
        const int row0 = u.pm * BM + wr * 64 + fr; int colt = u.pn * BM; bf16_t* base = O;
        float sc = 1.f; if (split_cols) { const int t = colt / split_cols; base += (size_t)t * split_stride; colt -= t * split_cols; if (t == 0) sc = scale0; }
        const int col0 = colt + wc * 32 + 8 * fq, bcol0 = u.pn * BM + wc * 32 + 8 * fq;
        f32x4 bv[2][2];
#pragma unroll
        for (int bj = 0; bj < 2; ++bj)
#pragma unroll
            for (int n = 0; n < 2; ++n) bv[bj][n] = bias ? *(const f32x4*)(bias + bcol0 + bj * HALF + 4 * n) : (f32x4){0.f, 0.f, 0.f, 0.f};
#pragma unroll
        for (int ai = 0; ai < 2; ++ai)
#pragma unroll
            for (int m = 0; m < 4; ++m) { bf16_t* rowp = base + (size_t)(row0 + ai * HALF + m * 16) * ldc + col0;
#pragma unroll
                for (int bj = 0; bj < 2; ++bj) { f32x4 v0 = acc[ai][bj][m][0] + bv[bj][0], v1 = acc[ai][bj][m][1] + bv[bj][1];
                    if (ACT == 1) { f32x2 a = gelu_pk((f32x2){v0[0], v0[1]}), b = gelu_pk((f32x2){v0[2], v0[3]}), c = gelu_pk((f32x2){v1[0], v1[1]}), d = gelu_pk((f32x2){v1[2], v1[3]});
                        v0 = (f32x4){a.x, a.y, b.x, b.y}; v1 = (f32x4){c.x, c.y, d.x, d.y}; }
                    v0 = v0 * sc; v1 = v1 * sc; u32x4 w; w.x = cvt_pk_bf16(v0[0], v0[1]); w.y = cvt_pk_bf16(v0[2], v0[3]); w.z = cvt_pk_bf16(v1[0], v1[1]); w.w = cvt_pk_bf16(v1[2], v1[3]);
                    *(u32x4*)(rowp + bj * HALF) = w; } }
    }
};

struct PanelStats {
    unsigned* xbuf;
    unsigned* cnt;
    unsigned* tmo;
    int ntn; float eps;
    unsigned code;
    __device__ __forceinline__ bool run(const f32x4 (&v)[2][2][4][2], const Unit& u, int wr, int wc, int fr, int fq, PG8_LAS unsigned char* lds, int wid, int lane) const {
        typedef float f32x2v __attribute__((ext_vector_type(2)));
        PG8_LAS f32x2v* P = (PG8_LAS f32x2v*)lds;
        PG8_LAS f32x2v* S = (PG8_LAS f32x2v*)(lds + 8192);
        PG8_LAS unsigned* flag = (PG8_LAS unsigned*)(lds + 8192 + 2048);
#pragma unroll
        for (int ai = 0; ai < 2; ++ai)
#pragma unroll
            for (int m = 0; m < 4; ++m) {
                float s = 0.f;
#pragma unroll
                for (int bj = 0; bj < 2; ++bj)
#pragma unroll
                    for (int n = 0; n < 2; ++n) { const f32x4 x = v[ai][bj][m][n]; s += (x[0] + x[1]) + (x[2] + x[3]); }
                s += __shfl_xor(s, 16); s += __shfl_xor(s, 32);
                const float mw = s * (1.0f / 64.0f); float q = 0.f;
#pragma unroll
                for (int bj = 0; bj < 2; ++bj)
#pragma unroll
                    for (int n = 0; n < 2; ++n) { const f32x4 d = v[ai][bj][m][n] - mw; q += (d[0] * d[0] + d[1] * d[1]) + (d[2] * d[2] + d[3] * d[3]); }
                q += __shfl_xor(q, 16); q += __shfl_xor(q, 32);
                if (fq == 0) P[(ai * HALF + wr * 64 + m * 16 + fr) * 4 + wc] = (f32x2v){mw, q};
            }
        asm volatile("s_waitcnt lgkmcnt(0)" ::: "memory"); __builtin_amdgcn_s_barrier(); asm volatile("" ::: "memory");
#if defined(BROKEN_EXCHANGE_NO_WAIT)
#warning BROKEN CONTROL BUILD: the row-statistics exchange does not wait; results are wrong by design
        if (blockIdx.x >= 64) { const long long t0_ = clock64(); while (clock64() - t0_ < 60000) __builtin_amdgcn_s_sleep(8); }
#endif
        const int row = wid * 32 + (lane & 31);
        if (lane < 32) {
            const f32x2v a = P[row * 4 + 0], b = P[row * 4 + 1], c = P[row * 4 + 2], d = P[row * 4 + 3];
            const float mt = (a.x + b.x + c.x + d.x) * 0.25f;
            const float da = a.x - mt, db = b.x - mt, dc = c.x - mt, dd = d.x - mt;
            const float m2 = (a.y + b.y) + (c.y + d.y) + 64.0f * ((da * da + db * db) + (dc * dc + dd * dd));
            unsigned long long* slot = (unsigned long long*)xbuf + ((size_t)(u.pm * BM + row) * 4 + u.pn);
            __hip_atomic_store(slot, ((unsigned long long)__float_as_uint(m2) << 32) | __float_as_uint(mt), __ATOMIC_RELAXED, __HIP_MEMORY_SCOPE_AGENT);
        }
        asm volatile("s_waitcnt vmcnt(0)" ::: "memory");
        if (lane == 0) __hip_atomic_fetch_add(cnt + 64 * u.pm, 1u, __ATOMIC_RELAXED, __HIP_MEMORY_SCOPE_AGENT);
        if (wid == 0) {
            bool dead = false; const unsigned long long t0 = __builtin_amdgcn_s_memrealtime(); const unsigned want = 8u * (unsigned)ntn;
            for (;;) {
#if defined(BROKEN_EXCHANGE_NO_WAIT)
                break;
#endif
                if ((unsigned)__builtin_amdgcn_readfirstlane(__hip_atomic_load(cnt + 64 * u.pm, __ATOMIC_RELAXED, __HIP_MEMORY_SCOPE_AGENT)) >= want) break;
                if (__builtin_amdgcn_s_memrealtime() - t0 > 2000000ull) {
                    if (lane == 0) { unsigned expect = 0u; __hip_atomic_compare_exchange_strong(tmo + 1, &expect, code | (unsigned)(u.pm & 0xff), __ATOMIC_RELAXED, __ATOMIC_RELAXED, __HIP_MEMORY_SCOPE_AGENT);
                                     __hip_atomic_store(tmo, 1u, __ATOMIC_RELAXED, __HIP_MEMORY_SCOPE_AGENT); }
                    dead = true; break; }
                __builtin_amdgcn_s_sleep(2);
            }
            __builtin_amdgcn_fence(__ATOMIC_ACQUIRE, "agent");
            if (lane == 0) flag[0] = dead ? 1u : 0u;
        }
        asm volatile("s_waitcnt vmcnt(0) lgkmcnt(0)" ::: "memory"); __builtin_amdgcn_s_barrier(); asm volatile("" ::: "memory");
        const bool bad = flag[0] != 0u;
        if (lane < 32) {
            const unsigned long long* slot = (const unsigned long long*)xbuf + (size_t)(u.pm * BM + row) * 4; float mt[4], m2[4]; float ms = 0.f;
#pragma unroll
            for (int t = 0; t < 4; ++t) { if (t < ntn) { const unsigned long long w = __hip_atomic_load(slot + t, __ATOMIC_RELAXED, __HIP_MEMORY_SCOPE_AGENT); mt[t] = __uint_as_float((unsigned)w); m2[t] = __uint_as_float((unsigned)(w >> 32)); } else { mt[t] = 0.f; m2[t] = 0.f; } ms += mt[t]; }
            const float mean = ms / (float)ntn; float q = 0.f;
#pragma unroll
            for (int t = 0; t < 4; ++t) if (t < ntn) { const float dm = mt[t] - mean; q += m2[t] + 256.0f * dm * dm; }
            S[row] = (f32x2v){mean, 1.0f / sqrtf(q / (256.0f * (float)ntn) + eps)};
        }
        asm volatile("s_waitcnt lgkmcnt(0)" ::: "memory"); __builtin_amdgcn_s_barrier(); asm volatile("" ::: "memory");
        return bad;
    }
};
struct EpiLnRes {
    static constexpr bool PERM = false, AFTER_DRAIN = true;
    const float* base; float* out; int ldc; const float* bias; PanelStats st; unsigned poison;
    __device__ __forceinline__ void fused(f32x4 (&acc)[2][2][4][2], const Unit& u, int wr, int wc, int fr, int fq, PG8_LAS unsigned char* lds, int wid, int lane) const {
        typedef float f32x2v __attribute__((ext_vector_type(2)));
        const PG8_LAS f32x2v* S = (const PG8_LAS f32x2v*)(lds + 8192);
        const int col0 = u.pn * BM + wc * 32 + 4 * fq;
#pragma unroll
        for (int bj = 0; bj < 2; ++bj)
#pragma unroll
            for (int n = 0; n < 2; ++n) { const f32x4 bv = bias ? *(const f32x4*)(bias + col0 + bj * HALF + n * 16) : (f32x4){0.f, 0.f, 0.f, 0.f};
#pragma unroll
                for (int ai = 0; ai < 2; ++ai)
#pragma unroll
                    for (int m = 0; m < 4; ++m) acc[ai][bj][m][n] += bv; }
        f32x4 pre[4][2][2];
#pragma unroll
        for (int m = 0; m < 4; ++m) { const size_t off = (size_t)(u.pm * BM + wr * 64 + m * 16 + fr) * ldc + col0;
#pragma unroll
            for (int bj = 0; bj < 2; ++bj)
#pragma unroll
                for (int n = 0; n < 2; ++n) pre[m][bj][n] = *(const f32x4*)(base + off + bj * HALF + n * 16); }
        const bool bad = st.run(acc, u, wr, wc, fr, fq, lds, wid, lane) || poison != 0u;
        const float qnan = __builtin_nanf("");
#pragma unroll
        for (int ai = 0; ai < 2; ++ai)
#pragma unroll
            for (int m = 0; m < 4; ++m) { const int r = ai * HALF + wr * 64 + m * 16 + fr; const f32x2v sr = S[r]; const size_t off = (size_t)(u.pm * BM + r) * ldc + col0;
#pragma unroll
                for (int bj = 0; bj < 2; ++bj)
#pragma unroll
                    for (int n = 0; n < 2; ++n) { const f32x4 bs = ai == 0 ? pre[m][bj][n] : *(const f32x4*)(base + off + bj * HALF + n * 16); f32x4 o = bs + (acc[ai][bj][m][n] - sr.x) * sr.y;
                        if (bad) o = (f32x4){qnan, qnan, qnan, qnan}; *(f32x4*)(out + off + bj * HALF + n * 16) = o; }
                if (m & 1) asm volatile("" ::: "memory"); }
    }
};
struct EpiLnResLn {
    static constexpr bool PERM = false, AFTER_DRAIN = true;
    const float* base; float* out; bf16_t* xn; int ldc; const float* bias; PanelStats st1, st2; unsigned poison;
    __device__ __forceinline__ void fused(f32x4 (&acc)[2][2][4][2], const Unit& u, int wr, int wc, int fr, int fq, PG8_LAS unsigned char* lds, int wid, int lane) const {
        typedef float f32x2v __attribute__((ext_vector_type(2))); typedef unsigned u32x2v __attribute__((ext_vector_type(2)));
        const PG8_LAS f32x2v* S = (const PG8_LAS f32x2v*)(lds + 8192);
        const int col0 = u.pn * BM + wc * 32 + 4 * fq;
#pragma unroll
        for (int bj = 0; bj < 2; ++bj)
#pragma unroll
            for (int n = 0; n < 2; ++n) { const f32x4 bv = bias ? *(const f32x4*)(bias + col0 + bj * HALF + n * 16) : (f32x4){0.f, 0.f, 0.f, 0.f};
#pragma unroll
                for (int ai = 0; ai < 2; ++ai)
#pragma unroll
                    for (int m = 0; m < 4; ++m) acc[ai][bj][m][n] += bv; }
        bool bad = st1.run(acc, u, wr, wc, fr, fq, lds, wid, lane) || poison != 0u;
        const float qnan = __builtin_nanf("");
#pragma unroll
        for (int ai = 0; ai < 2; ++ai)
#pragma unroll
            for (int m = 0; m < 4; ++m) { const int r = ai * HALF + wr * 64 + m * 16 + fr; const f32x2v sr = S[r]; const size_t off = (size_t)(u.pm * BM + r) * ldc + col0;
#pragma unroll
                for (int bj = 0; bj < 2; ++bj)
#pragma unroll
                    for (int n = 0; n < 2; ++n) { const f32x4 bs = *(const f32x4*)(base + off + bj * HALF + n * 16); acc[ai][bj][m][n] = bs + (acc[ai][bj][m][n] - sr.x) * sr.y; }
                asm volatile("" : "+v"(acc[ai][0][m][0]), "+v"(acc[ai][0][m][1]), "+v"(acc[ai][1][m][0]), "+v"(acc[ai][1][m][1]));
                if (m & 1) asm volatile("" ::: "memory"); }
        const bool bad1 = bad;
        bad = st2.run(acc, u, wr, wc, fr, fq, lds, wid, lane) || bad;
#pragma unroll
        for (int ai = 0; ai < 2; ++ai)
#pragma unroll
            for (int m = 0; m < 4; ++m) { const int r = ai * HALF + wr * 64 + m * 16 + fr; const f32x2v sr = S[r]; const size_t off = (size_t)(u.pm * BM + r) * ldc + col0;
#pragma unroll
                for (int bj = 0; bj < 2; ++bj)
#pragma unroll
                    for (int n = 0; n < 2; ++n) { const f32x4 x1 = acc[ai][bj][m][n]; *(f32x4*)(out + off + bj * HALF + n * 16) = bad1 ? (f32x4){qnan, qnan, qnan, qnan} : x1;
                        const f32x4 o = (x1 - sr.x) * sr.y; u32x2v w; w.x = cvt_pk_bf16(o[0], o[1]); w.y = cvt_pk_bf16(o[2], o[3]);
                        if (bad) { w.x = 0x7fc07fc0u; w.y = 0x7fc07fc0u; } *(u32x2v*)(xn + off + bj * HALF + n * 16) = w; }
                asm volatile("" ::: "memory"); }
    }
};

template <class Epi, class Sched, bool ALIGN_EPI = false, bool SP2 = false>
__device__ __forceinline__ void gemm_phase(PG8_LAS unsigned char* lds, const Gemm g, const Sched& S, const Epi& E) {
    const int tid = opaque_tid(), wid = __builtin_amdgcn_readfirstlane(tid >> 6), lane = tid & 63, wr = wid >> 2, wc = wid & 3, fr = lane & 15, fq = lane >> 4;
    const int K = g.K, nt = K / BK;
    unsigned voffA[2], voffB[2];
#pragma unroll
    for (int i = 0; i < 2; ++i) { int R, C; stage_rc(tid * 16 + i * 8192, R, C); const int Rb = Epi::PERM ? ((R & ~31) + perm32(R & 31)) : R;
        voffA[i] = (unsigned)(R * K + C) * 2u; voffB[i] = (unsigned)(Rb * K + C) * 2u; }
    const size_t kstep = (size_t)(BK * 2);
    const size_t hstep = (size_t)HALF * K * 2;
    const size_t tstep = 2 * hstep;
    const unsigned ldsw = (unsigned)wid * 1024u;
    const int aoff = lds_byte(wr * 64 + fr, fq * 8), boff = lds_byte(wc * 32 + fr, fq * 8);
#define PG8_SA(b, h) (((b) * 2 + (h)) * HTB)
#define PG8_SB(b, h) ((4 + (b) * 2 + (h)) * HTB)
#define PG8_STAGE(bufoff, gbase, voff) do { _Pragma("unroll") for (int _i = 0; _i < 2; ++_i) \
        __builtin_amdgcn_global_load_lds((const unsigned*)((const char*)(gbase) + (voff)[_i]), (PG8_LAS unsigned*)(lds + (bufoff) + ldsw + _i * 8192), 16, 0, 0); } while (0)
#define PG8_LDA(dst, b, h) do { _Pragma("unroll") for (int m = 0; m < 4; ++m) _Pragma("unroll") for (int k = 0; k < 2; ++k) dst[m][k] = *(const PG8_LAS bf16x8*)(lds + PG8_SA(b, h) + aoff + m * 2048 + k * 1024); } while (0)
#define PG8_LDB(dst, b, h) do { _Pragma("unroll") for (int n = 0; n < 2; ++n) _Pragma("unroll") for (int k = 0; k < 2; ++k) dst[n][k] = *(const PG8_LAS bf16x8*)(lds + PG8_SB(b, h) + boff + n * 2048 + k * 1024); } while (0)
#define PG8_MMA(ai, bj, At, Bt) do { __builtin_amdgcn_s_setprio(1); _Pragma("unroll") for (int m = 0; m < 4; ++m) _Pragma("unroll") for (int n = 0; n < 2; ++n) _Pragma("unroll") for (int k = 0; k < 2; ++k) \
        acc[ai][bj][m][n] = __builtin_amdgcn_mfma_f32_16x16x32_bf16(Bt[n][k], At[m][k], acc[ai][bj][m][n], 0, 0, 0); __builtin_amdgcn_s_setprio(0); } while (0)
#define PG8_WAIT_V(n) asm volatile("s_waitcnt vmcnt(" #n ")" ::: "memory")
#define PG8_WAIT_L(n) asm volatile("s_waitcnt lgkmcnt(" #n ")" ::: "memory")
#define PG8_BAR __builtin_amdgcn_s_barrier()
#define PG8_SCHED __builtin_amdgcn_sched_barrier(0)
    Unit cur, nxt; int ui = 0;
    if (!S.next(0, cur)) return;
    f32x4 acc[2][2][4][2];
#pragma unroll
    for (int a = 0; a < 2; ++a)
#pragma unroll
        for (int b = 0; b < 2; ++b)
#pragma unroll
            for (int m = 0; m < 4; ++m)
#pragma unroll
                for (int n = 0; n < 2; ++n) acc[a][b][m][n] = (f32x4){0.f, 0.f, 0.f, 0.f};
    bf16x8 At[4][2], B0[2][2], B1[2][2];
    const char* cA = (const char*)g.A + (size_t)cur.pm * tstep; const char* cB = (const char*)g.Bt + (size_t)cur.pn * tstep;
    S.a_ready(cur);
    if constexpr (SP2) {
        PG8_STAGE(PG8_SB(0, 0), cB, voffB); PG8_STAGE(PG8_SB(0, 1), cB + hstep, voffB); PG8_STAGE(PG8_SA(0, 0), cA, voffA); PG8_STAGE(PG8_SA(0, 1), cA + hstep, voffA);
        if (wr == 1) PG8_BAR;
        PG8_WAIT_V(2); PG8_BAR;
        PG8_STAGE(PG8_SB(1, 0), cB + kstep, voffB); PG8_STAGE(PG8_SA(1, 0), cA + kstep, voffA); PG8_STAGE(PG8_SB(1, 1), cB + hstep + kstep, voffB);
        PG8_WAIT_V(6); PG8_BAR;
    } else {
        PG8_STAGE(PG8_SB(0, 0), cB, voffB); PG8_STAGE(PG8_SA(0, 0), cA, voffA); PG8_STAGE(PG8_SB(0, 1), cB + hstep, voffB); PG8_STAGE(PG8_SA(0, 1), cA + hstep, voffA);
        if (wr == 1) PG8_BAR;
        PG8_WAIT_V(4); PG8_BAR;
        PG8_STAGE(PG8_SB(1, 0), cB + kstep, voffB); PG8_STAGE(PG8_SA(1, 0), cA + kstep, voffA); PG8_STAGE(PG8_SB(1, 1), cB + hstep + kstep, voffB);
        PG8_WAIT_V(6); PG8_BAR;
    }
    for (;;) {
        const bool has_next = S.next(ui + 1, nxt);
        const char* nA = has_next ? (const char*)g.A + (size_t)nxt.pm * tstep : cA; const char* nB = has_next ? (const char*)g.Bt + (size_t)nxt.pn * tstep : cB;
        for (int t = 0; t < nt; t += 2) {
            const bool last = (t == nt - 2);
            const char* a1 = cA + (size_t)(t + 1) * kstep;
            const char* a2 = last ? nA : cA + (size_t)(t + 2) * kstep; const char* b2 = last ? nB : cB + (size_t)(t + 2) * kstep;
            const char* a3 = a2 + kstep; const char* b3 = b2 + kstep;
            if (last && has_next) S.a_ready(nxt);
            if constexpr (SP2) {
            PG8_LDB(B0, 0, 0); PG8_LDB(B1, 0, 1); PG8_SCHED; PG8_LDA(At, 0, 0); PG8_STAGE(PG8_SA(1, 1), a1 + hstep, voffA);
            PG8_WAIT_V(8); PG8_WAIT_L(0); PG8_BAR; PG8_MMA(0, 0, At, B0); PG8_MMA(0, 1, At, B1); PG8_BAR; PG8_SCHED;
            PG8_LDA(At, 0, 1); PG8_STAGE(PG8_SB(0, 0), b2, voffB); PG8_STAGE(PG8_SB(0, 1), b2 + hstep, voffB); PG8_STAGE(PG8_SA(0, 0), a2, voffA);
            PG8_WAIT_V(8); PG8_WAIT_L(0); PG8_BAR; PG8_MMA(1, 0, At, B0); PG8_MMA(1, 1, At, B1); PG8_BAR; PG8_SCHED;
            PG8_LDB(B0, 1, 0); PG8_LDB(B1, 1, 1); PG8_SCHED; PG8_LDA(At, 1, 0); PG8_STAGE(PG8_SA(0, 1), a2 + hstep, voffA);
            PG8_WAIT_V(8); PG8_WAIT_L(0); PG8_BAR; PG8_MMA(0, 0, At, B0); PG8_MMA(0, 1, At, B1); PG8_BAR; PG8_SCHED;
            PG8_LDA(At, 1, 1); PG8_STAGE(PG8_SB(1, 0), b3, voffB); PG8_STAGE(PG8_SB(1, 1), b3 + hstep, voffB); PG8_STAGE(PG8_SA(1, 0), a3, voffA);
            PG8_WAIT_V(8); PG8_WAIT_L(0); PG8_BAR; PG8_MMA(1, 0, At, B0); PG8_MMA(1, 1, At, B1); PG8_BAR; PG8_SCHED;
            } else {
            PG8_LDB(B0, 0, 0); PG8_SCHED; PG8_LDA(At, 0, 0); PG8_STAGE(PG8_SA(1, 1), a1 + hstep, voffA);
            PG8_WAIT_L(8); PG8_BAR; PG8_WAIT_L(0); PG8_MMA(0, 0, At, B0); PG8_BAR; PG8_SCHED;
            PG8_LDB(B1, 0, 1); PG8_STAGE(PG8_SB(0, 0), b2, voffB);
            PG8_BAR; PG8_WAIT_L(0); PG8_MMA(0, 1, At, B1); PG8_BAR;
            PG8_LDA(At, 0, 1); PG8_STAGE(PG8_SA(0, 0), a2, voffA);
            PG8_BAR; PG8_WAIT_L(0); PG8_MMA(1, 0, At, B0); PG8_BAR; PG8_SCHED;
            PG8_STAGE(PG8_SB(0, 1), b2 + hstep, voffB);
            PG8_WAIT_V(6); PG8_BAR; PG8_MMA(1, 1, At, B1); PG8_BAR;
            PG8_LDB(B0, 1, 0); PG8_SCHED; PG8_LDA(At, 1, 0); PG8_STAGE(PG8_SA(0, 1), a2 + hstep, voffA);
            PG8_WAIT_L(8); PG8_BAR; PG8_WAIT_L(0); PG8_MMA(0, 0, At, B0); PG8_BAR; PG8_SCHED;
            PG8_LDB(B1, 1, 1); PG8_STAGE(PG8_SB(1, 0), b3, voffB);
            PG8_BAR; PG8_WAIT_L(0); PG8_MMA(0, 1, At, B1); PG8_BAR;
            PG8_LDA(At, 1, 1); PG8_STAGE(PG8_SA(1, 0), a3, voffA);
            PG8_BAR; PG8_WAIT_L(0); PG8_MMA(1, 0, At, B0); PG8_BAR; PG8_SCHED;
            PG8_STAGE(PG8_SB(1, 1), b3 + hstep, voffB);
            PG8_WAIT_V(6); PG8_BAR; PG8_MMA(1, 1, At, B1); PG8_BAR;
            }
        }
        if constexpr (ALIGN_EPI) { if (wr == 0) PG8_BAR; }
        if constexpr (!Epi::AFTER_DRAIN) { E(acc, cur, wr, wc, fr, fq); S.done(cur); }
        if (!has_next) break;
#pragma unroll
        for (int a = 0; a < 2; ++a)
#pragma unroll
            for (int b = 0; b < 2; ++b)
#pragma unroll
                for (int m = 0; m < 4; ++m)
#pragma unroll
                    for (int n = 0; n < 2; ++n) acc[a][b][m][n] = (f32x4){0.f, 0.f, 0.f, 0.f};
        cur = nxt; cA = nA; cB = nB; ++ui;
        if constexpr (ALIGN_EPI) { if (wr == 1) PG8_BAR; }
    }
    PG8_WAIT_V(0);
    if constexpr (!ALIGN_EPI) { if (wr == 0) PG8_BAR; }
    PG8_BAR;
    if constexpr (Epi::AFTER_DRAIN) { E.fused(acc, cur, wr, wc, fr, fq, lds, wid, lane); S.done(cur); }
#undef PG8_SA
#undef PG8_SB
#undef PG8_STAGE
#undef PG8_LDA
#undef PG8_LDB
#undef PG8_MMA
#undef PG8_WAIT_V
#undef PG8_WAIT_L
#undef PG8_BAR
#undef PG8_SCHED
}
}

#ifndef PG8_SP2
#define PG8_SP2 true
#endif
#ifndef PG8_ALIGN
#define PG8_ALIGN true
#endif
namespace pg8 {
constexpr int OUT_KP = 17301504, OUT_VP = 34078720, OUT_KS = 51122176, OUT_VS = 51646464;
__device__ __forceinline__ float row_rstd(const float* ssq, int row) {
    const f32x4* p = (const f32x4*)(ssq + (size_t)row * 16);
    const f32x4 a = p[0], b = p[1], c = p[2], d = p[3];
    const float s = (((a[0] + a[1]) + (a[2] + a[3])) + ((b[0] + b[1]) + (b[2] + b[3]))) + (((c[0] + c[1]) + (c[2] + c[3])) + ((d[0] + d[1]) + (d[2] + d[3])));
    return 1.0f / sqrtf(s * (1.0f / 1024.0f) + 1e-6f);
}
template <int ACT, bool KVF32> struct EpiAct {
    static constexpr bool PERM = true, AFTER_DRAIN = false;
    bf16_t* O; int ldc; const float* ssq; int split_cols; size_t split_stride; float* fout;
    __device__ __forceinline__ void operator()(const f32x4 (&acc)[2][2][4][2], const Unit& u, int wr, int wc, int fr, int fq) const {
        const int row0 = u.pm * BM + wr * 64 + fr; int colt = u.pn * BM; bf16_t* base = O; int t = 0;
        if (split_cols) { t = colt / split_cols; base += (size_t)t * split_stride; colt -= t * split_cols; }
        const int col0 = colt + wc * 32 + 8 * fq;
        float* fb = nullptr;
        if (KVF32) { if (t < 2) fb = fout + ((u.pm < 64) ? (size_t)(t == 0 ? OUT_KP : OUT_VP) : (size_t)(t == 0 ? OUT_KS : OUT_VS) - (size_t)16384 * 1024) + col0; }
#pragma unroll
        for (int ai = 0; ai < 2; ++ai)
#pragma unroll
            for (int m = 0; m < 4; ++m) { const int row = row0 + ai * HALF + m * 16; const float rs = row_rstd(ssq, row);
                bf16_t* rowp = base + (size_t)row * ldc + col0;
#pragma unroll
                for (int bj = 0; bj < 2; ++bj) { f32x4 v0 = acc[ai][bj][m][0] * rs, v1 = acc[ai][bj][m][1] * rs;
                    if (ACT == 1) {
#pragma unroll
                        for (int e = 0; e < 4; ++e) { const float a = fmaxf(v0[e], 0.f), b = fmaxf(v1[e], 0.f); v0[e] = a * a; v1[e] = b * b; } }
                    if (KVF32) { if (fb) { float* fr_ = fb + (size_t)row * 1024 + bj * HALF; *(f32x4*)fr_ = v0; *(f32x4*)(fr_ + 4) = v1; } }
                    u32x4 w; w.x = cvt_pk_bf16(v0[0], v0[1]); w.y = cvt_pk_bf16(v0[2], v0[3]); w.z = cvt_pk_bf16(v1[0], v1[1]); w.w = cvt_pk_bf16(v1[2], v1[3]);
                    *(u32x4*)(rowp + bj * HALF) = w; }
                asm volatile("" ::: "memory"); }
    }
};
struct EpiResid {
    static constexpr bool PERM = true, AFTER_DRAIN = false;
    float* X; bf16_t* XB; float* ssq;
    __device__ __forceinline__ void operator()(const f32x4 (&acc)[2][2][4][2], const Unit& u, int wr, int wc, int fr, int fq) const {
        const int row0 = u.pm * BM + wr * 64 + fr; const int col0 = u.pn * BM + wc * 32 + 8 * fq;
#pragma unroll
        for (int ai = 0; ai < 2; ++ai)
#pragma unroll
            for (int m = 0; m < 4; ++m) { const int row = row0 + ai * HALF + m * 16; float* xp = X + (size_t)row * 1024 + col0; bf16_t* bp = XB + (size_t)row * 1024 + col0; float q = 0.f;
#pragma unroll
                for (int bj = 0; bj < 2; ++bj) { f32x4 a0 = *(const f32x4*)(xp + bj * HALF), a1 = *(const f32x4*)(xp + bj * HALF + 4);
                    a0 += acc[ai][bj][m][0]; a1 += acc[ai][bj][m][1];
                    *(f32x4*)(xp + bj * HALF) = a0; *(f32x4*)(xp + bj * HALF + 4) = a1;
                    q += ((a0[0] * a0[0] + a0[1] * a0[1]) + (a0[2] * a0[2] + a0[3] * a0[3])) + ((a1[0] * a1[0] + a1[1] * a1[1]) + (a1[2] * a1[2] + a1[3] * a1[3]));
                    u32x4 w; w.x = cvt_pk_bf16(a0[0], a0[1]); w.y = cvt_pk_bf16(a0[2], a0[3]); w.z = cvt_pk_bf16(a1[0], a1[1]); w.w = cvt_pk_bf16(a1[2], a1[3]);
                    *(u32x4*)(bp + bj * HALF) = w; }
                q += __shfl_xor(q, 16); q += __shfl_xor(q, 32);
                if (fq == 0) ssq[(size_t)row * 16 + u.pn * 4 + wc] = q;
                asm volatile("" ::: "memory"); }
    }
};
}
#include <hip/hip_bf16.h>
#include <cmath>
namespace attn_body {
using bf16=__hip_bfloat16;
using bf16x8=__attribute__((ext_vector_type(8)))short;
using s16x4=__attribute__((ext_vector_type(4)))short;
using f32x16=__attribute__((ext_vector_type(16)))float;
using u32x4=__attribute__((ext_vector_type(4)))unsigned;
constexpr int BATCH=1,NHEAD=16,SEQ=16384,D=64,DM=NHEAD*D;
constexpr int NW=8,QBLK=32,QB=QBLK*NW,KVBLK=64,NQB=SEQ/QB;
constexpr int ATTN_PITCH=DM, ATTN_UNIT_ROWS=QB;
__device__ __forceinline__ int crow(int r,int hi){return (r&3)+8*(r>>2)+4*hi;}
#define SBAR() __builtin_amdgcn_sched_barrier(0)
__device__ __forceinline__ void cmask(f32x16&p0,f32x16&p1,int jb,int qrel,int hi){
  const float NEG=-INFINITY; int kb=64*jb+4*hi;
  #pragma unroll
  for(int r=0;r<16;++r){int kv=kb+(r&3)+8*(r>>2); if(kv>qrel)p0[r]=NEG; if(kv+32>qrel)p1[r]=NEG;}
}

constexpr int NSLOT=3, SLOTB=8192;
constexpr int LDS_K=0, LDS_V=NSLOT*SLOTB, LDS_WS=2*NSLOT*SLOTB, LDS_OST=LDS_WS+NW*64*4, LDS_CK=LDS_OST+NW*4096, LDS_BYTES=LDS_CK+SEQ*4;
constexpr float C2=0.125f*1.4426950408889634f;
__device__ __forceinline__ void glds16(const void*gsrc,unsigned lds_dst){unsigned keep;
  asm volatile("s_mov_b32 %0, m0\n\ts_mov_b32 m0, %2\n\ts_nop 0\n\tglobal_load_lds_dwordx4 %1, off\n\ts_mov_b32 m0, %0":"=&s"(keep):"v"(gsrc),"s"(lds_dst):"memory");}
__device__ __forceinline__ float max3f(float a,float b,float c){float r;asm("v_max3_f32 %0, %1, %2, %3":"=v"(r):"v"(a),"v"(b),"v"(c));return r;}
__device__ __forceinline__ float max2f(float a,float b){float r;asm("v_max_f32_e32 %0, %1, %2":"=v"(r):"v"(a),"v"(b));return r;}
__device__ __forceinline__ float fadd_s(float a,float b){float r;asm("v_add_f32_e32 %0, %1, %2":"=v"(r):"v"(a),"v"(b));return r;}
__device__ __forceinline__ float fsub_s(float a,float b){float r;asm("v_sub_f32_e32 %0, %1, %2":"=v"(r):"v"(a),"v"(b));return r;}
typedef float f32x2_t __attribute__((ext_vector_type(2))); typedef __bf16 bf16x2_t __attribute__((ext_vector_type(2)));
__device__ __forceinline__ unsigned cvtpk_s(float lo,float hi){f32x2_t v={lo,hi};bf16x2_t b=__builtin_convertvector(v,bf16x2_t);return __builtin_bit_cast(unsigned,b);}
#define WAIT_BAR(N) asm volatile("s_waitcnt vmcnt(" #N ") lgkmcnt(0)\n\ts_barrier":::"memory")

__device__ __forceinline__ void qkt(f32x16&p0,f32x16&p1,const char*Kslot,const bf16x8*qr,const f32x16&negm,int r32,int hi){
  const char*kb=Kslot+hi*1024+r32*16;
  #pragma unroll
  for(int d0=0;d0<4;++d0){
    const bf16x8 b0=*reinterpret_cast<const bf16x8*>(kb+d0*2048);
    const bf16x8 b1=*reinterpret_cast<const bf16x8*>(kb+d0*2048+512);
    if(d0==0){p0=__builtin_amdgcn_mfma_f32_32x32x16_bf16(b0,qr[0],negm,0,0,0);p1=__builtin_amdgcn_mfma_f32_32x32x16_bf16(b1,qr[0],negm,0,0,0);}
    else{p0=__builtin_amdgcn_mfma_f32_32x32x16_bf16(b0,qr[d0],p0,0,0,0);p1=__builtin_amdgcn_mfma_f32_32x32x16_bf16(b1,qr[d0],p1,0,0,0);}}
}
typedef __attribute__((address_space(3))) const char* lds_cptr;
typedef short v4i16_t __attribute__((ext_vector_type(4)));
__device__ __forceinline__ void kload8(bf16x8*kf,lds_cptr kp){
  kf[0]=*(const __attribute__((address_space(3))) bf16x8*)(kp);      kf[1]=*(const __attribute__((address_space(3))) bf16x8*)(kp+512);
  kf[2]=*(const __attribute__((address_space(3))) bf16x8*)(kp+2048); kf[3]=*(const __attribute__((address_space(3))) bf16x8*)(kp+2560);
  kf[4]=*(const __attribute__((address_space(3))) bf16x8*)(kp+4096); kf[5]=*(const __attribute__((address_space(3))) bf16x8*)(kp+4608);
  kf[6]=*(const __attribute__((address_space(3))) bf16x8*)(kp+6144); kf[7]=*(const __attribute__((address_space(3))) bf16x8*)(kp+6656);
}
__device__ __forceinline__ void kload2(bf16x8*kf,lds_cptr kp,int j){ kf[2*j]=*(const __attribute__((address_space(3))) bf16x8*)(kp+j*2048); kf[2*j+1]=*(const __attribute__((address_space(3))) bf16x8*)(kp+j*2048+512); }
__device__ __forceinline__ s16x4 vtr(lds_cptr p){ return __builtin_bit_cast(s16x4,__builtin_amdgcn_ds_read_tr16_b64_v4i16((__attribute__((address_space(3))) v4i16_t*)p)); }
__device__ __forceinline__ float rowmax(const f32x16&p0,const f32x16&p1){
  float a=max3f(p0[0],p0[1],p1[0]),b=max3f(p0[2],p0[3],p1[1]);a=max3f(a,p1[2],p1[3]);
  #pragma unroll
  for(int r=4;r<16;r+=4){a=max3f(a,p0[r],p0[r+1]);b=max3f(b,p0[r+2],p0[r+3]);a=max3f(a,p1[r],p1[r+1]);b=max3f(b,p1[r+2],p1[r+3]);}
  const float m=max2f(a,b);
  auto rr=__builtin_amdgcn_permlane32_swap(__float_as_uint(m),__float_as_uint(m),false,false);
  return max2f(__uint_as_float(rr[0]),__uint_as_float(rr[1]));
}
__device__ __forceinline__ void pv(f32x16*o,int vb,bf16x8 pa0,bf16x8 pa1,bf16x8 pa2,bf16x8 pa3){
  #pragma unroll
  for(int d0=0;d0<2;++d0){s16x4 lo[4],hi[4];
    #pragma unroll
    for(int ks=0;ks<4;++ks){
      asm volatile("ds_read_b64_tr_b16 %0,%1 offset:%c2":"=&v"(lo[ks]):"v"(vb),"i"(d0*4096+ks*1024):"memory");
      asm volatile("ds_read_b64_tr_b16 %0,%1 offset:%c2":"=&v"(hi[ks]):"v"(vb),"i"(d0*4096+ks*1024+512):"memory");}
    asm volatile("s_waitcnt lgkmcnt(0)":::"memory");SBAR();
    #define PK(k) (bf16x8){lo[k][0],lo[k][1],lo[k][2],lo[k][3],hi[k][0],hi[k][1],hi[k][2],hi[k][3]}
    o[d0]=__builtin_amdgcn_mfma_f32_32x32x16_bf16(pa0,PK(0),o[d0],0,0,0);
    o[d0]=__builtin_amdgcn_mfma_f32_32x32x16_bf16(pa1,PK(1),o[d0],0,0,0);
    o[d0]=__builtin_amdgcn_mfma_f32_32x32x16_bf16(pa2,PK(2),o[d0],0,0,0);
    o[d0]=__builtin_amdgcn_mfma_f32_32x32x16_bf16(pa3,PK(3),o[d0],0,0,0);
    #undef PK
  }
}

#ifndef ATTN_STORE16
#define ATTN_STORE16(p,v) (*(u32x4*)(p)=(v))
#endif
typedef float f32x4_t __attribute__((ext_vector_type(4)));
#define CKSUB(C0,C1,t) do{ const __attribute__((address_space(3))) f32x4_t* ck_=(const __attribute__((address_space(3))) f32x4_t*)(ckl+(t)*64+4*hi); \
   _Pragma("unroll") for(int g_=0;g_<4;++g_){ const f32x4_t a_=ck_[2*g_], b_=ck_[8+2*g_]; \
     _Pragma("unroll") for(int i_=0;i_<4;++i_){ C0[4*g_+i_]-=a_[i_]; C1[4*g_+i_]-=b_[i_]; } } }while(0)
template<int THRL> __device__ __forceinline__ void attn_unit(int b,int h,int qb,const bf16*Q,const bf16*__restrict__ K,const bf16*__restrict__ V,bf16*O,char*shm,const float*ckg){
  const int tid=opaque_tid(),lane=tid&63,r32=lane&31,hi=lane>>5; const int wid=__builtin_amdgcn_readfirstlane(tid>>6);
  const long rowbase=(long)b*SEQ; const int q0=qb*QB;
  const bf16*Qw=Q+(rowbase+q0+wid*QBLK)*DM+h*D;
  const bf16*Kh=K+rowbase*DM+h*D,*Vh=V+rowbase*DM+h*D;
  const unsigned lds0=(unsigned)(uintptr_t)shm;
  float*wsf=(float*)(shm+LDS_WS)+wid*64;
  __attribute__((address_space(3))) float* ckl=(__attribute__((address_space(3))) float*)((__attribute__((address_space(3))) char*)shm+LDS_CK);
  const float cqv=ckg[q0+wid*QBLK+r32];
  { const int nf4=(q0+QB)>>2; const f32x4_t* src_=(const f32x4_t*)ckg; __attribute__((address_space(3))) f32x4_t* dst_=(__attribute__((address_space(3))) f32x4_t*)ckl;
    for(int i_=tid;i_<nf4;i_+=NW*64) dst_[i_]=src_[i_]; }
  const bf16*ksrc=Kh+(long)lane*DM+wid*8;
  const bf16*vsrc=Vh+(long)(16*(wid&3)+(lane>>2))*DM+(wid>>2)*32+(lane&3)*8;
  const unsigned kdst=lds0+LDS_K+wid*1024, vdst=lds0+LDS_V+wid*1024;
  #define DMA_K(t,slot) glds16(ksrc+(long)(t)*KVBLK*DM,(unsigned)__builtin_amdgcn_readfirstlane(kdst+(slot)))
  #define DMA_V(t,slot) glds16(vsrc+(long)(t)*KVBLK*DM,(unsigned)__builtin_amdgcn_readfirstlane(vdst+(slot)))
  const int vb0=(int)(lds0+LDS_V)+((lane>>4)&1)*32+(lane&3)*8+(4*hi+((lane&15)>>2))*64;
  const char*Kbase=shm+LDS_K; bf16x8 kf[8];
  const lds_cptr shm3=(lds_cptr)shm; const lds_cptr kp0=shm3+LDS_K+hi*1024+r32*16; const lds_cptr vp0=shm3+LDS_V+((lane>>4)&1)*32+(lane&3)*8+(4*hi+((lane&15)>>2))*64;
  const int NT=(q0+QB)/KVBLK;
  DMA_K(0,0);DMA_V(0,0);DMA_K(1,SLOTB);
  bf16x8 qr[4];
  #pragma unroll
  for(int d0=0;d0<4;++d0)qr[d0]=*reinterpret_cast<const bf16x8*>(&Qw[(long)r32*DM+d0*16+hi*8]);
  float mhat=0.f,l_reg=0.f;f32x16 o[2];o[0]=f32x16{};o[1]=f32x16{};f32x16 negm;
  #pragma unroll
  for(int r=0;r<16;++r)negm[r]=cqv;
  asm volatile("":"+v"(negm));
  const int qrel=wid*QBLK+r32;
  #define CMASK(P0,P1,t) do{int jb_=(t)-(NT-4); if(jb_>=0)cmask(P0,P1,jb_,qrel,hi);}while(0)
  bool resc=false;
  #define START(P0,P1) do{ const float rm=rowmax(P0,P1); resc=false; \
    { const float dl=rm; mhat=fadd_s(mhat,dl); \
      _Pragma("unroll") for(int r=0;r<16;++r){P0[r]=fsub_s(P0[r],dl);P1[r]=fsub_s(P1[r],dl);} \
      _Pragma("unroll") for(int r=0;r<16;++r)negm[r]=cqv-mhat; asm volatile("":"+v"(negm)); } \
    _Pragma("unroll") for(int r=0;r<16;++r)P0[r]=__builtin_amdgcn_exp2f(P0[r]); }while(0)
  #define RESC() do{ if(resc){ asm volatile("s_waitcnt lgkmcnt(0)":::"memory"); \
      _Pragma("unroll") for(int d_=0;d_<2;++d_) _Pragma("unroll") for(int r=0;r<16;++r)o[d_][r]*=wsf[crow(r,hi)]; } }while(0)
  f32x16 pA0,pA1,pB0,pB1;
  int sl_prev=0,sl_cur=0,sl_next=SLOTB;
  #define ROT() do{sl_prev=sl_cur;sl_cur=sl_next;sl_next=(sl_next==(NSLOT-1)*SLOTB)?0:sl_next+SLOTB;}while(0)
  DMA_K(2,2*SLOTB);
  WAIT_BAR(3);
  qkt(pA0,pA1,Kbase,qr,negm,r32,hi);asm volatile("s_nop 15\n\ts_nop 7":"+v"(pA0),"+v"(pA1));CKSUB(pA0,pA1,0);CMASK(pA0,pA1,0);
  START(pA0,pA1);
  _Pragma("unroll") for(int r=0;r<16;++r)pA1[r]=__builtin_amdgcn_exp2f(pA1[r]);
  WAIT_BAR(0);
  DMA_K(3,0);DMA_V(1,SLOTB);
  ROT();
  kload8(kf,kp0+sl_cur);
  WAIT_BAR(2);
  s16x4 vlo[8],vhi[8]; u32x4 pw0,pw1,pw2,pw3;
  #define PKW(P,B) cvtpk_s(P[B],P[B+1])
  #define PAF(k) __builtin_bit_cast(bf16x8,pw##k)
  #define VFR(i) (bf16x8){vlo[i][0],vlo[i][1],vlo[i][2],vlo[i][3],vhi[i][0],vhi[i][1],vhi[i][2],vhi[i][3]}
  #define PIN(x) asm volatile("":"+v"(x))
  #define MX3(a,b,c) __builtin_fmaxf(__builtin_fmaxf((a),(b)),(c))
  #define GAPA(MF,A0,A1,A2,A3,W0,W1,PW) do{ MF; sacc+=A0; sacc+=A1; sacc+=A2; sacc+=A3; PIN(sacc); W0; W1; PIN(PW); SBAR(); }while(0)
  #define EX(v) __builtin_amdgcn_exp2f(v)
  #define GAPB(MF,X,B) do{ MF; X[B]=EX(X[B]); X[B+1]=EX(X[B+1]); X[B+2]=EX(X[B+2]); X[B+3]=EX(X[B+3]); PIN(X); SBAR(); }while(0)
  #define VRD(i) do{ vlo[i]=vtr(vp_+(((i)>>2)*4096+((i)&3)*1024)); vhi[i]=vtr(vp_+(((i)>>2)*4096+((i)&3)*1024+512)); }while(0)
  #define KRD(G,j) do{ if(G){ kload2(kf,kp0+sl_next,j); SBAR(); } }while(0)
  #define STEP(C0,C1,P0,P1,t,GK,GV,GL) do{ SBAR(); \
    const lds_cptr vp_=vp0+sl_prev; \
    VRD(0); SBAR(); float sacc=(P0[0]+P0[1]); \
    GAPA(C0=__builtin_amdgcn_mfma_f32_32x32x16_bf16(kf[0],qr[0],negm,0,0,0), P0[2],P0[3],P0[4],P0[5],     pw0[0]=PKW(P0,0), pw0[1]=PKW(P0,2), pw0); \
    VRD(4); SBAR(); GAPA(C1=__builtin_amdgcn_mfma_f32_32x32x16_bf16(kf[1],qr[0],negm,0,0,0), P0[6],P0[7],P0[8],P0[9],     pw0[2]=PKW(P0,4), pw0[3]=PKW(P0,6), pw0); \
    VRD(1); SBAR(); GAPA(C0=__builtin_amdgcn_mfma_f32_32x32x16_bf16(kf[2],qr[1],C0,0,0,0),   P0[10],P0[11],P0[12],P0[13], pw1[0]=PKW(P0,8), pw1[1]=PKW(P0,10), pw1); \
    VRD(5); SBAR(); GAPA(C1=__builtin_amdgcn_mfma_f32_32x32x16_bf16(kf[3],qr[1],C1,0,0,0),   P0[14],P0[15],P1[0],P1[1],   pw1[2]=PKW(P0,12),pw1[3]=PKW(P0,14), pw1); \
    VRD(2); SBAR(); GAPA(C0=__builtin_amdgcn_mfma_f32_32x32x16_bf16(kf[4],qr[2],C0,0,0,0),   P1[2],P1[3],P1[4],P1[5],     pw2[0]=PKW(P1,0), pw2[1]=PKW(P1,2), pw2); \
    VRD(6); SBAR(); GAPA(C1=__builtin_amdgcn_mfma_f32_32x32x16_bf16(kf[5],qr[2],C1,0,0,0),   P1[6],P1[7],P1[8],P1[9],     pw2[2]=PKW(P1,4), pw2[3]=PKW(P1,6), pw2); \
    VRD(3); SBAR(); GAPA(C0=__builtin_amdgcn_mfma_f32_32x32x16_bf16(kf[6],qr[3],C0,0,0,0),   P1[10],P1[11],P1[12],P1[13], pw3[0]=PKW(P1,8), pw3[1]=PKW(P1,10), pw3); \
    VRD(7); SBAR(); GAPA(C1=__builtin_amdgcn_mfma_f32_32x32x16_bf16(kf[7],qr[3],C1,0,0,0),   P1[14],P1[15],0.f,0.f,       pw3[2]=PKW(P1,12),pw3[3]=PKW(P1,14), pw3); \
    l_reg+=sacc; \
    if(GK){DMA_K((t)+3,sl_cur);} if(GV){DMA_V((t)+1,sl_next);} \
    CKSUB(C0,C1,t); CMASK(C0,C1,t); \
    { float a=MX3(C0[0],C0[1],C1[0]),b=MX3(C0[2],C0[3],C1[1]); a=MX3(a,C1[2],C1[3]); \
      _Pragma("unroll") for(int r=4;r<16;r+=4){a=MX3(a,C0[r],C0[r+1]);b=MX3(b,C0[r+2],C0[r+3]);a=MX3(a,C1[r],C1[r+1]);b=MX3(b,C1[r+2],C1[r+3]);} \
      float rm=__builtin_fmaxf(a,b); { auto rr=__builtin_amdgcn_permlane32_swap(__float_as_uint(rm),__float_as_uint(rm),false,false); rm=__builtin_fmaxf(__uint_as_float(rr[0]),__uint_as_float(rr[1])); } \
      resc=false; \
      if(__builtin_expect(__any(rm>(float)THRL),0)){ const float dl=__builtin_fmaxf(rm,0.f); mhat+=dl; \
        _Pragma("unroll") for(int r=0;r<16;++r){C0[r]-=dl;C1[r]-=dl;} \
        _Pragma("unroll") for(int r=0;r<16;++r)negm[r]=cqv-mhat; asm volatile("":"+v"(negm)); \
        const float f=__builtin_amdgcn_exp2f(-dl); l_reg*=f; if(hi==0)wsf[r32]=f; resc=true; } } \
    SBAR(); \
    GAPB(o[0]=__builtin_amdgcn_mfma_f32_32x32x16_bf16(PAF(0),VFR(0),o[0],0,0,0), C0,0); \
    GAPB(o[1]=__builtin_amdgcn_mfma_f32_32x32x16_bf16(PAF(0),VFR(4),o[1],0,0,0), C0,4); \
    KRD(GL,0); GAPB(o[0]=__builtin_amdgcn_mfma_f32_32x32x16_bf16(PAF(1),VFR(1),o[0],0,0,0), C0,8); \
    KRD(GL,1); GAPB(o[1]=__builtin_amdgcn_mfma_f32_32x32x16_bf16(PAF(1),VFR(5),o[1],0,0,0), C0,12); \
    KRD(GL,2); GAPB(o[0]=__builtin_amdgcn_mfma_f32_32x32x16_bf16(PAF(2),VFR(2),o[0],0,0,0), C1,0); \
    KRD(GL,3); GAPB(o[1]=__builtin_amdgcn_mfma_f32_32x32x16_bf16(PAF(2),VFR(6),o[1],0,0,0), C1,4); \
    GAPB(o[0]=__builtin_amdgcn_mfma_f32_32x32x16_bf16(PAF(3),VFR(3),o[0],0,0,0), C1,8); \
    GAPB(o[1]=__builtin_amdgcn_mfma_f32_32x32x16_bf16(PAF(3),VFR(7),o[1],0,0,0), C1,12); \
    }while(0)
  int t=1;
  #undef CMASK
  #define CMASK(P0,P1,t) do{}while(0)
  for(;t+5<NT;t+=2){
    STEP(pB0,pB1,pA0,pA1,t,true,true,true);     WAIT_BAR(2); RESC(); ROT();
    STEP(pA0,pA1,pB0,pB1,t+1,true,true,true);   WAIT_BAR(2); RESC(); ROT();
  }
  #undef CMASK
  #define CMASK(P0,P1,t) do{int jb_=(t)-(NT-4); if(jb_>=0)cmask(P0,P1,jb_,qrel,hi);}while(0)
  #define ENDW(tt) do{ if((tt)+3<NT){WAIT_BAR(2);} else if((tt)+2<NT){WAIT_BAR(1);} else {WAIT_BAR(0);} }while(0)
  for(;t+1<NT;t+=2){
    STEP(pB0,pB1,pA0,pA1,t,(t+3<NT),(t+1<NT),(t+1<NT));       ENDW(t);   RESC(); ROT();
    STEP(pA0,pA1,pB0,pB1,t+1,(t+4<NT),(t+2<NT),(t+2<NT));     ENDW(t+1); RESC(); ROT();
  }
  STEP(pB0,pB1,pA0,pA1,NT-1,false,false,false); RESC();
  { float sacc=pB0[0]+pB0[1]; _Pragma("unroll") for(int r=2;r<16;++r)sacc+=pB0[r]; _Pragma("unroll") for(int r=0;r<16;++r)sacc+=pB1[r]; l_reg+=sacc;
    pw0=(u32x4){PKW(pB0,0),PKW(pB0,2),PKW(pB0,4),PKW(pB0,6)};pw1=(u32x4){PKW(pB0,8),PKW(pB0,10),PKW(pB0,12),PKW(pB0,14)};pw2=(u32x4){PKW(pB1,0),PKW(pB1,2),PKW(pB1,4),PKW(pB1,6)};pw3=(u32x4){PKW(pB1,8),PKW(pB1,10),PKW(pB1,12),PKW(pB1,14)};
    SBAR(); pv(o,vb0+sl_cur,PAF(0),PAF(1),PAF(2),PAF(3)); }
  #undef PKW
  #undef PAF
  #undef VFR
  #undef PIN
  #undef MX3
  #undef GAPA
  #undef GAPB
  #undef EX
  #undef VRD
  #undef KRD
  #undef STEP
  #undef ENDW
  {auto rr=__builtin_amdgcn_permlane32_swap(__float_as_uint(l_reg),__float_as_uint(l_reg),false,false);l_reg=__uint_as_float(rr[0])+__uint_as_float(rr[1]);}
  if(hi==0)wsf[32+r32]=l_reg;asm volatile("s_waitcnt lgkmcnt(0)":::"memory");
  float rli[16];
  #pragma unroll
  for(int r=0;r<16;++r)rli[r]=__builtin_amdgcn_rcpf(wsf[32+crow(r,hi)]);
  bf16*Ow=O+(rowbase+q0+wid*QBLK)*DM+h*D;
  { bf16*stg=(bf16*)(shm+LDS_OST)+wid*2048;
    #pragma unroll
    for(int r=0;r<16;++r){const int orow=crow(r,hi);
      #pragma unroll
      for(int d0=0;d0<2;++d0)stg[orow*64+d0*32+r32]=__float2bfloat16(o[d0][r]*rli[r]);}
    asm volatile("s_waitcnt lgkmcnt(0)":::"memory");
    #pragma unroll
    for(int i=0;i<4;++i){const int row=i*8+(lane>>3),ch=lane&7; const u32x4 v=*(const u32x4*)(stg+row*64+ch*8); ATTN_STORE16(Ow+(long)row*DM+ch*8,v);} }
  asm volatile("s_waitcnt lgkmcnt(0)\n\ts_barrier":::"memory");
  #undef DMA_K
  #undef DMA_V
  #undef CMASK
  #undef START
  #undef RESC
  #undef ROT
}
constexpr int ATTN_LDS_BYTES=LDS_BYTES;
struct AttnTensors { const bf16* Q; const bf16* K; const bf16* V; bf16* O; const float* CL; };
struct AttnUnit { int bh; int qb; };
struct StaticOrder {
  int vcu;
  __device__ __forceinline__ explicit StaticOrder(int grid,int block):vcu((grid%8==0)?(block%8)*(grid/8)+block/8:block){}
  __device__ __forceinline__ bool next(int i,AttnUnit&u)const{ if(i>=4||vcu>=256)return false; const int s=vcu&15; u.bh=vcu>>4; u.qb=(i==0)?63-s:(i==1)?32+s:(i==2)?31-s:s; return true; }
};
template<class Sched,int THRL=8> __device__ __forceinline__ void attn_phase(char*lds,const AttnTensors&T,const Sched&S){
  AttnUnit u;
  for(int i=0;S.next(i,u);++i){ attn_unit<THRL>(0,u.bh,u.qb,T.Q,T.K,T.V,T.O,lds,T.CL+(size_t)u.bh*SEQ); }
}
#undef SBAR
#undef WAIT_BAR
}
namespace sattn {
#define SLAS __attribute__((address_space(3)))
typedef short bf16x8 __attribute__((ext_vector_type(8)));
typedef float f32x4 __attribute__((ext_vector_type(4)));
typedef unsigned u32x4 __attribute__((ext_vector_type(4)));
typedef unsigned u32x2 __attribute__((ext_vector_type(2)));
typedef float f32x2_t __attribute__((ext_vector_type(2))); typedef __bf16 bf16x2_t __attribute__((ext_vector_type(2)));
__device__ __forceinline__ unsigned pk(float lo, float hi) { f32x2_t v = {lo, hi}; bf16x2_t b = __builtin_convertvector(v, bf16x2_t); return __builtin_bit_cast(unsigned, b); }
__device__ __forceinline__ bf16x8 cvt8(f32x4 a, f32x4 b) { u32x4 w; w.x = pk(a[0], a[1]); w.y = pk(a[2], a[3]); w.z = pk(b[0], b[1]); w.w = pk(b[2], b[3]); return __builtin_bit_cast(bf16x8, w); }
constexpr int PAST = 2048, NEWK = 16, LKEYS = PAST + NEWK, VT_STRIDE = 80, VT_BYTES = 64 * VT_STRIDE;
constexpr int L_VT = 0, L_CO = 8 * VT_BYTES, L_CM = L_CO + 8 * 16 * 64 * 4, L_CL = L_CM + 8 * 16 * 4, L_END = L_CL + 8 * 16 * 4;
constexpr float NEG = -1.0e30f;
struct Tensors { const float* ck; const float* cv; const unsigned short* QB; const unsigned short* KB; const unsigned short* VB; unsigned short* O; const float* CLS; };
__device__ __forceinline__ void tile_tail(f32x4 (&s)[2], const bf16x8 (&vw)[4], float& m, float& l, f32x4 (&o)[4], SLAS char* vt, int r, int g) {
    float mx = fmaxf(fmaxf(fmaxf(s[0][0], s[0][1]), fmaxf(s[0][2], s[0][3])), fmaxf(fmaxf(s[1][0], s[1][1]), fmaxf(s[1][2], s[1][3])));
    mx = fmaxf(mx, __shfl_xor(mx, 16)); mx = fmaxf(mx, __shfl_xor(mx, 32));
    const float mn = fmaxf(m, mx), alpha = __builtin_amdgcn_exp2f(m - mn); m = mn;
    float ps = 0.f;
#pragma unroll
    for (int j = 0; j < 2; ++j)
#pragma unroll
        for (int e = 0; e < 4; ++e) { s[j][e] = __builtin_amdgcn_exp2f(s[j][e] - mn); ps += s[j][e]; }
    l = l * alpha + ps;
#pragma unroll
    for (int db = 0; db < 4; ++db) o[db] *= alpha;
    const bf16x8 pb = cvt8(s[0], s[1]);
#pragma unroll
    for (int dd = 0; dd < 4; ++dd) *(SLAS bf16x8*)(vt + (4 * r + dd) * VT_STRIDE + g * 16) = vw[dd];
#pragma unroll
    for (int db = 0; db < 4; ++db) { const bf16x8 va = *(const SLAS bf16x8*)(vt + (16 * db + r) * VT_STRIDE + g * 16); o[db] = __builtin_amdgcn_mfma_f32_16x16x32_bf16(va, pb, o[db], 0, 0, 0); }
}
__device__ __forceinline__ void unit(int b, int h, const Tensors& T, SLAS char* lds) {
    const int tid = opaque_tid(), lane = tid & 63, r = lane & 15, g = lane >> 4; const int wid = __builtin_amdgcn_readfirstlane(tid >> 6);
    SLAS char* vt = lds + L_VT + wid * VT_BYTES;
    const size_t srow = (size_t)16384 + (size_t)b * 16;
    const float* cls = T.CLS + (size_t)(b * 16 + h) * LKEYS;
    const unsigned short* qp = T.QB + (srow + r) * 1024 + h * 64 + 8 * g;
    const bf16x8 qf0 = *(const bf16x8*)qp, qf1 = *(const bf16x8*)(qp + 32);
    const float cq = cls[PAST + r];
    float m = NEG, l = 0.f; f32x4 o[4];
#pragma unroll
    for (int db = 0; db < 4; ++db) o[db] = (f32x4){0.f, 0.f, 0.f, 0.f};
    const float* kc = T.ck + ((size_t)b * PAST * 16 + h) * 64; const float* vc = T.cv + ((size_t)b * PAST * 16 + h) * 64;
    for (int tI = 0; tI < 8; ++tI) {
        const int k0 = wid * 256 + tI * 32;
        bf16x8 ka[2][2];
#pragma unroll
        for (int j = 0; j < 2; ++j)
#pragma unroll
            for (int dh = 0; dh < 2; ++dh) { const float* p = kc + (size_t)(k0 + 16 * j + r) * 1024 + dh * 32 + 8 * g; ka[j][dh] = cvt8(*(const f32x4*)p, *(const f32x4*)(p + 4)); }
        f32x4 vv[2][4];
#pragma unroll
        for (int j = 0; j < 2; ++j)
#pragma unroll
            for (int e = 0; e < 4; ++e) vv[j][e] = *(const f32x4*)(vc + (size_t)(k0 + 16 * j + 4 * g + e) * 1024 + 4 * r);
        f32x4 ckv[2];
#pragma unroll
        for (int j = 0; j < 2; ++j) ckv[j] = *(const f32x4*)(cls + k0 + 16 * j + 4 * g);
        f32x4 s[2];
#pragma unroll
        for (int j = 0; j < 2; ++j) { s[j] = __builtin_amdgcn_mfma_f32_16x16x32_bf16(ka[j][0], qf0, (f32x4){0.f, 0.f, 0.f, 0.f}, 0, 0, 0); s[j] = __builtin_amdgcn_mfma_f32_16x16x32_bf16(ka[j][1], qf1, s[j], 0, 0, 0); }
#pragma unroll
        for (int j = 0; j < 2; ++j)
#pragma unroll
            for (int e = 0; e < 4; ++e) s[j][e] += cq - ckv[j][e];
        bf16x8 vw[4];
#pragma unroll
        for (int dd = 0; dd < 4; ++dd) { u32x4 w; w.x = pk(vv[0][0][dd], vv[0][1][dd]); w.y = pk(vv[0][2][dd], vv[0][3][dd]); w.z = pk(vv[1][0][dd], vv[1][1][dd]); w.w = pk(vv[1][2][dd], vv[1][3][dd]); vw[dd] = __builtin_bit_cast(bf16x8, w); }
        tile_tail(s, vw, m, l, o, vt, r, g);
    }
    if (wid == 0) {
        bf16x8 ka[2]; { const unsigned short* p = T.KB + (srow + r) * 1024 + h * 64 + 8 * g; ka[0] = *(const bf16x8*)p; ka[1] = *(const bf16x8*)(p + 32); }
        const f32x4 ckv = *(const f32x4*)(cls + PAST + 4 * g);
        f32x4 s[2];
        s[0] = __builtin_amdgcn_mfma_f32_16x16x32_bf16(ka[0], qf0, (f32x4){0.f, 0.f, 0.f, 0.f}, 0, 0, 0); s[0] = __builtin_amdgcn_mfma_f32_16x16x32_bf16(ka[1], qf1, s[0], 0, 0, 0);
#pragma unroll
        for (int e = 0; e < 4; ++e) { s[0][e] += cq - ckv[e]; if (4 * g + e > r) s[0][e] = NEG; s[1][e] = NEG; }
        unsigned short ve[4][4];
#pragma unroll
        for (int e = 0; e < 4; ++e) { const u32x2 w = *(const u32x2*)(T.VB + (srow + 4 * g + e) * 1024 + h * 64 + 4 * r); ve[e][0] = (unsigned short)(w.x & 0xffffu); ve[e][1] = (unsigned short)(w.x >> 16); ve[e][2] = (unsigned short)(w.y & 0xffffu); ve[e][3] = (unsigned short)(w.y >> 16); }
        bf16x8 vw[4];
#pragma unroll
        for (int dd = 0; dd < 4; ++dd) { u32x4 w; w.x = (unsigned)ve[0][dd] | ((unsigned)ve[1][dd] << 16); w.y = (unsigned)ve[2][dd] | ((unsigned)ve[3][dd] << 16); w.z = 0u; w.w = 0u; vw[dd] = __builtin_bit_cast(bf16x8, w); }
        tile_tail(s, vw, m, l, o, vt, r, g);
    }
    l += __shfl_xor(l, 16); l += __shfl_xor(l, 32);
    SLAS float* co = (SLAS float*)(lds + L_CO) + (wid * 16 + r) * 64; SLAS float* cm = (SLAS float*)(lds + L_CM); SLAS float* cl = (SLAS float*)(lds + L_CL);
#pragma unroll
    for (int db = 0; db < 4; ++db) *(SLAS f32x4*)(co + 16 * db + 4 * g) = o[db];
    if (g == 0) { cm[wid * 16 + r] = m; cl[wid * 16 + r] = l; }
    __syncthreads();
    { const int q = tid >> 5, d2 = (tid & 31) * 2; float mm = NEG;
#pragma unroll
      for (int w = 0; w < 8; ++w) mm = fmaxf(mm, cm[w * 16 + q]);
      float den = 0.f, n0 = 0.f, n1 = 0.f;
#pragma unroll
      for (int w = 0; w < 8; ++w) { const float f = __builtin_amdgcn_exp2f(cm[w * 16 + q] - mm); den += f * cl[w * 16 + q]; const SLAS float* c = (const SLAS float*)(lds + L_CO) + (w * 16 + q) * 64 + d2; n0 += f * c[0]; n1 += f * c[1]; }
      const float inv = 1.0f / den;
      *(unsigned*)(T.O + (srow + q) * 1024 + h * 64 + d2) = pk(n0 * inv, n1 * inv); }
    __syncthreads();
}
#undef SLAS
}
namespace cg = cooperative_groups;
constexpr int NWAVES = 8;
constexpr int D = 1024, H = 16, FF = 4096, MP = 16384, MS = 512, M = MP + MS, PAST = 2048, DBATCH = 32, DSEQ = 16, LKEYS = PAST + DSEQ;
constexpr float RMS_EPS = 1e-6f, L2E = 1.4426950408889634f, QSCALE = 0.125f * 1.4426950408889634f;
constexpr size_t OUT_Y = 0, OUT_KP = 17301504, OUT_VP = 34078720, OUT_LP = 50855936, OUT_CP = 51118080, OUT_KS = 51122176, OUT_VS = 51646464, OUT_LS = 52170752, OUT_CS = 52178944, OUT_END = 52310016;
static_assert(OUT_KP == (size_t)pg8::OUT_KP && OUT_VP == (size_t)pg8::OUT_VP && OUT_KS == (size_t)pg8::OUT_KS && OUT_VS == (size_t)pg8::OUT_VS, "d_out map");
constexpr size_t MiB = 1u << 20;
constexpr size_t WS_CTL = 0, CTL_ZERO_BYTES = 1 * MiB;
constexpr size_t WS_WIN = 2 * MiB, WS_WOUT = 14 * MiB, WS_WKVQ = 18 * MiB, WS_WQ1 = 24 * MiB, WS_WO = 26 * MiB, WS_WUP = 30 * MiB, WS_WDN = 62 * MiB, WS_WF = 94 * MiB;
constexpr size_t WS_X = 96 * MiB, WS_XB = 162 * MiB, WS_G = 195 * MiB, WS_KB = 228 * MiB, WS_VB = 261 * MiB, WS_QB = 294 * MiB, WS_HB = 327 * MiB, WS_SSQ = 459 * MiB, WS_CLP = 461 * MiB, WS_CLS = 462 * MiB, WS_END = 467 * MiB;
static_assert((size_t)M * D * 4 == 66 * MiB && (size_t)M * FF * 2 == 132 * MiB && (size_t)512 * LKEYS * 4 <= 5 * MiB, "d_ws map");
constexpr int CW_BAR = 4096;
constexpr int RING_OFF = 0, RING_BYTES = 131072;
constexpr int ATT_LDS = attn_body::LDS_BYTES;
constexpr int LDSCTL_OFF = (ATT_LDS > RING_BYTES ? ATT_LDS : RING_BYTES), MISC_OFF = LDSCTL_OFF + 320;
constexpr int LDS_BYTES = LDSCTL_OFF + 1024;
static_assert(LDS_BYTES <= 163840 && sattn::L_END <= RING_BYTES, "LDS map");

#define GAS __attribute__((address_space(1)))
#define LAS __attribute__((address_space(3)))
typedef unsigned short bf16;
typedef unsigned v4u __attribute__((ext_vector_type(4)));
typedef unsigned v2u __attribute__((ext_vector_type(2)));
typedef float f32x4 __attribute__((ext_vector_type(4)));
typedef short bf16x8 __attribute__((ext_vector_type(8)));
typedef GAS unsigned gu32;
#define RLX_AGENT __ATOMIC_RELAXED, __HIP_MEMORY_SCOPE_AGENT
#define LDS_WAIT() asm volatile("s_waitcnt lgkmcnt(0)" ::: "memory")
#define VM_WAIT() asm volatile("s_waitcnt vmcnt(0)" ::: "memory")
__device__ __forceinline__ unsigned pk2(float lo, float hi) { return sattn::pk(lo, hi); }
__device__ __forceinline__ float bflo(unsigned w) { return __builtin_bit_cast(float, w << 16); }
__device__ __forceinline__ float bfhi(unsigned w) { return __builtin_bit_cast(float, w & 0xffff0000u); }
#define XB_TMO      128
#define XB_XCNT(j)  (256  + 64 * (j))
#define XB_XSUB(j)  (1280 + 64 * (j))
#define XB_XGEN(j)  (2304 + 64 * (j))
#define XB_TOP      3328
#define XB_TOPGEN   3392
#define XCD_BAR_WORDS 3456
#define XB_SPIN_CAP (1u << 18)

__device__ __forceinline__ unsigned xb_ld(unsigned* p)              { return __hip_atomic_load(p, __ATOMIC_RELAXED, __HIP_MEMORY_SCOPE_AGENT); }
__device__ __forceinline__ unsigned xb_add(unsigned* p, unsigned v) { return __hip_atomic_fetch_add(p, v, __ATOMIC_RELAXED, __HIP_MEMORY_SCOPE_AGENT); }
__device__ __forceinline__ unsigned xb_xcc_id() { return (unsigned)__builtin_amdgcn_s_getreg((3 << 11) | 20) & 0xFu; }
#define XB_SPIN(cond, bar) do { unsigned _sp = 0; while (cond) { __builtin_amdgcn_s_sleep(1); \
    if ((++_sp & 255u) == 0u) { if (xb_ld(&(bar)[XB_TMO])) break; if (_sp > XB_SPIN_CAP) { atomicAdd(&(bar)[XB_TMO], 1u); break; } } } } while (0)

struct XcdBarrier {
    unsigned* bar; unsigned x;
    volatile LAS unsigned* st;
};

__device__ __forceinline__ XcdBarrier xcd_barrier_post(unsigned* bar, volatile LAS unsigned* st) {
    XcdBarrier b; b.bar = bar; b.x = xb_xcc_id(); b.st = st;
    if (threadIdx.x == 0) (void)xb_add(&bar[XB_XCNT(b.x)], 1u);
    return b;
}
__device__ __forceinline__ void xcd_barrier_complete(unsigned* bar, unsigned x, unsigned& nloc, unsigned& nx) {
    const unsigned G = gridDim.x * gridDim.y * gridDim.z;
    unsigned sum, cnt, mine, sp = 0u;
    for (;;) {
        sum = 0u; cnt = 0u; mine = 0u;
#pragma unroll
        for (unsigned j = 0; j < 16; ++j) { const unsigned c = xb_ld(&bar[XB_XCNT(j)]); sum += c; cnt += (c > 0u) ? 1u : 0u; mine = (j == x) ? c : mine; }
        if (sum == G) break;
        __builtin_amdgcn_s_sleep(1);
        if ((++sp & 255u) == 0u) { if (xb_ld(&bar[XB_TMO])) break; if (sp > XB_SPIN_CAP) { atomicAdd(&bar[XB_TMO], 1u); break; } }
    }
    nloc = mine > 0u ? mine : 1u; nx = cnt > 0u ? cnt : 1u;
}

__device__ __forceinline__ void xcd_barrier(const XcdBarrier& b) {
    asm volatile("s_waitcnt vmcnt(0)" ::: "memory");
    __syncthreads();
    if (threadIdx.x == 0) {
        unsigned* bar = b.bar;
        __builtin_amdgcn_s_waitcnt(0);
        unsigned nloc = b.st[0], nx = b.st[1];
        if (nloc == 0u) { xcd_barrier_complete(bar, b.x, nloc, nx); b.st[0] = nloc; b.st[1] = nx; }
        const unsigned old = xb_add(&bar[XB_XSUB(b.x)], 1u);
        const unsigned gen = old / nloc;
        if (old + 1u == (gen + 1u) * nloc) {
            __builtin_amdgcn_fence(__ATOMIC_RELEASE, "agent");
            asm volatile("s_waitcnt vmcnt(0)" ::: "memory");
            const unsigned og = xb_add(&bar[XB_TOP], 1u);
            const unsigned tg = og / nx;
            if (og + 1u == (tg + 1u) * nx) xb_add(&bar[XB_TOPGEN], 1u);
            else XB_SPIN(xb_ld(&bar[XB_TOPGEN]) == tg, bar);
            __builtin_amdgcn_fence(__ATOMIC_ACQUIRE, "agent");
            xb_add(&bar[XB_XGEN(b.x)], 1u);
            asm volatile("s_waitcnt vmcnt(0)" ::: "memory");
        } else {
            XB_SPIN(xb_ld(&bar[XB_XGEN(b.x)]) == gen, bar);
            __builtin_amdgcn_fence(__ATOMIC_ACQUIRE, "agent");
            asm volatile("s_waitcnt vmcnt(0)" ::: "memory");
        }
    }
    __syncthreads();
}
struct Args { const float* in[21]; float* out; unsigned char* ws; };
typedef const __attribute__((address_space(4))) Args* KArgs;
__device__ __forceinline__ KArgs kargs() { KArgs p = (KArgs)__builtin_amdgcn_kernarg_segment_ptr(); asm volatile("" : "+s"(p)); return p; }
struct Frame {
    LAS unsigned char* lds; volatile LAS unsigned* MISC; gu32* ctl;
    int tid, lane, wave, vcu, G;
};
__device__ __forceinline__ float wave_sum(float v) {
#pragma unroll
    for (int o = 1; o < 64; o <<= 1) v += __shfl_xor(v, o);
    return v;
}
__device__ __forceinline__ void p0_transpose_item(const float* W, int K, int N, bf16* WT, int row_off, LAS float* scr, int item, int lane, const float* gain, float scale) {
    const int nblk = N / 32, kb = item / nblk, nb = item % nblk, k0 = 64 * kb, n0 = 32 * nb;
#pragma unroll 8
    for (int i = 0; i < 32; ++i) { const int kk = 2 * i + (lane >> 5); const float gsc = gain ? gain[k0 + kk] * scale : scale; scr[kk * 33 + (lane & 31)] = W[(size_t)(k0 + kk) * N + n0 + (lane & 31)] * gsc; }
    LDS_WAIT(); asm volatile("" ::: "memory");
    const int c = lane & 7;
#pragma unroll
    for (int j = 0; j < 4; ++j) { const int n = (lane >> 3) + 8 * j; const LAS float* s = scr + (8 * c) * 33 + n;
        v4u o; o.x = pk2(s[0 * 33], s[1 * 33]); o.y = pk2(s[2 * 33], s[3 * 33]); o.z = pk2(s[4 * 33], s[5 * 33]); o.w = pk2(s[6 * 33], s[7 * 33]);
        *(GAS v4u*)(WT + (size_t)(row_off + n0 + n) * K + k0 + 8 * c) = o; }
    LDS_WAIT(); asm volatile("" ::: "memory");
}
enum { I_XP = 0, I_XS, I_CK, I_CV, I_CLF, I_SC, I_NMIX, I_NMLP, I_CIN, I_CW, I_COUT, I_NKV, I_WK, I_WV, I_WF, I_BF, I_WQ, I_WO, I_UP, I_DN, I_NF };

__device__ __forceinline__ void p0_prologue(const Frame& F, KArgs a, unsigned char* ws) {
    LAS float* scr = (LAS float*)(F.lds + RING_OFF + F.wave * 16384);
    const int gw = F.vcu * NWAVES + F.wave, NGW = F.G * NWAVES;
    constexpr int NCHUNK = 46;
    for (int it = gw; it < NCHUNK * 512; it += NGW) {
        int c = it >> 9, base = 0; const float* src = nullptr; const float* gain = nullptr; bf16* dst = nullptr; int roff = 0, K = D, N = D; float sc = 1.f;
        if (c < 6) { const int l = c / 3; src = a->in[I_CIN] + (size_t)l * D * 3 * D; gain = a->in[I_NMIX] + l * D; dst = (bf16*)(ws + WS_WIN) + (size_t)l * 3 * D * D; N = 3 * D; base = l * 3; }
        else if (c < 8) { const int l = c - 6; src = a->in[I_COUT] + (size_t)l * D * D; dst = (bf16*)(ws + WS_WOUT) + (size_t)l * D * D; base = c; }
        else if (c < 9) { src = a->in[I_WK]; gain = a->in[I_NKV]; dst = (bf16*)(ws + WS_WKVQ); base = c; }
        else if (c < 10) { src = a->in[I_WV]; gain = a->in[I_NKV]; dst = (bf16*)(ws + WS_WKVQ); roff = D; base = c; }
        else if (c < 11) { src = a->in[I_WQ]; gain = a->in[I_NMIX] + 2 * D; dst = (bf16*)(ws + WS_WKVQ); roff = 2 * D; sc = QSCALE; base = c; }
        else if (c < 12) { src = a->in[I_WQ] + (size_t)D * D; gain = a->in[I_NMIX] + 3 * D; dst = (bf16*)(ws + WS_WQ1); sc = QSCALE; base = c; }
        else if (c < 14) { const int j = c - 12; src = a->in[I_WO] + (size_t)j * D * D; dst = (bf16*)(ws + WS_WO) + (size_t)j * D * D; base = c; }
        else if (c < 30) { const int l = (c - 14) >> 2; src = a->in[I_UP] + (size_t)l * D * FF; gain = a->in[I_NMLP] + l * D; dst = (bf16*)(ws + WS_WUP) + (size_t)l * D * FF; N = FF; base = 14 + 4 * l; }
        else { const int l = (c - 30) >> 2; src = a->in[I_DN] + (size_t)l * D * FF; dst = (bf16*)(ws + WS_WDN) + (size_t)l * D * FF; K = FF; base = 30 + 4 * l; }
        p0_transpose_item(src, K, N, dst, roff, scr, it - base * 512, F.lane, gain, sc);
    }
    for (int i = (F.vcu * NWAVES + F.wave) * 64 + F.lane; i < D * H; i += NGW * 64) { const int k = i >> 4, h = i & 15; ((bf16*)(ws + WS_WF))[h * D + k] = (bf16)(pk2(a->in[I_NKV][k] * a->in[I_WF][i], 0.f) & 0xffffu); }
    float* X = (float*)(ws + WS_X); bf16* XB = (bf16*)(ws + WS_XB); float* SSQ = (float*)(ws + WS_SSQ);
    for (int m = gw; m < M; m += NGW) {
        const float* xr = (m < MP) ? a->in[I_XP] + (size_t)m * D : a->in[I_XS] + (size_t)(m - MP) * D;
        const GAS f32x4* xp = (const GAS f32x4*)xr + F.lane; f32x4 v[4]; float s = 0.f;
#pragma unroll
        for (int j = 0; j < 4; ++j) { v[j] = xp[64 * j]; s += (v[j].x * v[j].x + v[j].y * v[j].y) + (v[j].z * v[j].z + v[j].w * v[j].w); }
        s = wave_sum(s);
        GAS f32x4* xo = (GAS f32x4*)(X + (size_t)m * D) + F.lane; GAS v2u* bo = (GAS v2u*)(XB + (size_t)m * D) + F.lane;
#pragma unroll
        for (int j = 0; j < 4; ++j) { xo[64 * j] = v[j]; v2u w; w.x = pk2(v[j].x, v[j].y); w.y = pk2(v[j].z, v[j].w); bo[64 * j] = w; }
        if (F.lane < 16) SSQ[(size_t)m * 16 + F.lane] = (F.lane == 0) ? s : 0.f;
    }
}
__device__ __forceinline__ void conv_gate_phase(const Frame& F, KArgs a, unsigned char* ws, int l) {
    const int gw = F.vcu * NWAVES + F.wave, NGW = F.G * NWAVES;
    const bf16* BCX = (const bf16*)(ws + WS_HB); bf16* Gm = (bf16*)(ws + WS_G);
    const float* cw = a->in[I_CW] + (size_t)l * 3 * D;
    for (int it = gw; it < (M / 8) * 2; it += NGW) {
        const int half = it & 1, row0 = (it >> 1) * 8, c0 = half * 512 + F.lane * 8;
        float w0[8], w1[8], w2[8], um2[8], um1[8];
        { const f32x4 a0 = *(const f32x4*)(cw + c0), a1 = *(const f32x4*)(cw + c0 + 4), b0 = *(const f32x4*)(cw + D + c0), b1 = *(const f32x4*)(cw + D + c0 + 4), d0 = *(const f32x4*)(cw + 2 * D + c0), d1 = *(const f32x4*)(cw + 2 * D + c0 + 4);
#pragma unroll
          for (int e = 0; e < 4; ++e) { w0[e] = a0[e]; w0[4 + e] = a1[e]; w1[e] = b0[e]; w1[4 + e] = b1[e]; w2[e] = d0[e]; w2[4 + e] = d1[e]; } }
        const bool sample = row0 >= MP; const int sb = sample ? (row0 - MP) >> 4 : 0; const int t0 = sample ? (row0 - MP) & 15 : row0;
        if (t0 == 0) {
            if (sample) { const float* st = a->in[I_SC] + ((size_t)(l * DBATCH + sb) * 2) * D + c0;
                const f32x4 p0 = *(const f32x4*)st, p1 = *(const f32x4*)(st + 4), q0 = *(const f32x4*)(st + D), q1 = *(const f32x4*)(st + D + 4);
#pragma unroll
                for (int e = 0; e < 4; ++e) { um2[e] = p0[e]; um2[4 + e] = p1[e]; um1[e] = q0[e]; um1[4 + e] = q1[e]; } }
            else {
#pragma unroll
                for (int e = 0; e < 8; ++e) { um2[e] = 0.f; um1[e] = 0.f; } }
        } else {
#pragma unroll
            for (int k = 0; k < 2; ++k) { const bf16* rp = BCX + (size_t)(row0 - 2 + k) * 3072 + c0; const v4u gc = *(const v4u*)(rp + D), xv = *(const v4u*)(rp + 2 * D);
#pragma unroll
                for (int e = 0; e < 4; ++e) { const float u0 = bflo(gc[e]) * bflo(xv[e]), u1 = bfhi(gc[e]) * bfhi(xv[e]); if (k == 0) { um2[2 * e] = u0; um2[2 * e + 1] = u1; } else { um1[2 * e] = u0; um1[2 * e + 1] = u1; } } }
        }
#pragma unroll
        for (int i = 0; i < 8; ++i) { const bf16* rp = BCX + (size_t)(row0 + i) * 3072 + c0; const v4u gb = *(const v4u*)rp, gc = *(const v4u*)(rp + D), xv = *(const v4u*)(rp + 2 * D);
            float u[8], o[8];
#pragma unroll
            for (int e = 0; e < 4; ++e) { u[2 * e] = bflo(gc[e]) * bflo(xv[e]); u[2 * e + 1] = bfhi(gc[e]) * bfhi(xv[e]); }
#pragma unroll
            for (int e = 0; e < 8; ++e) o[e] = w0[e] * um2[e] + w1[e] * um1[e] + w2[e] * u[e];
            v4u w;
#pragma unroll
            for (int e = 0; e < 4; ++e) w[e] = pk2(bflo(gb[e]) * o[2 * e], bfhi(gb[e]) * o[2 * e + 1]);
            *(v4u*)(Gm + (size_t)(row0 + i) * D + c0) = w;
#pragma unroll
            for (int e = 0; e < 8; ++e) { um2[e] = um1[e]; um1[e] = u[e]; } }
        const bool last = sample ? (t0 == 8) : (row0 + 8 == MP);
        if (last) { float* o = a->out + (sample ? OUT_CS + ((size_t)(l * DBATCH + sb) * 2) * D : OUT_CP + (size_t)l * 2 * D) + c0;
            *(f32x4*)o = (f32x4){um2[0], um2[1], um2[2], um2[3]}; *(f32x4*)(o + 4) = (f32x4){um2[4], um2[5], um2[6], um2[7]};
            *(f32x4*)(o + D) = (f32x4){um1[0], um1[1], um1[2], um1[3]}; *(f32x4*)(o + D + 4) = (f32x4){um1[4], um1[5], um1[6], um1[7]}; }
    }
}
__device__ __forceinline__ void logf_phase(const Frame& F, KArgs a, unsigned char* ws) {
    const int gw = F.vcu * NWAVES + F.wave, NGW = F.G * NWAVES; const int r = F.lane & 15, g = F.lane >> 4;
    const bf16* WF = (const bf16*)(ws + WS_WF); const bf16* XB = (const bf16*)(ws + WS_XB); const float* SSQ = (const float*)(ws + WS_SSQ);
    for (int blk = gw; blk < M / 16; blk += NGW) {
        const int row = blk * 16 + r; f32x4 acc = (f32x4){0.f, 0.f, 0.f, 0.f};
        const bf16* ap = WF + (size_t)r * D + 8 * g; const bf16* bp = XB + (size_t)row * D + 8 * g;
#pragma unroll 8
        for (int s = 0; s < 32; ++s) acc = __builtin_amdgcn_mfma_f32_16x16x32_bf16(*(const bf16x8*)(ap + 32 * s), *(const bf16x8*)(bp + 32 * s), acc, 0, 0, 0);
        const float rs = pg8::row_rstd(SSQ, row); const f32x4 bfv = *(const f32x4*)(a->in[I_BF] + 4 * g); f32x4 o;
#pragma unroll
        for (int e = 0; e < 4; ++e) { const float z = acc[e] * rs + bfv[e]; o[e] = fminf(z, 0.f) - log1pf(expf(-fabsf(z))); }
        float* op = a->out + ((row < MP) ? OUT_LP + (size_t)row * 16 : OUT_LS + (size_t)(row - MP) * 16) + 4 * g;
        *(f32x4*)op = o;
    }
}
__device__ __forceinline__ double wave_scan_incl(double v, int lane) {
#pragma unroll
    for (int o = 1; o < 64; o <<= 1) { const double t = __shfl_up(v, o); if (lane >= o) v += t; }
    return v;
}
__device__ __forceinline__ void scan_phase(const Frame& F, KArgs a, unsigned char* ws) {
    float* CLP = (float*)(ws + WS_CLP); float* CLS = (float*)(ws + WS_CLS);
    const int blk = blockIdx.x;
    if (blk < 16) {
        const int h = blk; const float* lf = a->out + OUT_LP; const int t0 = F.tid * 32; double s = 0.0;
#pragma unroll 8
        for (int i = 0; i < 32; ++i) s += (double)lf[(size_t)(t0 + i) * 16 + h];
        const double inc = wave_scan_incl(s, F.lane);
        LAS double* wt = (LAS double*)(F.lds + RING_OFF);
        if (F.lane == 63) wt[F.wave] = inc;
        __syncthreads();
        double run = inc - s;
        for (int w = 0; w < F.wave; ++w) run += wt[w];
#pragma unroll 8
        for (int i = 0; i < 32; ++i) { run += (double)lf[(size_t)(t0 + i) * 16 + h]; CLP[(size_t)h * MP + t0 + i] = (float)(run * (double)L2E); }
        __syncthreads();
    } else {
        const int nws = (F.G - 16) * NWAVES;
        for (int seq = (blk - 16) * NWAVES + F.wave; seq < DBATCH * H; seq += nws) {
            const int b = seq >> 4, h = seq & 15; const float* clf = a->in[I_CLF] + (size_t)b * PAST * 16 + h; const float* nlf = a->out + OUT_LS + (size_t)b * DSEQ * 16 + h;
            const int s0 = F.lane * 33; double s = 0.0;
            for (int i = 0; i < 33; ++i) { const int k = s0 + i; if (k < LKEYS) s += (double)(k < PAST ? clf[(size_t)k * 16] : nlf[(size_t)(k - PAST) * 16]); }
            double run = wave_scan_incl(s, F.lane) - s;
            for (int i = 0; i < 33; ++i) { const int k = s0 + i; if (k < LKEYS) { run += (double)(k < PAST ? clf[(size_t)k * 16] : nlf[(size_t)(k - PAST) * 16]); CLS[(size_t)seq * LKEYS + k] = (float)(run * (double)L2E); } }
        }
    }
}
__device__ __forceinline__ void final_norm_phase(const Frame& F, KArgs a, unsigned char* ws) {
    const int gw = F.vcu * NWAVES + F.wave, NGW = F.G * NWAVES; const float* X = (const float*)(ws + WS_X);
    const GAS f32x4* gp = (const GAS f32x4*)a->in[I_NF] + F.lane; f32x4 gn[4];
#pragma unroll
    for (int j = 0; j < 4; ++j) gn[j] = gp[64 * j];
    for (int m = gw; m < M; m += NGW) {
        const GAS f32x4* xp = (const GAS f32x4*)(X + (size_t)m * D) + F.lane; f32x4 v[4]; float s = 0.f;
#pragma unroll
        for (int j = 0; j < 4; ++j) { v[j] = xp[64 * j]; s += (v[j].x * v[j].x + v[j].y * v[j].y) + (v[j].z * v[j].z + v[j].w * v[j].w); }
        const float rs = 1.0f / sqrtf(wave_sum(s) * (1.0f / D) + RMS_EPS);
        GAS f32x4* op = (GAS f32x4*)(a->out + OUT_Y + (size_t)m * D) + F.lane;
#pragma unroll
        for (int j = 0; j < 4; ++j) op[64 * j] = v[j] * rs * gn[j];
    }
}

__global__ void __launch_bounds__(NWAVES * 64, 2) yoco_fwd(Args args) {
    extern __shared__ __attribute__((aligned(16))) unsigned char lds[];
    Frame F;
    F.lds = (LAS unsigned char*)lds;
    F.MISC = (volatile LAS unsigned*)(F.lds + MISC_OFF);
    F.tid = threadIdx.x; F.lane = F.tid & 63; F.wave = __builtin_amdgcn_readfirstlane(F.tid >> 6);
    F.G = gridDim.x; { const int bx = blockIdx.x; F.vcu = (F.G % 8 == 0) ? (bx % 8) * (F.G / 8) + bx / 8 : bx; }
    F.ctl = (gu32*)(kargs()->ws + WS_CTL);
    for (int u = F.tid; u < (LDS_BYTES - LDSCTL_OFF) / 4; u += NWAVES * 64) ((LAS unsigned*)(F.lds + LDSCTL_OFF))[u] = 0u;
    __syncthreads();
    XcdBarrier bar = xcd_barrier_post((unsigned*)(F.ctl + CW_BAR), F.MISC + 8);
#define GRID_BAR() xcd_barrier(bar)
#define WSP(T, off) ((T*)(kargs()->ws + (off)))

    p0_prologue(F, kargs(), kargs()->ws);
    cg::this_grid().sync();
    GRID_BAR();

#define LAYER(l) do { \
        if ((l) != 2) { \
            constexpr bool cv = (l) < 2; unsigned char* ws = kargs()->ws; \
            pg8::Gemm g{(const bf16*)(ws + WS_XB), cv ? (const bf16*)(ws + WS_WIN) + (size_t)(l) * 3 * D * D : (const bf16*)(ws + WS_WQ1), M, cv ? 3 * D : D, D}; \
            pg8::StaticOrder S; S.init(M, cv ? 3 * D : D, F.G, opaque_bid()); \
            pg8::EpiAct<0, false> E{cv ? (bf16*)(ws + WS_HB) : (bf16*)(ws + WS_QB), cv ? 3 * D : D, (const float*)(ws + WS_SSQ), 0, 0, nullptr}; \
            pg8::gemm_phase<pg8::EpiAct<0, false>, pg8::StaticOrder, PG8_ALIGN, PG8_SP2>(F.lds + RING_OFF, g, S, E); \
            GRID_BAR(); \
        } \
        if ((l) < 2) { conv_gate_phase(F, kargs(), kargs()->ws, (l)); } \
        else { \
            { unsigned char* ws = kargs()->ws; \
            const attn_body::AttnTensors AT{(const attn_body::bf16*)(ws + WS_QB), (const attn_body::bf16*)(ws + WS_KB), (const attn_body::bf16*)(ws + WS_VB), (attn_body::bf16*)(ws + WS_G), (const float*)(ws + WS_CLP)}; \
            const attn_body::StaticOrder S((int)F.G, opaque_bid()); \
            attn_body::attn_phase<attn_body::StaticOrder>((char*)lds + RING_OFF, AT, S); } \
            __syncthreads(); \
            KArgs ka = kargs(); unsigned char* ws = ka->ws; \
            const sattn::Tensors ST{ka->in[I_CK], ka->in[I_CV], (const bf16*)(ws + WS_QB), (const bf16*)(ws + WS_KB), (const bf16*)(ws + WS_VB), (bf16*)(ws + WS_G), (const float*)(ws + WS_CLS)}; \
            for (int u = F.vcu; u < DBATCH * H; u += F.G) sattn::unit(u >> 4, u & 15, ST, (LAS char*)(F.lds + RING_OFF)); \
        } \
        GRID_BAR(); \
        { unsigned char* ws = kargs()->ws; \
            pg8::Gemm g{(const bf16*)(ws + WS_G), ((l) < 2) ? (const bf16*)(ws + WS_WOUT) + (size_t)(l) * D * D : (const bf16*)(ws + WS_WO) + (size_t)((l) - 2) * D * D, M, D, D}; \
            pg8::StaticOrder S; S.init(M, D, F.G, opaque_bid()); \
            pg8::EpiResid E{(float*)(ws + WS_X), (bf16*)(ws + WS_XB), (float*)(ws + WS_SSQ)}; \
            pg8::gemm_phase<pg8::EpiResid, pg8::StaticOrder, PG8_ALIGN, PG8_SP2>(F.lds + RING_OFF, g, S, E); \
            GRID_BAR(); } \
        { unsigned char* ws = kargs()->ws; \
            pg8::Gemm g{(const bf16*)(ws + WS_XB), (const bf16*)(ws + WS_WUP) + (size_t)(l) * D * FF, M, FF, D}; \
            pg8::StaticOrder S; S.init(M, FF, F.G, opaque_bid()); \
            pg8::EpiAct<1, false> E{(bf16*)(ws + WS_HB), FF, (const float*)(ws + WS_SSQ), 0, 0, nullptr}; \
            pg8::gemm_phase<pg8::EpiAct<1, false>, pg8::StaticOrder, PG8_ALIGN, PG8_SP2>(F.lds + RING_OFF, g, S, E); \
            GRID_BAR(); } \
        { unsigned char* ws = kargs()->ws; \
            pg8::Gemm g{(const bf16*)(ws + WS_HB), (const bf16*)(ws + WS_WDN) + (size_t)(l) * D * FF, M, D, FF}; \
            pg8::StaticOrder S; S.init(M, D, F.G, opaque_bid()); \
            pg8::EpiResid E{(float*)(ws + WS_X), (bf16*)(ws + WS_XB), (float*)(ws + WS_SSQ)}; \
            pg8::gemm_phase<pg8::EpiResid, pg8::StaticOrder, PG8_ALIGN, PG8_SP2>(F.lds + RING_OFF, g, S, E); \
            GRID_BAR(); } \
        if ((l) == 1) { \
            KArgs ka = kargs(); unsigned char* ws = ka->ws; \
            pg8::Gemm g{(const bf16*)(ws + WS_XB), (const bf16*)(ws + WS_WKVQ), M, 3 * D, D}; \
            pg8::StaticOrder S; S.init(M, 3 * D, F.G, opaque_bid()); \
            pg8::EpiAct<0, true> E{(bf16*)(ws + WS_KB), D, (const float*)(ws + WS_SSQ), D, (size_t)(WS_VB - WS_KB) / 2, ka->out}; \
            pg8::gemm_phase<pg8::EpiAct<0, true>, pg8::StaticOrder, PG8_ALIGN, PG8_SP2>(F.lds + RING_OFF, g, S, E); \
            logf_phase(F, kargs(), kargs()->ws); \
            GRID_BAR(); \
            scan_phase(F, kargs(), kargs()->ws); \
            GRID_BAR(); \
        } } while (0)
    LAYER(0); LAYER(1); LAYER(2); LAYER(3);
    final_norm_phase(F, kargs(), kargs()->ws);
}

extern "C" void kernel_launch(void* const* d_in, const int* in_sizes, int n_in, void* d_out, int out_size, void* d_ws, size_t ws_size, hipStream_t stream) {
    static int grid = 0;
    if (grid == 0) {
        if (n_in != 21 || out_size != (int)OUT_END || ws_size < WS_END) { fprintf(stderr, "kernel_launch: unexpected sizes (n_in %d, out %d, ws %zu); nothing launched\n", n_in, out_size, ws_size); grid = -1; return; }
        int dev = 0, cus = 0, per_cu = 0;
        if (hipGetDevice(&dev) != hipSuccess || hipDeviceGetAttribute(&cus, hipDeviceAttributeMultiprocessorCount, dev) != hipSuccess) { grid = -1; return; }
        if (hipFuncSetAttribute((const void*)yoco_fwd, hipFuncAttributeMaxDynamicSharedMemorySize, LDS_BYTES) != hipSuccess) { fprintf(stderr, "kernel_launch: hipFuncSetAttribute failed\n"); grid = -1; return; }
        if (hipOccupancyMaxActiveBlocksPerMultiprocessor(&per_cu, (const void*)yoco_fwd, NWAVES * 64, LDS_BYTES) != hipSuccess || per_cu < 1) { fprintf(stderr, "kernel_launch: occupancy query says %d\n", per_cu); per_cu = 1; }
        (void)hipGetLastError();
        grid = cus;
    }
    if (grid < 0) return;
    if (hipMemsetAsync((char*)d_ws + WS_CTL, 0, CTL_ZERO_BYTES, stream) != hipSuccess) { fprintf(stderr, "kernel_launch: memset failed\n"); return; }
    Args a{};
    for (int i = 0; i < 21; ++i) a.in[i] = (const float*)d_in[i];
    a.out = (float*)d_out; a.ws = (unsigned char*)d_ws;
    void* kargv[] = {&a};
    const hipError_t e = hipLaunchCooperativeKernel((const void*)yoco_fwd, dim3(grid), dim3(NWAVES * 64), kargv, LDS_BYTES, stream);
    if (e != hipSuccess) fprintf(stderr, "kernel_launch: cooperative launch failed: %s (grid %d)\n", hipGetErrorString(e), grid);
}
```

```cpp
#include <hip/hip_runtime.h>
#include <hip/hip_cooperative_groups.h>
#include <cstdio>
#include <cstdint>
__device__ __forceinline__ int opaque_bid() { int b = (int)blockIdx.x; asm volatile("" : "+s"(b)); return b; }
__device__ __forceinline__ int opaque_tid() { int t = (int)threadIdx.x; asm volatile("" : "+v"(t)); return t; }
namespace pg8 {
#define PG8_LAS __attribute__((address_space(3)))
typedef unsigned short bf16_t;
typedef short bf16x8 __attribute__((ext_vector_type(8)));
typedef float f32x4 __attribute__((ext_vector_type(4)));
typedef unsigned u32x4 __attribute__((ext_vector_type(4)));
constexpr int BM = 256, BK = 64, HALF = 128, HTB = HALF * BK * 2  , STAGE_BYTES = 8 * HTB, NXCD = 8, WGM = 8;

__host__ __device__ __forceinline__ int lds_byte(int r, int c) { const int st = (r >> 4) * 2 + (c >> 5), rr = r & 15, cc = c & 31, ob = rr * 64 + cc * 2; return st * 1024 + (ob ^ (((ob >> 9) & 1) << 5)); }
__host__ __device__ __forceinline__ void stage_rc(int b, int& R, int& C) { const int st = b / 1024, sb = b % 1024, swz = sb ^ (((sb >> 9) & 1) << 5); R = (st >> 1) * 16 + swz / 64; C = (st & 1) * 32 + (swz % 64) / 2; }
__host__ __device__ __forceinline__ int perm32(int rho) { const int n = rho >> 4, i = rho & 15; return 8 * (i >> 2) + 4 * n + (i & 3); }

struct Unit { int pm, pn; };
struct Gemm { const bf16_t* A; const bf16_t* Bt; int M, N, K; };

struct StaticOrder {
    int nM, nN, nwg, G, c;
    __host__ __device__ void init(int M, int N, int G_, int c_) { nM = M / BM; nN = N / BM; nwg = nM * nN; G = G_; c = c_; }
    __host__ __device__ bool next(int i, Unit& u) const {
        const long L = (long)i * G + c; if (L >= nwg) return false;
        int wgid = (int)L; { const int q = nwg / NXCD, r = nwg % NXCD, xcd = wgid % NXCD, off = wgid / NXCD; wgid = (xcd < r ? xcd * (q + 1) : r * (q + 1) + (xcd - r) * q) + off; }
        const int nig = WGM * nN, gid = wgid / nig, fm = gid * WGM, gsz = (nM - fm) < WGM ? (nM - fm) : WGM;
        u.pm = fm + ((wgid % nig) % gsz); u.pn = (wgid % nig) / gsz; return true;
    }
    __device__ __forceinline__ void a_ready(const Unit&) const {}
    __device__ __forceinline__ void done(const Unit&) const {}
};

__device__ __forceinline__ unsigned cvt_pk_bf16(float lo, float hi) { unsigned r; asm volatile("v_cvt_pk_bf16_f32 %0, %1, %2" : "=v"(r) : "v"(lo), "v"(hi)); return r; }
typedef float f32x2 __attribute__((ext_vector_type(2)));
__device__ __forceinline__ f32x2 gelu_pk(f32x2 v) {
    const f32x2 av = __builtin_elementwise_abs(v), d = av * 0.2316418882f + 1.0f;
    f32x2 t; t.x = __builtin_amdgcn_rcpf(d.x); t.y = __builtin_amdgcn_rcpf(d.y);
    f32x2 q = t * 0.5307027145f + (-0.7265760135f); q = q * t + 0.7107068705f; q = q * t + (-0.142248368f); q = q * t + 0.127414796f; q = q * t;
    const f32x2 s = (v * v) * (-0.72134752044f);
    f32x2 e; e.x = __builtin_amdgcn_exp2f(s.x); e.y = __builtin_amdgcn_exp2f(s.y);
    const f32x2 m = v * (q * e), r = v - m;
    f32x2 o; o.x = v.x < 0.f ? m.x : r.x; o.y = v.y < 0.f ? m.y : r.y; return o;
}

template <int ACT  > struct EpiBf16 {
    static constexpr bool PERM = true, AFTER_DRAIN = false; static_assert(ACT == 0 || ACT == 1, "EpiBf16: ACT is 0 (none) or 1 (gelu_pk)");
    bf16_t* O; int ldc; const float* bias; int split_cols; size_t split_stride; float scale0;
    __device__ __forceinline__ void operator()(const f32x4 (&acc)[2][2][4][2], const Unit& u, int wr, int wc, int fr, int fq) const {
        const int row0 = u.pm * BM + wr * 64 + fr; int colt = u.pn * BM; bf16_t* base = O;
        float sc = 1.f; if (split_cols) { const int t = colt / split_cols; base += (size_t)t * split_stride; colt -= t * split_cols; if (t == 0) sc = scale0; }
        const int col0 = colt + wc * 32 + 8 * fq, bcol0 = u.pn * BM + wc * 32 + 8 * fq;
        f32x4 bv[2][2];
#pragma unroll
        for (int bj = 0; bj < 2; ++bj)
#pragma unroll
            for (int n = 0; n < 2; ++n) bv[bj][n] = bias ? *(const f32x4*)(bias + bcol0 + bj * HALF + 4 * n) : (f32x4){0.f, 0.f, 0.f, 0.f};
#pragma unroll
        for (int ai = 0; ai < 2; ++ai)
#pragma unroll
            for (int m = 0; m < 4; ++m) { bf16_t* rowp = base + (size_t)(row0 + ai * HALF + m * 16) * ldc + col0;
#pragma unroll
                for (int bj = 0; bj < 2; ++bj) { f32x4 v0 = acc[ai][bj][m][0] + bv[bj][0], v1 = acc[ai][bj][m][1] + bv[bj][1];
                    if (ACT == 1) { f32x2 a = gelu_pk((f32x2){v0[0], v0[1]}), b = gelu_pk((f32x2){v0[2], v0[3]}), c = gelu_pk((f32x2){v1[0], v1[1]}), d = gelu_pk((f32x2){v1[2], v1[3]});
                        v0 = (f32x4){a.x, a.y, b.x, b.y}; v1 = (f32x4){c.x, c.y, d.x, d.y}; }
                    v0 = v0 * sc; v1 = v1 * sc; u32x4 w; w.x = cvt_pk_bf16(v0[0], v0[1]); w.y = cvt_pk_bf16(v0[2], v0[3]); w.z = cvt_pk_bf16(v1[0], v1[1]); w.w = cvt_pk_bf16(v1[2], v1[3]);
                    *(u32x4*)(rowp + bj * HALF) = w; } }
    }
};

struct PanelStats {
    unsigned* xbuf;
    unsigned* cnt;
    unsigned* tmo;
    int ntn; float eps;
    unsigned code;
    __device__ __forceinline__ bool run(const f32x4 (&v)[2][2][4][2], const Unit& u, int wr, int wc, int fr, int fq, PG8_LAS unsigned char* lds, int wid, int lane) const {
        typedef float f32x2v __attribute__((ext_vector_type(2)));
        PG8_LAS f32x2v* P = (PG8_LAS f32x2v*)lds;
        PG8_LAS f32x2v* S = (PG8_LAS f32x2v*)(lds + 8192);
        PG8_LAS unsigned* flag = (PG8_LAS unsigned*)(lds + 8192 + 2048);
#pragma unroll
        for (int ai = 0; ai < 2; ++ai)
#pragma unroll
            for (int m = 0; m < 4; ++m) {
                float s = 0.f;
#pragma unroll
                for (int bj = 0; bj < 2; ++bj)
#pragma unroll
                    for (int n = 0; n < 2; ++n) { const f32x4 x = v[ai][bj][m][n]; s += (x[0] + x[1]) + (x[2] + x[3]); }
                s += __shfl_xor(s, 16); s += __shfl_xor(s, 32);
                const float mw = s * (1.0f / 64.0f); float q = 0.f;
#pragma unroll
                for (int bj = 0; bj < 2; ++bj)
#pragma unroll
                    for (int n = 0; n < 2; ++n) { const f32x4 d = v[ai][bj][m][n] - mw; q += (d[0] * d[0] + d[1] * d[1]) + (d[2] * d[2] + d[3] * d[3]); }
                q += __shfl_xor(q, 16); q += __shfl_xor(q, 32);
                if (fq == 0) P[(ai * HALF + wr * 64 + m * 16 + fr) * 4 + wc] = (f32x2v){mw, q};
            }
        asm volatile("s_waitcnt lgkmcnt(0)" ::: "memory"); __builtin_amdgcn_s_barrier(); asm volatile("" ::: "memory");
#if defined(BROKEN_EXCHANGE_NO_WAIT)
#warning BROKEN CONTROL BUILD: the row-statistics exchange does not wait; results are wrong by design
        if (blockIdx.x >= 64) { const long long t0_ = clock64(); while (clock64() - t0_ < 60000) __builtin_amdgcn_s_sleep(8); }
#endif
        const int row = wid * 32 + (lane & 31);
        if (lane < 32) {
            const f32x2v a = P[row * 4 + 0], b = P[row * 4 + 1], c = P[row * 4 + 2], d = P[row * 4 + 3];
            const float mt = (a.x + b.x + c.x + d.x) * 0.25f;
            const float da = a.x - mt, db = b.x - mt, dc = c.x - mt, dd = d.x - mt;
            const float m2 = (a.y + b.y) + (c.y + d.y) + 64.0f * ((da * da + db * db) + (dc * dc + dd * dd));
            unsigned long long* slot = (unsigned long long*)xbuf + ((size_t)(u.pm * BM + row) * 4 + u.pn);
            __hip_atomic_store(slot, ((unsigned long long)__float_as_uint(m2) << 32) | __float_as_uint(mt), __ATOMIC_RELAXED, __HIP_MEMORY_SCOPE_AGENT);
        }
        asm volatile("s_waitcnt vmcnt(0)" ::: "memory");
        if (lane == 0) __hip_atomic_fetch_add(cnt + 64 * u.pm, 1u, __ATOMIC_RELAXED, __HIP_MEMORY_SCOPE_AGENT);
        if (wid == 0) {
            bool dead = false; const unsigned long long t0 = __builtin_amdgcn_s_memrealtime(); const unsigned want = 8u * (unsigned)ntn;
            for (;;) {
#if defined(BROKEN_EXCHANGE_NO_WAIT)
                break;
#endif
                if ((unsigned)__builtin_amdgcn_readfirstlane(__hip_atomic_load(cnt + 64 * u.pm, __ATOMIC_RELAXED, __HIP_MEMORY_SCOPE_AGENT)) >= want) break;
                if (__builtin_amdgcn_s_memrealtime() - t0 > 2000000ull) {
                    if (lane == 0) { unsigned expect = 0u; __hip_atomic_compare_exchange_strong(tmo + 1, &expect, code | (unsigned)(u.pm & 0xff), __ATOMIC_RELAXED, __ATOMIC_RELAXED, __HIP_MEMORY_SCOPE_AGENT);
                                     __hip_atomic_store(tmo, 1u, __ATOMIC_RELAXED, __HIP_MEMORY_SCOPE_AGENT); }
                    dead = true; break; }
                __builtin_amdgcn_s_sleep(2);
            }
            __builtin_amdgcn_fence(__ATOMIC_ACQUIRE, "agent");
            if (lane == 0) flag[0] = dead ? 1u : 0u;
        }
        asm volatile("s_waitcnt vmcnt(0) lgkmcnt(0)" ::: "memory"); __builtin_amdgcn_s_barrier(); asm volatile("" ::: "memory");
        const bool bad = flag[0] != 0u;
        if (lane < 32) {
            const unsigned long long* slot = (const unsigned long long*)xbuf + (size_t)(u.pm * BM + row) * 4; float mt[4], m2[4]; float ms = 0.f;
#pragma unroll
            for (int t = 0; t < 4; ++t) { if (t < ntn) { const unsigned long long w = __hip_atomic_load(slot + t, __ATOMIC_RELAXED, __HIP_MEMORY_SCOPE_AGENT); mt[t] = __uint_as_float((unsigned)w); m2[t] = __uint_as_float((unsigned)(w >> 32)); } else { mt[t] = 0.f; m2[t] = 0.f; } ms += mt[t]; }
            const float mean = ms / (float)ntn; float q = 0.f;
#pragma unroll
            for (int t = 0; t < 4; ++t) if (t < ntn) { const float dm = mt[t] - mean; q += m2[t] + 256.0f * dm * dm; }
            S[row] = (f32x2v){mean, 1.0f / sqrtf(q / (256.0f * (float)ntn) + eps)};
        }
        asm volatile("s_waitcnt lgkmcnt(0)" ::: "memory"); __builtin_amdgcn_s_barrier(); asm volatile("" ::: "memory");
        return bad;
    }
};
struct EpiLnRes {
    static constexpr bool PERM = false, AFTER_DRAIN = true;
    const float* base; float* out; int ldc; const float* bias; PanelStats st; unsigned poison;
    __device__ __forceinline__ void fused(f32x4 (&acc)[2][2][4][2], const Unit& u, int wr, int wc, int fr, int fq, PG8_LAS unsigned char* lds, int wid, int lane) const {
        typedef float f32x2v __attribute__((ext_vector_type(2)));
        const PG8_LAS f32x2v* S = (const PG8_LAS f32x2v*)(lds + 8192);
        const int col0 = u.pn * BM + wc * 32 + 4 * fq;
#pragma unroll
        for (int bj = 0; bj < 2; ++bj)
#pragma unroll
            for (int n = 0; n < 2; ++n) { const f32x4 bv = bias ? *(const f32x4*)(bias + col0 + bj * HALF + n * 16) : (f32x4){0.f, 0.f, 0.f, 0.f};
#pragma unroll
                for (int ai = 0; ai < 2; ++ai)
#pragma unroll
                    for (int m = 0; m < 4; ++m) acc[ai][bj][m][n] += bv; }
        f32x4 pre[4][2][2];
#pragma unroll
        for (int m = 0; m < 4; ++m) { const size_t off = (size_t)(u.pm * BM + wr * 64 + m * 16 + fr) * ldc + col0;
#pragma unroll
            for (int bj = 0; bj < 2; ++bj)
#pragma unroll
                for (int n = 0; n < 2; ++n) pre[m][bj][n] = *(const f32x4*)(base + off + bj * HALF + n * 16); }
        const bool bad = st.run(acc, u, wr, wc, fr, fq, lds, wid, lane) || poison != 0u;
        const float qnan = __builtin_nanf("");
#pragma unroll
        for (int ai = 0; ai < 2; ++ai)
#pragma unroll
            for (int m = 0; m < 4; ++m) { const int r = ai * HALF + wr * 64 + m * 16 + fr; const f32x2v sr = S[r]; const size_t off = (size_t)(u.pm * BM + r) * ldc + col0;
#pragma unroll
                for (int bj = 0; bj < 2; ++bj)
#pragma unroll
                    for (int n = 0; n < 2; ++n) { const f32x4 bs = ai == 0 ? pre[m][bj][n] : *(const f32x4*)(base + off + bj * HALF + n * 16); f32x4 o = bs + (acc[ai][bj][m][n] - sr.x) * sr.y;
                        if (bad) o = (f32x4){qnan, qnan, qnan, qnan}; *(f32x4*)(out + off + bj * HALF + n * 16) = o; }
                if (m & 1) asm volatile("" ::: "memory"); }
    }
};
struct EpiLnResLn {
    static constexpr bool PERM = false, AFTER_DRAIN = true;
    const float* base; float* out; bf16_t* xn; int ldc; const float* bias; PanelStats st1, st2; unsigned poison;
    __device__ __forceinline__ void fused(f32x4 (&acc)[2][2][4][2], const Unit& u, int wr, int wc, int fr, int fq, PG8_LAS unsigned char* lds, int wid, int lane) const {
        typedef float f32x2v __attribute__((ext_vector_type(2))); typedef unsigned u32x2v __attribute__((ext_vector_type(2)));
        const PG8_LAS f32x2v* S = (const PG8_LAS f32x2v*)(lds + 8192);
        const int col0 = u.pn * BM + wc * 32 + 4 * fq;
#pragma unroll
        for (int bj = 0; bj < 2; ++bj)
#pragma unroll
            for (int n = 0; n < 2; ++n) { const f32x4 bv = bias ? *(const f32x4*)(bias + col0 + bj * HALF + n * 16) : (f32x4){0.f, 0.f, 0.f, 0.f};
#pragma unroll
                for (int ai = 0; ai < 2; ++ai)
#pragma unroll
                    for (int m = 0; m < 4; ++m) acc[ai][bj][m][n] += bv; }
        bool bad = st1.run(acc, u, wr, wc, fr, fq, lds, wid, lane) || poison != 0u;
        const float qnan = __builtin_nanf("");
#pragma unroll
        for (int ai = 0; ai < 2; ++ai)
#pragma unroll
            for (int m = 0; m < 4; ++m) { const int r = ai * HALF + wr * 64 + m * 16 + fr; const f32x2v sr = S[r]; const size_t off = (size_t)(u.pm * BM + r) * ldc + col0;
#pragma unroll
                for (int bj = 0; bj < 2; ++bj)
#pragma unroll
                    for (int n = 0; n < 2; ++n) { const f32x4 bs = *(const f32x4*)(base + off + bj * HALF + n * 16); acc[ai][bj][m][n] = bs + (acc[ai][bj][m][n] - sr.x) * sr.y; }
                asm volatile("" : "+v"(acc[ai][0][m][0]), "+v"(acc[ai][0][m][1]), "+v"(acc[ai][1][m][0]), "+v"(acc[ai][1][m][1]));
                if (m & 1) asm volatile("" ::: "memory"); }
        const bool bad1 = bad;
        bad = st2.run(acc, u, wr, wc, fr, fq, lds, wid, lane) || bad;
#pragma unroll
        for (int ai = 0; ai < 2; ++ai)
#pragma unroll
            for (int m = 0; m < 4; ++m) { const int r = ai * HALF + wr * 64 + m * 16 + fr; const f32x2v sr = S[r]; const size_t off = (size_t)(u.pm * BM + r) * ldc + col0;
#pragma unroll
                for (int bj = 0; bj < 2; ++bj)
#pragma unroll
                    for (int n = 0; n < 2; ++n) { const f32x4 x1 = acc[ai][bj][m][n]; *(f32x4*)(out + off + bj * HALF + n * 16) = bad1 ? (f32x4){qnan, qnan, qnan, qnan} : x1;
                        const f32x4 o = (x1 - sr.x) * sr.y; u32x2v w; w.x = cvt_pk_bf16(o[0], o[1]); w.y = cvt_pk_bf16(o[2], o[3]);
                        if (bad) { w.x = 0x7fc07fc0u; w.y = 0x7fc07fc0u; } *(u32x2v*)(xn + off + bj * HALF + n * 16) = w; }
                asm volatile("" ::: "memory"); }
    }
};

template <class Epi, class Sched, bool ALIGN_EPI = false, bool SP2 = false>
__device__ __forceinline__ void gemm_phase(PG8_LAS unsigned char* lds, const Gemm g, const Sched& S, const Epi& E) {
    const int tid = opaque_tid(), wid = __builtin_amdgcn_readfirstlane(tid >> 6), lane = tid & 63, wr = wid >> 2, wc = wid & 3, fr = lane & 15, fq = lane >> 4;
    const int K = g.K, nt = K / BK;
    unsigned voffA[2], voffB[2];
#pragma unroll
    for (int i = 0; i < 2; ++i) { int R, C; stage_rc(tid * 16 + i * 8192, R, C); const int Rb = Epi::PERM ? ((R & ~31) + perm32(R & 31)) : R;
        voffA[i] = (unsigned)(R * K + C) * 2u; voffB[i] = (unsigned)(Rb * K + C) * 2u; }
    const size_t kstep = (size_t)(BK * 2);
    const size_t hstep = (size_t)HALF * K * 2;
    const size_t tstep = 2 * hstep;
    const unsigned ldsw = (unsigned)wid * 1024u;
    const int aoff = lds_byte(wr * 64 + fr, fq * 8), boff = lds_byte(wc * 32 + fr, fq * 8);
#define PG8_SA(b, h) (((b) * 2 + (h)) * HTB)
#define PG8_SB(b, h) ((4 + (b) * 2 + (h)) * HTB)
#define PG8_STAGE(bufoff, gbase, voff) do { _Pragma("unroll") for (int _i = 0; _i < 2; ++_i) \
        __builtin_amdgcn_global_load_lds((const unsigned*)((const char*)(gbase) + (voff)[_i]), (PG8_LAS unsigned*)(lds + (bufoff) + ldsw + _i * 8192), 16, 0, 0); } while (0)
#define PG8_LDA(dst, b, h) do { _Pragma("unroll") for (int m = 0; m < 4; ++m) _Pragma("unroll") for (int k = 0; k < 2; ++k) dst[m][k] = *(const PG8_LAS bf16x8*)(lds + PG8_SA(b, h) + aoff + m * 2048 + k * 1024); } while (0)
#define PG8_LDB(dst, b, h) do { _Pragma("unroll") for (int n = 0; n < 2; ++n) _Pragma("unroll") for (int k = 0; k < 2; ++k) dst[n][k] = *(const PG8_LAS bf16x8*)(lds + PG8_SB(b, h) + boff + n * 2048 + k * 1024); } while (0)
#define PG8_MMA(ai, bj, At, Bt) do { __builtin_amdgcn_s_setprio(1); _Pragma("unroll") for (int m = 0; m < 4; ++m) _Pragma("unroll") for (int n = 0; n < 2; ++n) _Pragma("unroll") for (int k = 0; k < 2; ++k) \
        acc[ai][bj][m][n] = __builtin_amdgcn_mfma_f32_16x16x32_bf16(Bt[n][k], At[m][k], acc[ai][bj][m][n], 0, 0, 0); __builtin_amdgcn_s_setprio(0); } while (0)
#define PG8_WAIT_V(n) asm volatile("s_waitcnt vmcnt(" #n ")" ::: "memory")
#define PG8_WAIT_L(n) asm volatile("s_waitcnt lgkmcnt(" #n ")" ::: "memory")
#define PG8_BAR __builtin_amdgcn_s_barrier()
#define PG8_SCHED __builtin_amdgcn_sched_barrier(0)
    Unit cur, nxt; int ui = 0;
    if (!S.next(0, cur)) return;
    f32x4 acc[2][2][4][2];
#pragma unroll
    for (int a = 0; a < 2; ++a)
#pragma unroll
        for (int b = 0; b < 2; ++b)
#pragma unroll
            for (int m = 0; m < 4; ++m)
#pragma unroll
                for (int n = 0; n < 2; ++n) acc[a][b][m][n] = (f32x4){0.f, 0.f, 0.f, 0.f};
    bf16x8 At[4][2], B0[2][2], B1[2][2];
    const char* cA = (const char*)g.A + (size_t)cur.pm * tstep; const char* cB = (const char*)g.Bt + (size_t)cur.pn * tstep;
    S.a_ready(cur);
    if constexpr (SP2) {
        PG8_STAGE(PG8_SB(0, 0), cB, voffB); PG8_STAGE(PG8_SB(0, 1), cB + hstep, voffB); PG8_STAGE(PG8_SA(0, 0), cA, voffA); PG8_STAGE(PG8_SA(0, 1), cA + hstep, voffA);
        if (wr == 1) PG8_BAR;
        PG8_WAIT_V(2); PG8_BAR;
        PG8_STAGE(PG8_SB(1, 0), cB + kstep, voffB); PG8_STAGE(PG8_SA(1, 0), cA + kstep, voffA); PG8_STAGE(PG8_SB(1, 1), cB + hstep + kstep, voffB);
        PG8_WAIT_V(6); PG8_BAR;
    } else {
        PG8_STAGE(PG8_SB(0, 0), cB, voffB); PG8_STAGE(PG8_SA(0, 0), cA, voffA); PG8_STAGE(PG8_SB(0, 1), cB + hstep, voffB); PG8_STAGE(PG8_SA(0, 1), cA + hstep, voffA);
        if (wr == 1) PG8_BAR;
        PG8_WAIT_V(4); PG8_BAR;
        PG8_STAGE(PG8_SB(1, 0), cB + kstep, voffB); PG8_STAGE(PG8_SA(1, 0), cA + kstep, voffA); PG8_STAGE(PG8_SB(1, 1), cB + hstep + kstep, voffB);
        PG8_WAIT_V(6); PG8_BAR;
    }
    for (;;) {
        const bool has_next = S.next(ui + 1, nxt);
        const char* nA = has_next ? (const char*)g.A + (size_t)nxt.pm * tstep : cA; const char* nB = has_next ? (const char*)g.Bt + (size_t)nxt.pn * tstep : cB;
        for (int t = 0; t < nt; t += 2) {
            const bool last = (t == nt - 2);
            const char* a1 = cA + (size_t)(t + 1) * kstep;
            const char* a2 = last ? nA : cA + (size_t)(t + 2) * kstep; const char* b2 = last ? nB : cB + (size_t)(t + 2) * kstep;
            const char* a3 = a2 + kstep; const char* b3 = b2 + kstep;
            if (last && has_next) S.a_ready(nxt);
            if constexpr (SP2) {
            PG8_LDB(B0, 0, 0); PG8_LDB(B1, 0, 1); PG8_SCHED; PG8_LDA(At, 0, 0); PG8_STAGE(PG8_SA(1, 1), a1 + hstep, voffA);
            PG8_WAIT_V(8); PG8_WAIT_L(0); PG8_BAR; PG8_MMA(0, 0, At, B0); PG8_MMA(0, 1, At, B1); PG8_BAR; PG8_SCHED;
            PG8_LDA(At, 0, 1); PG8_STAGE(PG8_SB(0, 0), b2, voffB); PG8_STAGE(PG8_SB(0, 1), b2 + hstep, voffB); PG8_STAGE(PG8_SA(0, 0), a2, voffA);
            PG8_WAIT_V(8); PG8_WAIT_L(0); PG8_BAR; PG8_MMA(1, 0, At, B0); PG8_MMA(1, 1, At, B1); PG8_BAR; PG8_SCHED;
            PG8_LDB(B0, 1, 0); PG8_LDB(B1, 1, 1); PG8_SCHED; PG8_LDA(At, 1, 0); PG8_STAGE(PG8_SA(0, 1), a2 + hstep, voffA);
            PG8_WAIT_V(8); PG8_WAIT_L(0); PG8_BAR; PG8_MMA(0, 0, At, B0); PG8_MMA(0, 1, At, B1); PG8_BAR; PG8_SCHED;
            PG8_LDA(At, 1, 1); PG8_STAGE(PG8_SB(1, 0), b3, voffB); PG8_STAGE(PG8_SB(1, 1), b3 + hstep, voffB); PG8_STAGE(PG8_SA(1, 0), a3, voffA);
            PG8_WAIT_V(8); PG8_WAIT_L(0); PG8_BAR; PG8_MMA(1, 0, At, B0); PG8_MMA(1, 1, At, B1); PG8_BAR; PG8_SCHED;
            } else {
            PG8_LDB(B0, 0, 0); PG8_SCHED; PG8_LDA(At, 0, 0); PG8_STAGE(PG8_SA(1, 1), a1 + hstep, voffA);
            PG8_WAIT_L(8); PG8_BAR; PG8_WAIT_L(0); PG8_MMA(0, 0, At, B0); PG8_BAR; PG8_SCHED;
            PG8_LDB(B1, 0, 1); PG8_STAGE(PG8_SB(0, 0), b2, voffB);
            PG8_BAR; PG8_WAIT_L(0); PG8_MMA(0, 1, At, B1); PG8_BAR;
            PG8_LDA(At, 0, 1); PG8_STAGE(PG8_SA(0, 0), a2, voffA);
            PG8_BAR; PG8_WAIT_L(0); PG8_MMA(1, 0, At, B0); PG8_BAR; PG8_SCHED;
            PG8_STAGE(PG8_SB(0, 1), b2 + hstep, voffB);
            PG8_WAIT_V(6); PG8_BAR; PG8_MMA(1, 1, At, B1); PG8_BAR;
            PG8_LDB(B0, 1, 0); PG8_SCHED; PG8_LDA(At, 1, 0); PG8_STAGE(PG8_SA(0, 1), a2 + hstep, voffA);
            PG8_WAIT_L(8); PG8_BAR; PG8_WAIT_L(0); PG8_MMA(0, 0, At, B0); PG8_BAR; PG8_SCHED;
            PG8_LDB(B1, 1, 1); PG8_STAGE(PG8_SB(1, 0), b3, voffB);
            PG8_BAR; PG8_WAIT_L(0); PG8_MMA(0, 1, At, B1); PG8_BAR;
            PG8_LDA(At, 1, 1); PG8_STAGE(PG8_SA(1, 0), a3, voffA);
            PG8_BAR; PG8_WAIT_L(0); PG8_MMA(1, 0, At, B0); PG8_BAR; PG8_SCHED;
            PG8_STAGE(PG8_SB(1, 1), b3 + hstep, voffB);
            PG8_WAIT_V(6); PG8_BAR; PG8_MMA(1, 1, At, B1); PG8_BAR;
            }
        }
        if constexpr (ALIGN_EPI) { if (wr == 0) PG8_BAR; }
        if constexpr (!Epi::AFTER_DRAIN) { E(acc, cur, wr, wc, fr, fq); S.done(cur); }
        if (!has_next) break;
#pragma unroll
        for (int a = 0; a < 2; ++a)
#pragma unroll
            for (int b = 0; b < 2; ++b)
#pragma unroll
                for (int m = 0; m < 4; ++m)
#pragma unroll
                    for (int n = 0; n < 2; ++n) acc[a][b][m][n] = (f32x4){0.f, 0.f, 0.f, 0.f};
        cur = nxt; cA = nA; cB = nB; ++ui;
        if constexpr (ALIGN_EPI) { if (wr == 1) PG8_BAR; }
    }
    PG8_WAIT_V(0);
    if constexpr (!ALIGN_EPI) { if (wr == 0) PG8_BAR; }
    PG8_BAR;
    if constexpr (Epi::AFTER_DRAIN) { E.fused(acc, cur, wr, wc, fr, fq, lds, wid, lane); S.done(cur); }
#undef PG8_SA
#undef PG8_SB
#undef PG8_STAGE
#undef PG8_LDA
#undef PG8_LDB
#undef PG8_MMA
#undef PG8_WAIT_V
#undef PG8_WAIT_L
#undef PG8_BAR
#undef PG8_SCHED
}
}

#ifndef PG8_SP2
#define PG8_SP2 true
#endif
#ifndef PG8_ALIGN
#define PG8_ALIGN true
#endif
namespace pg8 {
constexpr int OUT_KP = 17301504, OUT_VP = 34078720, OUT_KS = 51122176, OUT_VS = 51646464;
__device__ __forceinline__ float row_rstd(const float* ssq, int row) {
    const f32x4* p = (const f32x4*)(ssq + (size_t)row * 16);
    const f32x4 a = p[0], b = p[1], c = p[2], d = p[3];
    const float s = (((a[0] + a[1]) + (a[2] + a[3])) + ((b[0] + b[1]) + (b[2] + b[3]))) + (((c[0] + c[1]) + (c[2] + c[3])) + ((d[0] + d[1]) + (d[2] + d[3])));
    return 1.0f / sqrtf(s * (1.0f / 1024.0f) + 1e-6f);
}
template <int ACT, bool KVF32> struct EpiAct {
    static constexpr bool PERM = true, AFTER_DRAIN = false;
    bf16_t* O; int ldc; const float* ssq; int split_cols; size_t split_stride; float* fout;
    __device__ __forceinline__ void operator()(const f32x4 (&acc)[2][2][4][2], const Unit& u, int wr, int wc, int fr, int fq) const {
        const int row0 = u.pm * BM + wr * 64 + fr; int colt = u.pn * BM; bf16_t* base = O; int t = 0;
        if (split_cols) { t = colt / split_cols; base += (size_t)t * split_stride; colt -= t * split_cols; }
        const int col0 = colt + wc * 32 + 8 * fq;
        float* fb = nullptr;
        if (KVF32) { if (t < 2) fb = fout + ((u.pm < 64) ? (size_t)(t == 0 ? OUT_KP : OUT_VP) : (size_t)(t == 0 ? OUT_KS : OUT_VS) - (size_t)16384 * 1024) + col0; }
#pragma unroll
        for (int ai = 0; ai < 2; ++ai)
#pragma unroll
            for (int m = 0; m < 4; ++m) { const int row = row0 + ai * HALF + m * 16; const float rs = row_rstd(ssq, row);
                bf16_t* rowp = base + (size_t)row * ldc + col0;
#pragma unroll
                for (int bj = 0; bj < 2; ++bj) { f32x4 v0 = acc[ai][bj][m][0] * rs, v1 = acc[ai][bj][m][1] * rs;
                    if (ACT == 1) {
#pragma unroll
                        for (int e = 0; e < 4; ++e) { const float a = fmaxf(v0[e], 0.f), b = fmaxf(v1[e], 0.f); v0[e] = a * a; v1[e] = b * b; } }
                    if (KVF32) { if (fb) { float* fr_ = fb + (size_t)row * 1024 + bj * HALF; *(f32x4*)fr_ = v0; *(f32x4*)(fr_ + 4) = v1; } }
                    u32x4 w; w.x = cvt_pk_bf16(v0[0], v0[1]); w.y = cvt_pk_bf16(v0[2], v0[3]); w.z = cvt_pk_bf16(v1[0], v1[1]); w.w = cvt_pk_bf16(v1[2], v1[3]);
                    *(u32x4*)(rowp + bj * HALF) = w; }
                asm volatile("" ::: "memory"); }
    }
};
struct EpiResid {
    static constexpr bool PERM = true, AFTER_DRAIN = false;
    float* X; bf16_t* XB; float* ssq;
    __device__ __forceinline__ void operator()(const f32x4 (&acc)[2][2][4][2], const Unit& u, int wr, int wc, int fr, int fq) const {
        const int row0 = u.pm * BM + wr * 64 + fr; const int col0 = u.pn * BM + wc * 32 + 8 * fq;
#pragma unroll
        for (int ai = 0; ai < 2; ++ai)
#pragma unroll
            for (int m = 0; m < 4; ++m) { const int row = row0 + ai * HALF + m * 16; float* xp = X + (size_t)row * 1024 + col0; bf16_t* bp = XB + (size_t)row * 1024 + col0; float q = 0.f;
#pragma unroll
                for (int bj = 0; bj < 2; ++bj) { f32x4 a0 = *(const f32x4*)(xp + bj * HALF), a1 = *(const f32x4*)(xp + bj * HALF + 4);
                    a0 += acc[ai][bj][m][0]; a1 += acc[ai][bj][m][1];
                    *(f32x4*)(xp + bj * HALF) = a0; *(f32x4*)(xp + bj * HALF + 4) = a1;
                    q += ((a0[0] * a0[0] + a0[1] * a0[1]) + (a0[2] * a0[2] + a0[3] * a0[3])) + ((a1[0] * a1[0] + a1[1] * a1[1]) + (a1[2] * a1[2] + a1[3] * a1[3]));
                    u32x4 w; w.x = cvt_pk_bf16(a0[0], a0[1]); w.y = cvt_pk_bf16(a0[2], a0[3]); w.z = cvt_pk_bf16(a1[0], a1[1]); w.w = cvt_pk_bf16(a1[2], a1[3]);
                    *(u32x4*)(bp + bj * HALF) = w; }
                q += __shfl_xor(q, 16); q += __shfl_xor(q, 32);
                if (fq == 0) ssq[(size_t)row * 16 + u.pn * 4 + wc] = q;
                asm volatile("" ::: "memory"); }
    }
};
}
#include <hip/hip_bf16.h>
#include <cmath>
namespace attn_body {
using bf16=__hip_bfloat16;
using bf16x8=__attribute__((ext_vector_type(8)))short;
using s16x4=__attribute__((ext_vector_type(4)))short;
using f32x16=__attribute__((ext_vector_type(16)))float;
using u32x4=__attribute__((ext_vector_type(4)))unsigned;
constexpr int BATCH=1,NHEAD=16,SEQ=16384,D=64,DM=NHEAD*D;
constexpr int NW=8,QBLK=32,QB=QBLK*NW,KVBLK=64,NQB=SEQ/QB;
constexpr int ATTN_PITCH=DM, ATTN_UNIT_ROWS=QB;
__device__ __forceinline__ int crow(int r,int hi){return (r&3)+8*(r>>2)+4*hi;}
#define SBAR() __builtin_amdgcn_sched_barrier(0)
__device__ __forceinline__ void cmask(f32x16&p0,f32x16&p1,int jb,int qrel,int hi){
  const float NEG=-INFINITY; int kb=64*jb+4*hi;
  #pragma unroll
  for(int r=0;r<16;++r){int kv=kb+(r&3)+8*(r>>2); if(kv>qrel)p0[r]=NEG; if(kv+32>qrel)p1[r]=NEG;}
}

constexpr int NSLOT=3, SLOTB=8192;
constexpr int LDS_K=0, LDS_V=NSLOT*SLOTB, LDS_WS=2*NSLOT*SLOTB, LDS_OST=LDS_WS+NW*64*4, LDS_CK=LDS_OST+NW*4096, LDS_BYTES=LDS_CK+SEQ*4;
constexpr float C2=0.125f*1.4426950408889634f;
__device__ __forceinline__ void glds16(const void*gsrc,unsigned lds_dst){unsigned keep;
  asm volatile("s_mov_b32 %0, m0\n\ts_mov_b32 m0, %2\n\ts_nop 0\n\tglobal_load_lds_dwordx4 %1, off\n\ts_mov_b32 m0, %0":"=&s"(keep):"v"(gsrc),"s"(lds_dst):"memory");}
__device__ __forceinline__ float max3f(float a,float b,float c){float r;asm("v_max3_f32 %0, %1, %2, %3":"=v"(r):"v"(a),"v"(b),"v"(c));return r;}
__device__ __forceinline__ float max2f(float a,float b){float r;asm("v_max_f32_e32 %0, %1, %2":"=v"(r):"v"(a),"v"(b));return r;}
__device__ __forceinline__ float fadd_s(float a,float b){float r;asm("v_add_f32_e32 %0, %1, %2":"=v"(r):"v"(a),"v"(b));return r;}
__device__ __forceinline__ float fsub_s(float a,float b){float r;asm("v_sub_f32_e32 %0, %1, %2":"=v"(r):"v"(a),"v"(b));return r;}
typedef float f32x2_t __attribute__((ext_vector_type(2))); typedef __bf16 bf16x2_t __attribute__((ext_vector_type(2)));
__device__ __forceinline__ unsigned cvtpk_s(float lo,float hi){f32x2_t v={lo,hi};bf16x2_t b=__builtin_convertvector(v,bf16x2_t);return __builtin_bit_cast(unsigned,b);}
#define WAIT_BAR(N) asm volatile("s_waitcnt vmcnt(" #N ") lgkmcnt(0)\n\ts_barrier":::"memory")

__device__ __forceinline__ void qkt(f32x16&p0,f32x16&p1,const char*Kslot,const bf16x8*qr,const f32x16&negm,int r32,int hi){
  const char*kb=Kslot+hi*1024+r32*16;
  #pragma unroll
  for(int d0=0;d0<4;++d0){
    const bf16x8 b0=*reinterpret_cast<const bf16x8*>(kb+d0*2048);
    const bf16x8 b1=*reinterpret_cast<const bf16x8*>(kb+d0*2048+512);
    if(d0==0){p0=__builtin_amdgcn_mfma_f32_32x32x16_bf16(b0,qr[0],negm,0,0,0);p1=__builtin_amdgcn_mfma_f32_32x32x16_bf16(b1,qr[0],negm,0,0,0);}
    else{p0=__builtin_amdgcn_mfma_f32_32x32x16_bf16(b0,qr[d0],p0,0,0,0);p1=__builtin_amdgcn_mfma_f32_32x32x16_bf16(b1,qr[d0],p1,0,0,0);}}
}
typedef __attribute__((address_space(3))) const char* lds_cptr;
typedef short v4i16_t __attribute__((ext_vector_type(4)));
__device__ __forceinline__ void kload8(bf16x8*kf,lds_cptr kp){
  kf[0]=*(const __attribute__((address_space(3))) bf16x8*)(kp);      kf[1]=*(const __attribute__((address_space(3))) bf16x8*)(kp+512);
  kf[2]=*(const __attribute__((address_space(3))) bf16x8*)(kp+2048); kf[3]=*(const __attribute__((address_space(3))) bf16x8*)(kp+2560);
  kf[4]=*(const __attribute__((address_space(3))) bf16x8*)(kp+4096); kf[5]=*(const __attribute__((address_space(3))) bf16x8*)(kp+4608);
  kf[6]=*(const __attribute__((address_space(3))) bf16x8*)(kp+6144); kf[7]=*(const __attribute__((address_space(3))) bf16x8*)(kp+6656);
}
__device__ __forceinline__ void kload2(bf16x8*kf,lds_cptr kp,int j){ kf[2*j]=*(const __attribute__((address_space(3))) bf16x8*)(kp+j*2048); kf[2*j+1]=*(const __attribute__((address_space(3))) bf16x8*)(kp+j*2048+512); }
__device__ __forceinline__ s16x4 vtr(lds_cptr p){ return __builtin_bit_cast(s16x4,__builtin_amdgcn_ds_read_tr16_b64_v4i16((__attribute__((address_space(3))) v4i16_t*)p)); }
__device__ __forceinline__ float rowmax(const f32x16&p0,const f32x16&p1){
  float a=max3f(p0[0],p0[1],p1[0]),b=max3f(p0[2],p0[3],p1[1]);a=max3f(a,p1[2],p1[3]);
  #pragma unroll
  for(int r=4;r<16;r+=4){a=max3f(a,p0[r],p0[r+1]);b=max3f(b,p0[r+2],p0[r+3]);a=max3f(a,p1[r],p1[r+1]);b=max3f(b,p1[r+2],p1[r+3]);}
  const float m=max2f(a,b);
  auto rr=__builtin_amdgcn_permlane32_swap(__float_as_uint(m),__float_as_uint(m),false,false);
  return max2f(__uint_as_float(rr[0]),__uint_as_float(rr[1]));
}
__device__ __forceinline__ void pv(f32x16*o,int vb,bf16x8 pa0,bf16x8 pa1,bf16x8 pa2,bf16x8 pa3){
  #pragma unroll
  for(int d0=0;d0<2;++d0){s16x4 lo[4],hi[4];
    #pragma unroll
    for(int ks=0;ks<4;++ks){
      asm volatile("ds_read_b64_tr_b16 %0,%1 offset:%c2":"=&v"(lo[ks]):"v"(vb),"i"(d0*4096+ks*1024):"memory");
      asm volatile("ds_read_b64_tr_b16 %0,%1 offset:%c2":"=&v"(hi[ks]):"v"(vb),"i"(d0*4096+ks*1024+512):"memory");}
    asm volatile("s_waitcnt lgkmcnt(0)":::"memory");SBAR();
    #define PK(k) (bf16x8){lo[k][0],lo[k][1],lo[k][2],lo[k][3],hi[k][0],hi[k][1],hi[k][2],hi[k][3]}
    o[d0]=__builtin_amdgcn_mfma_f32_32x32x16_bf16(pa0,PK(0),o[d0],0,0,0);
    o[d0]=__builtin_amdgcn_mfma_f32_32x32x16_bf16(pa1,PK(1),o[d0],0,0,0);
    o[d0]=__builtin_amdgcn_mfma_f32_32x32x16_bf16(pa2,PK(2),o[d0],0,0,0);
    o[d0]=__builtin_amdgcn_mfma_f32_32x32x16_bf16(pa3,PK(3),o[d0],0,0,0);
    #undef PK
  }
}

#ifndef ATTN_STORE16
#define ATTN_STORE16(p,v) (*(u32x4*)(p)=(v))
#endif
typedef float f32x4_t __attribute__((ext_vector_type(4)));
#define CKSUB(C0,C1,t) do{ const __attribute__((address_space(3))) f32x4_t* ck_=(const __attribute__((address_space(3))) f32x4_t*)(ckl+(t)*64+4*hi); \
   _Pragma("unroll") for(int g_=0;g_<4;++g_){ const f32x4_t a_=ck_[2*g_], b_=ck_[8+2*g_]; \
     _Pragma("unroll") for(int i_=0;i_<4;++i_){ C0[4*g_+i_]-=a_[i_]; C1[4*g_+i_]-=b_[i_]; } } }while(0)
template<int THRL> __device__ __forceinline__ void attn_unit(int b,int h,int qb,const bf16*Q,const bf16*__restrict__ K,const bf16*__restrict__ V,bf16*O,char*shm,const float*ckg,const float kmax2){
  const int tid=opaque_tid(),lane=tid&63,r32=lane&31,hi=lane>>5; const int wid=__builtin_amdgcn_readfirstlane(tid>>6);
  const long rowbase=(long)b*SEQ; const int q0=qb*QB;
  const bf16*Qw=Q+(rowbase+q0+wid*QBLK)*DM+h*D;
  const unsigned lds0=(unsigned)(uintptr_t)shm;
  float*wsf=(float*)(shm+LDS_WS)+wid*64;
  __attribute__((address_space(3))) float* ckl=(__attribute__((address_space(3))) float*)((__attribute__((address_space(3))) char*)shm+LDS_CK);
  const float cqv=ckg[q0+wid*QBLK+r32];
  bf16x8 qr[4];
  #pragma unroll
  for(int d0=0;d0<4;++d0)qr[d0]=*reinterpret_cast<const bf16x8*>(&Qw[(long)r32*DM+d0*16+hi*8]);
  int t0=0;
  if(qb>0){
    float*wsa=(float*)(shm+LDS_WS);
    float qs=0.f;
    #pragma unroll
    for(int d0=0;d0<4;++d0){
      #pragma unroll
      for(int e=0;e<8;++e){ const float v_=__builtin_bit_cast(float,((unsigned)(unsigned short)qr[d0][e])<<16); qs+=v_*v_; } }
    qs+=__shfl_xor(qs,32);
    #pragma unroll
    for(int o_=1;o_<32;o_<<=1) qs=fmaxf(qs,__shfl_xor(qs,o_));
    const int ncand=q0/KVBLK;
    float cend=0.f; if(tid<ncand) cend=ckg[tid*KVBLK+KVBLK-1];
    const float cq0=ckg[q0];
    if(lane==0) wsa[wid]=qs;
    __syncthreads();
    float qm=wsa[0];
    #pragma unroll
    for(int w_=1;w_<NW;++w_) qm=fmaxf(qm,wsa[w_]);
    const float thr=-40.f-2.f*sqrtf(qm*kmax2)*1.0001f;
    const bool skip_=(tid<ncand)&&((cq0-cend)<thr);
    const unsigned long long bal_=__ballot(skip_);
    if(lane==0) wsa[8+wid]=(float)__popcll(bal_);
    __syncthreads();
    float cnt_=0.f;
    #pragma unroll
    for(int w_=0;w_<NW;++w_) cnt_+=wsa[8+w_];
    t0=__builtin_amdgcn_readfirstlane(((int)cnt_)&~1);
    __syncthreads();
  }
  const bf16*Kh=K+(rowbase+(long)t0*KVBLK)*DM+h*D,*Vh=V+(rowbase+(long)t0*KVBLK)*DM+h*D;
  { const int nf4=(q0+QB-t0*KVBLK)>>2; const f32x4_t* src_=(const f32x4_t*)(ckg+t0*KVBLK); __attribute__((address_space(3))) f32x4_t* dst_=(__attribute__((address_space(3))) f32x4_t*)ckl;
    for(int i_=tid;i_<nf4;i_+=NW*64) dst_[i_]=src_[i_]; }
  const bf16*ksrc=Kh+(long)lane*DM+wid*8;
  const bf16*vsrc=Vh+(long)(16*(wid&3)+(lane>>2))*DM+(wid>>2)*32+(lane&3)*8;
  const unsigned kdst=lds0+LDS_K+wid*1024, vdst=lds0+LDS_V+wid*1024;
  #define DMA_K(t,slot) glds16(ksrc+(long)(t)*KVBLK*DM,(unsigned)__builtin_amdgcn_readfirstlane(kdst+(slot)))
  #define DMA_V(t,slot) glds16(vsrc+(long)(t)*KVBLK*DM,(unsigned)__builtin_amdgcn_readfirstlane(vdst+(slot)))
  const int vb0=(int)(lds0+LDS_V)+((lane>>4)&1)*32+(lane&3)*8+(4*hi+((lane&15)>>2))*64;
  const char*Kbase=shm+LDS_K; bf16x8 kf[8];
  const lds_cptr shm3=(lds_cptr)shm; const lds_cptr kp0=shm3+LDS_K+hi*1024+r32*16; const lds_cptr vp0=shm3+LDS_V+((lane>>4)&1)*32+(lane&3)*8+(4*hi+((lane&15)>>2))*64;
  const int NT=(q0+QB)/KVBLK-t0;
  DMA_K(0,0);DMA_V(0,0);DMA_K(1,SLOTB);
  float mhat=-cqv,l_reg=0.f;    f32x16 o[2];o[0]=f32x16{};o[1]=f32x16{};f32x16 negm;
  #pragma unroll
  for(int r=0;r<16;++r)negm[r]=cqv;
  asm volatile("":"+v"(negm));
  const int qrel=wid*QBLK+r32;
  #define CMASK(P0,P1,t) do{int jb_=(t)-(NT-4); if(jb_>=0)cmask(P0,P1,jb_,qrel,hi);}while(0)
  bool resc=false;
  #define START(P0,P1) do{ const float rm=rowmax(P0,P1); resc=false; \
    { const float dl=rm; mhat=fadd_s(mhat,dl); \
      _Pragma("unroll") for(int r=0;r<16;++r){P0[r]=fsub_s(P0[r],dl);P1[r]=fsub_s(P1[r],dl);} \
      _Pragma("unroll") for(int r=0;r<16;++r)negm[r]=-mhat; asm volatile("":"+v"(negm)); } \
    _Pragma("unroll") for(int r=0;r<16;++r)P0[r]=__builtin_amdgcn_exp2f(P0[r]); }while(0)
  #define RESC() do{ if(resc){ asm volatile("s_waitcnt lgkmcnt(0)":::"memory"); \
      _Pragma("unroll") for(int d_=0;d_<2;++d_) _Pragma("unroll") for(int r=0;r<16;++r)o[d_][r]*=wsf[crow(r,hi)]; } }while(0)
  f32x16 pA0,pA1,pB0,pB1;
  int sl_prev=0,sl_cur=0,sl_next=SLOTB;
  #define ROT() do{sl_prev=sl_cur;sl_cur=sl_next;sl_next=(sl_next==(NSLOT-1)*SLOTB)?0:sl_next+SLOTB;}while(0)
  DMA_K(2,2*SLOTB);
  WAIT_BAR(3);
  qkt(pA0,pA1,Kbase,qr,negm,r32,hi);asm volatile("s_nop 15\n\ts_nop 7":"+v"(pA0),"+v"(pA1));CKSUB(pA0,pA1,0);CMASK(pA0,pA1,0);
  START(pA0,pA1);
  _Pragma("unroll") for(int r=0;r<16;++r)pA1[r]=__builtin_amdgcn_exp2f(pA1[r]);
  WAIT_BAR(0);
  DMA_K(3,0);DMA_V(1,SLOTB);
  ROT();
  kload8(kf,kp0+sl_cur);
  WAIT_BAR(2);
  s16x4 vlo[8],vhi[8]; u32x4 pw0,pw1,pw2,pw3;
  #define PKW(P,B) cvtpk_s(P[B],P[B+1])
  #define PAF(k) __builtin_bit_cast(bf16x8,pw##k)
  #define VFR(i) (bf16x8){vlo[i][0],vlo[i][1],vlo[i][2],vlo[i][3],vhi[i][0],vhi[i][1],vhi[i][2],vhi[i][3]}
  #define PIN(x) asm volatile("":"+v"(x))
  #define MX3(a,b,c) __builtin_fmaxf(__builtin_fmaxf((a),(b)),(c))
  #define GAPA(MF,A0,A1,A2,A3,W0,W1,PW) do{ MF; sacc+=A0; sacc+=A1; sacc+=A2; sacc+=A3; PIN(sacc); W0; W1; PIN(PW); SBAR(); }while(0)
  #define EX(v) __builtin_amdgcn_exp2f(v)
  #define GAPB(MF,X,B) do{ MF; X[B]=EX(X[B]); X[B+1]=EX(X[B+1]); X[B+2]=EX(X[B+2]); X[B+3]=EX(X[B+3]); PIN(X); SBAR(); }while(0)
  #define VRD(i) do{ vlo[i]=vtr(vp_+(((i)>>2)*4096+((i)&3)*1024)); vhi[i]=vtr(vp_+(((i)>>2)*4096+((i)&3)*1024+512)); }while(0)
  #define KRD(G,j) do{ if(G){ kload2(kf,kp0+sl_next,j); SBAR(); } }while(0)
  #define STEP(C0,C1,P0,P1,t,GK,GV,GL) do{ SBAR(); \
    const lds_cptr vp_=vp0+sl_prev; \
    VRD(0); SBAR(); float sacc=(P0[0]+P0[1]); \
    GAPA(C0=__builtin_amdgcn_mfma_f32_32x32x16_bf16(kf[0],qr[0],negm,0,0,0), P0[2],P0[3],P0[4],P0[5],     pw0[0]=PKW(P0,0), pw0[1]=PKW(P0,2), pw0); \
    VRD(4); SBAR(); GAPA(C1=__builtin_amdgcn_mfma_f32_32x32x16_bf16(kf[1],qr[0],negm,0,0,0), P0[6],P0[7],P0[8],P0[9],     pw0[2]=PKW(P0,4), pw0[3]=PKW(P0,6), pw0); \
    VRD(1); SBAR(); GAPA(C0=__builtin_amdgcn_mfma_f32_32x32x16_bf16(kf[2],qr[1],C0,0,0,0),   P0[10],P0[11],P0[12],P0[13], pw1[0]=PKW(P0,8), pw1[1]=PKW(P0,10), pw1); \
    VRD(5); SBAR(); GAPA(C1=__builtin_amdgcn_mfma_f32_32x32x16_bf16(kf[3],qr[1],C1,0,0,0),   P0[14],P0[15],P1[0],P1[1],   pw1[2]=PKW(P0,12),pw1[3]=PKW(P0,14), pw1); \
    VRD(2); SBAR(); GAPA(C0=__builtin_amdgcn_mfma_f32_32x32x16_bf16(kf[4],qr[2],C0,0,0,0),   P1[2],P1[3],P1[4],P1[5],     pw2[0]=PKW(P1,0), pw2[1]=PKW(P1,2), pw2); \
    VRD(6); SBAR(); GAPA(C1=__builtin_amdgcn_mfma_f32_32x32x16_bf16(kf[5],qr[2],C1,0,0,0),   P1[6],P1[7],P1[8],P1[9],     pw2[2]=PKW(P1,4), pw2[3]=PKW(P1,6), pw2); \
    VRD(3); SBAR(); GAPA(C0=__builtin_amdgcn_mfma_f32_32x32x16_bf16(kf[6],qr[3],C0,0,0,0),   P1[10],P1[11],P1[12],P1[13], pw3[0]=PKW(P1,8), pw3[1]=PKW(P1,10), pw3); \
    VRD(7); SBAR(); GAPA(C1=__builtin_amdgcn_mfma_f32_32x32x16_bf16(kf[7],qr[3],C1,0,0,0),   P1[14],P1[15],0.f,0.f,       pw3[2]=PKW(P1,12),pw3[3]=PKW(P1,14), pw3); \
    l_reg+=sacc; \
    if(GK){DMA_K((t)+3,sl_cur);} if(GV){DMA_V((t)+1,sl_next);} \
    CKSUB(C0,C1,t); CMASK(C0,C1,t); \
    { float a=MX3(C0[0],C0[1],C1[0]),b=MX3(C0[2],C0[3],C1[1]); a=MX3(a,C1[2],C1[3]); \
      _Pragma("unroll") for(int r=4;r<16;r+=4){a=MX3(a,C0[r],C0[r+1]);b=MX3(b,C0[r+2],C0[r+3]);a=MX3(a,C1[r],C1[r+1]);b=MX3(b,C1[r+2],C1[r+3]);} \
      float rm=__builtin_fmaxf(a,b); { auto rr=__builtin_amdgcn_permlane32_swap(__float_as_uint(rm),__float_as_uint(rm),false,false); rm=__builtin_fmaxf(__uint_as_float(rr[0]),__uint_as_float(rr[1])); } \
      resc=false; \
      if(__builtin_expect(__any(rm>(float)THRL),0)){ const float dl=__builtin_fmaxf(rm,0.f); mhat+=dl; \
        _Pragma("unroll") for(int r=0;r<16;++r){C0[r]-=dl;C1[r]-=dl;} \
        _Pragma("unroll") for(int r=0;r<16;++r)negm[r]=-mhat; asm volatile("":"+v"(negm)); \
        const float f=__builtin_amdgcn_exp2f(-dl); l_reg*=f; if(hi==0)wsf[r32]=f; resc=true; } } \
    SBAR(); \
    GAPB(o[0]=__builtin_amdgcn_mfma_f32_32x32x16_bf16(PAF(0),VFR(0),o[0],0,0,0), C0,0); \
    GAPB(o[1]=__builtin_amdgcn_mfma_f32_32x32x16_bf16(PAF(0),VFR(4),o[1],0,0,0), C0,4); \
    KRD(GL,0); GAPB(o[0]=__builtin_amdgcn_mfma_f32_32x32x16_bf16(PAF(1),VFR(1),o[0],0,0,0), C0,8); \
    KRD(GL,1); GAPB(o[1]=__builtin_amdgcn_mfma_f32_32x32x16_bf16(PAF(1),VFR(5),o[1],0,0,0), C0,12); \
    KRD(GL,2); GAPB(o[0]=__builtin_amdgcn_mfma_f32_32x32x16_bf16(PAF(2),VFR(2),o[0],0,0,0), C1,0); \
    KRD(GL,3); GAPB(o[1]=__builtin_amdgcn_mfma_f32_32x32x16_bf16(PAF(2),VFR(6),o[1],0,0,0), C1,4); \
    GAPB(o[0]=__builtin_amdgcn_mfma_f32_32x32x16_bf16(PAF(3),VFR(3),o[0],0,0,0), C1,8); \
    GAPB(o[1]=__builtin_amdgcn_mfma_f32_32x32x16_bf16(PAF(3),VFR(7),o[1],0,0,0), C1,12); \
    }while(0)
  int t=1;
  #undef CMASK
  #define CMASK(P0,P1,t) do{}while(0)
  for(;t+5<NT;t+=2){
    STEP(pB0,pB1,pA0,pA1,t,true,true,true);     WAIT_BAR(2); RESC(); ROT();
    STEP(pA0,pA1,pB0,pB1,t+1,true,true,true);   WAIT_BAR(2); RESC(); ROT();
  }
  #undef CMASK
  #define CMASK(P0,P1,t) do{int jb_=(t)-(NT-4); if(jb_>=0)cmask(P0,P1,jb_,qrel,hi);}while(0)
  #define ENDW(tt) do{ if((tt)+3<NT){WAIT_BAR(2);} else if((tt)+2<NT){WAIT_BAR(1);} else {WAIT_BAR(0);} }while(0)
  for(;t+1<NT;t+=2){
    STEP(pB0,pB1,pA0,pA1,t,(t+3<NT),(t+1<NT),(t+1<NT));       ENDW(t);   RESC(); ROT();
    STEP(pA0,pA1,pB0,pB1,t+1,(t+4<NT),(t+2<NT),(t+2<NT));     ENDW(t+1); RESC(); ROT();
  }
  STEP(pB0,pB1,pA0,pA1,NT-1,false,false,false); RESC();
  { float sacc=pB0[0]+pB0[1]; _Pragma("unroll") for(int r=2;r<16;++r)sacc+=pB0[r]; _Pragma("unroll") for(int r=0;r<16;++r)sacc+=pB1[r]; l_reg+=sacc;
    pw0=(u32x4){PKW(pB0,0),PKW(pB0,2),PKW(pB0,4),PKW(pB0,6)};pw1=(u32x4){PKW(pB0,8),PKW(pB0,10),PKW(pB0,12),PKW(pB0,14)};pw2=(u32x4){PKW(pB1,0),PKW(pB1,2),PKW(pB1,4),PKW(pB1,6)};pw3=(u32x4){PKW(pB1,8),PKW(pB1,10),PKW(pB1,12),PKW(pB1,14)};
    SBAR(); pv(o,vb0+sl_cur,PAF(0),PAF(1),PAF(2),PAF(3)); }
  #undef PKW
  #undef PAF
  #undef VFR
  #undef PIN
  #undef MX3
  #undef GAPA
  #undef GAPB
  #undef EX
  #undef VRD
  #undef KRD
  #undef STEP
  #undef ENDW
  {auto rr=__builtin_amdgcn_permlane32_swap(__float_as_uint(l_reg),__float_as_uint(l_reg),false,false);l_reg=__uint_as_float(rr[0])+__uint_as_float(rr[1]);}
  if(hi==0)wsf[32+r32]=l_reg;asm volatile("s_waitcnt lgkmcnt(0)":::"memory");
  float rli[16];
  #pragma unroll
  for(int r=0;r<16;++r)rli[r]=__builtin_amdgcn_rcpf(wsf[32+crow(r,hi)]);
  bf16*Ow=O+(rowbase+q0+wid*QBLK)*DM+h*D;
  { bf16*stg=(bf16*)(shm+LDS_OST)+wid*2048;
    #pragma unroll
    for(int r=0;r<16;++r){const int orow=crow(r,hi);
      #pragma unroll
      for(int d0=0;d0<2;++d0)stg[orow*64+d0*32+r32]=__float2bfloat16(o[d0][r]*rli[r]);}
    asm volatile("s_waitcnt lgkmcnt(0)":::"memory");
    #pragma unroll
    for(int i=0;i<4;++i){const int row=i*8+(lane>>3),ch=lane&7; const u32x4 v=*(const u32x4*)(stg+row*64+ch*8); ATTN_STORE16(Ow+(long)row*DM+ch*8,v);} }
  asm volatile("s_waitcnt lgkmcnt(0)\n\ts_barrier":::"memory");
  #undef DMA_K
  #undef DMA_V
  #undef CMASK
  #undef START
  #undef RESC
  #undef ROT
}
constexpr int ATTN_LDS_BYTES=LDS_BYTES;
struct AttnTensors { const bf16* Q; const bf16* K; const bf16* V; bf16* O; const float* CL; const unsigned* KMAX; };
struct AttnUnit { int bh; int qb; };
struct StaticOrder {
  int vcu;
  __device__ __forceinline__ explicit StaticOrder(int grid,int block):vcu((grid%8==0)?(block%8)*(grid/8)+block/8:block){}
  __device__ __forceinline__ bool next(int i,AttnUnit&u)const{ if(i>=4||vcu>=256)return false; const int s=vcu&15; u.bh=vcu>>4; u.qb=(i==0)?63-s:(i==1)?32+s:(i==2)?31-s:s; return true; }
};
template<class Sched,int THRL=8> __device__ __forceinline__ void attn_phase(char*lds,const AttnTensors&T,const Sched&S){
  AttnUnit u;
  for(int i=0;S.next(i,u);++i){ attn_unit<THRL>(0,u.bh,u.qb,T.Q,T.K,T.V,T.O,lds,T.CL+(size_t)u.bh*SEQ,__builtin_bit_cast(float,T.KMAX[u.bh])); }
}
#undef SBAR
#undef WAIT_BAR
}
namespace sattn {
#define SLAS __attribute__((address_space(3)))
typedef short bf16x8 __attribute__((ext_vector_type(8)));
typedef float f32x4 __attribute__((ext_vector_type(4)));
typedef unsigned u32x4 __attribute__((ext_vector_type(4)));
typedef unsigned u32x2 __attribute__((ext_vector_type(2)));
typedef float f32x2_t __attribute__((ext_vector_type(2))); typedef __bf16 bf16x2_t __attribute__((ext_vector_type(2)));
__device__ __forceinline__ unsigned pk(float lo, float hi) { f32x2_t v = {lo, hi}; bf16x2_t b = __builtin_convertvector(v, bf16x2_t); return __builtin_bit_cast(unsigned, b); }
__device__ __forceinline__ bf16x8 cvt8(f32x4 a, f32x4 b) { u32x4 w; w.x = pk(a[0], a[1]); w.y = pk(a[2], a[3]); w.z = pk(b[0], b[1]); w.w = pk(b[2], b[3]); return __builtin_bit_cast(bf16x8, w); }
constexpr int PAST = 2048, NEWK = 16, LKEYS = PAST + NEWK, VT_STRIDE = 80, VT_BYTES = 64 * VT_STRIDE;
constexpr int L_VT = 0, L_CO = 8 * VT_BYTES, L_CM = L_CO + 8 * 16 * 64 * 4, L_CL = L_CM + 8 * 16 * 4, L_END = L_CL + 8 * 16 * 4;
constexpr float NEG = -1.0e30f;
struct Tensors { const float* ck; const float* cv; const unsigned short* QB; const unsigned short* KB; const unsigned short* VB; unsigned short* O; const float* CLS; };
__device__ __forceinline__ void tile_tail(f32x4 (&s)[2], const bf16x8 (&vw)[4], float& m, float& l, f32x4 (&o)[4], SLAS char* vt, int r, int g) {
    float mx = fmaxf(fmaxf(fmaxf(s[0][0], s[0][1]), fmaxf(s[0][2], s[0][3])), fmaxf(fmaxf(s[1][0], s[1][1]), fmaxf(s[1][2], s[1][3])));
    mx = fmaxf(mx, __shfl_xor(mx, 16)); mx = fmaxf(mx, __shfl_xor(mx, 32));
    const float mn = fmaxf(m, mx), alpha = __builtin_amdgcn_exp2f(m - mn); m = mn;
    float ps = 0.f;
#pragma unroll
    for (int j = 0; j < 2; ++j)
#pragma unroll
        for (int e = 0; e < 4; ++e) { s[j][e] = __builtin_amdgcn_exp2f(s[j][e] - mn); ps += s[j][e]; }
    l = l * alpha + ps;
#pragma unroll
    for (int db = 0; db < 4; ++db) o[db] *= alpha;
    const bf16x8 pb = cvt8(s[0], s[1]);
#pragma unroll
    for (int dd = 0; dd < 4; ++dd) *(SLAS bf16x8*)(vt + (4 * r + dd) * VT_STRIDE + g * 16) = vw[dd];
#pragma unroll
    for (int db = 0; db < 4; ++db) { const bf16x8 va = *(const SLAS bf16x8*)(vt + (16 * db + r) * VT_STRIDE + g * 16); o[db] = __builtin_amdgcn_mfma_f32_16x16x32_bf16(va, pb, o[db], 0, 0, 0); }
}
__device__ __forceinline__ void unit(int b, int h, const Tensors& T, SLAS char* lds) {
    const int tid = opaque_tid(), lane = tid & 63, r = lane & 15, g = lane >> 4; const int wid = __builtin_amdgcn_readfirstlane(tid >> 6);
    SLAS char* vt = lds + L_VT + wid * VT_BYTES;
    const size_t srow = (size_t)16384 + (size_t)b * 16;
    const float* cls = T.CLS + (size_t)(b * 16 + h) * LKEYS;
    const unsigned short* qp = T.QB + (srow + r) * 1024 + h * 64 + 8 * g;
    const bf16x8 qf0 = *(const bf16x8*)qp, qf1 = *(const bf16x8*)(qp + 32);
    const float cq = cls[PAST + r];
    float m = NEG, l = 0.f; f32x4 o[4];
#pragma unroll
    for (int db = 0; db < 4; ++db) o[db] = (f32x4){0.f, 0.f, 0.f, 0.f};
    const float* kc = T.ck + ((size_t)b * PAST * 16 + h) * 64; const float* vc = T.cv + ((size_t)b * PAST * 16 + h) * 64;
    for (int tI = 0; tI < 8; ++tI) {
        const int k0 = wid * 256 + tI * 32;
        bf16x8 ka[2][2];
#pragma unroll
        for (int j = 0; j < 2; ++j)
#pragma unroll
            for (int dh = 0; dh < 2; ++dh) { const float* p = kc + (size_t)(k0 + 16 * j + r) * 1024 + dh * 32 + 8 * g; ka[j][dh] = cvt8(*(const f32x4*)p, *(const f32x4*)(p + 4)); }
        f32x4 vv[2][4];
#pragma unroll
        for (int j = 0; j < 2; ++j)
#pragma unroll
            for (int e = 0; e < 4; ++e) vv[j][e] = *(const f32x4*)(vc + (size_t)(k0 + 16 * j + 4 * g + e) * 1024 + 4 * r);
        f32x4 ckv[2];
#pragma unroll
        for (int j = 0; j < 2; ++j) ckv[j] = *(const f32x4*)(cls + k0 + 16 * j + 4 * g);
        f32x4 s[2];
#pragma unroll
        for (int j = 0; j < 2; ++j) { s[j] = __builtin_amdgcn_mfma_f32_16x16x32_bf16(ka[j][0], qf0, (f32x4){0.f, 0.f, 0.f, 0.f}, 0, 0, 0); s[j] = __builtin_amdgcn_mfma_f32_16x16x32_bf16(ka[j][1], qf1, s[j], 0, 0, 0); }
#pragma unroll
        for (int j = 0; j < 2; ++j)
#pragma unroll
            for (int e = 0; e < 4; ++e) s[j][e] += cq - ckv[j][e];
        bf16x8 vw[4];
#pragma unroll
        for (int dd = 0; dd < 4; ++dd) { u32x4 w; w.x = pk(vv[0][0][dd], vv[0][1][dd]); w.y = pk(vv[0][2][dd], vv[0][3][dd]); w.z = pk(vv[1][0][dd], vv[1][1][dd]); w.w = pk(vv[1][2][dd], vv[1][3][dd]); vw[dd] = __builtin_bit_cast(bf16x8, w); }
        tile_tail(s, vw, m, l, o, vt, r, g);
    }
    if (wid == 0) {
        bf16x8 ka[2]; { const unsigned short* p = T.KB + (srow + r) * 1024 + h * 64 + 8 * g; ka[0] = *(const bf16x8*)p; ka[1] = *(const bf16x8*)(p + 32); }
        const f32x4 ckv = *(const f32x4*)(cls + PAST + 4 * g);
        f32x4 s[2];
        s[0] = __builtin_amdgcn_mfma_f32_16x16x32_bf16(ka[0], qf0, (f32x4){0.f, 0.f, 0.f, 0.f}, 0, 0, 0); s[0] = __builtin_amdgcn_mfma_f32_16x16x32_bf16(ka[1], qf1, s[0], 0, 0, 0);
#pragma unroll
        for (int e = 0; e < 4; ++e) { s[0][e] += cq - ckv[e]; if (4 * g + e > r) s[0][e] = NEG; s[1][e] = NEG; }
        unsigned short ve[4][4];
#pragma unroll
        for (int e = 0; e < 4; ++e) { const u32x2 w = *(const u32x2*)(T.VB + (srow + 4 * g + e) * 1024 + h * 64 + 4 * r); ve[e][0] = (unsigned short)(w.x & 0xffffu); ve[e][1] = (unsigned short)(w.x >> 16); ve[e][2] = (unsigned short)(w.y & 0xffffu); ve[e][3] = (unsigned short)(w.y >> 16); }
        bf16x8 vw[4];
#pragma unroll
        for (int dd = 0; dd < 4; ++dd) { u32x4 w; w.x = (unsigned)ve[0][dd] | ((unsigned)ve[1][dd] << 16); w.y = (unsigned)ve[2][dd] | ((unsigned)ve[3][dd] << 16); w.z = 0u; w.w = 0u; vw[dd] = __builtin_bit_cast(bf16x8, w); }
        tile_tail(s, vw, m, l, o, vt, r, g);
    }
    l += __shfl_xor(l, 16); l += __shfl_xor(l, 32);
    SLAS float* co = (SLAS float*)(lds + L_CO) + (wid * 16 + r) * 64; SLAS float* cm = (SLAS float*)(lds + L_CM); SLAS float* cl = (SLAS float*)(lds + L_CL);
#pragma unroll
    for (int db = 0; db < 4; ++db) *(SLAS f32x4*)(co + 16 * db + 4 * g) = o[db];
    if (g == 0) { cm[wid * 16 + r] = m; cl[wid * 16 + r] = l; }
    __syncthreads();
    { const int q = tid >> 5, d2 = (tid & 31) * 2; float mm = NEG;
#pragma unroll
      for (int w = 0; w < 8; ++w) mm = fmaxf(mm, cm[w * 16 + q]);
      float den = 0.f, n0 = 0.f, n1 = 0.f;
#pragma unroll
      for (int w = 0; w < 8; ++w) { const float f = __builtin_amdgcn_exp2f(cm[w * 16 + q] - mm); den += f * cl[w * 16 + q]; const SLAS float* c = (const SLAS float*)(lds + L_CO) + (w * 16 + q) * 64 + d2; n0 += f * c[0]; n1 += f * c[1]; }
      const float inv = 1.0f / den;
      *(unsigned*)(T.O + (srow + q) * 1024 + h * 64 + d2) = pk(n0 * inv, n1 * inv); }
    __syncthreads();
}
#undef SLAS
}
namespace cg = cooperative_groups;
constexpr int NWAVES = 8;
constexpr int D = 1024, H = 16, FF = 4096, MP = 16384, MS = 512, M = MP + MS, PAST = 2048, DBATCH = 32, DSEQ = 16, LKEYS = PAST + DSEQ;
constexpr float RMS_EPS = 1e-6f, L2E = 1.4426950408889634f, QSCALE = 0.125f * 1.4426950408889634f;
constexpr size_t OUT_Y = 0, OUT_KP = 17301504, OUT_VP = 34078720, OUT_LP = 50855936, OUT_CP = 51118080, OUT_KS = 51122176, OUT_VS = 51646464, OUT_LS = 52170752, OUT_CS = 52178944, OUT_END = 52310016;
static_assert(OUT_KP == (size_t)pg8::OUT_KP && OUT_VP == (size_t)pg8::OUT_VP && OUT_KS == (size_t)pg8::OUT_KS && OUT_VS == (size_t)pg8::OUT_VS, "d_out map");
constexpr size_t MiB = 1u << 20;
constexpr size_t WS_CTL = 0, CTL_ZERO_BYTES = 1 * MiB;
constexpr size_t WS_WIN = 2 * MiB, WS_WOUT = 14 * MiB, WS_WKVQ = 18 * MiB, WS_WQ1 = 24 * MiB, WS_WO = 26 * MiB, WS_WUP = 30 * MiB, WS_WDN = 62 * MiB, WS_WF = 94 * MiB;
constexpr size_t WS_X = 96 * MiB, WS_XB = 162 * MiB, WS_G = 195 * MiB, WS_KB = 228 * MiB, WS_VB = 261 * MiB, WS_QB = 294 * MiB, WS_HB = 327 * MiB, WS_SSQ = 459 * MiB, WS_CLP = 461 * MiB, WS_CLS = 462 * MiB, WS_END = 467 * MiB;
static_assert((size_t)M * D * 4 == 66 * MiB && (size_t)M * FF * 2 == 132 * MiB && (size_t)512 * LKEYS * 4 <= 5 * MiB, "d_ws map");
constexpr int CW_BAR = 4096, CW_KMAX = 2048;
constexpr int RING_OFF = 0, RING_BYTES = 131072;
constexpr int ATT_LDS = attn_body::LDS_BYTES;
constexpr int LDSCTL_OFF = (ATT_LDS > RING_BYTES ? ATT_LDS : RING_BYTES), MISC_OFF = LDSCTL_OFF + 320;
constexpr int LDS_BYTES = LDSCTL_OFF + 1024;
static_assert(LDS_BYTES <= 163840 && sattn::L_END <= RING_BYTES, "LDS map");

#define GAS __attribute__((address_space(1)))
#define LAS __attribute__((address_space(3)))
typedef unsigned short bf16;
typedef unsigned v4u __attribute__((ext_vector_type(4)));
typedef unsigned v2u __attribute__((ext_vector_type(2)));
typedef float f32x4 __attribute__((ext_vector_type(4)));
typedef short bf16x8 __attribute__((ext_vector_type(8)));
typedef GAS unsigned gu32;
#define RLX_AGENT __ATOMIC_RELAXED, __HIP_MEMORY_SCOPE_AGENT
#define LDS_WAIT() asm volatile("s_waitcnt lgkmcnt(0)" ::: "memory")
#define VM_WAIT() asm volatile("s_waitcnt vmcnt(0)" ::: "memory")
__device__ __forceinline__ unsigned pk2(float lo, float hi) { return sattn::pk(lo, hi); }
__device__ __forceinline__ float bflo(unsigned w) { return __builtin_bit_cast(float, w << 16); }
__device__ __forceinline__ float bfhi(unsigned w) { return __builtin_bit_cast(float, w & 0xffff0000u); }
#define XB_TMO      128
#define XB_XCNT(j)  (256  + 64 * (j))
#define XB_XSUB(j)  (1280 + 64 * (j))
#define XB_XGEN(j)  (2304 + 64 * (j))
#define XB_TOP      3328
#define XB_TOPGEN   3392
#define XCD_BAR_WORDS 3456
#define XB_SPIN_CAP (1u << 18)

__device__ __forceinline__ unsigned xb_ld(unsigned* p)              { return __hip_atomic_load(p, __ATOMIC_RELAXED, __HIP_MEMORY_SCOPE_AGENT); }
__device__ __forceinline__ unsigned xb_add(unsigned* p, unsigned v) { return __hip_atomic_fetch_add(p, v, __ATOMIC_RELAXED, __HIP_MEMORY_SCOPE_AGENT); }
__device__ __forceinline__ unsigned xb_xcc_id() { return (unsigned)__builtin_amdgcn_s_getreg((3 << 11) | 20) & 0xFu; }
#define XB_SPIN(cond, bar) do { unsigned _sp = 0; while (cond) { __builtin_amdgcn_s_sleep(1); \
    if ((++_sp & 255u) == 0u) { if (xb_ld(&(bar)[XB_TMO])) break; if (_sp > XB_SPIN_CAP) { atomicAdd(&(bar)[XB_TMO], 1u); break; } } } } while (0)

struct XcdBarrier {
    unsigned* bar; unsigned x;
    volatile LAS unsigned* st;
};

__device__ __forceinline__ XcdBarrier xcd_barrier_post(unsigned* bar, volatile LAS unsigned* st) {
    XcdBarrier b; b.bar = bar; b.x = xb_xcc_id(); b.st = st;
    if (threadIdx.x == 0) (void)xb_add(&bar[XB_XCNT(b.x)], 1u);
    return b;
}
__device__ __forceinline__ void xcd_barrier_complete(unsigned* bar, unsigned x, unsigned& nloc, unsigned& nx) {
    const unsigned G = gridDim.x * gridDim.y * gridDim.z;
    unsigned sum, cnt, mine, sp = 0u;
    for (;;) {
        sum = 0u; cnt = 0u; mine = 0u;
#pragma unroll
        for (unsigned j = 0; j < 16; ++j) { const unsigned c = xb_ld(&bar[XB_XCNT(j)]); sum += c; cnt += (c > 0u) ? 1u : 0u; mine = (j == x) ? c : mine; }
        if (sum == G) break;
        __builtin_amdgcn_s_sleep(1);
        if ((++sp & 255u) == 0u) { if (xb_ld(&bar[XB_TMO])) break; if (sp > XB_SPIN_CAP) { atomicAdd(&bar[XB_TMO], 1u); break; } }
    }
    nloc = mine > 0u ? mine : 1u; nx = cnt > 0u ? cnt : 1u;
}

__device__ __forceinline__ void xcd_barrier(const XcdBarrier& b) {
    asm volatile("s_waitcnt vmcnt(0)" ::: "memory");
    __syncthreads();
    if (threadIdx.x == 0) {
        unsigned* bar = b.bar;
        __builtin_amdgcn_s_waitcnt(0);
        unsigned nloc = b.st[0], nx = b.st[1];
        if (nloc == 0u) { xcd_barrier_complete(bar, b.x, nloc, nx); b.st[0] = nloc; b.st[1] = nx; }
        const unsigned old = xb_add(&bar[XB_XSUB(b.x)], 1u);
        const unsigned gen = old / nloc;
        if (old + 1u == (gen + 1u) * nloc) {
            __builtin_amdgcn_fence(__ATOMIC_RELEASE, "agent");
            asm volatile("s_waitcnt vmcnt(0)" ::: "memory");
            const unsigned og = xb_add(&bar[XB_TOP], 1u);
            const unsigned tg = og / nx;
            if (og + 1u == (tg + 1u) * nx) xb_add(&bar[XB_TOPGEN], 1u);
            else XB_SPIN(xb_ld(&bar[XB_TOPGEN]) == tg, bar);
            __builtin_amdgcn_fence(__ATOMIC_ACQUIRE, "agent");
            xb_add(&bar[XB_XGEN(b.x)], 1u);
            asm volatile("s_waitcnt vmcnt(0)" ::: "memory");
        } else {
            XB_SPIN(xb_ld(&bar[XB_XGEN(b.x)]) == gen, bar);
            __builtin_amdgcn_fence(__ATOMIC_ACQUIRE, "agent");
            asm volatile("s_waitcnt vmcnt(0)" ::: "memory");
        }
    }
    __syncthreads();
}
struct Args { const float* in[21]; float* out; unsigned char* ws; };
typedef const __attribute__((address_space(4))) Args* KArgs;
__device__ __forceinline__ KArgs kargs() { KArgs p = (KArgs)__builtin_amdgcn_kernarg_segment_ptr(); asm volatile("" : "+s"(p)); return p; }
struct Frame {
    LAS unsigned char* lds; volatile LAS unsigned* MISC; gu32* ctl;
    int tid, lane, wave, vcu, G;
};
__device__ __forceinline__ float wave_sum(float v) {
#pragma unroll
    for (int o = 1; o < 64; o <<= 1) v += __shfl_xor(v, o);
    return v;
}
__device__ __forceinline__ void p0_transpose_item(const float* W, int K, int N, bf16* WT, int row_off, LAS float* scr, int item, int lane, const float* gain, float scale) {
    const int nblk = N / 32, kb = item / nblk, nb = item % nblk, k0 = 64 * kb, n0 = 32 * nb;
#pragma unroll 8
    for (int i = 0; i < 32; ++i) { const int kk = 2 * i + (lane >> 5); const float gsc = gain ? gain[k0 + kk] * scale : scale; scr[kk * 33 + (lane & 31)] = W[(size_t)(k0 + kk) * N + n0 + (lane & 31)] * gsc; }
    LDS_WAIT(); asm volatile("" ::: "memory");
    const int c = lane & 7;
#pragma unroll
    for (int j = 0; j < 4; ++j) { const int n = (lane >> 3) + 8 * j; const LAS float* s = scr + (8 * c) * 33 + n;
        v4u o; o.x = pk2(s[0 * 33], s[1 * 33]); o.y = pk2(s[2 * 33], s[3 * 33]); o.z = pk2(s[4 * 33], s[5 * 33]); o.w = pk2(s[6 * 33], s[7 * 33]);
        *(GAS v4u*)(WT + (size_t)(row_off + n0 + n) * K + k0 + 8 * c) = o; }
    LDS_WAIT(); asm volatile("" ::: "memory");
}
enum { I_XP = 0, I_XS, I_CK, I_CV, I_CLF, I_SC, I_NMIX, I_NMLP, I_CIN, I_CW, I_COUT, I_NKV, I_WK, I_WV, I_WF, I_BF, I_WQ, I_WO, I_UP, I_DN, I_NF };

__device__ __forceinline__ void p0_prologue(const Frame& F, KArgs a, unsigned char* ws) {
    const int T_tid = opaque_tid(), T_lane = T_tid & 63, T_wave = __builtin_amdgcn_readfirstlane(T_tid >> 6);
    LAS float* scr = (LAS float*)(F.lds + RING_OFF + T_wave * 16384);
    const int gw = F.vcu * NWAVES + T_wave, NGW = F.G * NWAVES;
    constexpr int NCHUNK = 46;
    for (int it = gw; it < NCHUNK * 512; it += NGW) {
        int c = it >> 9, base = 0; const float* src = nullptr; const float* gain = nullptr; bf16* dst = nullptr; int roff = 0, K = D, N = D; float sc = 1.f;
        if (c < 6) { const int l = c / 3; src = a->in[I_CIN] + (size_t)l * D * 3 * D; gain = a->in[I_NMIX] + l * D; dst = (bf16*)(ws + WS_WIN) + (size_t)l * 3 * D * D; N = 3 * D; base = l * 3; }
        else if (c < 8) { const int l = c - 6; src = a->in[I_COUT] + (size_t)l * D * D; dst = (bf16*)(ws + WS_WOUT) + (size_t)l * D * D; base = c; }
        else if (c < 9) { src = a->in[I_WK]; gain = a->in[I_NKV]; dst = (bf16*)(ws + WS_WKVQ); base = c; }
        else if (c < 10) { src = a->in[I_WV]; gain = a->in[I_NKV]; dst = (bf16*)(ws + WS_WKVQ); roff = D; base = c; }
        else if (c < 11) { src = a->in[I_WQ]; gain = a->in[I_NMIX] + 2 * D; dst = (bf16*)(ws + WS_WKVQ); roff = 2 * D; sc = QSCALE; base = c; }
        else if (c < 12) { src = a->in[I_WQ] + (size_t)D * D; gain = a->in[I_NMIX] + 3 * D; dst = (bf16*)(ws + WS_WQ1); sc = QSCALE; base = c; }
        else if (c < 14) { const int j = c - 12; src = a->in[I_WO] + (size_t)j * D * D; dst = (bf16*)(ws + WS_WO) + (size_t)j * D * D; base = c; }
        else if (c < 30) { const int l = (c - 14) >> 2; src = a->in[I_UP] + (size_t)l * D * FF; gain = a->in[I_NMLP] + l * D; dst = (bf16*)(ws + WS_WUP) + (size_t)l * D * FF; N = FF; base = 14 + 4 * l; }
        else { const int l = (c - 30) >> 2; src = a->in[I_DN] + (size_t)l * D * FF; dst = (bf16*)(ws + WS_WDN) + (size_t)l * D * FF; K = FF; base = 30 + 4 * l; }
        p0_transpose_item(src, K, N, dst, roff, scr, it - base * 512, T_lane, gain, sc);
    }
    for (int i = (F.vcu * NWAVES + T_wave) * 64 + T_lane; i < D * H; i += NGW * 64) { const int k = i >> 4, h = i & 15; ((bf16*)(ws + WS_WF))[h * D + k] = (bf16)(pk2(a->in[I_NKV][k] * a->in[I_WF][i], 0.f) & 0xffffu); }
    float* X = (float*)(ws + WS_X); bf16* XB = (bf16*)(ws + WS_XB); float* SSQ = (float*)(ws + WS_SSQ);
    for (int m = gw; m < M; m += NGW) {
        const float* xr = (m < MP) ? a->in[I_XP] + (size_t)m * D : a->in[I_XS] + (size_t)(m - MP) * D;
        const GAS f32x4* xp = (const GAS f32x4*)xr + T_lane; f32x4 v[4]; float s = 0.f;
#pragma unroll
        for (int j = 0; j < 4; ++j) { v[j] = xp[64 * j]; s += (v[j].x * v[j].x + v[j].y * v[j].y) + (v[j].z * v[j].z + v[j].w * v[j].w); }
        s = wave_sum(s);
        GAS f32x4* xo = (GAS f32x4*)(X + (size_t)m * D) + T_lane; GAS v2u* bo = (GAS v2u*)(XB + (size_t)m * D) + T_lane;
#pragma unroll
        for (int j = 0; j < 4; ++j) { xo[64 * j] = v[j]; v2u w; w.x = pk2(v[j].x, v[j].y); w.y = pk2(v[j].z, v[j].w); bo[64 * j] = w; }
        if (T_lane < 16) SSQ[(size_t)m * 16 + T_lane] = (T_lane == 0) ? s : 0.f;
    }
}
__device__ __forceinline__ void conv_gate_phase(const Frame& F, KArgs a, unsigned char* ws, int l) {
    const int T_tid = opaque_tid(), T_lane = T_tid & 63, T_wave = __builtin_amdgcn_readfirstlane(T_tid >> 6);
    const int gw = F.vcu * NWAVES + T_wave, NGW = F.G * NWAVES;
    const bf16* BCX = (const bf16*)(ws + WS_HB); bf16* Gm = (bf16*)(ws + WS_G);
    const float* cw = a->in[I_CW] + (size_t)l * 3 * D;
    for (int it = gw; it < (M / 8) * 2; it += NGW) {
        const int half = it & 1, row0 = (it >> 1) * 8, c0 = half * 512 + T_lane * 8;
        float w0[8], w1[8], w2[8], um2[8], um1[8];
        { const f32x4 a0 = *(const f32x4*)(cw + c0), a1 = *(const f32x4*)(cw + c0 + 4), b0 = *(const f32x4*)(cw + D + c0), b1 = *(const f32x4*)(cw + D + c0 + 4), d0 = *(const f32x4*)(cw + 2 * D + c0), d1 = *(const f32x4*)(cw + 2 * D + c0 + 4);
#pragma unroll
          for (int e = 0; e < 4; ++e) { w0[e] = a0[e]; w0[4 + e] = a1[e]; w1[e] = b0[e]; w1[4 + e] = b1[e]; w2[e] = d0[e]; w2[4 + e] = d1[e]; } }
        const bool sample = row0 >= MP; const int sb = sample ? (row0 - MP) >> 4 : 0; const int t0 = sample ? (row0 - MP) & 15 : row0;
        if (t0 == 0) {
            if (sample) { const float* st = a->in[I_SC] + ((size_t)(l * DBATCH + sb) * 2) * D + c0;
                const f32x4 p0 = *(const f32x4*)st, p1 = *(const f32x4*)(st + 4), q0 = *(const f32x4*)(st + D), q1 = *(const f32x4*)(st + D + 4);
#pragma unroll
                for (int e = 0; e < 4; ++e) { um2[e] = p0[e]; um2[4 + e] = p1[e]; um1[e] = q0[e]; um1[4 + e] = q1[e]; } }
            else {
#pragma unroll
                for (int e = 0; e < 8; ++e) { um2[e] = 0.f; um1[e] = 0.f; } }
        } else {
#pragma unroll
            for (int k = 0; k < 2; ++k) { const bf16* rp = BCX + (size_t)(row0 - 2 + k) * 3072 + c0; const v4u gc = *(const v4u*)(rp + D), xv = *(const v4u*)(rp + 2 * D);
#pragma unroll
                for (int e = 0; e < 4; ++e) { const float u0 = bflo(gc[e]) * bflo(xv[e]), u1 = bfhi(gc[e]) * bfhi(xv[e]); if (k == 0) { um2[2 * e] = u0; um2[2 * e + 1] = u1; } else { um1[2 * e] = u0; um1[2 * e + 1] = u1; } } }
        }
#pragma unroll
        for (int i = 0; i < 8; ++i) { const bf16* rp = BCX + (size_t)(row0 + i) * 3072 + c0; const v4u gb = *(const v4u*)rp, gc = *(const v4u*)(rp + D), xv = *(const v4u*)(rp + 2 * D);
            float u[8], o[8];
#pragma unroll
            for (int e = 0; e < 4; ++e) { u[2 * e] = bflo(gc[e]) * bflo(xv[e]); u[2 * e + 1] = bfhi(gc[e]) * bfhi(xv[e]); }
#pragma unroll
            for (int e = 0; e < 8; ++e) o[e] = w0[e] * um2[e] + w1[e] * um1[e] + w2[e] * u[e];
            v4u w;
#pragma unroll
            for (int e = 0; e < 4; ++e) w[e] = pk2(bflo(gb[e]) * o[2 * e], bfhi(gb[e]) * o[2 * e + 1]);
            *(v4u*)(Gm + (size_t)(row0 + i) * D + c0) = w;
#pragma unroll
            for (int e = 0; e < 8; ++e) { um2[e] = um1[e]; um1[e] = u[e]; } }
        const bool last = sample ? (t0 == 8) : (row0 + 8 == MP);
        if (last) { float* o = a->out + (sample ? OUT_CS + ((size_t)(l * DBATCH + sb) * 2) * D : OUT_CP + (size_t)l * 2 * D) + c0;
            *(f32x4*)o = (f32x4){um2[0], um2[1], um2[2], um2[3]}; *(f32x4*)(o + 4) = (f32x4){um2[4], um2[5], um2[6], um2[7]};
            *(f32x4*)(o + D) = (f32x4){um1[0], um1[1], um1[2], um1[3]}; *(f32x4*)(o + D + 4) = (f32x4){um1[4], um1[5], um1[6], um1[7]}; }
    }
}
__device__ __forceinline__ void logf_phase(const Frame& F, KArgs a, unsigned char* ws) {
    const int T_tid = opaque_tid(), T_lane = T_tid & 63, T_wave = __builtin_amdgcn_readfirstlane(T_tid >> 6);
    const int gw = F.vcu * NWAVES + T_wave, NGW = F.G * NWAVES; const int r = T_lane & 15, g = T_lane >> 4;
    const bf16* WF = (const bf16*)(ws + WS_WF); const bf16* XB = (const bf16*)(ws + WS_XB); const float* SSQ = (const float*)(ws + WS_SSQ);
    for (int blk = gw; blk < M / 16; blk += NGW) {
        const int row = blk * 16 + r; f32x4 acc = (f32x4){0.f, 0.f, 0.f, 0.f};
        const bf16* ap = WF + (size_t)r * D + 8 * g; const bf16* bp = XB + (size_t)row * D + 8 * g;
#pragma unroll 8
        for (int s = 0; s < 32; ++s) acc = __builtin_amdgcn_mfma_f32_16x16x32_bf16(*(const bf16x8*)(ap + 32 * s), *(const bf16x8*)(bp + 32 * s), acc, 0, 0, 0);
        const float rs = pg8::row_rstd(SSQ, row); const f32x4 bfv = *(const f32x4*)(a->in[I_BF] + 4 * g); f32x4 o;
#pragma unroll
        for (int e = 0; e < 4; ++e) { const float z = acc[e] * rs + bfv[e]; o[e] = fminf(z, 0.f) - log1pf(expf(-fabsf(z))); }
        float* op = a->out + ((row < MP) ? OUT_LP + (size_t)row * 16 : OUT_LS + (size_t)(row - MP) * 16) + 4 * g;
        *(f32x4*)op = o;
    }
}
__device__ __forceinline__ double wave_scan_incl(double v, int lane) {
#pragma unroll
    for (int o = 1; o < 64; o <<= 1) { const double t = __shfl_up(v, o); if (lane >= o) v += t; }
    return v;
}
__device__ __forceinline__ void scan_phase(const Frame& F, KArgs a, unsigned char* ws) {
    const int T_tid = opaque_tid(), T_lane = T_tid & 63, T_wave = __builtin_amdgcn_readfirstlane(T_tid >> 6);
    float* CLP = (float*)(ws + WS_CLP); float* CLS = (float*)(ws + WS_CLS);
    const int blk = blockIdx.x;
    if (blk < 16) {
        const int h = blk; const float* lf = a->out + OUT_LP; const int t0 = T_tid * 32; double s = 0.0;
#pragma unroll 8
        for (int i = 0; i < 32; ++i) s += (double)lf[(size_t)(t0 + i) * 16 + h];
        const double inc = wave_scan_incl(s, T_lane);
        LAS double* wt = (LAS double*)(F.lds + RING_OFF);
        if (T_lane == 63) wt[T_wave] = inc;
        __syncthreads();
        double run = inc - s;
        for (int w = 0; w < T_wave; ++w) run += wt[w];
#pragma unroll 8
        for (int i = 0; i < 32; ++i) { run += (double)lf[(size_t)(t0 + i) * 16 + h]; CLP[(size_t)h * MP + t0 + i] = (float)(run * (double)L2E); }
        __syncthreads();
    } else {
        const int nws = (F.G - 16) * NWAVES;
        for (int seq = (blk - 16) * NWAVES + T_wave; seq < DBATCH * H; seq += nws) {
            const int b = seq >> 4, h = seq & 15; const float* clf = a->in[I_CLF] + (size_t)b * PAST * 16 + h; const float* nlf = a->out + OUT_LS + (size_t)b * DSEQ * 16 + h;
            const int s0 = T_lane * 33; double s = 0.0;
            for (int i = 0; i < 33; ++i) { const int k = s0 + i; if (k < LKEYS) s += (double)(k < PAST ? clf[(size_t)k * 16] : nlf[(size_t)(k - PAST) * 16]); }
            double run = wave_scan_incl(s, T_lane) - s;
            for (int i = 0; i < 33; ++i) { const int k = s0 + i; if (k < LKEYS) { run += (double)(k < PAST ? clf[(size_t)k * 16] : nlf[(size_t)(k - PAST) * 16]); CLS[(size_t)seq * LKEYS + k] = (float)(run * (double)L2E); } }
        }
    }
    { const int gw = F.vcu * NWAVES + T_wave, NGW = F.G * NWAVES; const bf16* KB = (const bf16*)(ws + WS_KB); float mx = 0.f;
      for (int row = gw; row < MP; row += NGW) { const v4u p = *(const v4u*)(KB + (size_t)row * D + T_lane * 16), q = *(const v4u*)(KB + (size_t)row * D + T_lane * 16 + 8); float sq = 0.f;
#pragma unroll
          for (int e = 0; e < 4; ++e) { const float a0 = bflo(p[e]), a1 = bfhi(p[e]), b0 = bflo(q[e]), b1 = bfhi(q[e]); sq += (a0 * a0 + a1 * a1) + (b0 * b0 + b1 * b1); }
          sq += __shfl_xor(sq, 1); sq += __shfl_xor(sq, 2); mx = fmaxf(mx, sq); }
      __syncthreads();
      LAS float* km = (LAS float*)(F.lds + RING_OFF) + 64;
      if ((T_lane & 3) == 0) km[T_wave * 16 + (T_lane >> 2)] = mx;
      __syncthreads();
      if (T_tid < 16) { float m = km[T_tid];
#pragma unroll
          for (int w = 1; w < NWAVES; ++w) m = fmaxf(m, km[w * 16 + T_tid]);
          atomicMax((unsigned*)(ws + WS_CTL) + CW_KMAX + T_tid, __builtin_bit_cast(unsigned, m)); }
      __syncthreads(); }
}
__device__ __forceinline__ void final_norm_phase(const Frame& F, KArgs a, unsigned char* ws) {
    const int T_tid = opaque_tid(), T_lane = T_tid & 63, T_wave = __builtin_amdgcn_readfirstlane(T_tid >> 6);
    const int gw = F.vcu * NWAVES + T_wave, NGW = F.G * NWAVES; const float* X = (const float*)(ws + WS_X);
    const GAS f32x4* gp = (const GAS f32x4*)a->in[I_NF] + T_lane; f32x4 gn[4];
#pragma unroll
    for (int j = 0; j < 4; ++j) gn[j] = gp[64 * j];
    for (int m = gw; m < M; m += NGW) {
        const GAS f32x4* xp = (const GAS f32x4*)(X + (size_t)m * D) + T_lane; f32x4 v[4]; float s = 0.f;
#pragma unroll
        for (int j = 0; j < 4; ++j) { v[j] = xp[64 * j]; s += (v[j].x * v[j].x + v[j].y * v[j].y) + (v[j].z * v[j].z + v[j].w * v[j].w); }
        const float rs = 1.0f / sqrtf(wave_sum(s) * (1.0f / D) + RMS_EPS);
        GAS f32x4* op = (GAS f32x4*)(a->out + OUT_Y + (size_t)m * D) + T_lane;
#pragma unroll
        for (int j = 0; j < 4; ++j) op[64 * j] = v[j] * rs * gn[j];
    }
}

__global__ void __launch_bounds__(NWAVES * 64, 2) yoco_fwd(Args args) {
    extern __shared__ __attribute__((aligned(16))) unsigned char lds[];
    Frame F;
    F.lds = (LAS unsigned char*)lds;
    F.MISC = (volatile LAS unsigned*)(F.lds + MISC_OFF);
    F.tid = threadIdx.x; F.lane = F.tid & 63; F.wave = __builtin_amdgcn_readfirstlane(F.tid >> 6);
    F.G = gridDim.x; { const int bx = blockIdx.x; F.vcu = (F.G % 8 == 0) ? (bx % 8) * (F.G / 8) + bx / 8 : bx; }
    F.ctl = (gu32*)(kargs()->ws + WS_CTL);
    for (int u = F.tid; u < (LDS_BYTES - LDSCTL_OFF) / 4; u += NWAVES * 64) ((LAS unsigned*)(F.lds + LDSCTL_OFF))[u] = 0u;
    __syncthreads();
    XcdBarrier bar = xcd_barrier_post((unsigned*)(F.ctl + CW_BAR), F.MISC + 8);
#define GRID_BAR() xcd_barrier(bar)
#define WSP(T, off) ((T*)(kargs()->ws + (off)))

    p0_prologue(F, kargs(), kargs()->ws);
    cg::this_grid().sync();
    GRID_BAR();

#define LAYER(l) do { \
        if ((l) != 2) { \
            constexpr bool cv = (l) < 2; unsigned char* ws = kargs()->ws; \
            pg8::Gemm g{(const bf16*)(ws + WS_XB), cv ? (const bf16*)(ws + WS_WIN) + (size_t)(l) * 3 * D * D : (const bf16*)(ws + WS_WQ1), M, cv ? 3 * D : D, D}; \
            pg8::StaticOrder S; S.init(M, cv ? 3 * D : D, F.G, opaque_bid()); \
            pg8::EpiAct<0, false> E{cv ? (bf16*)(ws + WS_HB) : (bf16*)(ws + WS_QB), cv ? 3 * D : D, (const float*)(ws + WS_SSQ), 0, 0, nullptr}; \
            pg8::gemm_phase<pg8::EpiAct<0, false>, pg8::StaticOrder, PG8_ALIGN, PG8_SP2>(F.lds + RING_OFF, g, S, E); \
            GRID_BAR(); \
        } \
        if ((l) < 2) { conv_gate_phase(F, kargs(), kargs()->ws, (l)); } \
        else { \
            { unsigned char* ws = kargs()->ws; \
            const attn_body::AttnTensors AT{(const attn_body::bf16*)(ws + WS_QB), (const attn_body::bf16*)(ws + WS_KB), (const attn_body::bf16*)(ws + WS_VB), (attn_body::bf16*)(ws + WS_G), (const float*)(ws + WS_CLP), (const unsigned*)(ws + WS_CTL) + CW_KMAX}; \
            const attn_body::StaticOrder S((int)F.G, opaque_bid()); \
            attn_body::attn_phase<attn_body::StaticOrder>((char*)lds + RING_OFF, AT, S); } \
            __syncthreads(); \
            KArgs ka = kargs(); unsigned char* ws = ka->ws; \
            const sattn::Tensors ST{ka->in[I_CK], ka->in[I_CV], (const bf16*)(ws + WS_QB), (const bf16*)(ws + WS_KB), (const bf16*)(ws + WS_VB), (bf16*)(ws + WS_G), (const float*)(ws + WS_CLS)}; \
            for (int u = F.vcu; u < DBATCH * H; u += F.G) sattn::unit(u >> 4, u & 15, ST, (LAS char*)(F.lds + RING_OFF)); \
        } \
        GRID_BAR(); \
        { unsigned char* ws = kargs()->ws; \
            pg8::Gemm g{(const bf16*)(ws + WS_G), ((l) < 2) ? (const bf16*)(ws + WS_WOUT) + (size_t)(l) * D * D : (const bf16*)(ws + WS_WO) + (size_t)((l) - 2) * D * D, M, D, D}; \
            pg8::StaticOrder S; S.init(M, D, F.G, opaque_bid()); \
            pg8::EpiResid E{(float*)(ws + WS_X), (bf16*)(ws + WS_XB), (float*)(ws + WS_SSQ)}; \
            pg8::gemm_phase<pg8::EpiResid, pg8::StaticOrder, PG8_ALIGN, PG8_SP2>(F.lds + RING_OFF, g, S, E); \
            GRID_BAR(); } \
        { unsigned char* ws = kargs()->ws; \
            pg8::Gemm g{(const bf16*)(ws + WS_XB), (const bf16*)(ws + WS_WUP) + (size_t)(l) * D * FF, M, FF, D}; \
            pg8::StaticOrder S; S.init(M, FF, F.G, opaque_bid()); \
            pg8::EpiAct<1, false> E{(bf16*)(ws + WS_HB), FF, (const float*)(ws + WS_SSQ), 0, 0, nullptr}; \
            pg8::gemm_phase<pg8::EpiAct<1, false>, pg8::StaticOrder, PG8_ALIGN, PG8_SP2>(F.lds + RING_OFF, g, S, E); \
            GRID_BAR(); } \
        { unsigned char* ws = kargs()->ws; \
            pg8::Gemm g{(const bf16*)(ws + WS_HB), (const bf16*)(ws + WS_WDN) + (size_t)(l) * D * FF, M, D, FF}; \
            pg8::StaticOrder S; S.init(M, D, F.G, opaque_bid()); \
            pg8::EpiResid E{(float*)(ws + WS_X), (bf16*)(ws + WS_XB), (float*)(ws + WS_SSQ)}; \
            pg8::gemm_phase<pg8::EpiResid, pg8::StaticOrder, PG8_ALIGN, PG8_SP2>(F.lds + RING_OFF, g, S, E); \
            GRID_BAR(); } \
        if ((l) == 1) { \
            KArgs ka = kargs(); unsigned char* ws = ka->ws; \
            pg8::Gemm g{(const bf16*)(ws + WS_XB), (const bf16*)(ws + WS_WKVQ), M, 3 * D, D}; \
            pg8::StaticOrder S; S.init(M, 3 * D, F.G, opaque_bid()); \
            pg8::EpiAct<0, true> E{(bf16*)(ws + WS_KB), D, (const float*)(ws + WS_SSQ), D, (size_t)(WS_VB - WS_KB) / 2, ka->out}; \
            pg8::gemm_phase<pg8::EpiAct<0, true>, pg8::StaticOrder, PG8_ALIGN, PG8_SP2>(F.lds + RING_OFF, g, S, E); \
            logf_phase(F, kargs(), kargs()->ws); \
            GRID_BAR(); \
            scan_phase(F, kargs(), kargs()->ws); \
            GRID_BAR(); \
        } } while (0)
    LAYER(0); LAYER(1); LAYER(2); LAYER(3);
    final_norm_phase(F, kargs(), kargs()->ws);
}

extern "C" void kernel_launch(void* const* d_in, const int* in_sizes, int n_in, void* d_out, int out_size, void* d_ws, size_t ws_size, hipStream_t stream) {
    static int grid = 0;
    if (grid == 0) {
        if (n_in != 21 || out_size != (int)OUT_END || ws_size < WS_END) { fprintf(stderr, "kernel_launch: unexpected sizes (n_in %d, out %d, ws %zu); nothing launched\n", n_in, out_size, ws_size); grid = -1; return; }
        int dev = 0, cus = 0, per_cu = 0;
        if (hipGetDevice(&dev) != hipSuccess || hipDeviceGetAttribute(&cus, hipDeviceAttributeMultiprocessorCount, dev) != hipSuccess) { grid = -1; return; }
        if (hipFuncSetAttribute((const void*)yoco_fwd, hipFuncAttributeMaxDynamicSharedMemorySize, LDS_BYTES) != hipSuccess) { fprintf(stderr, "kernel_launch: hipFuncSetAttribute failed\n"); grid = -1; return; }
        if (hipOccupancyMaxActiveBlocksPerMultiprocessor(&per_cu, (const void*)yoco_fwd, NWAVES * 64, LDS_BYTES) != hipSuccess || per_cu < 1) { fprintf(stderr, "kernel_launch: occupancy query says %d\n", per_cu); per_cu = 1; }
        (void)hipGetLastError();
        grid = cus;
    }
    if (grid < 0) return;
    if (hipMemsetAsync((char*)d_ws + WS_CTL, 0, CTL_ZERO_BYTES, stream) != hipSuccess) { fprintf(stderr, "kernel_launch: memset failed\n"); return; }
    Args a{};
    for (int i = 0; i < 21; ++i) a.in[i] = (const float*)d_in[i];
    a.out = (float*)d_out; a.ws = (unsigned char*)d_ws;
    void* kargv[] = {&a};
    const hipError_t e = hipLaunchCooperativeKernel((const void*)yoco_fwd, dim3(grid), dim3(NWAVES * 64), kargv, LDS_BYTES, stream);
    if (e != hipSuccess) fprintf(stderr, "kernel_launch: cooperative launch failed: %s (grid %d)\n", hipGetErrorString(e), grid);
}
```

```cpp
#include <hip/hip_runtime.h>
#include <hip/hip_cooperative_groups.h>
#include <cstdio>
#include <cstdint>
__device__ __forceinline__ int opaque_bid() { int b = (int)blockIdx.x; asm volatile("" : "+s"(b)); return b; }
__device__ __forceinline__ int opaque_tid() { int t = (int)threadIdx.x; asm volatile("" : "+v"(t)); return t; }
namespace pg8 {
#define PG8_LAS __attribute__((address_space(3)))
typedef unsigned short bf16_t;
typedef short bf16x8 __attribute__((ext_vector_type(8)));
typedef float f32x4 __attribute__((ext_vector_type(4)));
typedef unsigned u32x4 __attribute__((ext_vector_type(4)));
constexpr int BM = 256, BK = 64, HALF = 128, HTB = HALF * BK * 2  , STAGE_BYTES = 8 * HTB, NXCD = 8, WGM = 8;

__host__ __device__ __forceinline__ int lds_byte(int r, int c) { const int st = (r >> 4) * 2 + (c >> 5), rr = r & 15, cc = c & 31, ob = rr * 64 + cc * 2; return st * 1024 + (ob ^ (((ob >> 9) & 1) << 5)); }
__host__ __device__ __forceinline__ void stage_rc(int b, int& R, int& C) { const int st = b / 1024, sb = b % 1024, swz = sb ^ (((sb >> 9) & 1) << 5); R = (st >> 1) * 16 + swz / 64; C = (st & 1) * 32 + (swz % 64) / 2; }
__host__ __device__ __forceinline__ int perm32(int rho) { const int n = rho >> 4, i = rho & 15; return 8 * (i >> 2) + 4 * n + (i & 3); }

struct Unit { int pm, pn; };
struct Gemm { const bf16_t* A; const bf16_t* Bt; int M, N, K; };

struct StaticOrder {
    int nM, nN, nwg, G, c;
    __host__ __device__ void init(int M, int N, int G_, int c_) { nM = M / BM; nN = N / BM; nwg = nM * nN; G = G_; c = c_; }
    __host__ __device__ bool next(int i, Unit& u) const {
        const long L = (long)i * G + c; if (L >= nwg) return false;
        int wgid = (int)L; { const int q = nwg / NXCD, r = nwg % NXCD, xcd = wgid % NXCD, off = wgid / NXCD; wgid = (xcd < r ? xcd * (q + 1) : r * (q + 1) + (xcd - r) * q) + off; }
        const int nig = WGM * nN, gid = wgid / nig, fm = gid * WGM, gsz = (nM - fm) < WGM ? (nM - fm) : WGM;
        u.pm = fm + ((wgid % nig) % gsz); u.pn = (wgid % nig) / gsz; return true;
    }
    __device__ __forceinline__ void a_ready(const Unit&) const {}
    __device__ __forceinline__ void done(const Unit&) const {}
};

__device__ __forceinline__ unsigned cvt_pk_bf16(float lo, float hi) { unsigned r; asm volatile("v_cvt_pk_bf16_f32 %0, %1, %2" : "=v"(r) : "v"(lo), "v"(hi)); return r; }
typedef float f32x2 __attribute__((ext_vector_type(2)));
__device__ __forceinline__ f32x2 gelu_pk(f32x2 v) {
    const f32x2 av = __builtin_elementwise_abs(v), d = av * 0.2316418882f + 1.0f;
    f32x2 t; t.x = __builtin_amdgcn_rcpf(d.x); t.y = __builtin_amdgcn_rcpf(d.y);
    f32x2 q = t * 0.5307027145f + (-0.7265760135f); q = q * t + 0.7107068705f; q = q * t + (-0.142248368f); q = q * t + 0.127414796f; q = q * t;
    const f32x2 s = (v * v) * (-0.72134752044f);
    f32x2 e; e.x = __builtin_amdgcn_exp2f(s.x); e.y = __builtin_amdgcn_exp2f(s.y);
    const f32x2 m = v * (q * e), r = v - m;
    f32x2 o; o.x = v.x < 0.f ? m.x : r.x; o.y = v.y < 0.f ? m.y : r.y; return o;
}

template <int ACT  > struct EpiBf16 {
    static constexpr bool PERM = true, AFTER_DRAIN = false; static_assert(ACT == 0 || ACT == 1, "EpiBf16: ACT is 0 (none) or 1 (gelu_pk)");
    bf16_t* O; int ldc; const float* bias; int split_cols; size_t split_stride; float scale0;
    __device__ __forceinline__ void operator()(const f32x4 (&acc)[2][2][4][2], const Unit& u, int wr, int wc, int fr, int fq) const {
        const int row0 = u.pm * BM + wr * 64 + fr; int colt = u.pn * BM; bf16_t* base = O;
        float sc = 1.f; if (split_cols) { const int t = colt / split_cols; base += (size_t)t * split_stride; colt -= t * split_cols; if (t == 0) sc = scale0; }
        const int col0 = colt + wc * 32 + 8 * fq, bcol0 = u.pn * BM + wc * 32 + 8 * fq;
        f32x4 bv[2][2];
#pragma unroll
        for (int bj = 0; bj < 2; ++bj)
#pragma unroll
            for (int n = 0; n < 2; ++n) bv[bj][n] = bias ? *(const f32x4*)(bias + bcol0 + bj * HALF + 4 * n) : (f32x4){0.f, 0.f, 0.f, 0.f};
#pragma unroll
        for (int ai = 0; ai < 2; ++ai)
#pragma unroll
            for (int m = 0; m < 4; ++m) { bf16_t* rowp = base + (size_t)(row0 + ai * HALF + m * 16) * ldc + col0;
#pragma unroll
                for (int bj = 0; bj < 2; ++bj) { f32x4 v0 = acc[ai][bj][m][0] + bv[bj][0], v1 = acc[ai][bj][m][1] + bv[bj][1];
                    if (ACT == 1) { f32x2 a = gelu_pk((f32x2){v0[0], v0[1]}), b = gelu_pk((f32x2){v0[2], v0[3]}), c = gelu_pk((f32x2){v1[0], v1[1]}), d = gelu_pk((f32x2){v1[2], v1[3]});
                        v0 = (f32x4){a.x, a.y, b.x, b.y}; v1 = (f32x4){c.x, c.y, d.x, d.y}; }
                    v0 = v0 * sc; v1 = v1 * sc; u32x4 w; w.x = cvt_pk_bf16(v0[0], v0[1]); w.y = cvt_pk_bf16(v0[2], v0[3]); w.z = cvt_pk_bf16(v1[0], v1[1]); w.w = cvt_pk_bf16(v1[2], v1[3]);
                    *(u32x4*)(rowp + bj * HALF) = w; } }
    }
};

struct PanelStats {
    unsigned* xbuf;
    unsigned* cnt;
    unsigned* tmo;
    int ntn; float eps;
    unsigned code;
    __device__ __forceinline__ bool run(const f32x4 (&v)[2][2][4][2], const Unit& u, int wr, int wc, int fr, int fq, PG8_LAS unsigned char* lds, int wid, int lane) const {
        typedef float f32x2v __attribute__((ext_vector_type(2)));
        PG8_LAS f32x2v* P = (PG8_LAS f32x2v*)lds;
        PG8_LAS f32x2v* S = (PG8_LAS f32x2v*)(lds + 8192);
        PG8_LAS unsigned* flag = (PG8_LAS unsigned*)(lds + 8192 + 2048);
#pragma unroll
        for (int ai = 0; ai < 2; ++ai)
#pragma unroll
            for (int m = 0; m < 4; ++m) {
                float s = 0.f;
#pragma unroll
                for (int bj = 0; bj < 2; ++bj)
#pragma unroll
                    for (int n = 0; n < 2; ++n) { const f32x4 x = v[ai][bj][m][n]; s += (x[0] + x[1]) + (x[2] + x[3]); }
                s += __shfl_xor(s, 16); s += __shfl_xor(s, 32);
                const float mw = s * (1.0f / 64.0f); float q = 0.f;
#pragma unroll
                for (int bj = 0; bj < 2; ++bj)
#pragma unroll
                    for (int n = 0; n < 2; ++n) { const f32x4 d = v[ai][bj][m][n] - mw; q += (d[0] * d[0] + d[1] * d[1]) + (d[2] * d[2] + d[3] * d[3]); }
                q += __shfl_xor(q, 16); q += __shfl_xor(q, 32);
                if (fq == 0) P[(ai * HALF + wr * 64 + m * 16 + fr) * 4 + wc] = (f32x2v){mw, q};
            }
        asm volatile("s_waitcnt lgkmcnt(0)" ::: "memory"); __builtin_amdgcn_s_barrier(); asm volatile("" ::: "memory");
#if defined(BROKEN_EXCHANGE_NO_WAIT)
#warning BROKEN CONTROL BUILD: the row-statistics exchange does not wait; results are wrong by design
        if (blockIdx.x >= 64) { const long long t0_ = clock64(); while (clock64() - t0_ < 60000) __builtin_amdgcn_s_sleep(8); }
#endif
        const int row = wid * 32 + (lane & 31);
        if (lane < 32) {
            const f32x2v a = P[row * 4 + 0], b = P[row * 4 + 1], c = P[row * 4 + 2], d = P[row * 4 + 3];
            const float mt = (a.x + b.x + c.x + d.x) * 0.25f;
            const float da = a.x - mt, db = b.x - mt, dc = c.x - mt, dd = d.x - mt;
            const float m2 = (a.y + b.y) + (c.y + d.y) + 64.0f * ((da * da + db * db) + (dc * dc + dd * dd));
            unsigned long long* slot = (unsigned long long*)xbuf + ((size_t)(u.pm * BM + row) * 4 + u.pn);
            __hip_atomic_store(slot, ((unsigned long long)__float_as_uint(m2) << 32) | __float_as_uint(mt), __ATOMIC_RELAXED, __HIP_MEMORY_SCOPE_AGENT);
        }
        asm volatile("s_waitcnt vmcnt(0)" ::: "memory");
        if (lane == 0) __hip_atomic_fetch_add(cnt + 64 * u.pm, 1u, __ATOMIC_RELAXED, __HIP_MEMORY_SCOPE_AGENT);
        if (wid == 0) {
            bool dead = false; const unsigned long long t0 = __builtin_amdgcn_s_memrealtime(); const unsigned want = 8u * (unsigned)ntn;
            for (;;) {
#if defined(BROKEN_EXCHANGE_NO_WAIT)
                break;
#endif
                if ((unsigned)__builtin_amdgcn_readfirstlane(__hip_atomic_load(cnt + 64 * u.pm, __ATOMIC_RELAXED, __HIP_MEMORY_SCOPE_AGENT)) >= want) break;
                if (__builtin_amdgcn_s_memrealtime() - t0 > 2000000ull) {
                    if (lane == 0) { unsigned expect = 0u; __hip_atomic_compare_exchange_strong(tmo + 1, &expect, code | (unsigned)(u.pm & 0xff), __ATOMIC_RELAXED, __ATOMIC_RELAXED, __HIP_MEMORY_SCOPE_AGENT);
                                     __hip_atomic_store(tmo, 1u, __ATOMIC_RELAXED, __HIP_MEMORY_SCOPE_AGENT); }
                    dead = true; break; }
                __builtin_amdgcn_s_sleep(2);
            }
            __builtin_amdgcn_fence(__ATOMIC_ACQUIRE, "agent");
            if (lane == 0) flag[0] = dead ? 1u : 0u;
        }
        asm volatile("s_waitcnt vmcnt(0) lgkmcnt(0)" ::: "memory"); __builtin_amdgcn_s_barrier(); asm volatile("" ::: "memory");
        const bool bad = flag[0] != 0u;
        if (lane < 32) {
            const unsigned long long* slot = (const unsigned long long*)xbuf + (size_t)(u.pm * BM + row) * 4; float mt[4], m2[4]; float ms = 0.f;
#pragma unroll
            for (int t = 0; t < 4; ++t) { if (t < ntn) { const unsigned long long w = __hip_atomic_load(slot + t, __ATOMIC_RELAXED, __HIP_MEMORY_SCOPE_AGENT); mt[t] = __uint_as_float((unsigned)w); m2[t] = __uint_as_float((unsigned)(w >> 32)); } else { mt[t] = 0.f; m2[t] = 0.f; } ms += mt[t]; }
            const float mean = ms / (float)ntn; float q = 0.f;
#pragma unroll
            for (int t = 0; t < 4; ++t) if (t < ntn) { const float dm = mt[t] - mean; q += m2[t] + 256.0f * dm * dm; }
            S[row] = (f32x2v){mean, 1.0f / sqrtf(q / (256.0f * (float)ntn) + eps)};
        }
        asm volatile("s_waitcnt lgkmcnt(0)" ::: "memory"); __builtin_amdgcn_s_barrier(); asm volatile("" ::: "memory");
        return bad;
    }
};
struct EpiLnRes {
    static constexpr bool PERM = false, AFTER_DRAIN = true;
    const float* base; float* out; int ldc; const float* bias; PanelStats st; unsigned poison;
    __device__ __forceinline__ void fused(f32x4 (&acc)[2][2][4][2], const Unit& u, int wr, int wc, int fr, int fq, PG8_LAS unsigned char* lds, int wid, int lane) const {
        typedef float f32x2v __attribute__((ext_vector_type(2)));
        const PG8_LAS f32x2v* S = (const PG8_LAS f32x2v*)(lds + 8192);
        const int col0 = u.pn * BM + wc * 32 + 4 * fq;
#pragma unroll
        for (int bj = 0; bj < 2; ++bj)
#pragma unroll
            for (int n = 0; n < 2; ++n) { const f32x4 bv = bias ? *(const f32x4*)(bias + col0 + bj * HALF + n * 16) : (f32x4){0.f, 0.f, 0.f, 0.f};
#pragma unroll
                for (int ai = 0; ai < 2; ++ai)
#pragma unroll
                    for (int m = 0; m < 4; ++m) acc[ai][bj][m][n] += bv; }
        f32x4 pre[4][2][2];
#pragma unroll
        for (int m = 0; m < 4; ++m) { const size_t off = (size_t)(u.pm * BM + wr * 64 + m * 16 + fr) * ldc + col0;
#pragma unroll
            for (int bj = 0; bj < 2; ++bj)
#pragma unroll
                for (int n = 0; n < 2; ++n) pre[m][bj][n] = *(const f32x4*)(base + off + bj * HALF + n * 16); }
        const bool bad = st.run(acc, u, wr, wc, fr, fq, lds, wid, lane) || poison != 0u;
        const float qnan = __builtin_nanf("");
#pragma unroll
        for (int ai = 0; ai < 2; ++ai)
#pragma unroll
            for (int m = 0; m < 4; ++m) { const int r = ai * HALF + wr * 64 + m * 16 + fr; const f32x2v sr = S[r]; const size_t off = (size_t)(u.pm * BM + r) * ldc + col0;
#pragma unroll
                for (int bj = 0; bj < 2; ++bj)
#pragma unroll
                    for (int n = 0; n < 2; ++n) { const f32x4 bs = ai == 0 ? pre[m][bj][n] : *(const f32x4*)(base + off + bj * HALF + n * 16); f32x4 o = bs + (acc[ai][bj][m][n] - sr.x) * sr.y;
                        if (bad) o = (f32x4){qnan, qnan, qnan, qnan}; *(f32x4*)(out + off + bj * HALF + n * 16) = o; }
                if (m & 1) asm volatile("" ::: "memory"); }
    }
};
struct EpiLnResLn {
    static constexpr bool PERM = false, AFTER_DRAIN = true;
    const float* base; float* out; bf16_t* xn; int ldc; const float* bias; PanelStats st1, st2; unsigned poison;
    __device__ __forceinline__ void fused(f32x4 (&acc)[2][2][4][2], const Unit& u, int wr, int wc, int fr, int fq, PG8_LAS unsigned char* lds, int wid, int lane) const {
        typedef float f32x2v __attribute__((ext_vector_type(2))); typedef unsigned u32x2v __attribute__((ext_vector_type(2)));
        const PG8_LAS f32x2v* S = (const PG8_LAS f32x2v*)(lds + 8192);
        const int col0 = u.pn * BM + wc * 32 + 4 * fq;
#pragma unroll
        for (int bj = 0; bj < 2; ++bj)
#pragma unroll
            for (int n = 0; n < 2; ++n) { const f32x4 bv = bias ? *(const f32x4*)(bias + col0 + bj * HALF + n * 16) : (f32x4){0.f, 0.f, 0.f, 0.f};
#pragma unroll
                for (int ai = 0; ai < 2; ++ai)
#pragma unroll
                    for (int m = 0; m < 4; ++m) acc[ai][bj][m][n] += bv; }
        bool bad = st1.run(acc, u, wr, wc, fr, fq, lds, wid, lane) || poison != 0u;
        const float qnan = __builtin_nanf("");
#pragma unroll
        for (int ai = 0; ai < 2; ++ai)
#pragma unroll
            for (int m = 0; m < 4; ++m) { const int r = ai * HALF + wr * 64 + m * 16 + fr; const f32x2v sr = S[r]; const size_t off = (size_t)(u.pm * BM + r) * ldc + col0;
#pragma unroll
                for (int bj = 0; bj < 2; ++bj)
#pragma unroll
                    for (int n = 0; n < 2; ++n) { const f32x4 bs = *(const f32x4*)(base + off + bj * HALF + n * 16); acc[ai][bj][m][n] = bs + (acc[ai][bj][m][n] - sr.x) * sr.y; }
                asm volatile("" : "+v"(acc[ai][0][m][0]), "+v"(acc[ai][0][m][1]), "+v"(acc[ai][1][m][0]), "+v"(acc[ai][1][m][1]));
                if (m & 1) asm volatile("" ::: "memory"); }
        const bool bad1 = bad;
        bad = st2.run(acc, u, wr, wc, fr, fq, lds, wid, lane) || bad;
#pragma unroll
        for (int ai = 0; ai < 2; ++ai)
#pragma unroll
            for (int m = 0; m < 4; ++m) { const int r = ai * HALF + wr * 64 + m * 16 + fr; const f32x2v sr = S[r]; const size_t off = (size_t)(u.pm * BM + r) * ldc + col0;
#pragma unroll
                for (int bj = 0; bj < 2; ++bj)
#pragma unroll
                    for (int n = 0; n < 2; ++n) { const f32x4 x1 = acc[ai][bj][m][n]; *(f32x4*)(out + off + bj * HALF + n * 16) = bad1 ? (f32x4){qnan, qnan, qnan, qnan} : x1;
                        const f32x4 o = (x1 - sr.x) * sr.y; u32x2v w; w.x = cvt_pk_bf16(o[0], o[1]); w.y = cvt_pk_bf16(o[2], o[3]);
                        if (bad) { w.x = 0x7fc07fc0u; w.y = 0x7fc07fc0u; } *(u32x2v*)(xn + off + bj * HALF + n * 16) = w; }
                asm volatile("" ::: "memory"); }
    }
};

template <class Epi, class Sched, bool ALIGN_EPI = false, bool SP2 = false>
__device__ __forceinline__ void gemm_phase(PG8_LAS unsigned char* lds, const Gemm g, const Sched& S, const Epi& E) {
    const int tid = opaque_tid(), wid = __builtin_amdgcn_readfirstlane(tid >> 6), lane = tid & 63, wr = wid >> 2, wc = wid & 3, fr = lane & 15, fq = lane >> 4;
    const int K = g.K, nt = K / BK;
    unsigned voffA[2], voffB[2];
#pragma unroll
    for (int i = 0; i < 2; ++i) { int R, C; stage_rc(tid * 16 + i * 8192, R, C); const int Rb = Epi::PERM ? ((R & ~31) + perm32(R & 31)) : R;
        voffA[i] = (unsigned)(R * K + C) * 2u; voffB[i] = (unsigned)(Rb * K + C) * 2u; }
    const size_t kstep = (size_t)(BK * 2);
    const size_t hstep = (size_t)HALF * K * 2;
    const size_t tstep = 2 * hstep;
    const unsigned ldsw = (unsigned)wid * 1024u;
    const int aoff = lds_byte(wr * 64 + fr, fq * 8), boff = lds_byte(wc * 32 + fr, fq * 8);
#define PG8_SA(b, h) (((b) * 2 + (h)) * HTB)
#define PG8_SB(b, h) ((4 + (b) * 2 + (h)) * HTB)
#define PG8_STAGE(bufoff, gbase, voff) do { _Pragma("unroll") for (int _i = 0; _i < 2; ++_i) \
        __builtin_amdgcn_global_load_lds((const unsigned*)((const char*)(gbase) + (voff)[_i]), (PG8_LAS unsigned*)(lds + (bufoff) + ldsw + _i * 8192), 16, 0, 0); } while (0)
#define PG8_LDA(dst, b, h) do { _Pragma("unroll") for (int m = 0; m < 4; ++m) _Pragma("unroll") for (int k = 0; k < 2; ++k) dst[m][k] = *(const PG8_LAS bf16x8*)(lds + PG8_SA(b, h) + aoff + m * 2048 + k * 1024); } while (0)
#define PG8_LDB(dst, b, h) do { _Pragma("unroll") for (int n = 0; n < 2; ++n) _Pragma("unroll") for (int k = 0; k < 2; ++k) dst[n][k] = *(const PG8_LAS bf16x8*)(lds + PG8_SB(b, h) + boff + n * 2048 + k * 1024); } while (0)
#define PG8_MMA(ai, bj, At, Bt) do { __builtin_amdgcn_s_setprio(1); _Pragma("unroll") for (int m = 0; m < 4; ++m) _Pragma("unroll") for (int n = 0; n < 2; ++n) _Pragma("unroll") for (int k = 0; k < 2; ++k) \
        acc[ai][bj][m][n] = __builtin_amdgcn_mfma_f32_16x16x32_bf16(Bt[n][k], At[m][k], acc[ai][bj][m][n], 0, 0, 0); __builtin_amdgcn_s_setprio(0); } while (0)
#define PG8_WAIT_V(n) asm volatile("s_waitcnt vmcnt(" #n ")" ::: "memory")
#define PG8_WAIT_L(n) asm volatile("s_waitcnt lgkmcnt(" #n ")" ::: "memory")
#define PG8_BAR __builtin_amdgcn_s_barrier()
#define PG8_SCHED __builtin_amdgcn_sched_barrier(0)
    Unit cur, nxt; int ui = 0;
    if (!S.next(0, cur)) return;
    f32x4 acc[2][2][4][2];
#pragma unroll
    for (int a = 0; a < 2; ++a)
#pragma unroll
        for (int b = 0; b < 2; ++b)
#pragma unroll
            for (int m = 0; m < 4; ++m)
#pragma unroll
                for (int n = 0; n < 2; ++n) acc[a][b][m][n] = (f32x4){0.f, 0.f, 0.f, 0.f};
    bf16x8 At[4][2], B0[2][2], B1[2][2];
    const char* cA = (const char*)g.A + (size_t)cur.pm * tstep; const char* cB = (const char*)g.Bt + (size_t)cur.pn * tstep;
    S.a_ready(cur);
    if constexpr (SP2) {
        PG8_STAGE(PG8_SB(0, 0), cB, voffB); PG8_STAGE(PG8_SB(0, 1), cB + hstep, voffB); PG8_STAGE(PG8_SA(0, 0), cA, voffA); PG8_STAGE(PG8_SA(0, 1), cA + hstep, voffA);
        if (wr == 1) PG8_BAR;
        PG8_WAIT_V(2); PG8_BAR;
        PG8_STAGE(PG8_SB(1, 0), cB + kstep, voffB); PG8_STAGE(PG8_SA(1, 0), cA + kstep, voffA); PG8_STAGE(PG8_SB(1, 1), cB + hstep + kstep, voffB);
        PG8_WAIT_V(6); PG8_BAR;
    } else {
        PG8_STAGE(PG8_SB(0, 0), cB, voffB); PG8_STAGE(PG8_SA(0, 0), cA, voffA); PG8_STAGE(PG8_SB(0, 1), cB + hstep, voffB); PG8_STAGE(PG8_SA(0, 1), cA + hstep, voffA);
        if (wr == 1) PG8_BAR;
        PG8_WAIT_V(4); PG8_BAR;
        PG8_STAGE(PG8_SB(1, 0), cB + kstep, voffB); PG8_STAGE(PG8_SA(1, 0), cA + kstep, voffA); PG8_STAGE(PG8_SB(1, 1), cB + hstep + kstep, voffB);
        PG8_WAIT_V(6); PG8_BAR;
    }
    for (;;) {
        const bool has_next = S.next(ui + 1, nxt);
        const char* nA = has_next ? (const char*)g.A + (size_t)nxt.pm * tstep : cA; const char* nB = has_next ? (const char*)g.Bt + (size_t)nxt.pn * tstep : cB;
        for (int t = 0; t < nt; t += 2) {
            const bool last = (t == nt - 2);
            const char* a1 = cA + (size_t)(t + 1) * kstep;
            const char* a2 = last ? nA : cA + (size_t)(t + 2) * kstep; const char* b2 = last ? nB : cB + (size_t)(t + 2) * kstep;
            const char* a3 = a2 + kstep; const char* b3 = b2 + kstep;
            if (last && has_next) S.a_ready(nxt);
            if constexpr (SP2) {
            PG8_LDB(B0, 0, 0); PG8_LDB(B1, 0, 1); PG8_SCHED; PG8_LDA(At, 0, 0); PG8_STAGE(PG8_SA(1, 1), a1 + hstep, voffA);
            PG8_WAIT_V(8); PG8_WAIT_L(0); PG8_BAR; PG8_MMA(0, 0, At, B0); PG8_MMA(0, 1, At, B1); PG8_BAR; PG8_SCHED;
            PG8_LDA(At, 0, 1); PG8_STAGE(PG8_SB(0, 0), b2, voffB); PG8_STAGE(PG8_SB(0, 1), b2 + hstep, voffB); PG8_STAGE(PG8_SA(0, 0), a2, voffA);
            PG8_WAIT_V(8); PG8_WAIT_L(0); PG8_BAR; PG8_MMA(1, 0, At, B0); PG8_MMA(1, 1, At, B1); PG8_BAR; PG8_SCHED;
            PG8_LDB(B0, 1, 0); PG8_LDB(B1, 1, 1); PG8_SCHED; PG8_LDA(At, 1, 0); PG8_STAGE(PG8_SA(0, 1), a2 + hstep, voffA);
            PG8_WAIT_V(8); PG8_WAIT_L(0); PG8_BAR; PG8_MMA(0, 0, At, B0); PG8_MMA(0, 1, At, B1); PG8_BAR; PG8_SCHED;
            PG8_LDA(At, 1, 1); PG8_STAGE(PG8_SB(1, 0), b3, voffB); PG8_STAGE(PG8_SB(1, 1), b3 + hstep, voffB); PG8_STAGE(PG8_SA(1, 0), a3, voffA);
            PG8_WAIT_V(8); PG8_WAIT_L(0); PG8_BAR; PG8_MMA(1, 0, At, B0); PG8_MMA(1, 1, At, B1); PG8_BAR; PG8_SCHED;
            } else {
            PG8_LDB(B0, 0, 0); PG8_SCHED; PG8_LDA(At, 0, 0); PG8_STAGE(PG8_SA(1, 1), a1 + hstep, voffA);
            PG8_WAIT_L(8); PG8_BAR; PG8_WAIT_L(0); PG8_MMA(0, 0, At, B0); PG8_BAR; PG8_SCHED;
            PG8_LDB(B1, 0, 1); PG8_STAGE(PG8_SB(0, 0), b2, voffB);
            PG8_BAR; PG8_WAIT_L(0); PG8_MMA(0, 1, At, B1); PG8_BAR;
            PG8_LDA(At, 0, 1); PG8_STAGE(PG8_SA(0, 0), a2, voffA);
            PG8_BAR; PG8_WAIT_L(0); PG8_MMA(1, 0, At, B0); PG8_BAR; PG8_SCHED;
            PG8_STAGE(PG8_SB(0, 1), b2 + hstep, voffB);
            PG8_WAIT_V(6); PG8_BAR; PG8_MMA(1, 1, At, B1); PG8_BAR;
            PG8_LDB(B0, 1, 0); PG8_SCHED; PG8_LDA(At, 1, 0); PG8_STAGE(PG8_SA(0, 1), a2 + hstep, voffA);
            PG8_WAIT_L(8); PG8_BAR; PG8_WAIT_L(0); PG8_MMA(0, 0, At, B0); PG8_BAR; PG8_SCHED;
            PG8_LDB(B1, 1, 1); PG8_STAGE(PG8_SB(1, 0), b3, voffB);
            PG8_BAR; PG8_WAIT_L(0); PG8_MMA(0, 1, At, B1); PG8_BAR;
            PG8_LDA(At, 1, 1); PG8_STAGE(PG8_SA(1, 0), a3, voffA);
            PG8_BAR; PG8_WAIT_L(0); PG8_MMA(1, 0, At, B0); PG8_BAR; PG8_SCHED;
            PG8_STAGE(PG8_SB(1, 1), b3 + hstep, voffB);
            PG8_WAIT_V(6); PG8_BAR; PG8_MMA(1, 1, At, B1); PG8_BAR;
            }
        }
        if constexpr (ALIGN_EPI) { if (wr == 0) PG8_BAR; }
        if constexpr (!Epi::AFTER_DRAIN) { E(acc, cur, wr, wc, fr, fq); S.done(cur); }
        if (!has_next) break;
#pragma unroll
        for (int a = 0; a < 2; ++a)
#pragma unroll
            for (int b = 0; b < 2; ++b)
#pragma unroll
                for (int m = 0; m < 4; ++m)
#pragma unroll
                    for (int n = 0; n < 2; ++n) acc[a][b][m][n] = (f32x4){0.f, 0.f, 0.f, 0.f};
        cur = nxt; cA = nA; cB = nB; ++ui;
        if constexpr (ALIGN_EPI) { if (wr == 1) PG8_BAR; }
    }
    PG8_WAIT_V(0);
    if constexpr (!ALIGN_EPI) { if (wr == 0) PG8_BAR; }
    PG8_BAR;
    if constexpr (Epi::AFTER_DRAIN) { E.fused(acc, cur, wr, wc, fr, fq, lds, wid, lane); S.done(cur); }
#undef PG8_SA
#undef PG8_SB
#undef PG8_STAGE
#undef PG8_LDA
#undef PG8_LDB
#undef PG8_MMA
#undef PG8_WAIT_V
#undef PG8_WAIT_L
#undef PG8_BAR
#undef PG8_SCHED
}
}

#ifndef PG8_SP2
#define PG8_SP2 true
#endif
#ifndef PG8_ALIGN
#define PG8_ALIGN true
#endif
namespace pg8 {
constexpr int OUT_KP = 17301504, OUT_VP = 34078720, OUT_KS = 51122176, OUT_VS = 51646464;
constexpr int NSSQ = 32;
__device__ __forceinline__ float row_rstd(const float* ssq, int row) {
    const f32x4* p = (const f32x4*)(ssq + (size_t)row * NSSQ); float s = 0.f;
#pragma unroll
    for (int i = 0; i < NSSQ / 4; ++i) { const f32x4 a = p[i]; s += (a[0] + a[1]) + (a[2] + a[3]); }
    return __builtin_amdgcn_rsqf(s * (1.0f / 1024.0f) + 1e-6f);
}
template <int ACT, bool KVF32> struct EpiAct {
    static constexpr bool PERM = true, AFTER_DRAIN = false;
    bf16_t* O; int ldc; const float* ssq; int split_cols; size_t split_stride; float* fout;
    template <int NA, int NB> __device__ __forceinline__ void run(const f32x4 (&acc)[NA][NB][4][2], int rowt, int colt, bool sample, int wr, int wc, int fr, int fq) const {
        const int row0 = rowt + wr * 64 + fr; bf16_t* base = O; int t = 0;
        if (split_cols) { t = colt / split_cols; base += (size_t)t * split_stride; colt -= t * split_cols; }
        const int col0 = colt + wc * 32 + 8 * fq;
        float* fb = nullptr;
        if (KVF32) { if (t < 2) fb = fout + (!sample ? (size_t)(t == 0 ? OUT_KP : OUT_VP) : (size_t)(t == 0 ? OUT_KS : OUT_VS) - (size_t)16384 * 1024) + col0; }
        f32x4 pq[NA][4][2];
#pragma unroll
        for (int ai = 0; ai < NA; ++ai)
#pragma unroll
            for (int m = 0; m < 4; ++m) { const f32x4* p = (const f32x4*)(ssq + (size_t)(row0 + ai * HALF + m * 16) * NSSQ + 8 * fq); pq[ai][m][0] = p[0]; pq[ai][m][1] = p[1]; }
        float rsv[NA][4];
#pragma unroll
        for (int ai = 0; ai < NA; ++ai)
#pragma unroll
            for (int m = 0; m < 4; ++m) { const f32x4 a = pq[ai][m][0], b = pq[ai][m][1]; float sq = ((a[0] + a[1]) + (a[2] + a[3])) + ((b[0] + b[1]) + (b[2] + b[3]));
                sq += __shfl_xor(sq, 16); sq += __shfl_xor(sq, 32); rsv[ai][m] = __builtin_amdgcn_rsqf(sq * (1.0f / 1024.0f) + 1e-6f); }
#pragma unroll
        for (int ai = 0; ai < NA; ++ai)
#pragma unroll
            for (int m = 0; m < 4; ++m) { const int row = row0 + ai * HALF + m * 16; const float rs = rsv[ai][m];
                bf16_t* rowp = base + (size_t)row * ldc + col0;
#pragma unroll
                for (int bj = 0; bj < NB; ++bj) { f32x4 v0 = acc[ai][bj][m][0] * rs, v1 = acc[ai][bj][m][1] * rs;
                    if (ACT == 1) {
#pragma unroll
                        for (int e = 0; e < 4; ++e) { const float a = fmaxf(v0[e], 0.f), b = fmaxf(v1[e], 0.f); v0[e] = a * a; v1[e] = b * b; } }
                    if (KVF32) { if (fb) { float* fr_ = fb + (size_t)row * 1024 + bj * HALF; *(f32x4*)fr_ = v0; *(f32x4*)(fr_ + 4) = v1; } }
                    u32x4 w; w.x = cvt_pk_bf16(v0[0], v0[1]); w.y = cvt_pk_bf16(v0[2], v0[3]); w.z = cvt_pk_bf16(v1[0], v1[1]); w.w = cvt_pk_bf16(v1[2], v1[3]);
                    *(u32x4*)(rowp + bj * HALF) = w; } }
    }
    __device__ __forceinline__ void operator()(const f32x4 (&acc)[2][2][4][2], const Unit& u, int wr, int wc, int fr, int fq) const { run<2, 2>(acc, u.pm * BM, u.pn * BM, u.pm >= 64, wr, wc, fr, fq); }
};
struct EpiResid {
    static constexpr bool PERM = true, AFTER_DRAIN = false;
    float* X; bf16_t* XB; float* ssq;
    template <int NA, int NB> __device__ __forceinline__ void run(const f32x4 (&acc)[NA][NB][4][2], int rowt, int colt, bool sample, int wr, int wc, int fr, int fq) const {
        const int row0 = rowt + wr * 64 + fr; const int col0 = colt + wc * 32 + 8 * fq;
#pragma unroll
        for (int ai = 0; ai < NA; ++ai) {
            f32x4 xr[4][NB][2];
#pragma unroll
            for (int m = 0; m < 4; ++m) { const float* xp = X + (size_t)(row0 + ai * HALF + m * 16) * 1024 + col0;
#pragma unroll
                for (int bj = 0; bj < NB; ++bj) { xr[m][bj][0] = *(const f32x4*)(xp + bj * HALF); xr[m][bj][1] = *(const f32x4*)(xp + bj * HALF + 4); } }
#pragma unroll
            for (int m = 0; m < 4; ++m) { const int row = row0 + ai * HALF + m * 16; float* xp = X + (size_t)row * 1024 + col0; bf16_t* bp = XB + (size_t)row * 1024 + col0;
#pragma unroll
                for (int bj = 0; bj < NB; ++bj) { const f32x4 a0 = xr[m][bj][0] + acc[ai][bj][m][0], a1 = xr[m][bj][1] + acc[ai][bj][m][1];
                    *(f32x4*)(xp + bj * HALF) = a0; *(f32x4*)(xp + bj * HALF + 4) = a1;
                    float q = ((a0[0] * a0[0] + a0[1] * a0[1]) + (a0[2] * a0[2] + a0[3] * a0[3])) + ((a1[0] * a1[0] + a1[1] * a1[1]) + (a1[2] * a1[2] + a1[3] * a1[3]));
                    u32x4 w; w.x = cvt_pk_bf16(a0[0], a0[1]); w.y = cvt_pk_bf16(a0[2], a0[3]); w.z = cvt_pk_bf16(a1[0], a1[1]); w.w = cvt_pk_bf16(a1[2], a1[3]);
                    *(u32x4*)(bp + bj * HALF) = w;
                    q += __shfl_xor(q, 16); q += __shfl_xor(q, 32);
                    if (fq == 0) ssq[(size_t)row * NSSQ + ((colt + bj * HALF) >> 7) * 4 + wc] = q; } }
            asm volatile("" ::: "memory"); }
    }
    __device__ __forceinline__ void operator()(const f32x4 (&acc)[2][2][4][2], const Unit& u, int wr, int wc, int fr, int fq) const { run<2, 2>(acc, u.pm * BM, u.pn * BM, u.pm >= 64, wr, wc, fr, fq); }
};
__device__ __forceinline__ void glds16(const void* gsrc, unsigned lds_dst) { unsigned keep;
    asm volatile("s_mov_b32 %0, m0\n\ts_mov_b32 m0, %2\n\ts_nop 0\n\tglobal_load_lds_dwordx4 %1, off\n\ts_mov_b32 m0, %0" : "=&s"(keep) : "v"(gsrc), "s"(lds_dst) : "memory"); }
template <class Epi>
__device__ __forceinline__ void gemm128_tile(PG8_LAS unsigned char* lds, const bf16_t* A, const bf16_t* Bt, int K, const Epi& E, int rowt, int colt) {
    const int tid = opaque_tid(), wid = __builtin_amdgcn_readfirstlane(tid >> 6), lane = tid & 63, wr = wid >> 2, wc = wid & 3, fr = lane & 15, fq = lane >> 4;
    const int nt = K / BK;
    const char* gA[2]; const char* gB[2];
#pragma unroll
    for (int i = 0; i < 2; ++i) { int R, C; stage_rc(tid * 16 + i * 8192, R, C); const int Rb = (R & ~31) + perm32(R & 31);
        gA[i] = (const char*)A + (size_t)(R * K + C) * 2; gB[i] = (const char*)Bt + (size_t)(Rb * K + C) * 2; }
    const unsigned lds0 = (unsigned)(uintptr_t)lds + (unsigned)wid * 1024u;
    const int aoff = lds_byte(wr * 64 + fr, fq * 8), boff = lds_byte(wc * 32 + fr, fq * 8);
#define G128_STAGE(s, kt) do { _Pragma("unroll") for (int _i = 0; _i < 2; ++_i) { \
        glds16(gA[_i] + (size_t)(kt) * (BK * 2), (unsigned)__builtin_amdgcn_readfirstlane(lds0 + (unsigned)((s) * 2 * HTB + _i * 8192))); \
        glds16(gB[_i] + (size_t)(kt) * (BK * 2), (unsigned)__builtin_amdgcn_readfirstlane(lds0 + (unsigned)((s) * 2 * HTB + HTB + _i * 8192))); } } while (0)
    f32x4 acc[1][1][4][2];
#pragma unroll
    for (int m = 0; m < 4; ++m)
#pragma unroll
        for (int n = 0; n < 2; ++n) acc[0][0][m][n] = (f32x4){0.f, 0.f, 0.f, 0.f};
    G128_STAGE(0, 0); G128_STAGE(1, 1); G128_STAGE(2, 2);
    for (int t = 0; t < nt; ++t) {
        const int rem = nt - 1 - t;
        if (rem >= 2) asm volatile("s_waitcnt vmcnt(8)" ::: "memory"); else if (rem == 1) asm volatile("s_waitcnt vmcnt(4)" ::: "memory"); else asm volatile("s_waitcnt vmcnt(0)" ::: "memory");
        __builtin_amdgcn_s_barrier(); asm volatile("" ::: "memory");
        if (t + 3 < nt) G128_STAGE((t + 3) & 3, t + 3);
        const PG8_LAS unsigned char* sb = lds + (t & 3) * 2 * HTB;
        bf16x8 At[4][2], Bf[2][2];
#pragma unroll
        for (int m = 0; m < 4; ++m)
#pragma unroll
            for (int k = 0; k < 2; ++k) At[m][k] = *(const PG8_LAS bf16x8*)(sb + aoff + m * 2048 + k * 1024);
#pragma unroll
        for (int n = 0; n < 2; ++n)
#pragma unroll
            for (int k = 0; k < 2; ++k) Bf[n][k] = *(const PG8_LAS bf16x8*)(sb + HTB + boff + n * 2048 + k * 1024);
        asm volatile("s_waitcnt lgkmcnt(0)" ::: "memory");
#pragma unroll
        for (int m = 0; m < 4; ++m)
#pragma unroll
            for (int n = 0; n < 2; ++n)
#pragma unroll
                for (int k = 0; k < 2; ++k) acc[0][0][m][n] = __builtin_amdgcn_mfma_f32_16x16x32_bf16(Bf[n][k], At[m][k], acc[0][0][m][n], 0, 0, 0);
    }
#undef G128_STAGE
    E.template run<1, 1>(acc, rowt, colt, true, wr, wc, fr, fq);
    asm volatile("s_waitcnt lgkmcnt(0)" ::: "memory"); __builtin_amdgcn_s_barrier(); asm volatile("" ::: "memory");
}
}
#include <hip/hip_bf16.h>
#include <cmath>
namespace attn_body {
using bf16=__hip_bfloat16;
using bf16x8=__attribute__((ext_vector_type(8)))short;
using s16x4=__attribute__((ext_vector_type(4)))short;
using f32x16=__attribute__((ext_vector_type(16)))float;
using u32x4=__attribute__((ext_vector_type(4)))unsigned;
constexpr int BATCH=1,NHEAD=16,SEQ=16384,D=64,DM=NHEAD*D;
constexpr int NW=8,QBLK=32,QB=QBLK*NW,KVBLK=64,NQB=SEQ/QB;
constexpr int ATTN_PITCH=DM, ATTN_UNIT_ROWS=QB;
__device__ __forceinline__ int crow(int r,int hi){return (r&3)+8*(r>>2)+4*hi;}
#define SBAR() __builtin_amdgcn_sched_barrier(0)
__device__ __forceinline__ void cmask(f32x16&p0,f32x16&p1,int jb,int qrel,int hi){
  const float NEG=-INFINITY; int kb=64*jb+4*hi;
  #pragma unroll
  for(int r=0;r<16;++r){int kv=kb+(r&3)+8*(r>>2); if(kv>qrel)p0[r]=NEG; if(kv+32>qrel)p1[r]=NEG;}
}

constexpr int NSLOT=3, SLOTB=8192;
constexpr int LDS_K=0, LDS_V=NSLOT*SLOTB, LDS_WS=2*NSLOT*SLOTB, LDS_OST=LDS_WS+NW*64*4, LDS_CK=LDS_OST+NW*4096, LDS_BYTES=LDS_CK+SEQ*4;
constexpr float C2=0.125f*1.4426950408889634f;
__device__ __forceinline__ void glds16(const void*gsrc,unsigned lds_dst){unsigned keep;
  asm volatile("s_mov_b32 %0, m0\n\ts_mov_b32 m0, %2\n\ts_nop 0\n\tglobal_load_lds_dwordx4 %1, off\n\ts_mov_b32 m0, %0":"=&s"(keep):"v"(gsrc),"s"(lds_dst):"memory");}
__device__ __forceinline__ float max3f(float a,float b,float c){float r;asm("v_max3_f32 %0, %1, %2, %3":"=v"(r):"v"(a),"v"(b),"v"(c));return r;}
__device__ __forceinline__ float max2f(float a,float b){float r;asm("v_max_f32_e32 %0, %1, %2":"=v"(r):"v"(a),"v"(b));return r;}
__device__ __forceinline__ float fadd_s(float a,float b){float r;asm("v_add_f32_e32 %0, %1, %2":"=v"(r):"v"(a),"v"(b));return r;}
__device__ __forceinline__ float fsub_s(float a,float b){float r;asm("v_sub_f32_e32 %0, %1, %2":"=v"(r):"v"(a),"v"(b));return r;}
typedef float f32x2_t __attribute__((ext_vector_type(2))); typedef __bf16 bf16x2_t __attribute__((ext_vector_type(2)));
__device__ __forceinline__ unsigned cvtpk_s(float lo,float hi){f32x2_t v={lo,hi};bf16x2_t b=__builtin_convertvector(v,bf16x2_t);return __builtin_bit_cast(unsigned,b);}
#define WAIT_BAR(N) asm volatile("s_waitcnt vmcnt(" #N ") lgkmcnt(0)\n\ts_barrier":::"memory")

__device__ __forceinline__ void qkt(f32x16&p0,f32x16&p1,const char*Kslot,const bf16x8*qr,const f32x16&negm,int r32,int hi){
  const char*kb=Kslot+hi*1024+r32*16;
  #pragma unroll
  for(int d0=0;d0<4;++d0){
    const bf16x8 b0=*reinterpret_cast<const bf16x8*>(kb+d0*2048);
    const bf16x8 b1=*reinterpret_cast<const bf16x8*>(kb+d0*2048+512);
    if(d0==0){p0=__builtin_amdgcn_mfma_f32_32x32x16_bf16(b0,qr[0],negm,0,0,0);p1=__builtin_amdgcn_mfma_f32_32x32x16_bf16(b1,qr[0],negm,0,0,0);}
    else{p0=__builtin_amdgcn_mfma_f32_32x32x16_bf16(b0,qr[d0],p0,0,0,0);p1=__builtin_amdgcn_mfma_f32_32x32x16_bf16(b1,qr[d0],p1,0,0,0);}}
}
typedef __attribute__((address_space(3))) const char* lds_cptr;
typedef short v4i16_t __attribute__((ext_vector_type(4)));
__device__ __forceinline__ void kload8(bf16x8*kf,lds_cptr kp){
  kf[0]=*(const __attribute__((address_space(3))) bf16x8*)(kp);      kf[1]=*(const __attribute__((address_space(3))) bf16x8*)(kp+512);
  kf[2]=*(const __attribute__((address_space(3))) bf16x8*)(kp+2048); kf[3]=*(const __attribute__((address_space(3))) bf16x8*)(kp+2560);
  kf[4]=*(const __attribute__((address_space(3))) bf16x8*)(kp+4096); kf[5]=*(const __attribute__((address_space(3))) bf16x8*)(kp+4608);
  kf[6]=*(const __attribute__((address_space(3))) bf16x8*)(kp+6144); kf[7]=*(const __attribute__((address_space(3))) bf16x8*)(kp+6656);
}
__device__ __forceinline__ void kload2(bf16x8*kf,lds_cptr kp,int j){ kf[2*j]=*(const __attribute__((address_space(3))) bf16x8*)(kp+j*2048); kf[2*j+1]=*(const __attribute__((address_space(3))) bf16x8*)(kp+j*2048+512); }
__device__ __forceinline__ s16x4 vtr(lds_cptr p){ return __builtin_bit_cast(s16x4,__builtin_amdgcn_ds_read_tr16_b64_v4i16((__attribute__((address_space(3))) v4i16_t*)p)); }
__device__ __forceinline__ float rowmax(const f32x16&p0,const f32x16&p1){
  float a=max3f(p0[0],p0[1],p1[0]),b=max3f(p0[2],p0[3],p1[1]);a=max3f(a,p1[2],p1[3]);
  #pragma unroll
  for(int r=4;r<16;r+=4){a=max3f(a,p0[r],p0[r+1]);b=max3f(b,p0[r+2],p0[r+3]);a=max3f(a,p1[r],p1[r+1]);b=max3f(b,p1[r+2],p1[r+3]);}
  const float m=max2f(a,b);
  auto rr=__builtin_amdgcn_permlane32_swap(__float_as_uint(m),__float_as_uint(m),false,false);
  return max2f(__uint_as_float(rr[0]),__uint_as_float(rr[1]));
}
__device__ __forceinline__ void pv(f32x16*o,int vb,bf16x8 pa0,bf16x8 pa1,bf16x8 pa2,bf16x8 pa3){
  #pragma unroll
  for(int d0=0;d0<2;++d0){s16x4 lo[4],hi[4];
    #pragma unroll
    for(int ks=0;ks<4;++ks){
      asm volatile("ds_read_b64_tr_b16 %0,%1 offset:%c2":"=&v"(lo[ks]):"v"(vb),"i"(d0*4096+ks*1024):"memory");
      asm volatile("ds_read_b64_tr_b16 %0,%1 offset:%c2":"=&v"(hi[ks]):"v"(vb),"i"(d0*4096+ks*1024+512):"memory");}
    asm volatile("s_waitcnt lgkmcnt(0)":::"memory");SBAR();
    #define PK(k) (bf16x8){lo[k][0],lo[k][1],lo[k][2],lo[k][3],hi[k][0],hi[k][1],hi[k][2],hi[k][3]}
    o[d0]=__builtin_amdgcn_mfma_f32_32x32x16_bf16(pa0,PK(0),o[d0],0,0,0);
    o[d0]=__builtin_amdgcn_mfma_f32_32x32x16_bf16(pa1,PK(1),o[d0],0,0,0);
    o[d0]=__builtin_amdgcn_mfma_f32_32x32x16_bf16(pa2,PK(2),o[d0],0,0,0);
    o[d0]=__builtin_amdgcn_mfma_f32_32x32x16_bf16(pa3,PK(3),o[d0],0,0,0);
    #undef PK
  }
}

#ifndef ATTN_STORE16
#define ATTN_STORE16(p,v) (*(u32x4*)(p)=(v))
#endif
typedef float f32x4_t __attribute__((ext_vector_type(4)));
#define CKSUB(C0,C1,t) do{ const __attribute__((address_space(3))) f32x4_t* ck_=(const __attribute__((address_space(3))) f32x4_t*)(ckl+(t)*64+4*hi); \
   _Pragma("unroll") for(int g_=0;g_<4;++g_){ const f32x4_t a_=ck_[2*g_], b_=ck_[8+2*g_]; \
     _Pragma("unroll") for(int i_=0;i_<4;++i_){ C0[4*g_+i_]-=a_[i_]; C1[4*g_+i_]-=b_[i_]; } } }while(0)
template<int THRL> __device__ __forceinline__ void attn_unit(int b,int h,int qb,const bf16*Q,const bf16*__restrict__ K,const bf16*__restrict__ V,bf16*O,char*shm,const float*ckg,const float kmax2){
  const int tid=opaque_tid(),lane=tid&63,r32=lane&31,hi=lane>>5; const int wid=__builtin_amdgcn_readfirstlane(tid>>6);
  const long rowbase=(long)b*SEQ; const int q0=qb*QB;
  const bf16*Qw=Q+(rowbase+q0+wid*QBLK)*DM+h*D;
  const unsigned lds0=(unsigned)(uintptr_t)shm;
  float*wsf=(float*)(shm+LDS_WS)+wid*64;
  __attribute__((address_space(3))) float* ckl=(__attribute__((address_space(3))) float*)((__attribute__((address_space(3))) char*)shm+LDS_CK);
  const float cqv=ckg[q0+wid*QBLK+r32];
  bf16x8 qr[4];
  #pragma unroll
  for(int d0=0;d0<4;++d0)qr[d0]=*reinterpret_cast<const bf16x8*>(&Qw[(long)r32*DM+d0*16+hi*8]);
  int t0=0;
  if(qb>0){
    float*wsa=(float*)(shm+LDS_WS);
    float qs=0.f;
    #pragma unroll
    for(int d0=0;d0<4;++d0){
      #pragma unroll
      for(int e=0;e<8;++e){ const float v_=__builtin_bit_cast(float,((unsigned)(unsigned short)qr[d0][e])<<16); qs+=v_*v_; } }
    qs+=__shfl_xor(qs,32);
    #pragma unroll
    for(int o_=1;o_<32;o_<<=1) qs=fmaxf(qs,__shfl_xor(qs,o_));
    const int ncand=q0/KVBLK;
    float cend=0.f; if(tid<ncand) cend=ckg[tid*KVBLK+KVBLK-1];
    const float cq0=ckg[q0];
    if(lane==0) wsa[wid]=qs;
    __syncthreads();
    float qm=wsa[0];
    #pragma unroll
    for(int w_=1;w_<NW;++w_) qm=fmaxf(qm,wsa[w_]);
    const float thr=-40.f-2.f*sqrtf(qm*kmax2)*1.0001f;
    const bool skip_=(tid<ncand)&&((cq0-cend)<thr);
    const unsigned long long bal_=__ballot(skip_);
    if(lane==0) wsa[8+wid]=(float)__popcll(bal_);
    __syncthreads();
    float cnt_=0.f;
    #pragma unroll
    for(int w_=0;w_<NW;++w_) cnt_+=wsa[8+w_];
    t0=__builtin_amdgcn_readfirstlane(((int)cnt_)&~1);
    __syncthreads();
  }
  const bf16*Kh=K+(rowbase+(long)t0*KVBLK)*DM+h*D,*Vh=V+(rowbase+(long)t0*KVBLK)*DM+h*D;
  { const int nf4=(q0+QB-t0*KVBLK)>>2; const f32x4_t* src_=(const f32x4_t*)(ckg+t0*KVBLK); __attribute__((address_space(3))) f32x4_t* dst_=(__attribute__((address_space(3))) f32x4_t*)ckl;
    for(int i_=tid;i_<nf4;i_+=NW*64) dst_[i_]=src_[i_]; }
  const bf16*ksrc=Kh+(long)lane*DM+wid*8;
  const bf16*vsrc=Vh+(long)(16*(wid&3)+(lane>>2))*DM+(wid>>2)*32+(lane&3)*8;
  const unsigned kdst=lds0+LDS_K+wid*1024, vdst=lds0+LDS_V+wid*1024;
  #define DMA_K(t,slot) glds16(ksrc+(long)(t)*KVBLK*DM,(unsigned)__builtin_amdgcn_readfirstlane(kdst+(slot)))
  #define DMA_V(t,slot) glds16(vsrc+(long)(t)*KVBLK*DM,(unsigned)__builtin_amdgcn_readfirstlane(vdst+(slot)))
  const int vb0=(int)(lds0+LDS_V)+((lane>>4)&1)*32+(lane&3)*8+(4*hi+((lane&15)>>2))*64;
  const char*Kbase=shm+LDS_K; bf16x8 kf[8];
  const lds_cptr shm3=(lds_cptr)shm; const lds_cptr kp0=shm3+LDS_K+hi*1024+r32*16; const lds_cptr vp0=shm3+LDS_V+((lane>>4)&1)*32+(lane&3)*8+(4*hi+((lane&15)>>2))*64;
  const int NT=(q0+QB)/KVBLK-t0;
  DMA_K(0,0);DMA_V(0,0);DMA_K(1,SLOTB);
  float mhat=-cqv,l_reg=0.f;    f32x16 o[2];o[0]=f32x16{};o[1]=f32x16{};f32x16 negm;
  #pragma unroll
  for(int r=0;r<16;++r)negm[r]=cqv;
  asm volatile("":"+v"(negm));
  const int qrel=wid*QBLK+r32;
  #define CMASK(P0,P1,t) do{int jb_=(t)-(NT-4); if(jb_>=0)cmask(P0,P1,jb_,qrel,hi);}while(0)
  bool resc=false;
  #define START(P0,P1) do{ const float rm=rowmax(P0,P1); resc=false; \
    { const float dl=rm; mhat=fadd_s(mhat,dl); \
      _Pragma("unroll") for(int r=0;r<16;++r){P0[r]=fsub_s(P0[r],dl);P1[r]=fsub_s(P1[r],dl);} \
      _Pragma("unroll") for(int r=0;r<16;++r)negm[r]=-mhat; asm volatile("":"+v"(negm)); } \
    _Pragma("unroll") for(int r=0;r<16;++r)P0[r]=__builtin_amdgcn_exp2f(P0[r]); }while(0)
  #define RESC() do{ if(resc){ asm volatile("s_waitcnt lgkmcnt(0)":::"memory"); \
      _Pragma("unroll") for(int d_=0;d_<2;++d_) _Pragma("unroll") for(int r=0;r<16;++r)o[d_][r]*=wsf[crow(r,hi)]; } }while(0)
  f32x16 pA0,pA1,pB0,pB1;
  int sl_prev=0,sl_cur=0,sl_next=SLOTB;
  #define ROT() do{sl_prev=sl_cur;sl_cur=sl_next;sl_next=(sl_next==(NSLOT-1)*SLOTB)?0:sl_next+SLOTB;}while(0)
  DMA_K(2,2*SLOTB);
  WAIT_BAR(3);
  qkt(pA0,pA1,Kbase,qr,negm,r32,hi);asm volatile("s_nop 15\n\ts_nop 7":"+v"(pA0),"+v"(pA1));CKSUB(pA0,pA1,0);CMASK(pA0,pA1,0);
  START(pA0,pA1);
  _Pragma("unroll") for(int r=0;r<16;++r)pA1[r]=__builtin_amdgcn_exp2f(pA1[r]);
  WAIT_BAR(0);
  DMA_K(3,0);DMA_V(1,SLOTB);
  ROT();
  kload8(kf,kp0+sl_cur);
  WAIT_BAR(2);
  s16x4 vlo[8],vhi[8]; u32x4 pw0,pw1,pw2,pw3;
  #define PKW(P,B) cvtpk_s(P[B],P[B+1])
  #define PAF(k) __builtin_bit_cast(bf16x8,pw##k)
  #define VFR(i) (bf16x8){vlo[i][0],vlo[i][1],vlo[i][2],vlo[i][3],vhi[i][0],vhi[i][1],vhi[i][2],vhi[i][3]}
  #define PIN(x) asm volatile("":"+v"(x))
  #define MX3(a,b,c) __builtin_fmaxf(__builtin_fmaxf((a),(b)),(c))
  #define GAPA(MF,A0,A1,A2,A3,W0,W1,PW) do{ MF; sacc+=A0; sacc+=A1; sacc+=A2; sacc+=A3; PIN(sacc); W0; W1; PIN(PW); SBAR(); }while(0)
  #define EX(v) __builtin_amdgcn_exp2f(v)
  #define GAPB(MF,X,B) do{ MF; X[B]=EX(X[B]); X[B+1]=EX(X[B+1]); X[B+2]=EX(X[B+2]); X[B+3]=EX(X[B+3]); PIN(X); SBAR(); }while(0)
  #define VRD(i) do{ vlo[i]=vtr(vp_+(((i)>>2)*4096+((i)&3)*1024)); vhi[i]=vtr(vp_+(((i)>>2)*4096+((i)&3)*1024+512)); }while(0)
  #define KRD(G,j) do{ if(G){ kload2(kf,kp0+sl_next,j); SBAR(); } }while(0)
  #define STEP(C0,C1,P0,P1,t,GK,GV,GL) do{ SBAR(); \
    const lds_cptr vp_=vp0+sl_prev; \
    VRD(0); SBAR(); float sacc=(P0[0]+P0[1]); \
    GAPA(C0=__builtin_amdgcn_mfma_f32_32x32x16_bf16(kf[0],qr[0],negm,0,0,0), P0[2],P0[3],P0[4],P0[5],     pw0[0]=PKW(P0,0), pw0[1]=PKW(P0,2), pw0); \
    VRD(4); SBAR(); GAPA(C1=__builtin_amdgcn_mfma_f32_32x32x16_bf16(kf[1],qr[0],negm,0,0,0), P0[6],P0[7],P0[8],P0[9],     pw0[2]=PKW(P0,4), pw0[3]=PKW(P0,6), pw0); \
    VRD(1); SBAR(); GAPA(C0=__builtin_amdgcn_mfma_f32_32x32x16_bf16(kf[2],qr[1],C0,0,0,0),   P0[10],P0[11],P0[12],P0[13], pw1[0]=PKW(P0,8), pw1[1]=PKW(P0,10), pw1); \
    VRD(5); SBAR(); GAPA(C1=__builtin_amdgcn_mfma_f32_32x32x16_bf16(kf[3],qr[1],C1,0,0,0),   P0[14],P0[15],P1[0],P1[1],   pw1[2]=PKW(P0,12),pw1[3]=PKW(P0,14), pw1); \
    VRD(2); SBAR(); GAPA(C0=__builtin_amdgcn_mfma_f32_32x32x16_bf16(kf[4],qr[2],C0,0,0,0),   P1[2],P1[3],P1[4],P1[5],     pw2[0]=PKW(P1,0), pw2[1]=PKW(P1,2), pw2); \
    VRD(6); SBAR(); GAPA(C1=__builtin_amdgcn_mfma_f32_32x32x16_bf16(kf[5],qr[2],C1,0,0,0),   P1[6],P1[7],P1[8],P1[9],     pw2[2]=PKW(P1,4), pw2[3]=PKW(P1,6), pw2); \
    VRD(3); SBAR(); GAPA(C0=__builtin_amdgcn_mfma_f32_32x32x16_bf16(kf[6],qr[3],C0,0,0,0),   P1[10],P1[11],P1[12],P1[13], pw3[0]=PKW(P1,8), pw3[1]=PKW(P1,10), pw3); \
    VRD(7); SBAR(); GAPA(C1=__builtin_amdgcn_mfma_f32_32x32x16_bf16(kf[7],qr[3],C1,0,0,0),   P1[14],P1[15],0.f,0.f,       pw3[2]=PKW(P1,12),pw3[3]=PKW(P1,14), pw3); \
    l_reg+=sacc; \
    if(GK){DMA_K((t)+3,sl_cur);} if(GV){DMA_V((t)+1,sl_next);} \
    CKSUB(C0,C1,t); CMASK(C0,C1,t); \
    { float a=MX3(C0[0],C0[1],C1[0]),b=MX3(C0[2],C0[3],C1[1]); a=MX3(a,C1[2],C1[3]); \
      _Pragma("unroll") for(int r=4;r<16;r+=4){a=MX3(a,C0[r],C0[r+1]);b=MX3(b,C0[r+2],C0[r+3]);a=MX3(a,C1[r],C1[r+1]);b=MX3(b,C1[r+2],C1[r+3]);} \
      float rm=__builtin_fmaxf(a,b); { auto rr=__builtin_amdgcn_permlane32_swap(__float_as_uint(rm),__float_as_uint(rm),false,false); rm=__builtin_fmaxf(__uint_as_float(rr[0]),__uint_as_float(rr[1])); } \
      resc=false; \
      if(__builtin_expect(__any(rm>(float)THRL),0)){ const float dl=__builtin_fmaxf(rm,0.f); mhat+=dl; \
        _Pragma("unroll") for(int r=0;r<16;++r){C0[r]-=dl;C1[r]-=dl;} \
        _Pragma("unroll") for(int r=0;r<16;++r)negm[r]=-mhat; asm volatile("":"+v"(negm)); \
        const float f=__builtin_amdgcn_exp2f(-dl); l_reg*=f; if(hi==0)wsf[r32]=f; resc=true; } } \
    SBAR(); \
    GAPB(o[0]=__builtin_amdgcn_mfma_f32_32x32x16_bf16(PAF(0),VFR(0),o[0],0,0,0), C0,0); \
    GAPB(o[1]=__builtin_amdgcn_mfma_f32_32x32x16_bf16(PAF(0),VFR(4),o[1],0,0,0), C0,4); \
    KRD(GL,0); GAPB(o[0]=__builtin_amdgcn_mfma_f32_32x32x16_bf16(PAF(1),VFR(1),o[0],0,0,0), C0,8); \
    KRD(GL,1); GAPB(o[1]=__builtin_amdgcn_mfma_f32_32x32x16_bf16(PAF(1),VFR(5),o[1],0,0,0), C0,12); \
    KRD(GL,2); GAPB(o[0]=__builtin_amdgcn_mfma_f32_32x32x16_bf16(PAF(2),VFR(2),o[0],0,0,0), C1,0); \
    KRD(GL,3); GAPB(o[1]=__builtin_amdgcn_mfma_f32_32x32x16_bf16(PAF(2),VFR(6),o[1],0,0,0), C1,4); \
    GAPB(o[0]=__builtin_amdgcn_mfma_f32_32x32x16_bf16(PAF(3),VFR(3),o[0],0,0,0), C1,8); \
    GAPB(o[1]=__builtin_amdgcn_mfma_f32_32x32x16_bf16(PAF(3),VFR(7),o[1],0,0,0), C1,12); \
    }while(0)
  int t=1;
  #undef CMASK
  #define CMASK(P0,P1,t) do{}while(0)
  for(;t+5<NT;t+=2){
    STEP(pB0,pB1,pA0,pA1,t,true,true,true);     WAIT_BAR(2); RESC(); ROT();
    STEP(pA0,pA1,pB0,pB1,t+1,true,true,true);   WAIT_BAR(2); RESC(); ROT();
  }
  #undef CMASK
  #define CMASK(P0,P1,t) do{int jb_=(t)-(NT-4); if(jb_>=0)cmask(P0,P1,jb_,qrel,hi);}while(0)
  #define ENDW(tt) do{ if((tt)+3<NT){WAIT_BAR(2);} else if((tt)+2<NT){WAIT_BAR(1);} else {WAIT_BAR(0);} }while(0)
  for(;t+1<NT;t+=2){
    STEP(pB0,pB1,pA0,pA1,t,(t+3<NT),(t+1<NT),(t+1<NT));       ENDW(t);   RESC(); ROT();
    STEP(pA0,pA1,pB0,pB1,t+1,(t+4<NT),(t+2<NT),(t+2<NT));     ENDW(t+1); RESC(); ROT();
  }
  STEP(pB0,pB1,pA0,pA1,NT-1,false,false,false); RESC();
  { float sacc=pB0[0]+pB0[1]; _Pragma("unroll") for(int r=2;r<16;++r)sacc+=pB0[r]; _Pragma("unroll") for(int r=0;r<16;++r)sacc+=pB1[r]; l_reg+=sacc;
    pw0=(u32x4){PKW(pB0,0),PKW(pB0,2),PKW(pB0,4),PKW(pB0,6)};pw1=(u32x4){PKW(pB0,8),PKW(pB0,10),PKW(pB0,12),PKW(pB0,14)};pw2=(u32x4){PKW(pB1,0),PKW(pB1,2),PKW(pB1,4),PKW(pB1,6)};pw3=(u32x4){PKW(pB1,8),PKW(pB1,10),PKW(pB1,12),PKW(pB1,14)};
    SBAR(); pv(o,vb0+sl_cur,PAF(0),PAF(1),PAF(2),PAF(3)); }
  #undef PKW
  #undef PAF
  #undef VFR
  #undef PIN
  #undef MX3
  #undef GAPA
  #undef GAPB
  #undef EX
  #undef VRD
  #undef KRD
  #undef STEP
  #undef ENDW
  {auto rr=__builtin_amdgcn_permlane32_swap(__float_as_uint(l_reg),__float_as_uint(l_reg),false,false);l_reg=__uint_as_float(rr[0])+__uint_as_float(rr[1]);}
  if(hi==0)wsf[32+r32]=l_reg;asm volatile("s_waitcnt lgkmcnt(0)":::"memory");
  float rli[16];
  #pragma unroll
  for(int r=0;r<16;++r)rli[r]=__builtin_amdgcn_rcpf(wsf[32+crow(r,hi)]);
  bf16*Ow=O+(rowbase+q0+wid*QBLK)*DM+h*D;
  { bf16*stg=(bf16*)(shm+LDS_OST)+wid*2048;
    #pragma unroll
    for(int r=0;r<16;++r){const int orow=crow(r,hi);
      #pragma unroll
      for(int d0=0;d0<2;++d0)stg[orow*64+d0*32+r32]=__float2bfloat16(o[d0][r]*rli[r]);}
    asm volatile("s_waitcnt lgkmcnt(0)":::"memory");
    #pragma unroll
    for(int i=0;i<4;++i){const int row=i*8+(lane>>3),ch=lane&7; const u32x4 v=*(const u32x4*)(stg+row*64+ch*8); ATTN_STORE16(Ow+(long)row*DM+ch*8,v);} }
  asm volatile("s_waitcnt lgkmcnt(0)\n\ts_barrier":::"memory");
  #undef DMA_K
  #undef DMA_V
  #undef CMASK
  #undef START
  #undef RESC
  #undef ROT
}
constexpr int ATTN_LDS_BYTES=LDS_BYTES;
struct AttnTensors { const bf16* Q; const bf16* K; const bf16* V; bf16* O; const float* CL; const unsigned* KMAX; };
struct AttnUnit { int bh; int qb; };
struct StaticOrder {
  int vcu;
  __device__ __forceinline__ explicit StaticOrder(int grid,int block):vcu((grid%8==0)?(block%8)*(grid/8)+block/8:block){}
  __device__ __forceinline__ bool next(int i,AttnUnit&u)const{ if(i>=4||vcu>=256)return false; const int s=vcu&15; u.bh=vcu>>4; u.qb=(i==0)?63-s:(i==1)?32+s:(i==2)?31-s:s; return true; }
};
template<class Sched,int THRL=8> __device__ __forceinline__ void attn_phase(char*lds,const AttnTensors&T,const Sched&S){
  AttnUnit u;
  for(int i=0;S.next(i,u);++i){ attn_unit<THRL>(0,u.bh,u.qb,T.Q,T.K,T.V,T.O,lds,T.CL+(size_t)u.bh*SEQ,__builtin_bit_cast(float,T.KMAX[u.bh])); }
}
#undef SBAR
#undef WAIT_BAR
}
namespace sattn {
#define SLAS __attribute__((address_space(3)))
typedef short bf16x8 __attribute__((ext_vector_type(8)));
typedef float f32x4 __attribute__((ext_vector_type(4)));
typedef unsigned u32x4 __attribute__((ext_vector_type(4)));
typedef unsigned u32x2 __attribute__((ext_vector_type(2)));
typedef float f32x2_t __attribute__((ext_vector_type(2))); typedef __bf16 bf16x2_t __attribute__((ext_vector_type(2)));
__device__ __forceinline__ unsigned pk(float lo, float hi) { f32x2_t v = {lo, hi}; bf16x2_t b = __builtin_convertvector(v, bf16x2_t); return __builtin_bit_cast(unsigned, b); }
__device__ __forceinline__ bf16x8 cvt8(f32x4 a, f32x4 b) { u32x4 w; w.x = pk(a[0], a[1]); w.y = pk(a[2], a[3]); w.z = pk(b[0], b[1]); w.w = pk(b[2], b[3]); return __builtin_bit_cast(bf16x8, w); }
constexpr int PAST = 2048, NEWK = 16, LKEYS = PAST + NEWK, VT_STRIDE = 80, VT_BYTES = 64 * VT_STRIDE;
constexpr int L_VT = 0, L_CO = 8 * VT_BYTES, L_CM = L_CO + 8 * 16 * 64 * 4, L_CL = L_CM + 8 * 16 * 4, L_END = L_CL + 8 * 16 * 4;
constexpr float NEG = -1.0e30f;
struct Tensors { const float* ck; const float* cv; const unsigned short* QB; const unsigned short* KB; const unsigned short* VB; unsigned short* O; const float* CLS; };
__device__ __forceinline__ void tile_tail(f32x4 (&s)[2], const bf16x8 (&vw)[4], float& m, float& l, f32x4 (&o)[4], SLAS char* vt, int r, int g) {
    float mx = fmaxf(fmaxf(fmaxf(s[0][0], s[0][1]), fmaxf(s[0][2], s[0][3])), fmaxf(fmaxf(s[1][0], s[1][1]), fmaxf(s[1][2], s[1][3])));
    mx = fmaxf(mx, __shfl_xor(mx, 16)); mx = fmaxf(mx, __shfl_xor(mx, 32));
    const float mn = fmaxf(m, mx), alpha = __builtin_amdgcn_exp2f(m - mn); m = mn;
    float ps = 0.f;
#pragma unroll
    for (int j = 0; j < 2; ++j)
#pragma unroll
        for (int e = 0; e < 4; ++e) { s[j][e] = __builtin_amdgcn_exp2f(s[j][e] - mn); ps += s[j][e]; }
    l = l * alpha + ps;
#pragma unroll
    for (int db = 0; db < 4; ++db) o[db] *= alpha;
    const bf16x8 pb = cvt8(s[0], s[1]);
#pragma unroll
    for (int dd = 0; dd < 4; ++dd) *(SLAS bf16x8*)(vt + (4 * r + dd) * VT_STRIDE + g * 16) = vw[dd];
#pragma unroll
    for (int db = 0; db < 4; ++db) { const bf16x8 va = *(const SLAS bf16x8*)(vt + (16 * db + r) * VT_STRIDE + g * 16); o[db] = __builtin_amdgcn_mfma_f32_16x16x32_bf16(va, pb, o[db], 0, 0, 0); }
}
__device__ __forceinline__ void unit(int b, int h, const Tensors& T, SLAS char* lds) {
    const int tid = opaque_tid(), lane = tid & 63, r = lane & 15, g = lane >> 4; const int wid = __builtin_amdgcn_readfirstlane(tid >> 6);
    SLAS char* vt = lds + L_VT + wid * VT_BYTES;
    const size_t srow = (size_t)16384 + (size_t)b * 16;
    const float* cls = T.CLS + (size_t)(b * 16 + h) * LKEYS;
    const unsigned short* qp = T.QB + (srow + r) * 1024 + h * 64 + 8 * g;
    const bf16x8 qf0 = *(const bf16x8*)qp, qf1 = *(const bf16x8*)(qp + 32);
    const float cq = cls[PAST + r];
    float m = NEG, l = 0.f; f32x4 o[4];
#pragma unroll
    for (int db = 0; db < 4; ++db) o[db] = (f32x4){0.f, 0.f, 0.f, 0.f};
    const float* kc = T.ck + ((size_t)b * PAST * 16 + h) * 64; const float* vc = T.cv + ((size_t)b * PAST * 16 + h) * 64;
    for (int tI = 0; tI < 8; ++tI) {
        const int k0 = wid * 256 + tI * 32;
        bf16x8 ka[2][2];
#pragma unroll
        for (int j = 0; j < 2; ++j)
#pragma unroll
            for (int dh = 0; dh < 2; ++dh) { const float* p = kc + (size_t)(k0 + 16 * j + r) * 1024 + dh * 32 + 8 * g; ka[j][dh] = cvt8(*(const f32x4*)p, *(const f32x4*)(p + 4)); }
        f32x4 vv[2][4];
#pragma unroll
        for (int j = 0; j < 2; ++j)
#pragma unroll
            for (int e = 0; e < 4; ++e) vv[j][e] = *(const f32x4*)(vc + (size_t)(k0 + 16 * j + 4 * g + e) * 1024 + 4 * r);
        f32x4 ckv[2];
#pragma unroll
        for (int j = 0; j < 2; ++j) ckv[j] = *(const f32x4*)(cls + k0 + 16 * j + 4 * g);
        f32x4 s[2];
#pragma unroll
        for (int j = 0; j < 2; ++j) { s[j] = __builtin_amdgcn_mfma_f32_16x16x32_bf16(ka[j][0], qf0, (f32x4){0.f, 0.f, 0.f, 0.f}, 0, 0, 0); s[j] = __builtin_amdgcn_mfma_f32_16x16x32_bf16(ka[j][1], qf1, s[j], 0, 0, 0); }
#pragma unroll
        for (int j = 0; j < 2; ++j)
#pragma unroll
            for (int e = 0; e < 4; ++e) s[j][e] += cq - ckv[j][e];
        bf16x8 vw[4];
#pragma unroll
        for (int dd = 0; dd < 4; ++dd) { u32x4 w; w.x = pk(vv[0][0][dd], vv[0][1][dd]); w.y = pk(vv[0][2][dd], vv[0][3][dd]); w.z = pk(vv[1][0][dd], vv[1][1][dd]); w.w = pk(vv[1][2][dd], vv[1][3][dd]); vw[dd] = __builtin_bit_cast(bf16x8, w); }
        tile_tail(s, vw, m, l, o, vt, r, g);
    }
    if (wid == 0) {
        bf16x8 ka[2]; { const unsigned short* p = T.KB + (srow + r) * 1024 + h * 64 + 8 * g; ka[0] = *(const bf16x8*)p; ka[1] = *(const bf16x8*)(p + 32); }
        const f32x4 ckv = *(const f32x4*)(cls + PAST + 4 * g);
        f32x4 s[2];
        s[0] = __builtin_amdgcn_mfma_f32_16x16x32_bf16(ka[0], qf0, (f32x4){0.f, 0.f, 0.f, 0.f}, 0, 0, 0); s[0] = __builtin_amdgcn_mfma_f32_16x16x32_bf16(ka[1], qf1, s[0], 0, 0, 0);
#pragma unroll
        for (int e = 0; e < 4; ++e) { s[0][e] += cq - ckv[e]; if (4 * g + e > r) s[0][e] = NEG; s[1][e] = NEG; }
        unsigned short ve[4][4];
#pragma unroll
        for (int e = 0; e < 4; ++e) { const u32x2 w = *(const u32x2*)(T.VB + (srow + 4 * g + e) * 1024 + h * 64 + 4 * r); ve[e][0] = (unsigned short)(w.x & 0xffffu); ve[e][1] = (unsigned short)(w.x >> 16); ve[e][2] = (unsigned short)(w.y & 0xffffu); ve[e][3] = (unsigned short)(w.y >> 16); }
        bf16x8 vw[4];
#pragma unroll
        for (int dd = 0; dd < 4; ++dd) { u32x4 w; w.x = (unsigned)ve[0][dd] | ((unsigned)ve[1][dd] << 16); w.y = (unsigned)ve[2][dd] | ((unsigned)ve[3][dd] << 16); w.z = 0u; w.w = 0u; vw[dd] = __builtin_bit_cast(bf16x8, w); }
        tile_tail(s, vw, m, l, o, vt, r, g);
    }
    l += __shfl_xor(l, 16); l += __shfl_xor(l, 32);
    SLAS float* co = (SLAS float*)(lds + L_CO) + (wid * 16 + r) * 64; SLAS float* cm = (SLAS float*)(lds + L_CM); SLAS float* cl = (SLAS float*)(lds + L_CL);
#pragma unroll
    for (int db = 0; db < 4; ++db) *(SLAS f32x4*)(co + 16 * db + 4 * g) = o[db];
    if (g == 0) { cm[wid * 16 + r] = m; cl[wid * 16 + r] = l; }
    __syncthreads();
    { const int q = tid >> 5, d2 = (tid & 31) * 2; float mm = NEG;
#pragma unroll
      for (int w = 0; w < 8; ++w) mm = fmaxf(mm, cm[w * 16 + q]);
      float den = 0.f, n0 = 0.f, n1 = 0.f;
#pragma unroll
      for (int w = 0; w < 8; ++w) { const float f = __builtin_amdgcn_exp2f(cm[w * 16 + q] - mm); den += f * cl[w * 16 + q]; const SLAS float* c = (const SLAS float*)(lds + L_CO) + (w * 16 + q) * 64 + d2; n0 += f * c[0]; n1 += f * c[1]; }
      const float inv = 1.0f / den;
      *(unsigned*)(T.O + (srow + q) * 1024 + h * 64 + d2) = pk(n0 * inv, n1 * inv); }
    __syncthreads();
}
#undef SLAS
}
namespace cg = cooperative_groups;
constexpr int NWAVES = 8;
constexpr int D = 1024, H = 16, FF = 4096, MP = 16384, MS = 512, M = MP + MS, PAST = 2048, DBATCH = 32, DSEQ = 16, LKEYS = PAST + DSEQ;
constexpr float RMS_EPS = 1e-6f, L2E = 1.4426950408889634f, QSCALE = 0.125f * 1.4426950408889634f;
constexpr size_t OUT_Y = 0, OUT_KP = 17301504, OUT_VP = 34078720, OUT_LP = 50855936, OUT_CP = 51118080, OUT_KS = 51122176, OUT_VS = 51646464, OUT_LS = 52170752, OUT_CS = 52178944, OUT_END = 52310016;
static_assert(OUT_KP == (size_t)pg8::OUT_KP && OUT_VP == (size_t)pg8::OUT_VP && OUT_KS == (size_t)pg8::OUT_KS && OUT_VS == (size_t)pg8::OUT_VS, "d_out map");
constexpr size_t MiB = 1u << 20;
constexpr size_t WS_CTL = 0, CTL_ZERO_BYTES = 1 * MiB;
constexpr size_t WS_WIN = 2 * MiB, WS_WOUT = 14 * MiB, WS_WKVQ = 18 * MiB, WS_WQ1 = 24 * MiB, WS_WO = 26 * MiB, WS_WUP = 30 * MiB, WS_WDN = 62 * MiB, WS_WF = 94 * MiB;
constexpr size_t WS_X = 96 * MiB, WS_XB = 162 * MiB, WS_G = 195 * MiB, WS_KB = 228 * MiB, WS_VB = 261 * MiB, WS_QB = 294 * MiB, WS_HB = 327 * MiB, WS_SSQ = 459 * MiB, WS_CLP = 462 * MiB, WS_CLS = 463 * MiB, WS_END = 468 * MiB;
static_assert((size_t)M * D * 4 == 66 * MiB && (size_t)M * FF * 2 == 132 * MiB && (size_t)512 * LKEYS * 4 <= 5 * MiB && (size_t)M * pg8::NSSQ * 4 <= 3 * MiB, "d_ws map");
constexpr int CW_BAR = 4096, CW_KMAX = 2048;
constexpr int RING_OFF = 0, RING_BYTES = 131072;
constexpr int ATT_LDS = attn_body::LDS_BYTES;
constexpr int LDSCTL_OFF = (ATT_LDS > RING_BYTES ? ATT_LDS : RING_BYTES), MISC_OFF = LDSCTL_OFF + 320;
constexpr int LDS_BYTES = LDSCTL_OFF + 1024;
static_assert(LDS_BYTES <= 163840 && sattn::L_END <= RING_BYTES, "LDS map");

#define GAS __attribute__((address_space(1)))
#define LAS __attribute__((address_space(3)))
typedef unsigned short bf16;
typedef unsigned v4u __attribute__((ext_vector_type(4)));
typedef unsigned v2u __attribute__((ext_vector_type(2)));
typedef float f32x4 __attribute__((ext_vector_type(4)));
typedef short bf16x8 __attribute__((ext_vector_type(8)));
typedef GAS unsigned gu32;
#define RLX_AGENT __ATOMIC_RELAXED, __HIP_MEMORY_SCOPE_AGENT
#define LDS_WAIT() asm volatile("s_waitcnt lgkmcnt(0)" ::: "memory")
#define VM_WAIT() asm volatile("s_waitcnt vmcnt(0)" ::: "memory")
__device__ __forceinline__ unsigned pk2(float lo, float hi) { return sattn::pk(lo, hi); }
__device__ __forceinline__ float bflo(unsigned w) { return __builtin_bit_cast(float, w << 16); }
__device__ __forceinline__ float bfhi(unsigned w) { return __builtin_bit_cast(float, w & 0xffff0000u); }
#define XB_TMO      128
#define XB_XCNT(j)  (256  + 64 * (j))
#define XB_XSUB(j)  (1280 + 64 * (j))
#define XB_XGEN(j)  (2304 + 64 * (j))
#define XB_TOP      3328
#define XB_TOPGEN   3392
#define XCD_BAR_WORDS 3456
#define XB_SPIN_CAP (1u << 18)

__device__ __forceinline__ unsigned xb_ld(unsigned* p)              { return __hip_atomic_load(p, __ATOMIC_RELAXED, __HIP_MEMORY_SCOPE_AGENT); }
__device__ __forceinline__ unsigned xb_add(unsigned* p, unsigned v) { return __hip_atomic_fetch_add(p, v, __ATOMIC_RELAXED, __HIP_MEMORY_SCOPE_AGENT); }
__device__ __forceinline__ unsigned xb_xcc_id() { return (unsigned)__builtin_amdgcn_s_getreg((3 << 11) | 20) & 0xFu; }
#define XB_SPIN(cond, bar) do { unsigned _sp = 0; while (cond) { __builtin_amdgcn_s_sleep(1); \
    if ((++_sp & 255u) == 0u) { if (xb_ld(&(bar)[XB_TMO])) break; if (_sp > XB_SPIN_CAP) { atomicAdd(&(bar)[XB_TMO], 1u); break; } } } } while (0)

struct XcdBarrier {
    unsigned* bar; unsigned x;
    volatile LAS unsigned* st;
};

__device__ __forceinline__ XcdBarrier xcd_barrier_post(unsigned* bar, volatile LAS unsigned* st) {
    XcdBarrier b; b.bar = bar; b.x = xb_xcc_id(); b.st = st;
    if (threadIdx.x == 0) (void)xb_add(&bar[XB_XCNT(b.x)], 1u);
    return b;
}
__device__ __forceinline__ void xcd_barrier_complete(unsigned* bar, unsigned x, unsigned& nloc, unsigned& nx) {
    const unsigned G = gridDim.x * gridDim.y * gridDim.z;
    unsigned sum, cnt, mine, sp = 0u;
    for (;;) {
        sum = 0u; cnt = 0u; mine = 0u;
#pragma unroll
        for (unsigned j = 0; j < 16; ++j) { const unsigned c = xb_ld(&bar[XB_XCNT(j)]); sum += c; cnt += (c > 0u) ? 1u : 0u; mine = (j == x) ? c : mine; }
        if (sum == G) break;
        __builtin_amdgcn_s_sleep(1);
        if ((++sp & 255u) == 0u) { if (xb_ld(&bar[XB_TMO])) break; if (sp > XB_SPIN_CAP) { atomicAdd(&bar[XB_TMO], 1u); break; } }
    }
    nloc = mine > 0u ? mine : 1u; nx = cnt > 0u ? cnt : 1u;
}

__device__ __forceinline__ void xcd_barrier(const XcdBarrier& b) {
    asm volatile("s_waitcnt vmcnt(0)" ::: "memory");
    __syncthreads();
    if (threadIdx.x == 0) {
        unsigned* bar = b.bar;
        __builtin_amdgcn_s_waitcnt(0);
        unsigned nloc = b.st[0], nx = b.st[1];
        if (nloc == 0u) { xcd_barrier_complete(bar, b.x, nloc, nx); b.st[0] = nloc; b.st[1] = nx; }
        const unsigned old = xb_add(&bar[XB_XSUB(b.x)], 1u);
        const unsigned gen = old / nloc;
        if (old + 1u == (gen + 1u) * nloc) {
            __builtin_amdgcn_fence(__ATOMIC_RELEASE, "agent");
            asm volatile("s_waitcnt vmcnt(0)" ::: "memory");
            const unsigned og = xb_add(&bar[XB_TOP], 1u);
            const unsigned tg = og / nx;
            if (og + 1u == (tg + 1u) * nx) xb_add(&bar[XB_TOPGEN], 1u);
            else XB_SPIN(xb_ld(&bar[XB_TOPGEN]) == tg, bar);
            __builtin_amdgcn_fence(__ATOMIC_ACQUIRE, "agent");
            xb_add(&bar[XB_XGEN(b.x)], 1u);
            asm volatile("s_waitcnt vmcnt(0)" ::: "memory");
        } else {
            XB_SPIN(xb_ld(&bar[XB_XGEN(b.x)]) == gen, bar);
            __builtin_amdgcn_fence(__ATOMIC_ACQUIRE, "agent");
            asm volatile("s_waitcnt vmcnt(0)" ::: "memory");
        }
    }
    __syncthreads();
}
struct Args { const float* in[21]; float* out; unsigned char* ws; };
typedef const __attribute__((address_space(4))) Args* KArgs;
__device__ __forceinline__ KArgs kargs() { KArgs p = (KArgs)__builtin_amdgcn_kernarg_segment_ptr(); asm volatile("" : "+s"(p)); return p; }
struct Frame {
    LAS unsigned char* lds; volatile LAS unsigned* MISC; gu32* ctl;
    int tid, lane, wave, vcu, G;
};
__device__ __forceinline__ float wave_sum(float v) {
#pragma unroll
    for (int o = 1; o < 64; o <<= 1) v += __shfl_xor(v, o);
    return v;
}
__device__ __forceinline__ void p0_transpose_item(const float* W, int K, int N, bf16* WT, int row_off, LAS float* scr, int item, int lane, const float* gain, float scale) {
    const int nblk = N / 32, kb = item / nblk, nb = item % nblk, k0 = 64 * kb, n0 = 32 * nb;
#pragma unroll 8
    for (int i = 0; i < 32; ++i) { const int kk = 2 * i + (lane >> 5); const float gsc = gain ? gain[k0 + kk] * scale : scale; scr[kk * 33 + (lane & 31)] = W[(size_t)(k0 + kk) * N + n0 + (lane & 31)] * gsc; }
    LDS_WAIT(); asm volatile("" ::: "memory");
    const int c = lane & 7;
#pragma unroll
    for (int j = 0; j < 4; ++j) { const int n = (lane >> 3) + 8 * j; const LAS float* s = scr + (8 * c) * 33 + n;
        v4u o; o.x = pk2(s[0 * 33], s[1 * 33]); o.y = pk2(s[2 * 33], s[3 * 33]); o.z = pk2(s[4 * 33], s[5 * 33]); o.w = pk2(s[6 * 33], s[7 * 33]);
        *(GAS v4u*)(WT + (size_t)(row_off + n0 + n) * K + k0 + 8 * c) = o; }
    LDS_WAIT(); asm volatile("" ::: "memory");
}
enum { I_XP = 0, I_XS, I_CK, I_CV, I_CLF, I_SC, I_NMIX, I_NMLP, I_CIN, I_CW, I_COUT, I_NKV, I_WK, I_WV, I_WF, I_BF, I_WQ, I_WO, I_UP, I_DN, I_NF };

__device__ __forceinline__ void p0_prologue(const Frame& F, KArgs a, unsigned char* ws) {
    const int T_tid = opaque_tid(), T_lane = T_tid & 63, T_wave = __builtin_amdgcn_readfirstlane(T_tid >> 6);
    LAS float* scr = (LAS float*)(F.lds + RING_OFF + T_wave * 16384);
    const int gw = F.vcu * NWAVES + T_wave, NGW = F.G * NWAVES;
    constexpr int NCHUNK = 46;
    for (int it = gw; it < NCHUNK * 512; it += NGW) {
        int c = it >> 9, base = 0; const float* src = nullptr; const float* gain = nullptr; bf16* dst = nullptr; int roff = 0, K = D, N = D; float sc = 1.f;
        if (c < 6) { const int l = c / 3; src = a->in[I_CIN] + (size_t)l * D * 3 * D; gain = a->in[I_NMIX] + l * D; dst = (bf16*)(ws + WS_WIN) + (size_t)l * 3 * D * D; N = 3 * D; base = l * 3; }
        else if (c < 8) { const int l = c - 6; src = a->in[I_COUT] + (size_t)l * D * D; dst = (bf16*)(ws + WS_WOUT) + (size_t)l * D * D; base = c; }
        else if (c < 9) { src = a->in[I_WK]; gain = a->in[I_NKV]; dst = (bf16*)(ws + WS_WKVQ); base = c; }
        else if (c < 10) { src = a->in[I_WV]; gain = a->in[I_NKV]; dst = (bf16*)(ws + WS_WKVQ); roff = D; base = c; }
        else if (c < 11) { src = a->in[I_WQ]; gain = a->in[I_NMIX] + 2 * D; dst = (bf16*)(ws + WS_WKVQ); roff = 2 * D; sc = QSCALE; base = c; }
        else if (c < 12) { src = a->in[I_WQ] + (size_t)D * D; gain = a->in[I_NMIX] + 3 * D; dst = (bf16*)(ws + WS_WQ1); sc = QSCALE; base = c; }
        else if (c < 14) { const int j = c - 12; src = a->in[I_WO] + (size_t)j * D * D; dst = (bf16*)(ws + WS_WO) + (size_t)j * D * D; base = c; }
        else if (c < 30) { const int l = (c - 14) >> 2; src = a->in[I_UP] + (size_t)l * D * FF; gain = a->in[I_NMLP] + l * D; dst = (bf16*)(ws + WS_WUP) + (size_t)l * D * FF; N = FF; base = 14 + 4 * l; }
        else { const int l = (c - 30) >> 2; src = a->in[I_DN] + (size_t)l * D * FF; dst = (bf16*)(ws + WS_WDN) + (size_t)l * D * FF; K = FF; base = 30 + 4 * l; }
        p0_transpose_item(src, K, N, dst, roff, scr, it - base * 512, T_lane, gain, sc);
    }
    for (int i = (F.vcu * NWAVES + T_wave) * 64 + T_lane; i < D * H; i += NGW * 64) { const int k = i >> 4, h = i & 15; ((bf16*)(ws + WS_WF))[h * D + k] = (bf16)(pk2(a->in[I_NKV][k] * a->in[I_WF][i], 0.f) & 0xffffu); }
    float* X = (float*)(ws + WS_X); bf16* XB = (bf16*)(ws + WS_XB); float* SSQ = (float*)(ws + WS_SSQ);
    for (int m = gw; m < M; m += NGW) {
        const float* xr = (m < MP) ? a->in[I_XP] + (size_t)m * D : a->in[I_XS] + (size_t)(m - MP) * D;
        const GAS f32x4* xp = (const GAS f32x4*)xr + T_lane; f32x4 v[4]; float s = 0.f;
#pragma unroll
        for (int j = 0; j < 4; ++j) { v[j] = xp[64 * j]; s += (v[j].x * v[j].x + v[j].y * v[j].y) + (v[j].z * v[j].z + v[j].w * v[j].w); }
        s = wave_sum(s);
        GAS f32x4* xo = (GAS f32x4*)(X + (size_t)m * D) + T_lane; GAS v2u* bo = (GAS v2u*)(XB + (size_t)m * D) + T_lane;
#pragma unroll
        for (int j = 0; j < 4; ++j) { xo[64 * j] = v[j]; v2u w; w.x = pk2(v[j].x, v[j].y); w.y = pk2(v[j].z, v[j].w); bo[64 * j] = w; }
        if (T_lane < pg8::NSSQ) SSQ[(size_t)m * pg8::NSSQ + T_lane] = (T_lane == 0) ? s : 0.f;
    }
}
__device__ __forceinline__ void conv_gate_phase(const Frame& F, KArgs a, unsigned char* ws, int l) {
    const int T_tid = opaque_tid(), T_lane = T_tid & 63, T_wave = __builtin_amdgcn_readfirstlane(T_tid >> 6);
    const int gw = F.vcu * NWAVES + T_wave, NGW = F.G * NWAVES;
    const bf16* BCX = (const bf16*)(ws + WS_HB); bf16* Gm = (bf16*)(ws + WS_G);
    const float* cw = a->in[I_CW] + (size_t)l * 3 * D;
    for (int it = gw; it < (M / 8) * 2; it += NGW) {
        const int half = it & 1, row0 = (it >> 1) * 8, c0 = half * 512 + T_lane * 8;
        float w0[8], w1[8], w2[8], um2[8], um1[8];
        { const f32x4 a0 = *(const f32x4*)(cw + c0), a1 = *(const f32x4*)(cw + c0 + 4), b0 = *(const f32x4*)(cw + D + c0), b1 = *(const f32x4*)(cw + D + c0 + 4), d0 = *(const f32x4*)(cw + 2 * D + c0), d1 = *(const f32x4*)(cw + 2 * D + c0 + 4);
#pragma unroll
          for (int e = 0; e < 4; ++e) { w0[e] = a0[e]; w0[4 + e] = a1[e]; w1[e] = b0[e]; w1[4 + e] = b1[e]; w2[e] = d0[e]; w2[4 + e] = d1[e]; } }
        const bool sample = row0 >= MP; const int sb = sample ? (row0 - MP) >> 4 : 0; const int t0 = sample ? (row0 - MP) & 15 : row0;
        if (t0 == 0) {
            if (sample) { const float* st = a->in[I_SC] + ((size_t)(l * DBATCH + sb) * 2) * D + c0;
                const f32x4 p0 = *(const f32x4*)st, p1 = *(const f32x4*)(st + 4), q0 = *(const f32x4*)(st + D), q1 = *(const f32x4*)(st + D + 4);
#pragma unroll
                for (int e = 0; e < 4; ++e) { um2[e] = p0[e]; um2[4 + e] = p1[e]; um1[e] = q0[e]; um1[4 + e] = q1[e]; } }
            else {
#pragma unroll
                for (int e = 0; e < 8; ++e) { um2[e] = 0.f; um1[e] = 0.f; } }
        } else {
#pragma unroll
            for (int k = 0; k < 2; ++k) { const bf16* rp = BCX + (size_t)(row0 - 2 + k) * 3072 + c0; const v4u gc = *(const v4u*)(rp + D), xv = *(const v4u*)(rp + 2 * D);
#pragma unroll
                for (int e = 0; e < 4; ++e) { const float u0 = bflo(gc[e]) * bflo(xv[e]), u1 = bfhi(gc[e]) * bfhi(xv[e]); if (k == 0) { um2[2 * e] = u0; um2[2 * e + 1] = u1; } else { um1[2 * e] = u0; um1[2 * e + 1] = u1; } } }
        }
#pragma unroll
        for (int i = 0; i < 8; ++i) { const bf16* rp = BCX + (size_t)(row0 + i) * 3072 + c0; const v4u gb = *(const v4u*)rp, gc = *(const v4u*)(rp + D), xv = *(const v4u*)(rp + 2 * D);
            float u[8], o[8];
#pragma unroll
            for (int e = 0; e < 4; ++e) { u[2 * e] = bflo(gc[e]) * bflo(xv[e]); u[2 * e + 1] = bfhi(gc[e]) * bfhi(xv[e]); }
#pragma unroll
            for (int e = 0; e < 8; ++e) o[e] = w0[e] * um2[e] + w1[e] * um1[e] + w2[e] * u[e];
            v4u w;
#pragma unroll
            for (int e = 0; e < 4; ++e) w[e] = pk2(bflo(gb[e]) * o[2 * e], bfhi(gb[e]) * o[2 * e + 1]);
            *(v4u*)(Gm + (size_t)(row0 + i) * D + c0) = w;
#pragma unroll
            for (int e = 0; e < 8; ++e) { um2[e] = um1[e]; um1[e] = u[e]; } }
        const bool last = sample ? (t0 == 8) : (row0 + 8 == MP);
        if (last) { float* o = a->out + (sample ? OUT_CS + ((size_t)(l * DBATCH + sb) * 2) * D : OUT_CP + (size_t)l * 2 * D) + c0;
            *(f32x4*)o = (f32x4){um2[0], um2[1], um2[2], um2[3]}; *(f32x4*)(o + 4) = (f32x4){um2[4], um2[5], um2[6], um2[7]};
            *(f32x4*)(o + D) = (f32x4){um1[0], um1[1], um1[2], um1[3]}; *(f32x4*)(o + D + 4) = (f32x4){um1[4], um1[5], um1[6], um1[7]}; }
    }
}
__device__ __forceinline__ void logf_phase(const Frame& F, KArgs a, unsigned char* ws) {
    const int T_tid = opaque_tid(), T_lane = T_tid & 63, T_wave = __builtin_amdgcn_readfirstlane(T_tid >> 6);
    const int gw = F.vcu * NWAVES + T_wave, NGW = F.G * NWAVES; const int r = T_lane & 15, g = T_lane >> 4;
    const bf16* WF = (const bf16*)(ws + WS_WF); const bf16* XB = (const bf16*)(ws + WS_XB); const float* SSQ = (const float*)(ws + WS_SSQ);
    for (int blk = gw; blk < M / 16; blk += NGW) {
        const int row = blk * 16 + r; f32x4 acc = (f32x4){0.f, 0.f, 0.f, 0.f};
        const bf16* ap = WF + (size_t)r * D + 8 * g; const bf16* bp = XB + (size_t)row * D + 8 * g;
#pragma unroll 8
        for (int s = 0; s < 32; ++s) acc = __builtin_amdgcn_mfma_f32_16x16x32_bf16(*(const bf16x8*)(ap + 32 * s), *(const bf16x8*)(bp + 32 * s), acc, 0, 0, 0);
        const float rs = pg8::row_rstd(SSQ, row); const f32x4 bfv = *(const f32x4*)(a->in[I_BF] + 4 * g); f32x4 o;
#pragma unroll
        for (int e = 0; e < 4; ++e) { const float z = acc[e] * rs + bfv[e]; o[e] = fminf(z, 0.f) - log1pf(expf(-fabsf(z))); }
        float* op = a->out + ((row < MP) ? OUT_LP + (size_t)row * 16 : OUT_LS + (size_t)(row - MP) * 16) + 4 * g;
        *(f32x4*)op = o;
    }
}
__device__ __forceinline__ double wave_scan_incl(double v, int lane) {
#pragma unroll
    for (int o = 1; o < 64; o <<= 1) { const double t = __shfl_up(v, o); if (lane >= o) v += t; }
    return v;
}
__device__ __forceinline__ void scan_phase(const Frame& F, KArgs a, unsigned char* ws) {
    const int T_tid = opaque_tid(), T_lane = T_tid & 63, T_wave = __builtin_amdgcn_readfirstlane(T_tid >> 6);
    float* CLP = (float*)(ws + WS_CLP); float* CLS = (float*)(ws + WS_CLS);
    const int blk = blockIdx.x;
    if (blk < 16) {
        const int h = blk; const float* lf = a->out + OUT_LP; const int t0 = T_tid * 32; double s = 0.0;
#pragma unroll 8
        for (int i = 0; i < 32; ++i) s += (double)lf[(size_t)(t0 + i) * 16 + h];
        const double inc = wave_scan_incl(s, T_lane);
        LAS double* wt = (LAS double*)(F.lds + RING_OFF);
        if (T_lane == 63) wt[T_wave] = inc;
        __syncthreads();
        double run = inc - s;
        for (int w = 0; w < T_wave; ++w) run += wt[w];
#pragma unroll 8
        for (int i = 0; i < 32; ++i) { run += (double)lf[(size_t)(t0 + i) * 16 + h]; CLP[(size_t)h * MP + t0 + i] = (float)(run * (double)L2E); }
        __syncthreads();
    } else {
        const int nws = (F.G - 16) * NWAVES;
        for (int seq = (blk - 16) * NWAVES + T_wave; seq < DBATCH * H; seq += nws) {
            const int b = seq >> 4, h = seq & 15; const float* clf = a->in[I_CLF] + (size_t)b * PAST * 16 + h; const float* nlf = a->out + OUT_LS + (size_t)b * DSEQ * 16 + h;
            const int s0 = T_lane * 33; double s = 0.0;
            for (int i = 0; i < 33; ++i) { const int k = s0 + i; if (k < LKEYS) s += (double)(k < PAST ? clf[(size_t)k * 16] : nlf[(size_t)(k - PAST) * 16]); }
            double run = wave_scan_incl(s, T_lane) - s;
            for (int i = 0; i < 33; ++i) { const int k = s0 + i; if (k < LKEYS) { run += (double)(k < PAST ? clf[(size_t)k * 16] : nlf[(size_t)(k - PAST) * 16]); CLS[(size_t)seq * LKEYS + k] = (float)(run * (double)L2E); } }
        }
    }
    { const int gw = F.vcu * NWAVES + T_wave, NGW = F.G * NWAVES; const bf16* KB = (const bf16*)(ws + WS_KB); float mx = 0.f;
      for (int row = gw; row < MP; row += NGW) { const v4u p = *(const v4u*)(KB + (size_t)row * D + T_lane * 16), q = *(const v4u*)(KB + (size_t)row * D + T_lane * 16 + 8); float sq = 0.f;
#pragma unroll
          for (int e = 0; e < 4; ++e) { const float a0 = bflo(p[e]), a1 = bfhi(p[e]), b0 = bflo(q[e]), b1 = bfhi(q[e]); sq += (a0 * a0 + a1 * a1) + (b0 * b0 + b1 * b1); }
          sq += __shfl_xor(sq, 1); sq += __shfl_xor(sq, 2); mx = fmaxf(mx, sq); }
      __syncthreads();
      LAS float* km = (LAS float*)(F.lds + RING_OFF) + 64;
      if ((T_lane & 3) == 0) km[T_wave * 16 + (T_lane >> 2)] = mx;
      __syncthreads();
      if (T_tid < 16) { float m = km[T_tid];
#pragma unroll
          for (int w = 1; w < NWAVES; ++w) m = fmaxf(m, km[w * 16 + T_tid]);
          atomicMax((unsigned*)(ws + WS_CTL) + CW_KMAX + T_tid, __builtin_bit_cast(unsigned, m)); }
      __syncthreads(); }
}
__device__ __forceinline__ void final_norm_phase(const Frame& F, KArgs a, unsigned char* ws) {
    const int T_tid = opaque_tid(), T_lane = T_tid & 63, T_wave = __builtin_amdgcn_readfirstlane(T_tid >> 6);
    const int gw = F.vcu * NWAVES + T_wave, NGW = F.G * NWAVES; const float* X = (const float*)(ws + WS_X);
    const GAS f32x4* gp = (const GAS f32x4*)a->in[I_NF] + T_lane; f32x4 gn[4];
#pragma unroll
    for (int j = 0; j < 4; ++j) gn[j] = gp[64 * j];
    for (int m = gw; m < M; m += NGW) {
        const GAS f32x4* xp = (const GAS f32x4*)(X + (size_t)m * D) + T_lane; f32x4 v[4]; float s = 0.f;
#pragma unroll
        for (int j = 0; j < 4; ++j) { v[j] = xp[64 * j]; s += (v[j].x * v[j].x + v[j].y * v[j].y) + (v[j].z * v[j].z + v[j].w * v[j].w); }
        const float rs = 1.0f / sqrtf(wave_sum(s) * (1.0f / D) + RMS_EPS);
        GAS f32x4* op = (GAS f32x4*)(a->out + OUT_Y + (size_t)m * D) + T_lane;
#pragma unroll
        for (int j = 0; j < 4; ++j) op[64 * j] = v[j] * rs * gn[j];
    }
}

__global__ void __launch_bounds__(NWAVES * 64, 2) yoco_fwd(Args args) {
    extern __shared__ __attribute__((aligned(16))) unsigned char lds[];
    Frame F;
    F.lds = (LAS unsigned char*)lds;
    F.MISC = (volatile LAS unsigned*)(F.lds + MISC_OFF);
    F.tid = threadIdx.x; F.lane = F.tid & 63; F.wave = __builtin_amdgcn_readfirstlane(F.tid >> 6);
    F.G = gridDim.x; { const int bx = blockIdx.x; F.vcu = (F.G % 8 == 0) ? (bx % 8) * (F.G / 8) + bx / 8 : bx; }
    F.ctl = (gu32*)(kargs()->ws + WS_CTL);
    for (int u = F.tid; u < (LDS_BYTES - LDSCTL_OFF) / 4; u += NWAVES * 64) ((LAS unsigned*)(F.lds + LDSCTL_OFF))[u] = 0u;
    __syncthreads();
    XcdBarrier bar = xcd_barrier_post((unsigned*)(F.ctl + CW_BAR), F.MISC + 8);
#define GRID_BAR() xcd_barrier(bar)
#define WSP(T, off) ((T*)(kargs()->ws + (off)))

    p0_prologue(F, kargs(), kargs()->ws);
    cg::this_grid().sync();
    GRID_BAR();

#define SAMPLE_TILES(g, E) do { const int id_ = opaque_bid(); if (id_ < 4 * ((g).N / 128)) { const int mi_ = id_ & 3, ni_ = id_ >> 2; \
        pg8::gemm128_tile(F.lds + RING_OFF, (g).A + (size_t)(MP + 128 * mi_) * (g).K, (g).Bt + (size_t)(128 * ni_) * (g).K, (g).K, E, MP + 128 * mi_, 128 * ni_); } } while (0)
#define LAYER(l) do { \
        if ((l) != 2) { \
            constexpr bool cv = (l) < 2; unsigned char* ws = kargs()->ws; \
            pg8::Gemm g{(const bf16*)(ws + WS_XB), cv ? (const bf16*)(ws + WS_WIN) + (size_t)(l) * 3 * D * D : (const bf16*)(ws + WS_WQ1), M, cv ? 3 * D : D, D}; \
            pg8::StaticOrder S; S.init(MP, cv ? 3 * D : D, F.G, opaque_bid()); \
            pg8::EpiAct<0, false> E{cv ? (bf16*)(ws + WS_HB) : (bf16*)(ws + WS_QB), cv ? 3 * D : D, (const float*)(ws + WS_SSQ), 0, 0, nullptr}; \
            pg8::gemm_phase<pg8::EpiAct<0, false>, pg8::StaticOrder, PG8_ALIGN, PG8_SP2>(F.lds + RING_OFF, g, S, E); \
            SAMPLE_TILES(g, E); \
            GRID_BAR(); \
        } \
        if ((l) < 2) { conv_gate_phase(F, kargs(), kargs()->ws, (l)); } \
        else { \
            { unsigned char* ws = kargs()->ws; \
            const attn_body::AttnTensors AT{(const attn_body::bf16*)(ws + WS_QB), (const attn_body::bf16*)(ws + WS_KB), (const attn_body::bf16*)(ws + WS_VB), (attn_body::bf16*)(ws + WS_G), (const float*)(ws + WS_CLP), (const unsigned*)(ws + WS_CTL) + CW_KMAX}; \
            const attn_body::StaticOrder S((int)F.G, opaque_bid()); \
            attn_body::attn_phase<attn_body::StaticOrder>((char*)lds + RING_OFF, AT, S); } \
            __syncthreads(); \
            KArgs ka = kargs(); unsigned char* ws = ka->ws; \
            const sattn::Tensors ST{ka->in[I_CK], ka->in[I_CV], (const bf16*)(ws + WS_QB), (const bf16*)(ws + WS_KB), (const bf16*)(ws + WS_VB), (bf16*)(ws + WS_G), (const float*)(ws + WS_CLS)}; \
            for (int u = F.vcu; u < DBATCH * H; u += F.G) sattn::unit(u >> 4, u & 15, ST, (LAS char*)(F.lds + RING_OFF)); \
        } \
        GRID_BAR(); \
        { unsigned char* ws = kargs()->ws; \
            pg8::Gemm g{(const bf16*)(ws + WS_G), ((l) < 2) ? (const bf16*)(ws + WS_WOUT) + (size_t)(l) * D * D : (const bf16*)(ws + WS_WO) + (size_t)((l) - 2) * D * D, M, D, D}; \
            pg8::StaticOrder S; S.init(MP, D, F.G, opaque_bid()); \
            pg8::EpiResid E{(float*)(ws + WS_X), (bf16*)(ws + WS_XB), (float*)(ws + WS_SSQ)}; \
            pg8::gemm_phase<pg8::EpiResid, pg8::StaticOrder, PG8_ALIGN, PG8_SP2>(F.lds + RING_OFF, g, S, E); \
            SAMPLE_TILES(g, E); \
            GRID_BAR(); } \
        { unsigned char* ws = kargs()->ws; \
            pg8::Gemm g{(const bf16*)(ws + WS_XB), (const bf16*)(ws + WS_WUP) + (size_t)(l) * D * FF, M, FF, D}; \
            pg8::StaticOrder S; S.init(MP, FF, F.G, opaque_bid()); \
            pg8::EpiAct<1, false> E{(bf16*)(ws + WS_HB), FF, (const float*)(ws + WS_SSQ), 0, 0, nullptr}; \
            pg8::gemm_phase<pg8::EpiAct<1, false>, pg8::StaticOrder, PG8_ALIGN, PG8_SP2>(F.lds + RING_OFF, g, S, E); \
            SAMPLE_TILES(g, E); \
            GRID_BAR(); } \
        { unsigned char* ws = kargs()->ws; \
            pg8::Gemm g{(const bf16*)(ws + WS_HB), (const bf16*)(ws + WS_WDN) + (size_t)(l) * D * FF, M, D, FF}; \
            pg8::StaticOrder S; S.init(MP, D, F.G, opaque_bid()); \
            pg8::EpiResid E{(float*)(ws + WS_X), (bf16*)(ws + WS_XB), (float*)(ws + WS_SSQ)}; \
            pg8::gemm_phase<pg8::EpiResid, pg8::StaticOrder, PG8_ALIGN, PG8_SP2>(F.lds + RING_OFF, g, S, E); \
            SAMPLE_TILES(g, E); \
            GRID_BAR(); } \
        if ((l) == 1) { \
            KArgs ka = kargs(); unsigned char* ws = ka->ws; \
            pg8::Gemm g{(const bf16*)(ws + WS_XB), (const bf16*)(ws + WS_WKVQ), M, 3 * D, D}; \
            pg8::StaticOrder S; S.init(MP, 3 * D, F.G, opaque_bid()); \
            pg8::EpiAct<0, true> E{(bf16*)(ws + WS_KB), D, (const float*)(ws + WS_SSQ), D, (size_t)(WS_VB - WS_KB) / 2, ka->out}; \
            pg8::gemm_phase<pg8::EpiAct<0, true>, pg8::StaticOrder, PG8_ALIGN, PG8_SP2>(F.lds + RING_OFF, g, S, E); \
            SAMPLE_TILES(g, E); \
            logf_phase(F, kargs(), kargs()->ws); \
            GRID_BAR(); \
            scan_phase(F, kargs(), kargs()->ws); \
            GRID_BAR(); \
        } } while (0)
    LAYER(0); LAYER(1); LAYER(2); LAYER(3);
    final_norm_phase(F, kargs(), kargs()->ws);
}

extern "C" void kernel_launch(void* const* d_in, const int* in_sizes, int n_in, void* d_out, int out_size, void* d_ws, size_t ws_size, hipStream_t stream) {
    static int grid = 0;
    if (grid == 0) {
        if (n_in != 21 || out_size != (int)OUT_END || ws_size < WS_END) { fprintf(stderr, "kernel_launch: unexpected sizes (n_in %d, out %d, ws %zu); nothing launched\n", n_in, out_size, ws_size); grid = -1; return; }
        int dev = 0, cus = 0, per_cu = 0;
        if (hipGetDevice(&dev) != hipSuccess || hipDeviceGetAttribute(&cus, hipDeviceAttributeMultiprocessorCount, dev) != hipSuccess) { grid = -1; return; }
        if (hipFuncSetAttribute((const void*)yoco_fwd, hipFuncAttributeMaxDynamicSharedMemorySize, LDS_BYTES) != hipSuccess) { fprintf(stderr, "kernel_launch: hipFuncSetAttribute failed\n"); grid = -1; return; }
        if (hipOccupancyMaxActiveBlocksPerMultiprocessor(&per_cu, (const void*)yoco_fwd, NWAVES * 64, LDS_BYTES) != hipSuccess || per_cu < 1) { fprintf(stderr, "kernel_launch: occupancy query says %d\n", per_cu); per_cu = 1; }
        (void)hipGetLastError();
        grid = cus;
    }
    if (grid < 0) return;
    if (hipMemsetAsync((char*)d_ws + WS_CTL, 0, CTL_ZERO_BYTES, stream) != hipSuccess) { fprintf(stderr, "kernel_launch: memset failed\n"); return; }
    Args a{};
    for (int i = 0; i < 21; ++i) a.in[i] = (const float*)d_in[i];
    a.out = (float*)d_out; a.ws = (unsigned char*)d_ws;
    void* kargv[] = {&a};
    const hipError_t e = hipLaunchCooperativeKernel((const void*)yoco_fwd, dim3(grid), dim3(NWAVES * 64), kargv, LDS_BYTES, stream);
    if (e != hipSuccess) fprintf(stderr, "kernel_launch: cooperative launch failed: %s (grid %d)\n", hipGetErrorString(e), grid);
}
```

```cpp
#include <hip/hip_runtime.h>
#include <hip/hip_cooperative_groups.h>
#include <cstdio>
#include <cstdint>
__device__ __forceinline__ int opaque_bid() { int b = (int)blockIdx.x; asm volatile("" : "+s"(b)); return b; }
__device__ __forceinline__ int opaque_tid() { int t = (int)threadIdx.x; asm volatile("" : "+v"(t)); return t; }
namespace pg8 {
#define PG8_LAS __attribute__((address_space(3)))
typedef unsigned short bf16_t;
typedef short bf16x8 __attribute__((ext_vector_type(8)));
typedef float f32x4 __attribute__((ext_vector_type(4)));
typedef unsigned u32x4 __attribute__((ext_vector_type(4)));
constexpr int BM = 256, BK = 64, HALF = 128, HTB = HALF * BK * 2  , STAGE_BYTES = 8 * HTB, NXCD = 8, WGM = 8;

__host__ __device__ __forceinline__ int lds_byte(int r, int c) { const int st = (r >> 4) * 2 + (c >> 5), rr = r & 15, cc = c & 31, ob = rr * 64 + cc * 2; return st * 1024 + (ob ^ (((ob >> 9) & 1) << 5)); }
__host__ __device__ __forceinline__ void stage_rc(int b, int& R, int& C) { const int st = b / 1024, sb = b % 1024, swz = sb ^ (((sb >> 9) & 1) << 5); R = (st >> 1) * 16 + swz / 64; C = (st & 1) * 32 + (swz % 64) / 2; }
__host__ __device__ __forceinline__ int perm32(int rho) { const int n = rho >> 4, i = rho & 15; return 8 * (i >> 2) + 4 * n + (i & 3); }

struct Unit { int pm, pn; };
struct Gemm { const bf16_t* A; const bf16_t* Bt; int M, N, K; };

struct StaticOrder {
    int nM, nN, nwg, G, c;
    __host__ __device__ void init(int M, int N, int G_, int c_) { nM = M / BM; nN = N / BM; nwg = nM * nN; G = G_; c = c_; }
    __host__ __device__ bool next(int i, Unit& u) const {
        const long L = (long)i * G + c; if (L >= nwg) return false;
        int wgid = (int)L; { const int q = nwg / NXCD, r = nwg % NXCD, xcd = wgid % NXCD, off = wgid / NXCD; wgid = (xcd < r ? xcd * (q + 1) : r * (q + 1) + (xcd - r) * q) + off; }
        const int nig = WGM * nN, gid = wgid / nig, fm = gid * WGM, gsz = (nM - fm) < WGM ? (nM - fm) : WGM;
        u.pm = fm + ((wgid % nig) % gsz); u.pn = (wgid % nig) / gsz; return true;
    }
    __device__ __forceinline__ void a_ready(const Unit&) const {}
    __device__ __forceinline__ void done(const Unit&) const {}
};

__device__ __forceinline__ unsigned cvt_pk_bf16(float lo, float hi) { unsigned r; asm volatile("v_cvt_pk_bf16_f32 %0, %1, %2" : "=v"(r) : "v"(lo), "v"(hi)); return r; }
typedef float f32x2 __attribute__((ext_vector_type(2)));
__device__ __forceinline__ f32x2 gelu_pk(f32x2 v) {
    const f32x2 av = __builtin_elementwise_abs(v), d = av * 0.2316418882f + 1.0f;
    f32x2 t; t.x = __builtin_amdgcn_rcpf(d.x); t.y = __builtin_amdgcn_rcpf(d.y);
    f32x2 q = t * 0.5307027145f + (-0.7265760135f); q = q * t + 0.7107068705f; q = q * t + (-0.142248368f); q = q * t + 0.127414796f; q = q * t;
    const f32x2 s = (v * v) * (-0.72134752044f);
    f32x2 e; e.x = __builtin_amdgcn_exp2f(s.x); e.y = __builtin_amdgcn_exp2f(s.y);
    const f32x2 m = v * (q * e), r = v - m;
    f32x2 o; o.x = v.x < 0.f ? m.x : r.x; o.y = v.y < 0.f ? m.y : r.y; return o;
}

template <int ACT  > struct EpiBf16 {
    static constexpr bool PERM = true, AFTER_DRAIN = false; static_assert(ACT == 0 || ACT == 1, "EpiBf16: ACT is 0 (none) or 1 (gelu_pk)");
    bf16_t* O; int ldc; const float* bias; int split_cols; size_t split_stride; float scale0;
    __device__ __forceinline__ void operator()(const f32x4 (&acc)[2][2][4][2], const Unit& u, int wr, int wc, int fr, int fq) const {
        const int row0 = u.pm * BM + wr * 64 + fr; int colt = u.pn * BM; bf16_t* base = O;
        float sc = 1.f; if (split_cols) { const int t = colt / split_cols; base += (size_t)t * split_stride; colt -= t * split_cols; if (t == 0) sc = scale0; }
        const int col0 = colt + wc * 32 + 8 * fq, bcol0 = u.pn * BM + wc * 32 + 8 * fq;
        f32x4 bv[2][2];
#pragma unroll
        for (int bj = 0; bj < 2; ++bj)
#pragma unroll
            for (int n = 0; n < 2; ++n) bv[bj][n] = bias ? *(const f32x4*)(bias + bcol0 + bj * HALF + 4 * n) : (f32x4){0.f, 0.f, 0.f, 0.f};
#pragma unroll
        for (int ai = 0; ai < 2; ++ai)
#pragma unroll
            for (int m = 0; m < 4; ++m) { bf16_t* rowp = base + (size_t)(row0 + ai * HALF + m * 16) * ldc + col0;
#pragma unroll
                for (int bj = 0; bj < 2; ++bj) { f32x4 v0 = acc[ai][bj][m][0] + bv[bj][0], v1 = acc[ai][bj][m][1] + bv[bj][1];
                    if (ACT == 1) { f32x2 a = gelu_pk((f32x2){v0[0], v0[1]}), b = gelu_pk((f32x2){v0[2], v0[3]}), c = gelu_pk((f32x2){v1[0], v1[1]}), d = gelu_pk((f32x2){v1[2], v1[3]});
                        v0 = (f32x4){a.x, a.y, b.x, b.y}; v1 = (f32x4){c.x, c.y, d.x, d.y}; }
                    v0 = v0 * sc; v1 = v1 * sc; u32x4 w; w.x = cvt_pk_bf16(v0[0], v0[1]); w.y = cvt_pk_bf16(v0[2], v0[3]); w.z = cvt_pk_bf16(v1[0], v1[1]); w.w = cvt_pk_bf16(v1[2], v1[3]);
                    *(u32x4*)(rowp + bj * HALF) = w; } }
    }
};

struct PanelStats {
    unsigned* xbuf;
    unsigned* cnt;
    unsigned* tmo;
    int ntn; float eps;
    unsigned code;
    __device__ __forceinline__ bool run(const f32x4 (&v)[2][2][4][2], const Unit& u, int wr, int wc, int fr, int fq, PG8_LAS unsigned char* lds, int wid, int lane) const {
        typedef float f32x2v __attribute__((ext_vector_type(2)));
        PG8_LAS f32x2v* P = (PG8_LAS f32x2v*)lds;
        PG8_LAS f32x2v* S = (PG8_LAS f32x2v*)(lds + 8192);
        PG8_LAS unsigned* flag = (PG8_LAS unsigned*)(lds + 8192 + 2048);
#pragma unroll
        for (int ai = 0; ai < 2; ++ai)
#pragma unroll
            for (int m = 0; m < 4; ++m) {
                float s = 0.f;
#pragma unroll
                for (int bj = 0; bj < 2; ++bj)
#pragma unroll
                    for (int n = 0; n < 2; ++n) { const f32x4 x = v[ai][bj][m][n]; s += (x[0] + x[1]) + (x[2] + x[3]); }
                s += __shfl_xor(s, 16); s += __shfl_xor(s, 32);
                const float mw = s * (1.0f / 64.0f); float q = 0.f;
#pragma unroll
                for (int bj = 0; bj < 2; ++bj)
#pragma unroll
                    for (int n = 0; n < 2; ++n) { const f32x4 d = v[ai][bj][m][n] - mw; q += (d[0] * d[0] + d[1] * d[1]) + (d[2] * d[2] + d[3] * d[3]); }
                q += __shfl_xor(q, 16); q += __shfl_xor(q, 32);
                if (fq == 0) P[(ai * HALF + wr * 64 + m * 16 + fr) * 4 + wc] = (f32x2v){mw, q};
            }
        asm volatile("s_waitcnt lgkmcnt(0)" ::: "memory"); __builtin_amdgcn_s_barrier(); asm volatile("" ::: "memory");
#if defined(BROKEN_EXCHANGE_NO_WAIT)
#warning BROKEN CONTROL BUILD: the row-statistics exchange does not wait; results are wrong by design
        if (blockIdx.x >= 64) { const long long t0_ = clock64(); while (clock64() - t0_ < 60000) __builtin_amdgcn_s_sleep(8); }
#endif
        const int row = wid * 32 + (lane & 31);
        if (lane < 32) {
            const f32x2v a = P[row * 4 + 0], b = P[row * 4 + 1], c = P[row * 4 + 2], d = P[row * 4 + 3];
            const float mt = (a.x + b.x + c.x + d.x) * 0.25f;
            const float da = a.x - mt, db = b.x - mt, dc = c.x - mt, dd = d.x - mt;
            const float m2 = (a.y + b.y) + (c.y + d.y) + 64.0f * ((da * da + db * db) + (dc * dc + dd * dd));
            unsigned long long* slot = (unsigned long long*)xbuf + ((size_t)(u.pm * BM + row) * 4 + u.pn);
            __hip_atomic_store(slot, ((unsigned long long)__float_as_uint(m2) << 32) | __float_as_uint(mt), __ATOMIC_RELAXED, __HIP_MEMORY_SCOPE_AGENT);
        }
        asm volatile("s_waitcnt vmcnt(0)" ::: "memory");
        if (lane == 0) __hip_atomic_fetch_add(cnt + 64 * u.pm, 1u, __ATOMIC_RELAXED, __HIP_MEMORY_SCOPE_AGENT);
        if (wid == 0) {
            bool dead = false; const unsigned long long t0 = __builtin_amdgcn_s_memrealtime(); const unsigned want = 8u * (unsigned)ntn;
            for (;;) {
#if defined(BROKEN_EXCHANGE_NO_WAIT)
                break;
#endif
                if ((unsigned)__builtin_amdgcn_readfirstlane(__hip_atomic_load(cnt + 64 * u.pm, __ATOMIC_RELAXED, __HIP_MEMORY_SCOPE_AGENT)) >= want) break;
                if (__builtin_amdgcn_s_memrealtime() - t0 > 2000000ull) {
                    if (lane == 0) { unsigned expect = 0u; __hip_atomic_compare_exchange_strong(tmo + 1, &expect, code | (unsigned)(u.pm & 0xff), __ATOMIC_RELAXED, __ATOMIC_RELAXED, __HIP_MEMORY_SCOPE_AGENT);
                                     __hip_atomic_store(tmo, 1u, __ATOMIC_RELAXED, __HIP_MEMORY_SCOPE_AGENT); }
                    dead = true; break; }
                __builtin_amdgcn_s_sleep(2);
            }
            __builtin_amdgcn_fence(__ATOMIC_ACQUIRE, "agent");
            if (lane == 0) flag[0] = dead ? 1u : 0u;
        }
        asm volatile("s_waitcnt vmcnt(0) lgkmcnt(0)" ::: "memory"); __builtin_amdgcn_s_barrier(); asm volatile("" ::: "memory");
        const bool bad = flag[0] != 0u;
        if (lane < 32) {
            const unsigned long long* slot = (const unsigned long long*)xbuf + (size_t)(u.pm * BM + row) * 4; float mt[4], m2[4]; float ms = 0.f;
#pragma unroll
            for (int t = 0; t < 4; ++t) { if (t < ntn) { const unsigned long long w = __hip_atomic_load(slot + t, __ATOMIC_RELAXED, __HIP_MEMORY_SCOPE_AGENT); mt[t] = __uint_as_float((unsigned)w); m2[t] = __uint_as_float((unsigned)(w >> 32)); } else { mt[t] = 0.f; m2[t] = 0.f; } ms += mt[t]; }
            const float mean = ms / (float)ntn; float q = 0.f;
#pragma unroll
            for (int t = 0; t < 4; ++t) if (t < ntn) { const float dm = mt[t] - mean; q += m2[t] + 256.0f * dm * dm; }
            S[row] = (f32x2v){mean, 1.0f / sqrtf(q / (256.0f * (float)ntn) + eps)};
        }
        asm volatile("s_waitcnt lgkmcnt(0)" ::: "memory"); __builtin_amdgcn_s_barrier(); asm volatile("" ::: "memory");
        return bad;
    }
};
struct EpiLnRes {
    static constexpr bool PERM = false, AFTER_DRAIN = true;
    const float* base; float* out; int ldc; const float* bias; PanelStats st; unsigned poison;
    __device__ __forceinline__ void fused(f32x4 (&acc)[2][2][4][2], const Unit& u, int wr, int wc, int fr, int fq, PG8_LAS unsigned char* lds, int wid, int lane) const {
        typedef float f32x2v __attribute__((ext_vector_type(2)));
        const PG8_LAS f32x2v* S = (const PG8_LAS f32x2v*)(lds + 8192);
        const int col0 = u.pn * BM + wc * 32 + 4 * fq;
#pragma unroll
        for (int bj = 0; bj < 2; ++bj)
#pragma unroll
            for (int n = 0; n < 2; ++n) { const f32x4 bv = bias ? *(const f32x4*)(bias + col0 + bj * HALF + n * 16) : (f32x4){0.f, 0.f, 0.f, 0.f};
#pragma unroll
                for (int ai = 0; ai < 2; ++ai)
#pragma unroll
                    for (int m = 0; m < 4; ++m) acc[ai][bj][m][n] += bv; }
        f32x4 pre[4][2][2];
#pragma unroll
        for (int m = 0; m < 4; ++m) { const size_t off = (size_t)(u.pm * BM + wr * 64 + m * 16 + fr) * ldc + col0;
#pragma unroll
            for (int bj = 0; bj < 2; ++bj)
#pragma unroll
                for (int n = 0; n < 2; ++n) pre[m][bj][n] = *(const f32x4*)(base + off + bj * HALF + n * 16); }
        const bool bad = st.run(acc, u, wr, wc, fr, fq, lds, wid, lane) || poison != 0u;
        const float qnan = __builtin_nanf("");
#pragma unroll
        for (int ai = 0; ai < 2; ++ai)
#pragma unroll
            for (int m = 0; m < 4; ++m) { const int r = ai * HALF + wr * 64 + m * 16 + fr; const f32x2v sr = S[r]; const size_t off = (size_t)(u.pm * BM + r) * ldc + col0;
#pragma unroll
                for (int bj = 0; bj < 2; ++bj)
#pragma unroll
                    for (int n = 0; n < 2; ++n) { const f32x4 bs = ai == 0 ? pre[m][bj][n] : *(const f32x4*)(base + off + bj * HALF + n * 16); f32x4 o = bs + (acc[ai][bj][m][n] - sr.x) * sr.y;
                        if (bad) o = (f32x4){qnan, qnan, qnan, qnan}; *(f32x4*)(out + off + bj * HALF + n * 16) = o; }
                if (m & 1) asm volatile("" ::: "memory"); }
    }
};
struct EpiLnResLn {
    static constexpr bool PERM = false, AFTER_DRAIN = true;
    const float* base; float* out; bf16_t* xn; int ldc; const float* bias; PanelStats st1, st2; unsigned poison;
    __device__ __forceinline__ void fused(f32x4 (&acc)[2][2][4][2], const Unit& u, int wr, int wc, int fr, int fq, PG8_LAS unsigned char* lds, int wid, int lane) const {
        typedef float f32x2v __attribute__((ext_vector_type(2))); typedef unsigned u32x2v __attribute__((ext_vector_type(2)));
        const PG8_LAS f32x2v* S = (const PG8_LAS f32x2v*)(lds + 8192);
        const int col0 = u.pn * BM + wc * 32 + 4 * fq;
#pragma unroll
        for (int bj = 0; bj < 2; ++bj)
#pragma unroll
            for (int n = 0; n < 2; ++n) { const f32x4 bv = bias ? *(const f32x4*)(bias + col0 + bj * HALF + n * 16) : (f32x4){0.f, 0.f, 0.f, 0.f};
#pragma unroll
                for (int ai = 0; ai < 2; ++ai)
#pragma unroll
                    for (int m = 0; m < 4; ++m) acc[ai][bj][m][n] += bv; }
        bool bad = st1.run(acc, u, wr, wc, fr, fq, lds, wid, lane) || poison != 0u;
        const float qnan = __builtin_nanf("");
#pragma unroll
        for (int ai = 0; ai < 2; ++ai)
#pragma unroll
            for (int m = 0; m < 4; ++m) { const int r = ai * HALF + wr * 64 + m * 16 + fr; const f32x2v sr = S[r]; const size_t off = (size_t)(u.pm * BM + r) * ldc + col0;
#pragma unroll
                for (int bj = 0; bj < 2; ++bj)
#pragma unroll
                    for (int n = 0; n < 2; ++n) { const f32x4 bs = *(const f32x4*)(base + off + bj * HALF + n * 16); acc[ai][bj][m][n] = bs + (acc[ai][bj][m][n] - sr.x) * sr.y; }
                asm volatile("" : "+v"(acc[ai][0][m][0]), "+v"(acc[ai][0][m][1]), "+v"(acc[ai][1][m][0]), "+v"(acc[ai][1][m][1]));
                if (m & 1) asm volatile("" ::: "memory"); }
        const bool bad1 = bad;
        bad = st2.run(acc, u, wr, wc, fr, fq, lds, wid, lane) || bad;
#pragma unroll
        for (int ai = 0; ai < 2; ++ai)
#pragma unroll
            for (int m = 0; m < 4; ++m) { const int r = ai * HALF + wr * 64 + m * 16 + fr; const f32x2v sr = S[r]; const size_t off = (size_t)(u.pm * BM + r) * ldc + col0;
#pragma unroll
                for (int bj = 0; bj < 2; ++bj)
#pragma unroll
                    for (int n = 0; n < 2; ++n) { const f32x4 x1 = acc[ai][bj][m][n]; *(f32x4*)(out + off + bj * HALF + n * 16) = bad1 ? (f32x4){qnan, qnan, qnan, qnan} : x1;
                        const f32x4 o = (x1 - sr.x) * sr.y; u32x2v w; w.x = cvt_pk_bf16(o[0], o[1]); w.y = cvt_pk_bf16(o[2], o[3]);
                        if (bad) { w.x = 0x7fc07fc0u; w.y = 0x7fc07fc0u; } *(u32x2v*)(xn + off + bj * HALF + n * 16) = w; }
                asm volatile("" ::: "memory"); }
    }
};

template <class Epi, class Sched, bool ALIGN_EPI = false, bool SP2 = false>
__device__ __forceinline__ void gemm_phase(PG8_LAS unsigned char* lds, const Gemm g, const Sched& S, const Epi& E) {
    const int tid = opaque_tid(), wid = __builtin_amdgcn_readfirstlane(tid >> 6), lane = tid & 63, wr = wid >> 2, wc = wid & 3, fr = lane & 15, fq = lane >> 4;
    const int K = g.K, nt = K / BK;
    unsigned voffA[2], voffB[2];
#pragma unroll
    for (int i = 0; i < 2; ++i) { int R, C; stage_rc(tid * 16 + i * 8192, R, C); const int Rb = Epi::PERM ? ((R & ~31) + perm32(R & 31)) : R;
        voffA[i] = (unsigned)(R * K + C) * 2u; voffB[i] = (unsigned)(Rb * K + C) * 2u; }
    const size_t kstep = (size_t)(BK * 2);
    const size_t hstep = (size_t)HALF * K * 2;
    const size_t tstep = 2 * hstep;
    const unsigned ldsw = (unsigned)wid * 1024u;
    const int aoff = lds_byte(wr * 64 + fr, fq * 8), boff = lds_byte(wc * 32 + fr, fq * 8);
#define PG8_SA(b, h) (((b) * 2 + (h)) * HTB)
#define PG8_SB(b, h) ((4 + (b) * 2 + (h)) * HTB)
#define PG8_STAGE(bufoff, gbase, voff) do { _Pragma("unroll") for (int _i = 0; _i < 2; ++_i) \
        __builtin_amdgcn_global_load_lds((const unsigned*)((const char*)(gbase) + (voff)[_i]), (PG8_LAS unsigned*)(lds + (bufoff) + ldsw + _i * 8192), 16, 0, 0); } while (0)
#define PG8_LDA(dst, b, h) do { _Pragma("unroll") for (int m = 0; m < 4; ++m) _Pragma("unroll") for (int k = 0; k < 2; ++k) dst[m][k] = *(const PG8_LAS bf16x8*)(lds + PG8_SA(b, h) + aoff + m * 2048 + k * 1024); } while (0)
#define PG8_LDB(dst, b, h) do { _Pragma("unroll") for (int n = 0; n < 2; ++n) _Pragma("unroll") for (int k = 0; k < 2; ++k) dst[n][k] = *(const PG8_LAS bf16x8*)(lds + PG8_SB(b, h) + boff + n * 2048 + k * 1024); } while (0)
#define PG8_MMA(ai, bj, At, Bt) do { __builtin_amdgcn_s_setprio(1); _Pragma("unroll") for (int m = 0; m < 4; ++m) _Pragma("unroll") for (int n = 0; n < 2; ++n) _Pragma("unroll") for (int k = 0; k < 2; ++k) \
        acc[ai][bj][m][n] = __builtin_amdgcn_mfma_f32_16x16x32_bf16(Bt[n][k], At[m][k], acc[ai][bj][m][n], 0, 0, 0); __builtin_amdgcn_s_setprio(0); } while (0)
#define PG8_WAIT_V(n) asm volatile("s_waitcnt vmcnt(" #n ")" ::: "memory")
#define PG8_WAIT_L(n) asm volatile("s_waitcnt lgkmcnt(" #n ")" ::: "memory")
#define PG8_BAR __builtin_amdgcn_s_barrier()
#define PG8_SCHED __builtin_amdgcn_sched_barrier(0)
    Unit cur, nxt; int ui = 0;
    if (!S.next(0, cur)) return;
    f32x4 acc[2][2][4][2];
#pragma unroll
    for (int a = 0; a < 2; ++a)
#pragma unroll
        for (int b = 0; b < 2; ++b)
#pragma unroll
            for (int m = 0; m < 4; ++m)
#pragma unroll
                for (int n = 0; n < 2; ++n) acc[a][b][m][n] = (f32x4){0.f, 0.f, 0.f, 0.f};
    bf16x8 At[4][2], B0[2][2], B1[2][2];
    const char* cA = (const char*)g.A + (size_t)cur.pm * tstep; const char* cB = (const char*)g.Bt + (size_t)cur.pn * tstep;
    S.a_ready(cur);
    if constexpr (SP2) {
        PG8_STAGE(PG8_SB(0, 0), cB, voffB); PG8_STAGE(PG8_SB(0, 1), cB + hstep, voffB); PG8_STAGE(PG8_SA(0, 0), cA, voffA); PG8_STAGE(PG8_SA(0, 1), cA + hstep, voffA);
        if (wr == 1) PG8_BAR;
        PG8_WAIT_V(2); PG8_BAR;
        PG8_STAGE(PG8_SB(1, 0), cB + kstep, voffB); PG8_STAGE(PG8_SA(1, 0), cA + kstep, voffA); PG8_STAGE(PG8_SB(1, 1), cB + hstep + kstep, voffB);
        PG8_WAIT_V(6); PG8_BAR;
    } else {
        PG8_STAGE(PG8_SB(0, 0), cB, voffB); PG8_STAGE(PG8_SA(0, 0), cA, voffA); PG8_STAGE(PG8_SB(0, 1), cB + hstep, voffB); PG8_STAGE(PG8_SA(0, 1), cA + hstep, voffA);
        if (wr == 1) PG8_BAR;
        PG8_WAIT_V(4); PG8_BAR;
        PG8_STAGE(PG8_SB(1, 0), cB + kstep, voffB); PG8_STAGE(PG8_SA(1, 0), cA + kstep, voffA); PG8_STAGE(PG8_SB(1, 1), cB + hstep + kstep, voffB);
        PG8_WAIT_V(6); PG8_BAR;
    }
    for (;;) {
        const bool has_next = S.next(ui + 1, nxt);
        const char* nA = has_next ? (const char*)g.A + (size_t)nxt.pm * tstep : cA; const char* nB = has_next ? (const char*)g.Bt + (size_t)nxt.pn * tstep : cB;
        for (int t = 0; t < nt; t += 2) {
            const bool last = (t == nt - 2);
            const char* a1 = cA + (size_t)(t + 1) * kstep;
            const char* a2 = last ? nA : cA + (size_t)(t + 2) * kstep; const char* b2 = last ? nB : cB + (size_t)(t + 2) * kstep;
            const char* a3 = a2 + kstep; const char* b3 = b2 + kstep;
            if (last && has_next) S.a_ready(nxt);
            if constexpr (SP2) {
            PG8_LDB(B0, 0, 0); PG8_LDB(B1, 0, 1); PG8_SCHED; PG8_LDA(At, 0, 0); PG8_STAGE(PG8_SA(1, 1), a1 + hstep, voffA);
            PG8_WAIT_V(8); PG8_WAIT_L(0); PG8_BAR; PG8_MMA(0, 0, At, B0); PG8_MMA(0, 1, At, B1); PG8_BAR; PG8_SCHED;
            PG8_LDA(At, 0, 1); PG8_STAGE(PG8_SB(0, 0), b2, voffB); PG8_STAGE(PG8_SB(0, 1), b2 + hstep, voffB); PG8_STAGE(PG8_SA(0, 0), a2, voffA);
            PG8_WAIT_V(8); PG8_WAIT_L(0); PG8_BAR; PG8_MMA(1, 0, At, B0); PG8_MMA(1, 1, At, B1); PG8_BAR; PG8_SCHED;
            PG8_LDB(B0, 1, 0); PG8_LDB(B1, 1, 1); PG8_SCHED; PG8_LDA(At, 1, 0); PG8_STAGE(PG8_SA(0, 1), a2 + hstep, voffA);
            PG8_WAIT_V(8); PG8_WAIT_L(0); PG8_BAR; PG8_MMA(0, 0, At, B0); PG8_MMA(0, 1, At, B1); PG8_BAR; PG8_SCHED;
            PG8_LDA(At, 1, 1); PG8_STAGE(PG8_SB(1, 0), b3, voffB); PG8_STAGE(PG8_SB(1, 1), b3 + hstep, voffB); PG8_STAGE(PG8_SA(1, 0), a3, voffA);
            PG8_WAIT_V(8); PG8_WAIT_L(0); PG8_BAR; PG8_MMA(1, 0, At, B0); PG8_MMA(1, 1, At, B1); PG8_BAR; PG8_SCHED;
            } else {
            PG8_LDB(B0, 0, 0); PG8_SCHED; PG8_LDA(At, 0, 0); PG8_STAGE(PG8_SA(1, 1), a1 + hstep, voffA);
            PG8_WAIT_L(8); PG8_BAR; PG8_WAIT_L(0); PG8_MMA(0, 0, At, B0); PG8_BAR; PG8_SCHED;
            PG8_LDB(B1, 0, 1); PG8_STAGE(PG8_SB(0, 0), b2, voffB);
            PG8_BAR; PG8_WAIT_L(0); PG8_MMA(0, 1, At, B1); PG8_BAR;
            PG8_LDA(At, 0, 1); PG8_STAGE(PG8_SA(0, 0), a2, voffA);
            PG8_BAR; PG8_WAIT_L(0); PG8_MMA(1, 0, At, B0); PG8_BAR; PG8_SCHED;
            PG8_STAGE(PG8_SB(0, 1), b2 + hstep, voffB);
            PG8_WAIT_V(6); PG8_BAR; PG8_MMA(1, 1, At, B1); PG8_BAR;
            PG8_LDB(B0, 1, 0); PG8_SCHED; PG8_LDA(At, 1, 0); PG8_STAGE(PG8_SA(0, 1), a2 + hstep, voffA);
            PG8_WAIT_L(8); PG8_BAR; PG8_WAIT_L(0); PG8_MMA(0, 0, At, B0); PG8_BAR; PG8_SCHED;
            PG8_LDB(B1, 1, 1); PG8_STAGE(PG8_SB(1, 0), b3, voffB);
            PG8_BAR; PG8_WAIT_L(0); PG8_MMA(0, 1, At, B1); PG8_BAR;
            PG8_LDA(At, 1, 1); PG8_STAGE(PG8_SA(1, 0), a3, voffA);
            PG8_BAR; PG8_WAIT_L(0); PG8_MMA(1, 0, At, B0); PG8_BAR; PG8_SCHED;
            PG8_STAGE(PG8_SB(1, 1), b3 + hstep, voffB);
            PG8_WAIT_V(6); PG8_BAR; PG8_MMA(1, 1, At, B1); PG8_BAR;
            }
        }
        if constexpr (ALIGN_EPI) { if (wr == 0) PG8_BAR; }
        if constexpr (!Epi::AFTER_DRAIN) { E(acc, cur, wr, wc, fr, fq); S.done(cur); }
        if (!has_next) break;
#pragma unroll
        for (int a = 0; a < 2; ++a)
#pragma unroll
            for (int b = 0; b < 2; ++b)
#pragma unroll
                for (int m = 0; m < 4; ++m)
#pragma unroll
                    for (int n = 0; n < 2; ++n) acc[a][b][m][n] = (f32x4){0.f, 0.f, 0.f, 0.f};
        cur = nxt; cA = nA; cB = nB; ++ui;
        if constexpr (ALIGN_EPI) { if (wr == 1) PG8_BAR; }
    }
    PG8_WAIT_V(0);
    if constexpr (!ALIGN_EPI) { if (wr == 0) PG8_BAR; }
    PG8_BAR;
    if constexpr (Epi::AFTER_DRAIN) { E.fused(acc, cur, wr, wc, fr, fq, lds, wid, lane); S.done(cur); }
#undef PG8_SA
#undef PG8_SB
#undef PG8_STAGE
#undef PG8_LDA
#undef PG8_LDB
#undef PG8_MMA
#undef PG8_WAIT_V
#undef PG8_WAIT_L
#undef PG8_BAR
#undef PG8_SCHED
}
}

#ifndef PG8_SP2
#define PG8_SP2 true
#endif
#ifndef PG8_ALIGN
#define PG8_ALIGN true
#endif
namespace pg8 {
constexpr int OUT_KP = 17301504, OUT_VP = 34078720, OUT_KS = 51122176, OUT_VS = 51646464;
constexpr int NSSQ = 32;
__device__ __forceinline__ float row_rstd(const float* ssq, int row) {
    const f32x4* p = (const f32x4*)(ssq + (size_t)row * NSSQ); float s = 0.f;
#pragma unroll
    for (int i = 0; i < NSSQ / 4; ++i) { const f32x4 a = p[i]; s += (a[0] + a[1]) + (a[2] + a[3]); }
    return __builtin_amdgcn_rsqf(s * (1.0f / 1024.0f) + 1e-6f);
}
template <int ACT, bool KVF32> struct EpiAct {
    static constexpr bool PERM = true, AFTER_DRAIN = false;
    bf16_t* O; int ldc; const float* ssq; int split_cols; size_t split_stride; float* fout;
    template <int NA, int NB> __device__ __forceinline__ void run(const f32x4 (&acc)[NA][NB][4][2], int rowt, int colt, bool sample, int wr, int wc, int fr, int fq) const {
        const int row0 = rowt + wr * 64 + fr; bf16_t* base = O; int t = 0;
        if (split_cols) { t = colt / split_cols; base += (size_t)t * split_stride; colt -= t * split_cols; }
        const int col0 = colt + wc * 32 + 8 * fq;
        float* fb = nullptr;
        if (KVF32) { if (t < 2) fb = fout + (!sample ? (size_t)(t == 0 ? OUT_KP : OUT_VP) : (size_t)(t == 0 ? OUT_KS : OUT_VS) - (size_t)16384 * 1024) + col0; }
        f32x4 pq[NA][4][2];
#pragma unroll
        for (int ai = 0; ai < NA; ++ai)
#pragma unroll
            for (int m = 0; m < 4; ++m) { const f32x4* p = (const f32x4*)(ssq + (size_t)(row0 + ai * HALF + m * 16) * NSSQ + 8 * fq); pq[ai][m][0] = p[0]; pq[ai][m][1] = p[1]; }
        float rsv[NA][4];
#pragma unroll
        for (int ai = 0; ai < NA; ++ai)
#pragma unroll
            for (int m = 0; m < 4; ++m) { const f32x4 a = pq[ai][m][0], b = pq[ai][m][1]; float sq = ((a[0] + a[1]) + (a[2] + a[3])) + ((b[0] + b[1]) + (b[2] + b[3]));
                sq += __shfl_xor(sq, 16); sq += __shfl_xor(sq, 32); rsv[ai][m] = __builtin_amdgcn_rsqf(sq * (1.0f / 1024.0f) + 1e-6f); }
#pragma unroll
        for (int ai = 0; ai < NA; ++ai)
#pragma unroll
            for (int m = 0; m < 4; ++m) { const int row = row0 + ai * HALF + m * 16; const float rs = rsv[ai][m];
                bf16_t* rowp = base + (size_t)row * ldc + col0;
#pragma unroll
                for (int bj = 0; bj < NB; ++bj) { f32x4 v0 = acc[ai][bj][m][0] * rs, v1 = acc[ai][bj][m][1] * rs;
                    if (ACT == 1) {
#pragma unroll
                        for (int e = 0; e < 4; ++e) { const float a = fmaxf(v0[e], 0.f), b = fmaxf(v1[e], 0.f); v0[e] = a * a; v1[e] = b * b; } }
                    if (KVF32) { if (fb) { float* fr_ = fb + (size_t)row * 1024 + bj * HALF; *(f32x4*)fr_ = v0; *(f32x4*)(fr_ + 4) = v1; } }
                    u32x4 w; w.x = cvt_pk_bf16(v0[0], v0[1]); w.y = cvt_pk_bf16(v0[2], v0[3]); w.z = cvt_pk_bf16(v1[0], v1[1]); w.w = cvt_pk_bf16(v1[2], v1[3]);
                    *(u32x4*)(rowp + bj * HALF) = w; } }
    }
    __device__ __forceinline__ void operator()(const f32x4 (&acc)[2][2][4][2], const Unit& u, int wr, int wc, int fr, int fq) const { run<2, 2>(acc, u.pm * BM, u.pn * BM, u.pm >= 64, wr, wc, fr, fq); }
};
struct EpiResid {
    static constexpr bool PERM = true, AFTER_DRAIN = false;
    float* X; bf16_t* XB; float* ssq; const float* Xp; const float* Xs;
    template <int NA, int NB> __device__ __forceinline__ void run(const f32x4 (&acc)[NA][NB][4][2], int rowt, int colt, bool sample, int wr, int wc, int fr, int fq) const {
        const int row0 = rowt + wr * 64 + fr; const int col0 = colt + wc * 32 + 8 * fq;
#pragma unroll
        for (int ai = 0; ai < NA; ++ai) {
            f32x4 xr[4][NB][2];
#pragma unroll
            for (int m = 0; m < 4; ++m) { const float* xp = (Xp ? (sample ? Xs - (size_t)16384 * 1024 : Xp) : (const float*)X) + (size_t)(row0 + ai * HALF + m * 16) * 1024 + col0;
#pragma unroll
                for (int bj = 0; bj < NB; ++bj) { xr[m][bj][0] = *(const f32x4*)(xp + bj * HALF); xr[m][bj][1] = *(const f32x4*)(xp + bj * HALF + 4); } }
#pragma unroll
            for (int m = 0; m < 4; ++m) { const int row = row0 + ai * HALF + m * 16; float* xp = X + (size_t)row * 1024 + col0; bf16_t* bp = XB + (size_t)row * 1024 + col0;
#pragma unroll
                for (int bj = 0; bj < NB; ++bj) { const f32x4 a0 = xr[m][bj][0] + acc[ai][bj][m][0], a1 = xr[m][bj][1] + acc[ai][bj][m][1];
                    *(f32x4*)(xp + bj * HALF) = a0; *(f32x4*)(xp + bj * HALF + 4) = a1;
                    float q = ((a0[0] * a0[0] + a0[1] * a0[1]) + (a0[2] * a0[2] + a0[3] * a0[3])) + ((a1[0] * a1[0] + a1[1] * a1[1]) + (a1[2] * a1[2] + a1[3] * a1[3]));
                    u32x4 w; w.x = cvt_pk_bf16(a0[0], a0[1]); w.y = cvt_pk_bf16(a0[2], a0[3]); w.z = cvt_pk_bf16(a1[0], a1[1]); w.w = cvt_pk_bf16(a1[2], a1[3]);
                    *(u32x4*)(bp + bj * HALF) = w;
                    q += __shfl_xor(q, 16); q += __shfl_xor(q, 32);
                    if (fq == 0) ssq[(size_t)row * NSSQ + ((colt + bj * HALF) >> 7) * 4 + wc] = q; } }
            asm volatile("" ::: "memory"); }
    }
    __device__ __forceinline__ void operator()(const f32x4 (&acc)[2][2][4][2], const Unit& u, int wr, int wc, int fr, int fq) const { run<2, 2>(acc, u.pm * BM, u.pn * BM, u.pm >= 64, wr, wc, fr, fq); }
};
__device__ __forceinline__ void glds16(const void* gsrc, unsigned lds_dst) { unsigned keep;
    asm volatile("s_mov_b32 %0, m0\n\ts_mov_b32 m0, %2\n\ts_nop 0\n\tglobal_load_lds_dwordx4 %1, off\n\ts_mov_b32 m0, %0" : "=&s"(keep) : "v"(gsrc), "s"(lds_dst) : "memory"); }
template <class Epi>
__device__ __forceinline__ void gemm128_tile(PG8_LAS unsigned char* lds, const bf16_t* A, const bf16_t* Bt, int K, const Epi& E, int rowt, int colt) {
    const int tid = opaque_tid(), wid = __builtin_amdgcn_readfirstlane(tid >> 6), lane = tid & 63, wr = wid >> 2, wc = wid & 3, fr = lane & 15, fq = lane >> 4;
    const int nt = K / BK;
    const char* gA[2]; const char* gB[2];
#pragma unroll
    for (int i = 0; i < 2; ++i) { int R, C; stage_rc(tid * 16 + i * 8192, R, C); const int Rb = (R & ~31) + perm32(R & 31);
        gA[i] = (const char*)A + (size_t)(R * K + C) * 2; gB[i] = (const char*)Bt + (size_t)(Rb * K + C) * 2; }
    const unsigned lds0 = (unsigned)(uintptr_t)lds + (unsigned)wid * 1024u;
    const int aoff = lds_byte(wr * 64 + fr, fq * 8), boff = lds_byte(wc * 32 + fr, fq * 8);
#define G128_STAGE(s, kt) do { _Pragma("unroll") for (int _i = 0; _i < 2; ++_i) { \
        glds16(gA[_i] + (size_t)(kt) * (BK * 2), (unsigned)__builtin_amdgcn_readfirstlane(lds0 + (unsigned)((s) * 2 * HTB + _i * 8192))); \
        glds16(gB[_i] + (size_t)(kt) * (BK * 2), (unsigned)__builtin_amdgcn_readfirstlane(lds0 + (unsigned)((s) * 2 * HTB + HTB + _i * 8192))); } } while (0)
    f32x4 acc[1][1][4][2];
#pragma unroll
    for (int m = 0; m < 4; ++m)
#pragma unroll
        for (int n = 0; n < 2; ++n) acc[0][0][m][n] = (f32x4){0.f, 0.f, 0.f, 0.f};
    G128_STAGE(0, 0); G128_STAGE(1, 1); G128_STAGE(2, 2);
    for (int t = 0; t < nt; ++t) {
        const int rem = nt - 1 - t;
        if (rem >= 2) asm volatile("s_waitcnt vmcnt(8)" ::: "memory"); else if (rem == 1) asm volatile("s_waitcnt vmcnt(4)" ::: "memory"); else asm volatile("s_waitcnt vmcnt(0)" ::: "memory");
        __builtin_amdgcn_s_barrier(); asm volatile("" ::: "memory");
        if (t + 3 < nt) G128_STAGE((t + 3) & 3, t + 3);
        const PG8_LAS unsigned char* sb = lds + (t & 3) * 2 * HTB;
        bf16x8 At[4][2], Bf[2][2];
#pragma unroll
        for (int m = 0; m < 4; ++m)
#pragma unroll
            for (int k = 0; k < 2; ++k) At[m][k] = *(const PG8_LAS bf16x8*)(sb + aoff + m * 2048 + k * 1024);
#pragma unroll
        for (int n = 0; n < 2; ++n)
#pragma unroll
            for (int k = 0; k < 2; ++k) Bf[n][k] = *(const PG8_LAS bf16x8*)(sb + HTB + boff + n * 2048 + k * 1024);
        asm volatile("s_waitcnt lgkmcnt(0)" ::: "memory");
#pragma unroll
        for (int m = 0; m < 4; ++m)
#pragma unroll
            for (int n = 0; n < 2; ++n)
#pragma unroll
                for (int k = 0; k < 2; ++k) acc[0][0][m][n] = __builtin_amdgcn_mfma_f32_16x16x32_bf16(Bf[n][k], At[m][k], acc[0][0][m][n], 0, 0, 0);
    }
#undef G128_STAGE
    E.template run<1, 1>(acc, rowt, colt, true, wr, wc, fr, fq);
    asm volatile("s_waitcnt lgkmcnt(0)" ::: "memory"); __builtin_amdgcn_s_barrier(); asm volatile("" ::: "memory");
}
}
#include <hip/hip_bf16.h>
#include <cmath>
namespace attn_body {
using bf16=__hip_bfloat16;
using bf16x8=__attribute__((ext_vector_type(8)))short;
using s16x4=__attribute__((ext_vector_type(4)))short;
using f32x16=__attribute__((ext_vector_type(16)))float;
using u32x4=__attribute__((ext_vector_type(4)))unsigned;
constexpr int BATCH=1,NHEAD=16,SEQ=16384,D=64,DM=NHEAD*D;
constexpr int NW=8,QBLK=32,QB=QBLK*NW,KVBLK=64,NQB=SEQ/QB;
constexpr int ATTN_PITCH=DM, ATTN_UNIT_ROWS=QB;
__device__ __forceinline__ int crow(int r,int hi){return (r&3)+8*(r>>2)+4*hi;}
#define SBAR() __builtin_amdgcn_sched_barrier(0)
__device__ __forceinline__ void cmask(f32x16&p0,f32x16&p1,int jb,int qrel,int hi){
  const float NEG=-INFINITY; int kb=64*jb+4*hi;
  #pragma unroll
  for(int r=0;r<16;++r){int kv=kb+(r&3)+8*(r>>2); if(kv>qrel)p0[r]=NEG; if(kv+32>qrel)p1[r]=NEG;}
}

constexpr int NSLOT=3, SLOTB=8192;
constexpr int LDS_K=0, LDS_V=NSLOT*SLOTB, LDS_WS=2*NSLOT*SLOTB, LDS_OST=LDS_WS+NW*64*4, LDS_CK=LDS_OST+NW*4096, LDS_BYTES=LDS_CK+SEQ*4;
constexpr float C2=0.125f*1.4426950408889634f;
__device__ __forceinline__ void glds16(const void*gsrc,unsigned lds_dst){unsigned keep;
  asm volatile("s_mov_b32 %0, m0\n\ts_mov_b32 m0, %2\n\ts_nop 0\n\tglobal_load_lds_dwordx4 %1, off\n\ts_mov_b32 m0, %0":"=&s"(keep):"v"(gsrc),"s"(lds_dst):"memory");}
__device__ __forceinline__ void glds16s(const void*sbase,unsigned voff,unsigned lds_dst){unsigned keep;
  asm volatile("s_mov_b32 %0, m0\n\ts_mov_b32 m0, %3\n\ts_nop 0\n\tglobal_load_lds_dwordx4 %1, %2\n\ts_mov_b32 m0, %0":"=&s"(keep):"v"(voff),"s"(sbase),"s"(lds_dst):"memory");}
__device__ __forceinline__ float max3f(float a,float b,float c){float r;asm("v_max3_f32 %0, %1, %2, %3":"=v"(r):"v"(a),"v"(b),"v"(c));return r;}
__device__ __forceinline__ float max2f(float a,float b){float r;asm("v_max_f32_e32 %0, %1, %2":"=v"(r):"v"(a),"v"(b));return r;}
__device__ __forceinline__ float fadd_s(float a,float b){float r;asm("v_add_f32_e32 %0, %1, %2":"=v"(r):"v"(a),"v"(b));return r;}
__device__ __forceinline__ float fsub_s(float a,float b){float r;asm("v_sub_f32_e32 %0, %1, %2":"=v"(r):"v"(a),"v"(b));return r;}
typedef float f32x2_t __attribute__((ext_vector_type(2))); typedef __bf16 bf16x2_t __attribute__((ext_vector_type(2)));
__device__ __forceinline__ unsigned cvtpk_s(float lo,float hi){f32x2_t v={lo,hi};bf16x2_t b=__builtin_convertvector(v,bf16x2_t);return __builtin_bit_cast(unsigned,b);}
#define WAIT_BAR(N) asm volatile("s_waitcnt vmcnt(" #N ") lgkmcnt(0)\n\ts_barrier":::"memory")

__device__ __forceinline__ void qkt(f32x16&p0,f32x16&p1,const char*Kslot,const bf16x8*qr,const f32x16&negm,int r32,int hi){
  const char*kb=Kslot+hi*1024+r32*16;
  #pragma unroll
  for(int d0=0;d0<4;++d0){
    const bf16x8 b0=*reinterpret_cast<const bf16x8*>(kb+d0*2048);
    const bf16x8 b1=*reinterpret_cast<const bf16x8*>(kb+d0*2048+512);
    if(d0==0){p0=__builtin_amdgcn_mfma_f32_32x32x16_bf16(b0,qr[0],negm,0,0,0);p1=__builtin_amdgcn_mfma_f32_32x32x16_bf16(b1,qr[0],negm,0,0,0);}
    else{p0=__builtin_amdgcn_mfma_f32_32x32x16_bf16(b0,qr[d0],p0,0,0,0);p1=__builtin_amdgcn_mfma_f32_32x32x16_bf16(b1,qr[d0],p1,0,0,0);}}
}
typedef __attribute__((address_space(3))) const char* lds_cptr;
typedef short v4i16_t __attribute__((ext_vector_type(4)));
__device__ __forceinline__ void kload8(bf16x8*kf,lds_cptr kp){
  kf[0]=*(const __attribute__((address_space(3))) bf16x8*)(kp);      kf[1]=*(const __attribute__((address_space(3))) bf16x8*)(kp+512);
  kf[2]=*(const __attribute__((address_space(3))) bf16x8*)(kp+2048); kf[3]=*(const __attribute__((address_space(3))) bf16x8*)(kp+2560);
  kf[4]=*(const __attribute__((address_space(3))) bf16x8*)(kp+4096); kf[5]=*(const __attribute__((address_space(3))) bf16x8*)(kp+4608);
  kf[6]=*(const __attribute__((address_space(3))) bf16x8*)(kp+6144); kf[7]=*(const __attribute__((address_space(3))) bf16x8*)(kp+6656);
}
__device__ __forceinline__ void kload2(bf16x8*kf,lds_cptr kp,int j){ kf[2*j]=*(const __attribute__((address_space(3))) bf16x8*)(kp+j*2048); kf[2*j+1]=*(const __attribute__((address_space(3))) bf16x8*)(kp+j*2048+512); }
__device__ __forceinline__ s16x4 vtr(lds_cptr p){ return __builtin_bit_cast(s16x4,__builtin_amdgcn_ds_read_tr16_b64_v4i16((__attribute__((address_space(3))) v4i16_t*)p)); }
__device__ __forceinline__ float rowmax(const f32x16&p0,const f32x16&p1){
  float a=max3f(p0[0],p0[1],p1[0]),b=max3f(p0[2],p0[3],p1[1]);a=max3f(a,p1[2],p1[3]);
  #pragma unroll
  for(int r=4;r<16;r+=4){a=max3f(a,p0[r],p0[r+1]);b=max3f(b,p0[r+2],p0[r+3]);a=max3f(a,p1[r],p1[r+1]);b=max3f(b,p1[r+2],p1[r+3]);}
  const float m=max2f(a,b);
  auto rr=__builtin_amdgcn_permlane32_swap(__float_as_uint(m),__float_as_uint(m),false,false);
  return max2f(__uint_as_float(rr[0]),__uint_as_float(rr[1]));
}
__device__ __forceinline__ void pv(f32x16*o,int vb,bf16x8 pa0,bf16x8 pa1,bf16x8 pa2,bf16x8 pa3){
  #pragma unroll
  for(int d0=0;d0<2;++d0){s16x4 lo[4],hi[4];
    #pragma unroll
    for(int ks=0;ks<4;++ks){
      asm volatile("ds_read_b64_tr_b16 %0,%1 offset:%c2":"=&v"(lo[ks]):"v"(vb),"i"(d0*4096+ks*1024):"memory");
      asm volatile("ds_read_b64_tr_b16 %0,%1 offset:%c2":"=&v"(hi[ks]):"v"(vb),"i"(d0*4096+ks*1024+512):"memory");}
    asm volatile("s_waitcnt lgkmcnt(0)":::"memory");SBAR();
    #define PK(k) (bf16x8){lo[k][0],lo[k][1],lo[k][2],lo[k][3],hi[k][0],hi[k][1],hi[k][2],hi[k][3]}
    o[d0]=__builtin_amdgcn_mfma_f32_32x32x16_bf16(pa0,PK(0),o[d0],0,0,0);
    o[d0]=__builtin_amdgcn_mfma_f32_32x32x16_bf16(pa1,PK(1),o[d0],0,0,0);
    o[d0]=__builtin_amdgcn_mfma_f32_32x32x16_bf16(pa2,PK(2),o[d0],0,0,0);
    o[d0]=__builtin_amdgcn_mfma_f32_32x32x16_bf16(pa3,PK(3),o[d0],0,0,0);
    #undef PK
  }
}

#ifndef ATTN_STORE16
#define ATTN_STORE16(p,v) (*(u32x4*)(p)=(v))
#endif
typedef float f32x4_t __attribute__((ext_vector_type(4)));
#define CKSUB(C0,C1,t) do{ const __attribute__((address_space(3))) f32x4_t* ck_=(const __attribute__((address_space(3))) f32x4_t*)(ckl+(t)*64+4*hi); \
   _Pragma("unroll") for(int g_=0;g_<4;++g_){ const f32x4_t a_=ck_[2*g_], b_=ck_[8+2*g_]; \
     _Pragma("unroll") for(int i_=0;i_<4;++i_){ C0[4*g_+i_]-=a_[i_]; C1[4*g_+i_]-=b_[i_]; } } }while(0)
template<int THRL> __device__ __forceinline__ void attn_unit(int b,int h,int qb,const bf16*Q,const bf16*__restrict__ K,const bf16*__restrict__ V,bf16*O,char*shm,const float*ckg,const float kmax2){
  const int tid=opaque_tid(),lane=tid&63,r32=lane&31,hi=lane>>5; const int wid=__builtin_amdgcn_readfirstlane(tid>>6);
  const long rowbase=(long)b*SEQ; const int q0=qb*QB;
  const bf16*Qw=Q+(rowbase+q0+wid*QBLK)*DM+h*D;
  const unsigned lds0=(unsigned)(uintptr_t)shm;
  float*wsf=(float*)(shm+LDS_WS)+wid*64;
  __attribute__((address_space(3))) float* ckl=(__attribute__((address_space(3))) float*)((__attribute__((address_space(3))) char*)shm+LDS_CK);
  const float cqv=ckg[q0+wid*QBLK+r32];
  bf16x8 qr[4];
  #pragma unroll
  for(int d0=0;d0<4;++d0)qr[d0]=*reinterpret_cast<const bf16x8*>(&Qw[(long)r32*DM+d0*16+hi*8]);
  int t0=0;
  if(qb>0){
    float*wsa=(float*)(shm+LDS_WS);
    float qs=0.f;
    #pragma unroll
    for(int d0=0;d0<4;++d0){
      #pragma unroll
      for(int e=0;e<8;++e){ const float v_=__builtin_bit_cast(float,((unsigned)(unsigned short)qr[d0][e])<<16); qs+=v_*v_; } }
    qs+=__shfl_xor(qs,32);
    #pragma unroll
    for(int o_=1;o_<32;o_<<=1) qs=fmaxf(qs,__shfl_xor(qs,o_));
    const int ncand=q0/KVBLK;
    float cend=0.f; if(tid<ncand) cend=ckg[tid*KVBLK+KVBLK-1];
    const float cq0=ckg[q0];
    if(lane==0) wsa[wid]=qs;
    __syncthreads();
    float qm=wsa[0];
    #pragma unroll
    for(int w_=1;w_<NW;++w_) qm=fmaxf(qm,wsa[w_]);
    const float thr=-40.f-2.f*sqrtf(qm*kmax2)*1.0001f;
    const bool skip_=(tid<ncand)&&((cq0-cend)<thr);
    const unsigned long long bal_=__ballot(skip_);
    if(lane==0) wsa[8+wid]=(float)__popcll(bal_);
    __syncthreads();
    float cnt_=0.f;
    #pragma unroll
    for(int w_=0;w_<NW;++w_) cnt_+=wsa[8+w_];
    t0=__builtin_amdgcn_readfirstlane(((int)cnt_)&~1);
    __syncthreads();
  }
  const bf16*Kh=K+(rowbase+(long)t0*KVBLK)*DM+h*D,*Vh=V+(rowbase+(long)t0*KVBLK)*DM+h*D;
  { const int nf4=(q0+QB-t0*KVBLK)>>2; const f32x4_t* src_=(const f32x4_t*)(ckg+t0*KVBLK); __attribute__((address_space(3))) f32x4_t* dst_=(__attribute__((address_space(3))) f32x4_t*)ckl;
    for(int i_=tid;i_<nf4;i_+=NW*64) dst_[i_]=src_[i_]; }
  const unsigned kvoff=(unsigned)((lane*DM+wid*8)*2);
  const unsigned vvoff=(unsigned)(((16*(wid&3)+(lane>>2))*DM+(wid>>2)*32+(lane&3)*8)*2);
  const unsigned kdst=lds0+LDS_K+wid*1024, vdst=lds0+LDS_V+wid*1024;
  #define DMA_K(t,slot) glds16s(Kh+(long)(t)*KVBLK*DM,kvoff,(unsigned)__builtin_amdgcn_readfirstlane(kdst+(slot)))
  #define DMA_V(t,slot) glds16s(Vh+(long)(t)*KVBLK*DM,vvoff,(unsigned)__builtin_amdgcn_readfirstlane(vdst+(slot)))
  const int vb0=(int)(lds0+LDS_V)+((lane>>4)&1)*32+(lane&3)*8+(4*hi+((lane&15)>>2))*64;
  const char*Kbase=shm+LDS_K; bf16x8 kf[8];
  const lds_cptr shm3=(lds_cptr)shm; const lds_cptr kp0=shm3+LDS_K+hi*1024+r32*16; const lds_cptr vp0=shm3+LDS_V+((lane>>4)&1)*32+(lane&3)*8+(4*hi+((lane&15)>>2))*64;
  const int NT=(q0+QB)/KVBLK-t0;
  DMA_K(0,0);DMA_V(0,0);DMA_K(1,SLOTB);
  float mhat=-cqv,l_reg=0.f;    f32x16 o[2];o[0]=f32x16{};o[1]=f32x16{};f32x16 negm;
  #pragma unroll
  for(int r=0;r<16;++r)negm[r]=cqv;
  asm volatile("":"+v"(negm));
  const int qrel=wid*QBLK+r32;
  #define CMASK(P0,P1,t) do{int jb_=(t)-(NT-4); if(jb_>=0)cmask(P0,P1,jb_,qrel,hi);}while(0)
  bool resc=false;
  #define START(P0,P1) do{ const float rm=rowmax(P0,P1); resc=false; \
    { const float dl=rm; mhat=fadd_s(mhat,dl); \
      _Pragma("unroll") for(int r=0;r<16;++r){P0[r]=fsub_s(P0[r],dl);P1[r]=fsub_s(P1[r],dl);} \
      _Pragma("unroll") for(int r=0;r<16;++r)negm[r]=-mhat; asm volatile("":"+v"(negm)); } \
    _Pragma("unroll") for(int r=0;r<16;++r)P0[r]=__builtin_amdgcn_exp2f(P0[r]); }while(0)
  #define RESC() do{ if(resc){ asm volatile("s_waitcnt lgkmcnt(0)":::"memory"); \
      _Pragma("unroll") for(int d_=0;d_<2;++d_) _Pragma("unroll") for(int r=0;r<16;++r)o[d_][r]*=wsf[crow(r,hi)]; } }while(0)
  f32x16 pA0,pA1,pB0,pB1;
  int sl_prev=0,sl_cur=0,sl_next=SLOTB;
  #define ROT() do{sl_prev=sl_cur;sl_cur=sl_next;sl_next=(sl_next==(NSLOT-1)*SLOTB)?0:sl_next+SLOTB;}while(0)
  DMA_K(2,2*SLOTB);
  WAIT_BAR(3);
  qkt(pA0,pA1,Kbase,qr,negm,r32,hi);asm volatile("s_nop 15\n\ts_nop 7":"+v"(pA0),"+v"(pA1));CKSUB(pA0,pA1,0);CMASK(pA0,pA1,0);
  START(pA0,pA1);
  _Pragma("unroll") for(int r=0;r<16;++r)pA1[r]=__builtin_amdgcn_exp2f(pA1[r]);
  WAIT_BAR(0);
  DMA_K(3,0);DMA_V(1,SLOTB);
  ROT();
  kload8(kf,kp0+sl_cur);
  WAIT_BAR(2);
  s16x4 vlo[8],vhi[8]; u32x4 pw0,pw1,pw2,pw3;
  #define PKW(P,B) cvtpk_s(P[B],P[B+1])
  #define PAF(k) __builtin_bit_cast(bf16x8,pw##k)
  #define VFR(i) (bf16x8){vlo[i][0],vlo[i][1],vlo[i][2],vlo[i][3],vhi[i][0],vhi[i][1],vhi[i][2],vhi[i][3]}
  #define PIN(x) asm volatile("":"+v"(x))
  #define MX3(a,b,c) __builtin_fmaxf(__builtin_fmaxf((a),(b)),(c))
  #define GAPA(MF,A0,A1,A2,A3,W0,W1,PW) do{ MF; sacc+=A0; sacc+=A1; sacc+=A2; sacc+=A3; PIN(sacc); W0; W1; PIN(PW); SBAR(); }while(0)
  #define EX(v) __builtin_amdgcn_exp2f(v)
  #define GAPB(MF,X,B) do{ MF; X[B]=EX(X[B]); X[B+1]=EX(X[B+1]); X[B+2]=EX(X[B+2]); X[B+3]=EX(X[B+3]); PIN(X); SBAR(); }while(0)
  #define VRD(i) do{ vlo[i]=vtr(vp_+(((i)>>2)*4096+((i)&3)*1024)); vhi[i]=vtr(vp_+(((i)>>2)*4096+((i)&3)*1024+512)); }while(0)
  #define KRD(G,j) do{ if(G){ kload2(kf,kp0+sl_next,j); SBAR(); } }while(0)
  #define STEP(C0,C1,P0,P1,t,GK,GV,GL) do{ SBAR(); \
    const lds_cptr vp_=vp0+sl_prev; \
    VRD(0); SBAR(); float sacc=(P0[0]+P0[1]); \
    GAPA(C0=__builtin_amdgcn_mfma_f32_32x32x16_bf16(kf[0],qr[0],negm,0,0,0), P0[2],P0[3],P0[4],P0[5],     pw0[0]=PKW(P0,0), pw0[1]=PKW(P0,2), pw0); \
    VRD(4); SBAR(); GAPA(C1=__builtin_amdgcn_mfma_f32_32x32x16_bf16(kf[1],qr[0],negm,0,0,0), P0[6],P0[7],P0[8],P0[9],     pw0[2]=PKW(P0,4), pw0[3]=PKW(P0,6), pw0); \
    VRD(1); SBAR(); GAPA(C0=__builtin_amdgcn_mfma_f32_32x32x16_bf16(kf[2],qr[1],C0,0,0,0),   P0[10],P0[11],P0[12],P0[13], pw1[0]=PKW(P0,8), pw1[1]=PKW(P0,10), pw1); \
    VRD(5); SBAR(); GAPA(C1=__builtin_amdgcn_mfma_f32_32x32x16_bf16(kf[3],qr[1],C1,0,0,0),   P0[14],P0[15],P1[0],P1[1],   pw1[2]=PKW(P0,12),pw1[3]=PKW(P0,14), pw1); \
    VRD(2); SBAR(); GAPA(C0=__builtin_amdgcn_mfma_f32_32x32x16_bf16(kf[4],qr[2],C0,0,0,0),   P1[2],P1[3],P1[4],P1[5],     pw2[0]=PKW(P1,0), pw2[1]=PKW(P1,2), pw2); \
    VRD(6); SBAR(); GAPA(C1=__builtin_amdgcn_mfma_f32_32x32x16_bf16(kf[5],qr[2],C1,0,0,0),   P1[6],P1[7],P1[8],P1[9],     pw2[2]=PKW(P1,4), pw2[3]=PKW(P1,6), pw2); \
    VRD(3); SBAR(); GAPA(C0=__builtin_amdgcn_mfma_f32_32x32x16_bf16(kf[6],qr[3],C0,0,0,0),   P1[10],P1[11],P1[12],P1[13], pw3[0]=PKW(P1,8), pw3[1]=PKW(P1,10), pw3); \
    VRD(7); SBAR(); GAPA(C1=__builtin_amdgcn_mfma_f32_32x32x16_bf16(kf[7],qr[3],C1,0,0,0),   P1[14],P1[15],0.f,0.f,       pw3[2]=PKW(P1,12),pw3[3]=PKW(P1,14), pw3); \
    l_reg+=sacc; \
    if(GK){DMA_K((t)+3,sl_cur);} if(GV){DMA_V((t)+1,sl_next);} \
    CKSUB(C0,C1,t); CMASK(C0,C1,t); \
    { float a=MX3(C0[0],C0[1],C1[0]),b=MX3(C0[2],C0[3],C1[1]); a=MX3(a,C1[2],C1[3]); \
      _Pragma("unroll") for(int r=4;r<16;r+=4){a=MX3(a,C0[r],C0[r+1]);b=MX3(b,C0[r+2],C0[r+3]);a=MX3(a,C1[r],C1[r+1]);b=MX3(b,C1[r+2],C1[r+3]);} \
      float rm=__builtin_fmaxf(a,b); { auto rr=__builtin_amdgcn_permlane32_swap(__float_as_uint(rm),__float_as_uint(rm),false,false); rm=__builtin_fmaxf(__uint_as_float(rr[0]),__uint_as_float(rr[1])); } \
      resc=false; \
      if(__builtin_expect(__any(rm>(float)THRL),0)){ const float dl=__builtin_fmaxf(rm,0.f); mhat+=dl; \
        _Pragma("unroll") for(int r=0;r<16;++r){C0[r]-=dl;C1[r]-=dl;} \
        _Pragma("unroll") for(int r=0;r<16;++r)negm[r]=-mhat; asm volatile("":"+v"(negm)); \
        const float f=__builtin_amdgcn_exp2f(-dl); l_reg*=f; if(hi==0)wsf[r32]=f; resc=true; } } \
    SBAR(); \
    GAPB(o[0]=__builtin_amdgcn_mfma_f32_32x32x16_bf16(PAF(0),VFR(0),o[0],0,0,0), C0,0); \
    GAPB(o[1]=__builtin_amdgcn_mfma_f32_32x32x16_bf16(PAF(0),VFR(4),o[1],0,0,0), C0,4); \
    KRD(GL,0); GAPB(o[0]=__builtin_amdgcn_mfma_f32_32x32x16_bf16(PAF(1),VFR(1),o[0],0,0,0), C0,8); \
    KRD(GL,1); GAPB(o[1]=__builtin_amdgcn_mfma_f32_32x32x16_bf16(PAF(1),VFR(5),o[1],0,0,0), C0,12); \
    KRD(GL,2); GAPB(o[0]=__builtin_amdgcn_mfma_f32_32x32x16_bf16(PAF(2),VFR(2),o[0],0,0,0), C1,0); \
    KRD(GL,3); GAPB(o[1]=__builtin_amdgcn_mfma_f32_32x32x16_bf16(PAF(2),VFR(6),o[1],0,0,0), C1,4); \
    GAPB(o[0]=__builtin_amdgcn_mfma_f32_32x32x16_bf16(PAF(3),VFR(3),o[0],0,0,0), C1,8); \
    GAPB(o[1]=__builtin_amdgcn_mfma_f32_32x32x16_bf16(PAF(3),VFR(7),o[1],0,0,0), C1,12); \
    }while(0)
  int t=1;
  #undef CMASK
  #define CMASK(P0,P1,t) do{}while(0)
  for(;t+5<NT;t+=2){
    STEP(pB0,pB1,pA0,pA1,t,true,true,true);     WAIT_BAR(2); RESC(); ROT();
    STEP(pA0,pA1,pB0,pB1,t+1,true,true,true);   WAIT_BAR(2); RESC(); ROT();
  }
  #undef CMASK
  #define CMASK(P0,P1,t) do{int jb_=(t)-(NT-4); if(jb_>=0)cmask(P0,P1,jb_,qrel,hi);}while(0)
  #define ENDW(tt) do{ if((tt)+3<NT){WAIT_BAR(2);} else if((tt)+2<NT){WAIT_BAR(1);} else {WAIT_BAR(0);} }while(0)
  for(;t+1<NT;t+=2){
    STEP(pB0,pB1,pA0,pA1,t,(t+3<NT),(t+1<NT),(t+1<NT));       ENDW(t);   RESC(); ROT();
    STEP(pA0,pA1,pB0,pB1,t+1,(t+4<NT),(t+2<NT),(t+2<NT));     ENDW(t+1); RESC(); ROT();
  }
  STEP(pB0,pB1,pA0,pA1,NT-1,false,false,false); RESC();
  { float sacc=pB0[0]+pB0[1]; _Pragma("unroll") for(int r=2;r<16;++r)sacc+=pB0[r]; _Pragma("unroll") for(int r=0;r<16;++r)sacc+=pB1[r]; l_reg+=sacc;
    pw0=(u32x4){PKW(pB0,0),PKW(pB0,2),PKW(pB0,4),PKW(pB0,6)};pw1=(u32x4){PKW(pB0,8),PKW(pB0,10),PKW(pB0,12),PKW(pB0,14)};pw2=(u32x4){PKW(pB1,0),PKW(pB1,2),PKW(pB1,4),PKW(pB1,6)};pw3=(u32x4){PKW(pB1,8),PKW(pB1,10),PKW(pB1,12),PKW(pB1,14)};
    SBAR(); pv(o,vb0+sl_cur,PAF(0),PAF(1),PAF(2),PAF(3)); }
  #undef PKW
  #undef PAF
  #undef VFR
  #undef PIN
  #undef MX3
  #undef GAPA
  #undef GAPB
  #undef EX
  #undef VRD
  #undef KRD
  #undef STEP
  #undef ENDW
  {auto rr=__builtin_amdgcn_permlane32_swap(__float_as_uint(l_reg),__float_as_uint(l_reg),false,false);l_reg=__uint_as_float(rr[0])+__uint_as_float(rr[1]);}
  if(hi==0)wsf[32+r32]=l_reg;asm volatile("s_waitcnt lgkmcnt(0)":::"memory");
  float rli[16];
  #pragma unroll
  for(int r=0;r<16;++r)rli[r]=__builtin_amdgcn_rcpf(wsf[32+crow(r,hi)]);
  bf16*Ow=O+(rowbase+q0+wid*QBLK)*DM+h*D;
  { bf16*stg=(bf16*)(shm+LDS_OST)+wid*2048;
    #pragma unroll
    for(int r=0;r<16;++r){const int orow=crow(r,hi);
      #pragma unroll
      for(int d0=0;d0<2;++d0)stg[orow*64+d0*32+r32]=__float2bfloat16(o[d0][r]*rli[r]);}
    asm volatile("s_waitcnt lgkmcnt(0)":::"memory");
    #pragma unroll
    for(int i=0;i<4;++i){const int row=i*8+(lane>>3),ch=lane&7; const u32x4 v=*(const u32x4*)(stg+row*64+ch*8); ATTN_STORE16(Ow+(long)row*DM+ch*8,v);} }
  asm volatile("s_waitcnt lgkmcnt(0)\n\ts_barrier":::"memory");
  #undef DMA_K
  #undef DMA_V
  #undef CMASK
  #undef START
  #undef RESC
  #undef ROT
}
constexpr int ATTN_LDS_BYTES=LDS_BYTES;
struct AttnTensors { const bf16* Q; const bf16* K; const bf16* V; bf16* O; const float* CL; const unsigned* KMAX; };
struct AttnUnit { int bh; int qb; };
template<int THRL=8> __device__ __forceinline__ void attn_phase_q(char*lds,const AttnTensors&T,unsigned*qctr,int block){
  volatile __attribute__((address_space(3))) int* tk=(volatile __attribute__((address_space(3))) int*)((__attribute__((address_space(3))) char*)lds+LDS_WS);
  for(;;){
    if(threadIdx.x==0){ int v=-1,q=block&7; for(int tried=0;tried<8;++tried){ const unsigned i_=__hip_atomic_fetch_add(qctr+64*q,1u,__ATOMIC_RELAXED,__HIP_MEMORY_SCOPE_AGENT); if(i_<128u){ v=(int)(q*128u+i_); break; } q=(q+1)&7; } tk[0]=v; }
    __syncthreads();
    const int u=__builtin_amdgcn_readfirstlane(tk[0]);
    __syncthreads();
    if(u<0)break;
    const int qq=u>>7,i_=u&127,h=2*qq+(i_&1),qb=63-(i_>>1);
    attn_unit<THRL>(0,h,qb,T.Q,T.K,T.V,T.O,lds,T.CL+(size_t)h*SEQ,__builtin_bit_cast(float,T.KMAX[h]));
  }
}
#undef SBAR
#undef WAIT_BAR
}
namespace sattn {
#define SLAS __attribute__((address_space(3)))
typedef short bf16x8 __attribute__((ext_vector_type(8)));
typedef float f32x4 __attribute__((ext_vector_type(4)));
typedef unsigned u32x4 __attribute__((ext_vector_type(4)));
typedef unsigned u32x2 __attribute__((ext_vector_type(2)));
typedef float f32x2_t __attribute__((ext_vector_type(2))); typedef __bf16 bf16x2_t __attribute__((ext_vector_type(2)));
__device__ __forceinline__ unsigned pk(float lo, float hi) { f32x2_t v = {lo, hi}; bf16x2_t b = __builtin_convertvector(v, bf16x2_t); return __builtin_bit_cast(unsigned, b); }
__device__ __forceinline__ bf16x8 cvt8(f32x4 a, f32x4 b) { u32x4 w; w.x = pk(a[0], a[1]); w.y = pk(a[2], a[3]); w.z = pk(b[0], b[1]); w.w = pk(b[2], b[3]); return __builtin_bit_cast(bf16x8, w); }
constexpr int PAST = 2048, NEWK = 16, LKEYS = PAST + NEWK, VT_STRIDE = 80, VT_BYTES = 64 * VT_STRIDE;
constexpr int L_VT = 0, L_CO = 8 * VT_BYTES, L_CM = L_CO + 8 * 16 * 64 * 4, L_CL = L_CM + 8 * 16 * 4, L_END = L_CL + 8 * 16 * 4;
constexpr float NEG = -1.0e30f;
struct Tensors { const float* ck; const float* cv; const unsigned short* QB; const unsigned short* KB; const unsigned short* VB; unsigned short* O; const float* CLS; };
__device__ __forceinline__ void tile_tail(f32x4 (&s)[2], const bf16x8 (&vw)[4], float& m, float& l, f32x4 (&o)[4], SLAS char* vt, int r, int g) {
    float mx = fmaxf(fmaxf(fmaxf(s[0][0], s[0][1]), fmaxf(s[0][2], s[0][3])), fmaxf(fmaxf(s[1][0], s[1][1]), fmaxf(s[1][2], s[1][3])));
    mx = fmaxf(mx, __shfl_xor(mx, 16)); mx = fmaxf(mx, __shfl_xor(mx, 32));
    const float mn = fmaxf(m, mx), alpha = __builtin_amdgcn_exp2f(m - mn); m = mn;
    float ps = 0.f;
#pragma unroll
    for (int j = 0; j < 2; ++j)
#pragma unroll
        for (int e = 0; e < 4; ++e) { s[j][e] = __builtin_amdgcn_exp2f(s[j][e] - mn); ps += s[j][e]; }
    l = l * alpha + ps;
#pragma unroll
    for (int db = 0; db < 4; ++db) o[db] *= alpha;
    const bf16x8 pb = cvt8(s[0], s[1]);
#pragma unroll
    for (int dd = 0; dd < 4; ++dd) *(SLAS bf16x8*)(vt + (4 * r + dd) * VT_STRIDE + g * 16) = vw[dd];
#pragma unroll
    for (int db = 0; db < 4; ++db) { const bf16x8 va = *(const SLAS bf16x8*)(vt + (16 * db + r) * VT_STRIDE + g * 16); o[db] = __builtin_amdgcn_mfma_f32_16x16x32_bf16(va, pb, o[db], 0, 0, 0); }
}
__device__ __forceinline__ void unit(int b, int h, const Tensors& T, SLAS char* lds) {
    const int tid = opaque_tid(), lane = tid & 63, r = lane & 15, g = lane >> 4; const int wid = __builtin_amdgcn_readfirstlane(tid >> 6);
    SLAS char* vt = lds + L_VT + wid * VT_BYTES;
    const size_t srow = (size_t)16384 + (size_t)b * 16;
    const float* cls = T.CLS + (size_t)(b * 16 + h) * LKEYS;
    const unsigned short* qp = T.QB + (srow + r) * 1024 + h * 64 + 8 * g;
    const bf16x8 qf0 = *(const bf16x8*)qp, qf1 = *(const bf16x8*)(qp + 32);
    const float cq = cls[PAST + r];
    float m = NEG, l = 0.f; f32x4 o[4];
#pragma unroll
    for (int db = 0; db < 4; ++db) o[db] = (f32x4){0.f, 0.f, 0.f, 0.f};
    const float* kc = T.ck + ((size_t)b * PAST * 16 + h) * 64; const float* vc = T.cv + ((size_t)b * PAST * 16 + h) * 64;
    for (int tI = 0; tI < 8; ++tI) {
        const int k0 = wid * 256 + tI * 32;
        bf16x8 ka[2][2];
#pragma unroll
        for (int j = 0; j < 2; ++j)
#pragma unroll
            for (int dh = 0; dh < 2; ++dh) { const float* p = kc + (size_t)(k0 + 16 * j + r) * 1024 + dh * 32 + 8 * g; ka[j][dh] = cvt8(*(const f32x4*)p, *(const f32x4*)(p + 4)); }
        f32x4 vv[2][4];
#pragma unroll
        for (int j = 0; j < 2; ++j)
#pragma unroll
            for (int e = 0; e < 4; ++e) vv[j][e] = *(const f32x4*)(vc + (size_t)(k0 + 16 * j + 4 * g + e) * 1024 + 4 * r);
        f32x4 ckv[2];
#pragma unroll
        for (int j = 0; j < 2; ++j) ckv[j] = *(const f32x4*)(cls + k0 + 16 * j + 4 * g);
        f32x4 s[2];
#pragma unroll
        for (int j = 0; j < 2; ++j) { s[j] = __builtin_amdgcn_mfma_f32_16x16x32_bf16(ka[j][0], qf0, (f32x4){0.f, 0.f, 0.f, 0.f}, 0, 0, 0); s[j] = __builtin_amdgcn_mfma_f32_16x16x32_bf16(ka[j][1], qf1, s[j], 0, 0, 0); }
#pragma unroll
        for (int j = 0; j < 2; ++j)
#pragma unroll
            for (int e = 0; e < 4; ++e) s[j][e] += cq - ckv[j][e];
        bf16x8 vw[4];
#pragma unroll
        for (int dd = 0; dd < 4; ++dd) { u32x4 w; w.x = pk(vv[0][0][dd], vv[0][1][dd]); w.y = pk(vv[0][2][dd], vv[0][3][dd]); w.z = pk(vv[1][0][dd], vv[1][1][dd]); w.w = pk(vv[1][2][dd], vv[1][3][dd]); vw[dd] = __builtin_bit_cast(bf16x8, w); }
        tile_tail(s, vw, m, l, o, vt, r, g);
    }
    if (wid == 0) {
        bf16x8 ka[2]; { const unsigned short* p = T.KB + (srow + r) * 1024 + h * 64 + 8 * g; ka[0] = *(const bf16x8*)p; ka[1] = *(const bf16x8*)(p + 32); }
        const f32x4 ckv = *(const f32x4*)(cls + PAST + 4 * g);
        f32x4 s[2];
        s[0] = __builtin_amdgcn_mfma_f32_16x16x32_bf16(ka[0], qf0, (f32x4){0.f, 0.f, 0.f, 0.f}, 0, 0, 0); s[0] = __builtin_amdgcn_mfma_f32_16x16x32_bf16(ka[1], qf1, s[0], 0, 0, 0);
#pragma unroll
        for (int e = 0; e < 4; ++e) { s[0][e] += cq - ckv[e]; if (4 * g + e > r) s[0][e] = NEG; s[1][e] = NEG; }
        unsigned short ve[4][4];
#pragma unroll
        for (int e = 0; e < 4; ++e) { const u32x2 w = *(const u32x2*)(T.VB + (srow + 4 * g + e) * 1024 + h * 64 + 4 * r); ve[e][0] = (unsigned short)(w.x & 0xffffu); ve[e][1] = (unsigned short)(w.x >> 16); ve[e][2] = (unsigned short)(w.y & 0xffffu); ve[e][3] = (unsigned short)(w.y >> 16); }
        bf16x8 vw[4];
#pragma unroll
        for (int dd = 0; dd < 4; ++dd) { u32x4 w; w.x = (unsigned)ve[0][dd] | ((unsigned)ve[1][dd] << 16); w.y = (unsigned)ve[2][dd] | ((unsigned)ve[3][dd] << 16); w.z = 0u; w.w = 0u; vw[dd] = __builtin_bit_cast(bf16x8, w); }
        tile_tail(s, vw, m, l, o, vt, r, g);
    }
    l += __shfl_xor(l, 16); l += __shfl_xor(l, 32);
    SLAS float* co = (SLAS float*)(lds + L_CO) + (wid * 16 + r) * 64; SLAS float* cm = (SLAS float*)(lds + L_CM); SLAS float* cl = (SLAS float*)(lds + L_CL);
#pragma unroll
    for (int db = 0; db < 4; ++db) *(SLAS f32x4*)(co + 16 * db + 4 * g) = o[db];
    if (g == 0) { cm[wid * 16 + r] = m; cl[wid * 16 + r] = l; }
    __syncthreads();
    { const int q = tid >> 5, d2 = (tid & 31) * 2; float mm = NEG;
#pragma unroll
      for (int w = 0; w < 8; ++w) mm = fmaxf(mm, cm[w * 16 + q]);
      float den = 0.f, n0 = 0.f, n1 = 0.f;
#pragma unroll
      for (int w = 0; w < 8; ++w) { const float f = __builtin_amdgcn_exp2f(cm[w * 16 + q] - mm); den += f * cl[w * 16 + q]; const SLAS float* c = (const SLAS float*)(lds + L_CO) + (w * 16 + q) * 64 + d2; n0 += f * c[0]; n1 += f * c[1]; }
      const float inv = 1.0f / den;
      *(unsigned*)(T.O + (srow + q) * 1024 + h * 64 + d2) = pk(n0 * inv, n1 * inv); }
    __syncthreads();
}
#undef SLAS
}
namespace cg = cooperative_groups;
constexpr int NWAVES = 8;
constexpr int D = 1024, H = 16, FF = 4096, MP = 16384, MS = 512, M = MP + MS, PAST = 2048, DBATCH = 32, DSEQ = 16, LKEYS = PAST + DSEQ;
constexpr float RMS_EPS = 1e-6f, L2E = 1.4426950408889634f, QSCALE = 0.125f * 1.4426950408889634f;
constexpr size_t OUT_Y = 0, OUT_KP = 17301504, OUT_VP = 34078720, OUT_LP = 50855936, OUT_CP = 51118080, OUT_KS = 51122176, OUT_VS = 51646464, OUT_LS = 52170752, OUT_CS = 52178944, OUT_END = 52310016;
static_assert(OUT_KP == (size_t)pg8::OUT_KP && OUT_VP == (size_t)pg8::OUT_VP && OUT_KS == (size_t)pg8::OUT_KS && OUT_VS == (size_t)pg8::OUT_VS, "d_out map");
constexpr size_t MiB = 1u << 20;
constexpr size_t WS_CTL = 0, CTL_ZERO_BYTES = 1 * MiB;
constexpr size_t WS_WIN = 2 * MiB, WS_WOUT = 14 * MiB, WS_WKVQ = 18 * MiB, WS_WQ1 = 24 * MiB, WS_WO = 26 * MiB, WS_WUP = 30 * MiB, WS_WDN = 62 * MiB, WS_WF = 94 * MiB;
constexpr size_t WS_X = 96 * MiB, WS_XB = 162 * MiB, WS_G = 195 * MiB, WS_KB = 228 * MiB, WS_VB = 261 * MiB, WS_QB = 294 * MiB, WS_HB = 327 * MiB, WS_SSQ = 459 * MiB, WS_CLP = 462 * MiB, WS_CLS = 463 * MiB, WS_END = 468 * MiB;
static_assert((size_t)M * D * 4 == 66 * MiB && (size_t)M * FF * 2 == 132 * MiB && (size_t)512 * LKEYS * 4 <= 5 * MiB && (size_t)M * pg8::NSSQ * 4 <= 3 * MiB, "d_ws map");
constexpr int CW_BAR = 4096, CW_KMAX = 2048, CW_ATQ = 2304  ;
constexpr int RING_OFF = 0, RING_BYTES = 131072;
constexpr int ATT_LDS = attn_body::LDS_BYTES;
constexpr int LDSCTL_OFF = (ATT_LDS > RING_BYTES ? ATT_LDS : RING_BYTES), MISC_OFF = LDSCTL_OFF + 320;
constexpr int LDS_BYTES = LDSCTL_OFF + 1024;
static_assert(LDS_BYTES <= 163840 && sattn::L_END <= RING_BYTES, "LDS map");

#define GAS __attribute__((address_space(1)))
#define LAS __attribute__((address_space(3)))
typedef unsigned short bf16;
typedef unsigned v4u __attribute__((ext_vector_type(4)));
typedef unsigned v2u __attribute__((ext_vector_type(2)));
typedef float f32x4 __attribute__((ext_vector_type(4)));
typedef short bf16x8 __attribute__((ext_vector_type(8)));
typedef GAS unsigned gu32;
#define RLX_AGENT __ATOMIC_RELAXED, __HIP_MEMORY_SCOPE_AGENT
#define LDS_WAIT() asm volatile("s_waitcnt lgkmcnt(0)" ::: "memory")
#define VM_WAIT() asm volatile("s_waitcnt vmcnt(0)" ::: "memory")
__device__ __forceinline__ unsigned pk2(float lo, float hi) { return sattn::pk(lo, hi); }
__device__ __forceinline__ float bflo(unsigned w) { return __builtin_bit_cast(float, w << 16); }
__device__ __forceinline__ float bfhi(unsigned w) { return __builtin_bit_cast(float, w & 0xffff0000u); }
#define XB_TMO      128
#define XB_XCNT(j)  (256  + 64 * (j))
#define XB_XSUB(j)  (1280 + 64 * (j))
#define XB_XGEN(j)  (2304 + 64 * (j))
#define XB_TOP      3328
#define XB_TOPGEN   3392
#define XCD_BAR_WORDS 3456
#define XB_SPIN_CAP (1u << 18)

__device__ __forceinline__ unsigned xb_ld(unsigned* p)              { return __hip_atomic_load(p, __ATOMIC_RELAXED, __HIP_MEMORY_SCOPE_AGENT); }
__device__ __forceinline__ unsigned xb_add(unsigned* p, unsigned v) { return __hip_atomic_fetch_add(p, v, __ATOMIC_RELAXED, __HIP_MEMORY_SCOPE_AGENT); }
__device__ __forceinline__ unsigned xb_xcc_id() { return (unsigned)__builtin_amdgcn_s_getreg((3 << 11) | 20) & 0xFu; }
#define XB_SPIN(cond, bar) do { unsigned _sp = 0; while (cond) { __builtin_amdgcn_s_sleep(1); \
    if ((++_sp & 255u) == 0u) { if (xb_ld(&(bar)[XB_TMO])) break; if (_sp > XB_SPIN_CAP) { atomicAdd(&(bar)[XB_TMO], 1u); break; } } } } while (0)

struct XcdBarrier {
    unsigned* bar; unsigned x;
    volatile LAS unsigned* st;
};

__device__ __forceinline__ XcdBarrier xcd_barrier_post(unsigned* bar, volatile LAS unsigned* st) {
    XcdBarrier b; b.bar = bar; b.x = xb_xcc_id(); b.st = st;
    if (threadIdx.x == 0) (void)xb_add(&bar[XB_XCNT(b.x)], 1u);
    return b;
}
__device__ __forceinline__ void xcd_barrier_complete(unsigned* bar, unsigned x, unsigned& nloc, unsigned& nx) {
    const unsigned G = gridDim.x * gridDim.y * gridDim.z;
    unsigned sum, cnt, mine, sp = 0u;
    for (;;) {
        sum = 0u; cnt = 0u; mine = 0u;
#pragma unroll
        for (unsigned j = 0; j < 16; ++j) { const unsigned c = xb_ld(&bar[XB_XCNT(j)]); sum += c; cnt += (c > 0u) ? 1u : 0u; mine = (j == x) ? c : mine; }
        if (sum == G) break;
        __builtin_amdgcn_s_sleep(1);
        if ((++sp & 255u) == 0u) { if (xb_ld(&bar[XB_TMO])) break; if (sp > XB_SPIN_CAP) { atomicAdd(&bar[XB_TMO], 1u); break; } }
    }
    nloc = mine > 0u ? mine : 1u; nx = cnt > 0u ? cnt : 1u;
}

__device__ __forceinline__ void xcd_barrier(const XcdBarrier& b) {
    asm volatile("s_waitcnt vmcnt(0)" ::: "memory");
    __syncthreads();
    if (threadIdx.x == 0) {
        unsigned* bar = b.bar;
        __builtin_amdgcn_s_waitcnt(0);
        unsigned nloc = b.st[0], nx = b.st[1];
        if (nloc == 0u) { xcd_barrier_complete(bar, b.x, nloc, nx); b.st[0] = nloc; b.st[1] = nx; }
        const unsigned old = xb_add(&bar[XB_XSUB(b.x)], 1u);
        const unsigned gen = old / nloc;
        if (old + 1u == (gen + 1u) * nloc) {
            __builtin_amdgcn_fence(__ATOMIC_RELEASE, "agent");
            asm volatile("s_waitcnt vmcnt(0)" ::: "memory");
            const unsigned og = xb_add(&bar[XB_TOP], 1u);
            const unsigned tg = og / nx;
            if (og + 1u == (tg + 1u) * nx) xb_add(&bar[XB_TOPGEN], 1u);
            else XB_SPIN(xb_ld(&bar[XB_TOPGEN]) == tg, bar);
            __builtin_amdgcn_fence(__ATOMIC_ACQUIRE, "agent");
            xb_add(&bar[XB_XGEN(b.x)], 1u);
            asm volatile("s_waitcnt vmcnt(0)" ::: "memory");
        } else {
            XB_SPIN(xb_ld(&bar[XB_XGEN(b.x)]) == gen, bar);
            __builtin_amdgcn_fence(__ATOMIC_ACQUIRE, "agent");
            asm volatile("s_waitcnt vmcnt(0)" ::: "memory");
        }
    }
    __syncthreads();
}
struct Args { const float* in[21]; float* out; unsigned char* ws; };
typedef const __attribute__((address_space(4))) Args* KArgs;
__device__ __forceinline__ KArgs kargs() { KArgs p = (KArgs)__builtin_amdgcn_kernarg_segment_ptr(); asm volatile("" : "+s"(p)); return p; }
struct Frame {
    LAS unsigned char* lds; volatile LAS unsigned* MISC; gu32* ctl;
    int tid, lane, wave, vcu, G;
};
__device__ __forceinline__ float wave_sum(float v) {
#pragma unroll
    for (int o = 1; o < 64; o <<= 1) v += __shfl_xor(v, o);
    return v;
}
constexpr int P0_TILE_FLOATS = 64 * 65;
__device__ __forceinline__ void p0_transpose_item(const float* W, int K, int N, bf16* WT, int row_off, LAS float* scr, int item, int lane, const float* gain, float scale) {
    const int nblk = N / 64, kb = item / nblk, nb = item % nblk, k0 = 64 * kb, n0 = 64 * nb;
    const int c4 = lane & 15, kr = lane >> 4;
    f32x4 v[16];
#pragma unroll
    for (int i = 0; i < 16; ++i) v[i] = *(const GAS f32x4*)(W + (size_t)(k0 + 4 * i + kr) * N + n0 + 4 * c4);
#pragma unroll
    for (int i = 0; i < 16; ++i) { const int kk = 4 * i + kr; const float gsc = gain ? gain[k0 + kk] * scale : scale; LAS float* d = scr + kk * 65 + 4 * c4;
        d[0] = v[i].x * gsc; d[1] = v[i].y * gsc; d[2] = v[i].z * gsc; d[3] = v[i].w * gsc; }
    LDS_WAIT(); asm volatile("" ::: "memory");
    const int c = lane & 7;
#pragma unroll
    for (int j = 0; j < 8; ++j) { const int n = (lane >> 3) + 8 * j; const LAS float* s = scr + (8 * c) * 65 + n;
        v4u o; o.x = pk2(s[0 * 65], s[1 * 65]); o.y = pk2(s[2 * 65], s[3 * 65]); o.z = pk2(s[4 * 65], s[5 * 65]); o.w = pk2(s[6 * 65], s[7 * 65]);
        *(GAS v4u*)(WT + (size_t)(row_off + n0 + n) * K + k0 + 8 * c) = o; }
    LDS_WAIT(); asm volatile("" ::: "memory");
}
enum { I_XP = 0, I_XS, I_CK, I_CV, I_CLF, I_SC, I_NMIX, I_NMLP, I_CIN, I_CW, I_COUT, I_NKV, I_WK, I_WV, I_WF, I_BF, I_WQ, I_WO, I_UP, I_DN, I_NF };

__device__ __forceinline__ void p0_prologue(const Frame& F, KArgs a, unsigned char* ws) {
    const int T_tid = opaque_tid(), T_lane = T_tid & 63, T_wave = __builtin_amdgcn_readfirstlane(T_tid >> 6);
    LAS float* scr = (LAS float*)(F.lds + RING_OFF) + T_wave * P0_TILE_FLOATS;
    const int gw = F.vcu * NWAVES + T_wave, NGW = F.G * NWAVES;
    constexpr int NCHUNK = 46;
    for (int it = gw; it < NCHUNK * 256; it += NGW) {
        int c = it >> 8, base = 0; const float* src = nullptr; const float* gain = nullptr; bf16* dst = nullptr; int roff = 0, K = D, N = D; float sc = 1.f;
        if (c < 6) { const int l = c / 3; src = a->in[I_CIN] + (size_t)l * D * 3 * D; gain = a->in[I_NMIX] + l * D; dst = (bf16*)(ws + WS_WIN) + (size_t)l * 3 * D * D; N = 3 * D; base = l * 3; }
        else if (c < 8) { const int l = c - 6; src = a->in[I_COUT] + (size_t)l * D * D; dst = (bf16*)(ws + WS_WOUT) + (size_t)l * D * D; base = c; }
        else if (c < 9) { src = a->in[I_WK]; gain = a->in[I_NKV]; dst = (bf16*)(ws + WS_WKVQ); base = c; }
        else if (c < 10) { src = a->in[I_WV]; gain = a->in[I_NKV]; dst = (bf16*)(ws + WS_WKVQ); roff = D; base = c; }
        else if (c < 11) { src = a->in[I_WQ]; gain = a->in[I_NMIX] + 2 * D; dst = (bf16*)(ws + WS_WKVQ); roff = 2 * D; sc = QSCALE; base = c; }
        else if (c < 12) { src = a->in[I_WQ] + (size_t)D * D; gain = a->in[I_NMIX] + 3 * D; dst = (bf16*)(ws + WS_WQ1); sc = QSCALE; base = c; }
        else if (c < 14) { const int j = c - 12; src = a->in[I_WO] + (size_t)j * D * D; dst = (bf16*)(ws + WS_WO) + (size_t)j * D * D; base = c; }
        else if (c < 30) { const int l = (c - 14) >> 2; src = a->in[I_UP] + (size_t)l * D * FF; gain = a->in[I_NMLP] + l * D; dst = (bf16*)(ws + WS_WUP) + (size_t)l * D * FF; N = FF; base = 14 + 4 * l; }
        else { const int l = (c - 30) >> 2; src = a->in[I_DN] + (size_t)l * D * FF; dst = (bf16*)(ws + WS_WDN) + (size_t)l * D * FF; K = FF; base = 30 + 4 * l; }
        p0_transpose_item(src, K, N, dst, roff, scr, it - base * 256, T_lane, gain, sc);
    }
    for (int i = (F.vcu * NWAVES + T_wave) * 64 + T_lane; i < D * H; i += NGW * 64) { const int k = i >> 4, h = i & 15; ((bf16*)(ws + WS_WF))[h * D + k] = (bf16)(pk2(a->in[I_NKV][k] * a->in[I_WF][i], 0.f) & 0xffffu); }
    bf16* XB = (bf16*)(ws + WS_XB); float* SSQ = (float*)(ws + WS_SSQ);
    for (int m = gw; m < M; m += NGW) {
        const float* xr = (m < MP) ? a->in[I_XP] + (size_t)m * D : a->in[I_XS] + (size_t)(m - MP) * D;
        const GAS f32x4* xp = (const GAS f32x4*)xr + T_lane; f32x4 v[4]; float s = 0.f;
#pragma unroll
        for (int j = 0; j < 4; ++j) { v[j] = xp[64 * j]; s += (v[j].x * v[j].x + v[j].y * v[j].y) + (v[j].z * v[j].z + v[j].w * v[j].w); }
        s = wave_sum(s);
        GAS v2u* bo = (GAS v2u*)(XB + (size_t)m * D) + T_lane;
#pragma unroll
        for (int j = 0; j < 4; ++j) { v2u w; w.x = pk2(v[j].x, v[j].y); w.y = pk2(v[j].z, v[j].w); bo[64 * j] = w; }
        if (T_lane < pg8::NSSQ) SSQ[(size_t)m * pg8::NSSQ + T_lane] = (T_lane == 0) ? s : 0.f;
    }
}
__device__ __forceinline__ void conv_gate_phase(const Frame& F, KArgs a, unsigned char* ws, int l) {
    const int T_tid = opaque_tid(), T_lane = T_tid & 63, T_wave = __builtin_amdgcn_readfirstlane(T_tid >> 6);
    const int gw = F.vcu * NWAVES + T_wave, NGW = F.G * NWAVES;
    const bf16* BCX = (const bf16*)(ws + WS_HB); bf16* Gm = (bf16*)(ws + WS_G);
    const float* cw = a->in[I_CW] + (size_t)l * 3 * D;
    for (int it = gw; it < (M / 8) * 2; it += NGW) {
        const int half = it & 1, row0 = (it >> 1) * 8, c0 = half * 512 + T_lane * 8;
        float w0[8], w1[8], w2[8], um2[8], um1[8];
        { const f32x4 a0 = *(const f32x4*)(cw + c0), a1 = *(const f32x4*)(cw + c0 + 4), b0 = *(const f32x4*)(cw + D + c0), b1 = *(const f32x4*)(cw + D + c0 + 4), d0 = *(const f32x4*)(cw + 2 * D + c0), d1 = *(const f32x4*)(cw + 2 * D + c0 + 4);
#pragma unroll
          for (int e = 0; e < 4; ++e) { w0[e] = a0[e]; w0[4 + e] = a1[e]; w1[e] = b0[e]; w1[4 + e] = b1[e]; w2[e] = d0[e]; w2[4 + e] = d1[e]; } }
        const bool sample = row0 >= MP; const int sb = sample ? (row0 - MP) >> 4 : 0; const int t0 = sample ? (row0 - MP) & 15 : row0;
        if (t0 == 0) {
            if (sample) { const float* st = a->in[I_SC] + ((size_t)(l * DBATCH + sb) * 2) * D + c0;
                const f32x4 p0 = *(const f32x4*)st, p1 = *(const f32x4*)(st + 4), q0 = *(const f32x4*)(st + D), q1 = *(const f32x4*)(st + D + 4);
#pragma unroll
                for (int e = 0; e < 4; ++e) { um2[e] = p0[e]; um2[4 + e] = p1[e]; um1[e] = q0[e]; um1[4 + e] = q1[e]; } }
            else {
#pragma unroll
                for (int e = 0; e < 8; ++e) { um2[e] = 0.f; um1[e] = 0.f; } }
        } else {
#pragma unroll
            for (int k = 0; k < 2; ++k) { const bf16* rp = BCX + (size_t)(row0 - 2 + k) * 3072 + c0; const v4u gc = *(const v4u*)(rp + D), xv = *(const v4u*)(rp + 2 * D);
#pragma unroll
                for (int e = 0; e < 4; ++e) { const float u0 = bflo(gc[e]) * bflo(xv[e]), u1 = bfhi(gc[e]) * bfhi(xv[e]); if (k == 0) { um2[2 * e] = u0; um2[2 * e + 1] = u1; } else { um1[2 * e] = u0; um1[2 * e + 1] = u1; } } }
        }
#pragma unroll
        for (int i = 0; i < 8; ++i) { const bf16* rp = BCX + (size_t)(row0 + i) * 3072 + c0; const v4u gb = *(const v4u*)rp, gc = *(const v4u*)(rp + D), xv = *(const v4u*)(rp + 2 * D);
            float u[8], o[8];
#pragma unroll
            for (int e = 0; e < 4; ++e) { u[2 * e] = bflo(gc[e]) * bflo(xv[e]); u[2 * e + 1] = bfhi(gc[e]) * bfhi(xv[e]); }
#pragma unroll
            for (int e = 0; e < 8; ++e) o[e] = w0[e] * um2[e] + w1[e] * um1[e] + w2[e] * u[e];
            v4u w;
#pragma unroll
            for (int e = 0; e < 4; ++e) w[e] = pk2(bflo(gb[e]) * o[2 * e], bfhi(gb[e]) * o[2 * e + 1]);
            *(v4u*)(Gm + (size_t)(row0 + i) * D + c0) = w;
#pragma unroll
            for (int e = 0; e < 8; ++e) { um2[e] = um1[e]; um1[e] = u[e]; } }
        const bool last = sample ? (t0 == 8) : (row0 + 8 == MP);
        if (last) { float* o = a->out + (sample ? OUT_CS + ((size_t)(l * DBATCH + sb) * 2) * D : OUT_CP + (size_t)l * 2 * D) + c0;
            *(f32x4*)o = (f32x4){um2[0], um2[1], um2[2], um2[3]}; *(f32x4*)(o + 4) = (f32x4){um2[4], um2[5], um2[6], um2[7]};
            *(f32x4*)(o + D) = (f32x4){um1[0], um1[1], um1[2], um1[3]}; *(f32x4*)(o + D + 4) = (f32x4){um1[4], um1[5], um1[6], um1[7]}; }
    }
}
__device__ __forceinline__ void logf_phase(const Frame& F, KArgs a, unsigned char* ws) {
    const int T_tid = opaque_tid(), T_lane = T_tid & 63, T_wave = __builtin_amdgcn_readfirstlane(T_tid >> 6);
    const int gw = F.vcu * NWAVES + T_wave, NGW = F.G * NWAVES; const int r = T_lane & 15, g = T_lane >> 4;
    const bf16* WF = (const bf16*)(ws + WS_WF); const bf16* XB = (const bf16*)(ws + WS_XB); const float* SSQ = (const float*)(ws + WS_SSQ);
    for (int blk = gw; blk < M / 16; blk += NGW) {
        const int row = blk * 16 + r; f32x4 acc = (f32x4){0.f, 0.f, 0.f, 0.f};
        const bf16* ap = WF + (size_t)r * D + 8 * g; const bf16* bp = XB + (size_t)row * D + 8 * g;
#pragma unroll 8
        for (int s = 0; s < 32; ++s) acc = __builtin_amdgcn_mfma_f32_16x16x32_bf16(*(const bf16x8*)(ap + 32 * s), *(const bf16x8*)(bp + 32 * s), acc, 0, 0, 0);
        const float rs = pg8::row_rstd(SSQ, row); const f32x4 bfv = *(const f32x4*)(a->in[I_BF] + 4 * g); f32x4 o;
#pragma unroll
        for (int e = 0; e < 4; ++e) { const float z = acc[e] * rs + bfv[e]; o[e] = fminf(z, 0.f) - log1pf(expf(-fabsf(z))); }
        float* op = a->out + ((row < MP) ? OUT_LP + (size_t)row * 16 : OUT_LS + (size_t)(row - MP) * 16) + 4 * g;
        *(f32x4*)op = o;
    }
}
__device__ __forceinline__ double wave_scan_incl(double v, int lane) {
#pragma unroll
    for (int o = 1; o < 64; o <<= 1) { const double t = __shfl_up(v, o); if (lane >= o) v += t; }
    return v;
}
__device__ __forceinline__ void scan_phase(const Frame& F, KArgs a, unsigned char* ws) {
    const int T_tid = opaque_tid(), T_lane = T_tid & 63, T_wave = __builtin_amdgcn_readfirstlane(T_tid >> 6);
    float* CLP = (float*)(ws + WS_CLP); float* CLS = (float*)(ws + WS_CLS);
    const int blk = blockIdx.x;
    if (blk < 16) {
        const int h = blk; const float* lf = a->out + OUT_LP; const int t0 = T_tid * 32; double s = 0.0;
#pragma unroll 8
        for (int i = 0; i < 32; ++i) s += (double)lf[(size_t)(t0 + i) * 16 + h];
        const double inc = wave_scan_incl(s, T_lane);
        LAS double* wt = (LAS double*)(F.lds + RING_OFF);
        if (T_lane == 63) wt[T_wave] = inc;
        __syncthreads();
        double run = inc - s;
        for (int w = 0; w < T_wave; ++w) run += wt[w];
#pragma unroll 8
        for (int i = 0; i < 32; ++i) { run += (double)lf[(size_t)(t0 + i) * 16 + h]; CLP[(size_t)h * MP + t0 + i] = (float)(run * (double)L2E); }
        __syncthreads();
    } else {
        const int nws = (F.G - 16) * NWAVES;
        for (int seq = (blk - 16) * NWAVES + T_wave; seq < DBATCH * H; seq += nws) {
            const int b = seq >> 4, h = seq & 15; const float* clf = a->in[I_CLF] + (size_t)b * PAST * 16 + h; const float* nlf = a->out + OUT_LS + (size_t)b * DSEQ * 16 + h;
            const int s0 = T_lane * 33; double s = 0.0;
            for (int i = 0; i < 33; ++i) { const int k = s0 + i; if (k < LKEYS) s += (double)(k < PAST ? clf[(size_t)k * 16] : nlf[(size_t)(k - PAST) * 16]); }
            double run = wave_scan_incl(s, T_lane) - s;
            for (int i = 0; i < 33; ++i) { const int k = s0 + i; if (k < LKEYS) { run += (double)(k < PAST ? clf[(size_t)k * 16] : nlf[(size_t)(k - PAST) * 16]); CLS[(size_t)seq * LKEYS + k] = (float)(run * (double)L2E); } }
        }
    }
    { const int gw = F.vcu * NWAVES + T_wave, NGW = F.G * NWAVES; const bf16* KB = (const bf16*)(ws + WS_KB); float mx = 0.f;
      for (int row = gw; row < MP; row += NGW) { const v4u p = *(const v4u*)(KB + (size_t)row * D + T_lane * 16), q = *(const v4u*)(KB + (size_t)row * D + T_lane * 16 + 8); float sq = 0.f;
#pragma unroll
          for (int e = 0; e < 4; ++e) { const float a0 = bflo(p[e]), a1 = bfhi(p[e]), b0 = bflo(q[e]), b1 = bfhi(q[e]); sq += (a0 * a0 + a1 * a1) + (b0 * b0 + b1 * b1); }
          sq += __shfl_xor(sq, 1); sq += __shfl_xor(sq, 2); mx = fmaxf(mx, sq); }
      __syncthreads();
      LAS float* km = (LAS float*)(F.lds + RING_OFF) + 64;
      if ((T_lane & 3) == 0) km[T_wave * 16 + (T_lane >> 2)] = mx;
      __syncthreads();
      if (T_tid < 16) { float m = km[T_tid];
#pragma unroll
          for (int w = 1; w < NWAVES; ++w) m = fmaxf(m, km[w * 16 + T_tid]);
          atomicMax((unsigned*)(ws + WS_CTL) + CW_KMAX + T_tid, __builtin_bit_cast(unsigned, m)); }
      __syncthreads(); }
}
__device__ __forceinline__ void final_norm_phase(const Frame& F, KArgs a, unsigned char* ws) {
    const int T_tid = opaque_tid(), T_lane = T_tid & 63, T_wave = __builtin_amdgcn_readfirstlane(T_tid >> 6);
    const int gw = F.vcu * NWAVES + T_wave, NGW = F.G * NWAVES; const float* X = (const float*)(ws + WS_X);
    const GAS f32x4* gp = (const GAS f32x4*)a->in[I_NF] + T_lane; f32x4 gn[4];
#pragma unroll
    for (int j = 0; j < 4; ++j) gn[j] = gp[64 * j];
    for (int m = gw; m < M; m += NGW) {
        const GAS f32x4* xp = (const GAS f32x4*)(X + (size_t)m * D) + T_lane; f32x4 v[4]; float s = 0.f;
#pragma unroll
        for (int j = 0; j < 4; ++j) { v[j] = xp[64 * j]; s += (v[j].x * v[j].x + v[j].y * v[j].y) + (v[j].z * v[j].z + v[j].w * v[j].w); }
        const float rs = 1.0f / sqrtf(wave_sum(s) * (1.0f / D) + RMS_EPS);
        GAS f32x4* op = (GAS f32x4*)(a->out + OUT_Y + (size_t)m * D) + T_lane;
#pragma unroll
        for (int j = 0; j < 4; ++j) op[64 * j] = v[j] * rs * gn[j];
    }
}

__global__ void __launch_bounds__(NWAVES * 64, 2) yoco_fwd(Args args) {
    extern __shared__ __attribute__((aligned(16))) unsigned char lds[];
    Frame F;
    F.lds = (LAS unsigned char*)lds;
    F.MISC = (volatile LAS unsigned*)(F.lds + MISC_OFF);
    F.tid = threadIdx.x; F.lane = F.tid & 63; F.wave = __builtin_amdgcn_readfirstlane(F.tid >> 6);
    F.G = gridDim.x; { const int bx = blockIdx.x; F.vcu = (F.G % 8 == 0) ? (bx % 8) * (F.G / 8) + bx / 8 : bx; }
    F.ctl = (gu32*)(kargs()->ws + WS_CTL);
    for (int u = F.tid; u < (LDS_BYTES - LDSCTL_OFF) / 4; u += NWAVES * 64) ((LAS unsigned*)(F.lds + LDSCTL_OFF))[u] = 0u;
    __syncthreads();
    XcdBarrier bar = xcd_barrier_post((unsigned*)(F.ctl + CW_BAR), F.MISC + 8);
#define GRID_BAR() xcd_barrier(bar)
#define WSP(T, off) ((T*)(kargs()->ws + (off)))

    p0_prologue(F, kargs(), kargs()->ws);
    cg::this_grid().sync();
    GRID_BAR();

#define SAMPLE_TILES(g, E) do { const int id_ = opaque_bid(); if (id_ < 4 * ((g).N / 128)) { const int mi_ = id_ & 3, ni_ = id_ >> 2; \
        pg8::gemm128_tile(F.lds + RING_OFF, (g).A + (size_t)(MP + 128 * mi_) * (g).K, (g).Bt + (size_t)(128 * ni_) * (g).K, (g).K, E, MP + 128 * mi_, 128 * ni_); } } while (0)
#define LAYER(l) do { \
        if ((l) != 2) { \
            constexpr bool cv = (l) < 2; unsigned char* ws = kargs()->ws; \
            pg8::Gemm g{(const bf16*)(ws + WS_XB), cv ? (const bf16*)(ws + WS_WIN) + (size_t)(l) * 3 * D * D : (const bf16*)(ws + WS_WQ1), M, cv ? 3 * D : D, D}; \
            pg8::StaticOrder S; S.init(MP, cv ? 3 * D : D, F.G, opaque_bid()); \
            pg8::EpiAct<0, false> E{cv ? (bf16*)(ws + WS_HB) : (bf16*)(ws + WS_QB), cv ? 3 * D : D, (const float*)(ws + WS_SSQ), 0, 0, nullptr}; \
            pg8::gemm_phase<pg8::EpiAct<0, false>, pg8::StaticOrder, PG8_ALIGN, PG8_SP2>(F.lds + RING_OFF, g, S, E); \
            SAMPLE_TILES(g, E); \
            GRID_BAR(); \
        } \
        if ((l) < 2) { conv_gate_phase(F, kargs(), kargs()->ws, (l)); } \
        else { \
            { unsigned char* ws = kargs()->ws; \
            const attn_body::AttnTensors AT{(const attn_body::bf16*)(ws + WS_QB), (const attn_body::bf16*)(ws + WS_KB), (const attn_body::bf16*)(ws + WS_VB), (attn_body::bf16*)(ws + WS_G), (const float*)(ws + WS_CLP), (const unsigned*)(ws + WS_CTL) + CW_KMAX}; \
            attn_body::attn_phase_q<24>((char*)lds + RING_OFF, AT, (unsigned*)(ws + WS_CTL) + CW_ATQ + ((l) - 2) * 512, opaque_bid()); } \
            __syncthreads(); \
            KArgs ka = kargs(); unsigned char* ws = ka->ws; \
            const sattn::Tensors ST{ka->in[I_CK], ka->in[I_CV], (const bf16*)(ws + WS_QB), (const bf16*)(ws + WS_KB), (const bf16*)(ws + WS_VB), (bf16*)(ws + WS_G), (const float*)(ws + WS_CLS)}; \
            for (int u = F.vcu; u < DBATCH * H; u += F.G) sattn::unit(u >> 4, u & 15, ST, (LAS char*)(F.lds + RING_OFF)); \
        } \
        GRID_BAR(); \
        { unsigned char* ws = kargs()->ws; \
            pg8::Gemm g{(const bf16*)(ws + WS_G), ((l) < 2) ? (const bf16*)(ws + WS_WOUT) + (size_t)(l) * D * D : (const bf16*)(ws + WS_WO) + (size_t)((l) - 2) * D * D, M, D, D}; \
            pg8::StaticOrder S; S.init(MP, D, F.G, opaque_bid()); \
            pg8::EpiResid E{(float*)(ws + WS_X), (bf16*)(ws + WS_XB), (float*)(ws + WS_SSQ), ((l) == 0) ? kargs()->in[I_XP] : nullptr, ((l) == 0) ? kargs()->in[I_XS] : nullptr}; \
            pg8::gemm_phase<pg8::EpiResid, pg8::StaticOrder, PG8_ALIGN, PG8_SP2>(F.lds + RING_OFF, g, S, E); \
            SAMPLE_TILES(g, E); \
            GRID_BAR(); } \
        { unsigned char* ws = kargs()->ws; \
            pg8::Gemm g{(const bf16*)(ws + WS_XB), (const bf16*)(ws + WS_WUP) + (size_t)(l) * D * FF, M, FF, D}; \
            pg8::StaticOrder S; S.init(MP, FF, F.G, opaque_bid()); \
            pg8::EpiAct<1, false> E{(bf16*)(ws + WS_HB), FF, (const float*)(ws + WS_SSQ), 0, 0, nullptr}; \
            pg8::gemm_phase<pg8::EpiAct<1, false>, pg8::StaticOrder, PG8_ALIGN, PG8_SP2>(F.lds + RING_OFF, g, S, E); \
            SAMPLE_TILES(g, E); \
            GRID_BAR(); } \
        { unsigned char* ws = kargs()->ws; \
            pg8::Gemm g{(const bf16*)(ws + WS_HB), (const bf16*)(ws + WS_WDN) + (size_t)(l) * D * FF, M, D, FF}; \
            pg8::StaticOrder S; S.init(MP, D, F.G, opaque_bid()); \
            pg8::EpiResid E{(float*)(ws + WS_X), (bf16*)(ws + WS_XB), (float*)(ws + WS_SSQ), nullptr, nullptr}; \
            pg8::gemm_phase<pg8::EpiResid, pg8::StaticOrder, PG8_ALIGN, PG8_SP2>(F.lds + RING_OFF, g, S, E); \
            SAMPLE_TILES(g, E); \
            GRID_BAR(); } \
        if ((l) == 1) { \
            KArgs ka = kargs(); unsigned char* ws = ka->ws; \
            pg8::Gemm g{(const bf16*)(ws + WS_XB), (const bf16*)(ws + WS_WKVQ), M, 3 * D, D}; \
            pg8::StaticOrder S; S.init(MP, 3 * D, F.G, opaque_bid()); \
            pg8::EpiAct<0, true> E{(bf16*)(ws + WS_KB), D, (const float*)(ws + WS_SSQ), D, (size_t)(WS_VB - WS_KB) / 2, ka->out}; \
            pg8::gemm_phase<pg8::EpiAct<0, true>, pg8::StaticOrder, PG8_ALIGN, PG8_SP2>(F.lds + RING_OFF, g, S, E); \
            SAMPLE_TILES(g, E); \
            logf_phase(F, kargs(), kargs()->ws); \
            GRID_BAR(); \
            scan_phase(F, kargs(), kargs()->ws); \
            GRID_BAR(); \
        } } while (0)
    LAYER(0); LAYER(1); LAYER(2); LAYER(3);
    final_norm_phase(F, kargs(), kargs()->ws);
}

extern "C" void kernel_launch(void* const* d_in, const int* in_sizes, int n_in, void* d_out, int out_size, void* d_ws, size_t ws_size, hipStream_t stream) {
    static int grid = 0;
    if (grid == 0) {
        if (n_in != 21 || out_size != (int)OUT_END || ws_size < WS_END) { fprintf(stderr, "kernel_launch: unexpected sizes (n_in %d, out %d, ws %zu); nothing launched\n", n_in, out_size, ws_size); grid = -1; return; }
        int dev = 0, cus = 0, per_cu = 0;
        if (hipGetDevice(&dev) != hipSuccess || hipDeviceGetAttribute(&cus, hipDeviceAttributeMultiprocessorCount, dev) != hipSuccess) { grid = -1; return; }
        if (hipFuncSetAttribute((const void*)yoco_fwd, hipFuncAttributeMaxDynamicSharedMemorySize, LDS_BYTES) != hipSuccess) { fprintf(stderr, "kernel_launch: hipFuncSetAttribute failed\n"); grid = -1; return; }
        if (hipOccupancyMaxActiveBlocksPerMultiprocessor(&per_cu, (const void*)yoco_fwd, NWAVES * 64, LDS_BYTES) != hipSuccess || per_cu < 1) { fprintf(stderr, "kernel_launch: occupancy query says %d\n", per_cu); per_cu = 1; }
        (void)hipGetLastError();
        grid = cus;
    }
    if (grid < 0) return;
    if (hipMemsetAsync((char*)d_ws + WS_CTL, 0, CTL_ZERO_BYTES, stream) != hipSuccess) { fprintf(stderr, "kernel_launch: memset failed\n"); return; }
    Args a{};
    for (int i = 0; i < 21; ++i) a.in[i] = (const float*)d_in[i];
    a.out = (float*)d_out; a.ws = (unsigned char*)d_ws;
    void* kargv[] = {&a};
    const hipError_t e = hipLaunchCooperativeKernel((const void*)yoco_fwd, dim3(grid), dim3(NWAVES * 64), kargv, LDS_BYTES, stream);
    if (e != hipSuccess) fprintf(stderr, "kernel_launch: cooperative launch failed: %s (grid %d)\n", hipGetErrorString(e), grid);
}
```

```cpp
#include <hip/hip_runtime.h>
#include <hip/hip_cooperative_groups.h>
#include <cstdio>
#include <cstdint>
__device__ __forceinline__ int opaque_bid() { int b = (int)blockIdx.x; asm volatile("" : "+s"(b)); return b; }
__device__ __forceinline__ int opaque_tid() { int t = (int)threadIdx.x; asm volatile("" : "+v"(t)); return t; }
namespace pg8 {
#define PG8_LAS __attribute__((address_space(3)))
typedef unsigned short bf16_t;
typedef short bf16x8 __attribute__((ext_vector_type(8)));
typedef float f32x4 __attribute__((ext_vector_type(4)));
typedef unsigned u32x4 __attribute__((ext_vector_type(4)));
constexpr int BM = 256, BK = 64, HALF = 128, HTB = HALF * BK * 2  , STAGE_BYTES = 8 * HTB, NXCD = 8, WGM = 8;

__host__ __device__ __forceinline__ int lds_byte(int r, int c) { const int st = (r >> 4) * 2 + (c >> 5), rr = r & 15, cc = c & 31, ob = rr * 64 + cc * 2; return st * 1024 + (ob ^ (((ob >> 9) & 1) << 5)); }
__host__ __device__ __forceinline__ void stage_rc(int b, int& R, int& C) { const int st = b / 1024, sb = b % 1024, swz = sb ^ (((sb >> 9) & 1) << 5); R = (st >> 1) * 16 + swz / 64; C = (st & 1) * 32 + (swz % 64) / 2; }
__host__ __device__ __forceinline__ int perm32(int rho) { const int n = rho >> 4, i = rho & 15; return 8 * (i >> 2) + 4 * n + (i & 3); }

struct Unit { int pm, pn; };
struct Gemm { const bf16_t* A; const bf16_t* Bt; int M, N, K; };

struct StaticOrder {
    int nM, nN, nwg, G, c;
    __host__ __device__ void init(int M, int N, int G_, int c_) { nM = M / BM; nN = N / BM; nwg = nM * nN; G = G_; c = c_; }
    __host__ __device__ bool next(int i, Unit& u) const {
        const long L = (long)i * G + c; if (L >= nwg) return false;
        int wgid = (int)L; { const int q = nwg / NXCD, r = nwg % NXCD, xcd = wgid % NXCD, off = wgid / NXCD; wgid = (xcd < r ? xcd * (q + 1) : r * (q + 1) + (xcd - r) * q) + off; }
        const int nig = WGM * nN, gid = wgid / nig, fm = gid * WGM, gsz = (nM - fm) < WGM ? (nM - fm) : WGM;
        u.pm = fm + ((wgid % nig) % gsz); u.pn = (wgid % nig) / gsz; return true;
    }
    __device__ __forceinline__ void a_ready(const Unit&) const {}
    __device__ __forceinline__ void done(const Unit&) const {}
};

__device__ __forceinline__ unsigned cvt_pk_bf16(float lo, float hi) { unsigned r; asm volatile("v_cvt_pk_bf16_f32 %0, %1, %2" : "=v"(r) : "v"(lo), "v"(hi)); return r; }
typedef float f32x2 __attribute__((ext_vector_type(2)));
__device__ __forceinline__ f32x2 gelu_pk(f32x2 v) {
    const f32x2 av = __builtin_elementwise_abs(v), d = av * 0.2316418882f + 1.0f;
    f32x2 t; t.x = __builtin_amdgcn_rcpf(d.x); t.y = __builtin_amdgcn_rcpf(d.y);
    f32x2 q = t * 0.5307027145f + (-0.7265760135f); q = q * t + 0.7107068705f; q = q * t + (-0.142248368f); q = q * t + 0.127414796f; q = q * t;
    const f32x2 s = (v * v) * (-0.72134752044f);
    f32x2 e; e.x = __builtin_amdgcn_exp2f(s.x); e.y = __builtin_amdgcn_exp2f(s.y);
    const f32x2 m = v * (q * e), r = v - m;
    f32x2 o; o.x = v.x < 0.f ? m.x : r.x; o.y = v.y < 0.f ? m.y : r.y; return o;
}

template <int ACT  > struct EpiBf16 {
    static constexpr bool PERM = true, AFTER_DRAIN = false; static_assert(ACT == 0 || ACT == 1, "EpiBf16: ACT is 0 (none) or 1 (gelu_pk)");
    bf16_t* O; int ldc; const float* bias; int split_cols; size_t split_stride; float scale0;
    __device__ __forceinline__ void operator()(const f32x4 (&acc)[2][2][4][2], const Unit& u, int wr, int wc, int fr, int fq) const {
        const int row0 = u.pm * BM + wr * 64 + fr; int colt = u.pn * BM; bf16_t* base = O;
        float sc = 1.f; if (split_cols) { const int t = colt / split_cols; base += (size_t)t * split_stride; colt -= t * split_cols; if (t == 0) sc = scale0; }
        const int col0 = colt + wc * 32 + 8 * fq, bcol0 = u.pn * BM + wc * 32 + 8 * fq;
        f32x4 bv[2][2];
#pragma unroll
        for (int bj = 0; bj < 2; ++bj)
#pragma unroll
            for (int n = 0; n < 2; ++n) bv[bj][n] = bias ? *(const f32x4*)(bias + bcol0 + bj * HALF + 4 * n) : (f32x4){0.f, 0.f, 0.f, 0.f};
#pragma unroll
        for (int ai = 0; ai < 2; ++ai)
#pragma unroll
            for (int m = 0; m < 4; ++m) { bf16_t* rowp = base + (size_t)(row0 + ai * HALF + m * 16) * ldc + col0;
#pragma unroll
                for (int bj = 0; bj < 2; ++bj) { f32x4 v0 = acc[ai][bj][m][0] + bv[bj][0], v1 = acc[ai][bj][m][1] + bv[bj][1];
                    if (ACT == 1) { f32x2 a = gelu_pk((f32x2){v0[0], v0[1]}), b = gelu_pk((f32x2){v0[2], v0[3]}), c = gelu_pk((f32x2){v1[0], v1[1]}), d = gelu_pk((f32x2){v1[2], v1[3]});
                        v0 = (f32x4){a.x, a.y, b.x, b.y}; v1 = (f32x4){c.x, c.y, d.x, d.y}; }
                    v0 = v0 * sc; v1 = v1 * sc; u32x4 w; w.x = cvt_pk_bf16(v0[0], v0[1]); w.y = cvt_pk_bf16(v0[2], v0[3]); w.z = cvt_pk_bf16(v1[0], v1[1]); w.w = cvt_pk_bf16(v1[2], v1[3]);
                    *(u32x4*)(rowp + bj * HALF) = w; } }
    }
};

struct PanelStats {
    unsigned* xbuf;
    unsigned* cnt;
    unsigned* tmo;
    int ntn; float eps;
    unsigned code;
    __device__ __forceinline__ bool run(const f32x4 (&v)[2][2][4][2], const Unit& u, int wr, int wc, int fr, int fq, PG8_LAS unsigned char* lds, int wid, int lane) const {
        typedef float f32x2v __attribute__((ext_vector_type(2)));
        PG8_LAS f32x2v* P = (PG8_LAS f32x2v*)lds;
        PG8_LAS f32x2v* S = (PG8_LAS f32x2v*)(lds + 8192);
        PG8_LAS unsigned* flag = (PG8_LAS unsigned*)(lds + 8192 + 2048);
#pragma unroll
        for (int ai = 0; ai < 2; ++ai)
#pragma unroll
            for (int m = 0; m < 4; ++m) {
                float s = 0.f;
#pragma unroll
                for (int bj = 0; bj < 2; ++bj)
#pragma unroll
                    for (int n = 0; n < 2; ++n) { const f32x4 x = v[ai][bj][m][n]; s += (x[0] + x[1]) + (x[2] + x[3]); }
                s += __shfl_xor(s, 16); s += __shfl_xor(s, 32);
                const float mw = s * (1.0f / 64.0f); float q = 0.f;
#pragma unroll
                for (int bj = 0; bj < 2; ++bj)
#pragma unroll
                    for (int n = 0; n < 2; ++n) { const f32x4 d = v[ai][bj][m][n] - mw; q += (d[0] * d[0] + d[1] * d[1]) + (d[2] * d[2] + d[3] * d[3]); }
                q += __shfl_xor(q, 16); q += __shfl_xor(q, 32);
                if (fq == 0) P[(ai * HALF + wr * 64 + m * 16 + fr) * 4 + wc] = (f32x2v){mw, q};
            }
        asm volatile("s_waitcnt lgkmcnt(0)" ::: "memory"); __builtin_amdgcn_s_barrier(); asm volatile("" ::: "memory");
#if defined(BROKEN_EXCHANGE_NO_WAIT)
#warning BROKEN CONTROL BUILD: the row-statistics exchange does not wait; results are wrong by design
        if (blockIdx.x >= 64) { const long long t0_ = clock64(); while (clock64() - t0_ < 60000) __builtin_amdgcn_s_sleep(8); }
#endif
        const int row = wid * 32 + (lane & 31);
        if (lane < 32) {
            const f32x2v a = P[row * 4 + 0], b = P[row * 4 + 1], c = P[row * 4 + 2], d = P[row * 4 + 3];
            const float mt = (a.x + b.x + c.x + d.x) * 0.25f;
            const float da = a.x - mt, db = b.x - mt, dc = c.x - mt, dd = d.x - mt;
            const float m2 = (a.y + b.y) + (c.y + d.y) + 64.0f * ((da * da + db * db) + (dc * dc + dd * dd));
            unsigned long long* slot = (unsigned long long*)xbuf + ((size_t)(u.pm * BM + row) * 4 + u.pn);
            __hip_atomic_store(slot, ((unsigned long long)__float_as_uint(m2) << 32) | __float_as_uint(mt), __ATOMIC_RELAXED, __HIP_MEMORY_SCOPE_AGENT);
        }
        asm volatile("s_waitcnt vmcnt(0)" ::: "memory");
        if (lane == 0) __hip_atomic_fetch_add(cnt + 64 * u.pm, 1u, __ATOMIC_RELAXED, __HIP_MEMORY_SCOPE_AGENT);
        if (wid == 0) {
            bool dead = false; const unsigned long long t0 = __builtin_amdgcn_s_memrealtime(); const unsigned want = 8u * (unsigned)ntn;
            for (;;) {
#if defined(BROKEN_EXCHANGE_NO_WAIT)
                break;
#endif
                if ((unsigned)__builtin_amdgcn_readfirstlane(__hip_atomic_load(cnt + 64 * u.pm, __ATOMIC_RELAXED, __HIP_MEMORY_SCOPE_AGENT)) >= want) break;
                if (__builtin_amdgcn_s_memrealtime() - t0 > 2000000ull) {
                    if (lane == 0) { unsigned expect = 0u; __hip_atomic_compare_exchange_strong(tmo + 1, &expect, code | (unsigned)(u.pm & 0xff), __ATOMIC_RELAXED, __ATOMIC_RELAXED, __HIP_MEMORY_SCOPE_AGENT);
                                     __hip_atomic_store(tmo, 1u, __ATOMIC_RELAXED, __HIP_MEMORY_SCOPE_AGENT); }
                    dead = true; break; }
                __builtin_amdgcn_s_sleep(2);
            }
            __builtin_amdgcn_fence(__ATOMIC_ACQUIRE, "agent");
            if (lane == 0) flag[0] = dead ? 1u : 0u;
        }
        asm volatile("s_waitcnt vmcnt(0) lgkmcnt(0)" ::: "memory"); __builtin_amdgcn_s_barrier(); asm volatile("" ::: "memory");
        const bool bad = flag[0] != 0u;
        if (lane < 32) {
            const unsigned long long* slot = (const unsigned long long*)xbuf + (size_t)(u.pm * BM + row) * 4; float mt[4], m2[4]; float ms = 0.f;
#pragma unroll
            for (int t = 0; t < 4; ++t) { if (t < ntn) { const unsigned long long w = __hip_atomic_load(slot + t, __ATOMIC_RELAXED, __HIP_MEMORY_SCOPE_AGENT); mt[t] = __uint_as_float((unsigned)w); m2[t] = __uint_as_float((unsigned)(w >> 32)); } else { mt[t] = 0.f; m2[t] = 0.f; } ms += mt[t]; }
            const float mean = ms / (float)ntn; float q = 0.f;
#pragma unroll
            for (int t = 0; t < 4; ++t) if (t < ntn) { const float dm = mt[t] - mean; q += m2[t] + 256.0f * dm * dm; }
            S[row] = (f32x2v){mean, 1.0f / sqrtf(q / (256.0f * (float)ntn) + eps)};
        }
        asm volatile("s_waitcnt lgkmcnt(0)" ::: "memory"); __builtin_amdgcn_s_barrier(); asm volatile("" ::: "memory");
        return bad;
    }
};
struct EpiLnRes {
    static constexpr bool PERM = false, AFTER_DRAIN = true;
    const float* base; float* out; int ldc; const float* bias; PanelStats st; unsigned poison;
    __device__ __forceinline__ void fused(f32x4 (&acc)[2][2][4][2], const Unit& u, int wr, int wc, int fr, int fq, PG8_LAS unsigned char* lds, int wid, int lane) const {
        typedef float f32x2v __attribute__((ext_vector_type(2)));
        const PG8_LAS f32x2v* S = (const PG8_LAS f32x2v*)(lds + 8192);
        const int col0 = u.pn * BM + wc * 32 + 4 * fq;
#pragma unroll
        for (int bj = 0; bj < 2; ++bj)
#pragma unroll
            for (int n = 0; n < 2; ++n) { const f32x4 bv = bias ? *(const f32x4*)(bias + col0 + bj * HALF + n * 16) : (f32x4){0.f, 0.f, 0.f, 0.f};
#pragma unroll
                for (int ai = 0; ai < 2; ++ai)
#pragma unroll
                    for (int m = 0; m < 4; ++m) acc[ai][bj][m][n] += bv; }
        f32x4 pre[4][2][2];
#pragma unroll
        for (int m = 0; m < 4; ++m) { const size_t off = (size_t)(u.pm * BM + wr * 64 + m * 16 + fr) * ldc + col0;
#pragma unroll
            for (int bj = 0; bj < 2; ++bj)
#pragma unroll
                for (int n = 0; n < 2; ++n) pre[m][bj][n] = *(const f32x4*)(base + off + bj * HALF + n * 16); }
        const bool bad = st.run(acc, u, wr, wc, fr, fq, lds, wid, lane) || poison != 0u;
        const float qnan = __builtin_nanf("");
#pragma unroll
        for (int ai = 0; ai < 2; ++ai)
#pragma unroll
            for (int m = 0; m < 4; ++m) { const int r = ai * HALF + wr * 64 + m * 16 + fr; const f32x2v sr = S[r]; const size_t off = (size_t)(u.pm * BM + r) * ldc + col0;
#pragma unroll
                for (int bj = 0; bj < 2; ++bj)
#pragma unroll
                    for (int n = 0; n < 2; ++n) { const f32x4 bs = ai == 0 ? pre[m][bj][n] : *(const f32x4*)(base + off + bj * HALF + n * 16); f32x4 o = bs + (acc[ai][bj][m][n] - sr.x) * sr.y;
                        if (bad) o = (f32x4){qnan, qnan, qnan, qnan}; *(f32x4*)(out + off + bj * HALF + n * 16) = o; }
                if (m & 1) asm volatile("" ::: "memory"); }
    }
};
struct EpiLnResLn {
    static constexpr bool PERM = false, AFTER_DRAIN = true;
    const float* base; float* out; bf16_t* xn; int ldc; const float* bias; PanelStats st1, st2; unsigned poison;
    __device__ __forceinline__ void fused(f32x4 (&acc)[2][2][4][2], const Unit& u, int wr, int wc, int fr, int fq, PG8_LAS unsigned char* lds, int wid, int lane) const {
        typedef float f32x2v __attribute__((ext_vector_type(2))); typedef unsigned u32x2v __attribute__((ext_vector_type(2)));
        const PG8_LAS f32x2v* S = (const PG8_LAS f32x2v*)(lds + 8192);
        const int col0 = u.pn * BM + wc * 32 + 4 * fq;
#pragma unroll
        for (int bj = 0; bj < 2; ++bj)
#pragma unroll
            for (int n = 0; n < 2; ++n) { const f32x4 bv = bias ? *(const f32x4*)(bias + col0 + bj * HALF + n * 16) : (f32x4){0.f, 0.f, 0.f, 0.f};
#pragma unroll
                for (int ai = 0; ai < 2; ++ai)
#pragma unroll
                    for (int m = 0; m < 4; ++m) acc[ai][bj][m][n] += bv; }
        bool bad = st1.run(acc, u, wr, wc, fr, fq, lds, wid, lane) || poison != 0u;
        const float qnan = __builtin_nanf("");
#pragma unroll
        for (int ai = 0; ai < 2; ++ai)
#pragma unroll
            for (int m = 0; m < 4; ++m) { const int r = ai * HALF + wr * 64 + m * 16 + fr; const f32x2v sr = S[r]; const size_t off = (size_t)(u.pm * BM + r) * ldc + col0;
#pragma unroll
                for (int bj = 0; bj < 2; ++bj)
#pragma unroll
                    for (int n = 0; n < 2; ++n) { const f32x4 bs = *(const f32x4*)(base + off + bj * HALF + n * 16); acc[ai][bj][m][n] = bs + (acc[ai][bj][m][n] - sr.x) * sr.y; }
                asm volatile("" : "+v"(acc[ai][0][m][0]), "+v"(acc[ai][0][m][1]), "+v"(acc[ai][1][m][0]), "+v"(acc[ai][1][m][1]));
                if (m & 1) asm volatile("" ::: "memory"); }
        const bool bad1 = bad;
        bad = st2.run(acc, u, wr, wc, fr, fq, lds, wid, lane) || bad;
#pragma unroll
        for (int ai = 0; ai < 2; ++ai)
#pragma unroll
            for (int m = 0; m < 4; ++m) { const int r = ai * HALF + wr * 64 + m * 16 + fr; const f32x2v sr = S[r]; const size_t off = (size_t)(u.pm * BM + r) * ldc + col0;
#pragma unroll
                for (int bj = 0; bj < 2; ++bj)
#pragma unroll
                    for (int n = 0; n < 2; ++n) { const f32x4 x1 = acc[ai][bj][m][n]; *(f32x4*)(out + off + bj * HALF + n * 16) = bad1 ? (f32x4){qnan, qnan, qnan, qnan} : x1;
                        const f32x4 o = (x1 - sr.x) * sr.y; u32x2v w; w.x = cvt_pk_bf16(o[0], o[1]); w.y = cvt_pk_bf16(o[2], o[3]);
                        if (bad) { w.x = 0x7fc07fc0u; w.y = 0x7fc07fc0u; } *(u32x2v*)(xn + off + bj * HALF + n * 16) = w; }
                asm volatile("" ::: "memory"); }
    }
};

template <class Epi, class Sched, bool ALIGN_EPI = false, bool SP2 = false>
__device__ __forceinline__ void gemm_phase(PG8_LAS unsigned char* lds, const Gemm g, const Sched& S, const Epi& E) {
    const int tid = opaque_tid(), wid = __builtin_amdgcn_readfirstlane(tid >> 6), lane = tid & 63, wr = wid >> 2, wc = wid & 3, fr = lane & 15, fq = lane >> 4;
    const int K = g.K, nt = K / BK;
    unsigned voffA[2], voffB[2];
#pragma unroll
    for (int i = 0; i < 2; ++i) { int R, C; stage_rc(tid * 16 + i * 8192, R, C); const int Rb = Epi::PERM ? ((R & ~31) + perm32(R & 31)) : R;
        voffA[i] = (unsigned)(R * K + C) * 2u; voffB[i] = (unsigned)(Rb * K + C) * 2u; }
    const size_t kstep = (size_t)(BK * 2);
    const size_t hstep = (size_t)HALF * K * 2;
    const size_t tstep = 2 * hstep;
    const unsigned ldsw = (unsigned)wid * 1024u;
    const int aoff = lds_byte(wr * 64 + fr, fq * 8), boff = lds_byte(wc * 32 + fr, fq * 8);
#define PG8_SA(b, h) (((b) * 2 + (h)) * HTB)
#define PG8_SB(b, h) ((4 + (b) * 2 + (h)) * HTB)
#define PG8_STAGE(bufoff, gbase, voff) do { _Pragma("unroll") for (int _i = 0; _i < 2; ++_i) \
        __builtin_amdgcn_global_load_lds((const unsigned*)((const char*)(gbase) + (voff)[_i]), (PG8_LAS unsigned*)(lds + (bufoff) + ldsw + _i * 8192), 16, 0, 0); } while (0)
#define PG8_LDA(dst, b, h) do { _Pragma("unroll") for (int m = 0; m < 4; ++m) _Pragma("unroll") for (int k = 0; k < 2; ++k) dst[m][k] = *(const PG8_LAS bf16x8*)(lds + PG8_SA(b, h) + aoff + m * 2048 + k * 1024); } while (0)
#define PG8_LDB(dst, b, h) do { _Pragma("unroll") for (int n = 0; n < 2; ++n) _Pragma("unroll") for (int k = 0; k < 2; ++k) dst[n][k] = *(const PG8_LAS bf16x8*)(lds + PG8_SB(b, h) + boff + n * 2048 + k * 1024); } while (0)
#define PG8_MMA(ai, bj, At, Bt) do { __builtin_amdgcn_s_setprio(1); _Pragma("unroll") for (int m = 0; m < 4; ++m) _Pragma("unroll") for (int n = 0; n < 2; ++n) _Pragma("unroll") for (int k = 0; k < 2; ++k) \
        acc[ai][bj][m][n] = __builtin_amdgcn_mfma_f32_16x16x32_bf16(Bt[n][k], At[m][k], acc[ai][bj][m][n], 0, 0, 0); __builtin_amdgcn_s_setprio(0); } while (0)
#define PG8_WAIT_V(n) asm volatile("s_waitcnt vmcnt(" #n ")" ::: "memory")
#define PG8_WAIT_L(n) asm volatile("s_waitcnt lgkmcnt(" #n ")" ::: "memory")
#define PG8_BAR __builtin_amdgcn_s_barrier()
#define PG8_SCHED __builtin_amdgcn_sched_barrier(0)
    Unit cur, nxt; int ui = 0;
    if (!S.next(0, cur)) return;
    f32x4 acc[2][2][4][2];
#pragma unroll
    for (int a = 0; a < 2; ++a)
#pragma unroll
        for (int b = 0; b < 2; ++b)
#pragma unroll
            for (int m = 0; m < 4; ++m)
#pragma unroll
                for (int n = 0; n < 2; ++n) acc[a][b][m][n] = (f32x4){0.f, 0.f, 0.f, 0.f};
    bf16x8 At[4][2], B0[2][2], B1[2][2];
    const char* cA = (const char*)g.A + (size_t)cur.pm * tstep; const char* cB = (const char*)g.Bt + (size_t)cur.pn * tstep;
    S.a_ready(cur);
    if constexpr (SP2) {
        PG8_STAGE(PG8_SB(0, 0), cB, voffB); PG8_STAGE(PG8_SB(0, 1), cB + hstep, voffB); PG8_STAGE(PG8_SA(0, 0), cA, voffA); PG8_STAGE(PG8_SA(0, 1), cA + hstep, voffA);
        if (wr == 1) PG8_BAR;
        PG8_WAIT_V(2); PG8_BAR;
        PG8_STAGE(PG8_SB(1, 0), cB + kstep, voffB); PG8_STAGE(PG8_SA(1, 0), cA + kstep, voffA); PG8_STAGE(PG8_SB(1, 1), cB + hstep + kstep, voffB);
        PG8_WAIT_V(6); PG8_BAR;
    } else {
        PG8_STAGE(PG8_SB(0, 0), cB, voffB); PG8_STAGE(PG8_SA(0, 0), cA, voffA); PG8_STAGE(PG8_SB(0, 1), cB + hstep, voffB); PG8_STAGE(PG8_SA(0, 1), cA + hstep, voffA);
        if (wr == 1) PG8_BAR;
        PG8_WAIT_V(4); PG8_BAR;
        PG8_STAGE(PG8_SB(1, 0), cB + kstep, voffB); PG8_STAGE(PG8_SA(1, 0), cA + kstep, voffA); PG8_STAGE(PG8_SB(1, 1), cB + hstep + kstep, voffB);
        PG8_WAIT_V(6); PG8_BAR;
    }
    for (;;) {
        const bool has_next = S.next(ui + 1, nxt);
        const char* nA = has_next ? (const char*)g.A + (size_t)nxt.pm * tstep : cA; const char* nB = has_next ? (const char*)g.Bt + (size_t)nxt.pn * tstep : cB;
        for (int t = 0; t < nt; t += 2) {
            const bool last = (t == nt - 2);
            const char* a1 = cA + (size_t)(t + 1) * kstep;
            const char* a2 = last ? nA : cA + (size_t)(t + 2) * kstep; const char* b2 = last ? nB : cB + (size_t)(t + 2) * kstep;
            const char* a3 = a2 + kstep; const char* b3 = b2 + kstep;
            if (last && has_next) S.a_ready(nxt);
            if constexpr (SP2) {
            PG8_LDB(B0, 0, 0); PG8_LDB(B1, 0, 1); PG8_SCHED; PG8_LDA(At, 0, 0); PG8_STAGE(PG8_SA(1, 1), a1 + hstep, voffA);
            PG8_WAIT_V(8); PG8_WAIT_L(0); PG8_BAR; PG8_MMA(0, 0, At, B0); PG8_MMA(0, 1, At, B1); PG8_BAR; PG8_SCHED;
            PG8_LDA(At, 0, 1); PG8_STAGE(PG8_SB(0, 0), b2, voffB); PG8_STAGE(PG8_SB(0, 1), b2 + hstep, voffB); PG8_STAGE(PG8_SA(0, 0), a2, voffA);
            PG8_WAIT_V(8); PG8_WAIT_L(0); PG8_BAR; PG8_MMA(1, 0, At, B0); PG8_MMA(1, 1, At, B1); PG8_BAR; PG8_SCHED;
            PG8_LDB(B0, 1, 0); PG8_LDB(B1, 1, 1); PG8_SCHED; PG8_LDA(At, 1, 0); PG8_STAGE(PG8_SA(0, 1), a2 + hstep, voffA);
            PG8_WAIT_V(8); PG8_WAIT_L(0); PG8_BAR; PG8_MMA(0, 0, At, B0); PG8_MMA(0, 1, At, B1); PG8_BAR; PG8_SCHED;
            PG8_LDA(At, 1, 1); PG8_STAGE(PG8_SB(1, 0), b3, voffB); PG8_STAGE(PG8_SB(1, 1), b3 + hstep, voffB); PG8_STAGE(PG8_SA(1, 0), a3, voffA);
            PG8_WAIT_V(8); PG8_WAIT_L(0); PG8_BAR; PG8_MMA(1, 0, At, B0); PG8_MMA(1, 1, At, B1); PG8_BAR; PG8_SCHED;
            } else {
            PG8_LDB(B0, 0, 0); PG8_SCHED; PG8_LDA(At, 0, 0); PG8_STAGE(PG8_SA(1, 1), a1 + hstep, voffA);
            PG8_WAIT_L(8); PG8_BAR; PG8_WAIT_L(0); PG8_MMA(0, 0, At, B0); PG8_BAR; PG8_SCHED;
            PG8_LDB(B1, 0, 1); PG8_STAGE(PG8_SB(0, 0), b2, voffB);
            PG8_BAR; PG8_WAIT_L(0); PG8_MMA(0, 1, At, B1); PG8_BAR;
            PG8_LDA(At, 0, 1); PG8_STAGE(PG8_SA(0, 0), a2, voffA);
            PG8_BAR; PG8_WAIT_L(0); PG8_MMA(1, 0, At, B0); PG8_BAR; PG8_SCHED;
            PG8_STAGE(PG8_SB(0, 1), b2 + hstep, voffB);
            PG8_WAIT_V(6); PG8_BAR; PG8_MMA(1, 1, At, B1); PG8_BAR;
            PG8_LDB(B0, 1, 0); PG8_SCHED; PG8_LDA(At, 1, 0); PG8_STAGE(PG8_SA(0, 1), a2 + hstep, voffA);
            PG8_WAIT_L(8); PG8_BAR; PG8_WAIT_L(0); PG8_MMA(0, 0, At, B0); PG8_BAR; PG8_SCHED;
            PG8_LDB(B1, 1, 1); PG8_STAGE(PG8_SB(1, 0), b3, voffB);
            PG8_BAR; PG8_WAIT_L(0); PG8_MMA(0, 1, At, B1); PG8_BAR;
            PG8_LDA(At, 1, 1); PG8_STAGE(PG8_SA(1, 0), a3, voffA);
            PG8_BAR; PG8_WAIT_L(0); PG8_MMA(1, 0, At, B0); PG8_BAR; PG8_SCHED;
            PG8_STAGE(PG8_SB(1, 1), b3 + hstep, voffB);
            PG8_WAIT_V(6); PG8_BAR; PG8_MMA(1, 1, At, B1); PG8_BAR;
            }
        }
        if constexpr (ALIGN_EPI) { if (wr == 0) PG8_BAR; }
        if constexpr (!Epi::AFTER_DRAIN) { E(acc, cur, wr, wc, fr, fq); S.done(cur); }
        if (!has_next) break;
#pragma unroll
        for (int a = 0; a < 2; ++a)
#pragma unroll
            for (int b = 0; b < 2; ++b)
#pragma unroll
                for (int m = 0; m < 4; ++m)
#pragma unroll
                    for (int n = 0; n < 2; ++n) acc[a][b][m][n] = (f32x4){0.f, 0.f, 0.f, 0.f};
        cur = nxt; cA = nA; cB = nB; ++ui;
        if constexpr (ALIGN_EPI) { if (wr == 1) PG8_BAR; }
    }
    PG8_WAIT_V(0);
    if constexpr (!ALIGN_EPI) { if (wr == 0) PG8_BAR; }
    PG8_BAR;
    if constexpr (Epi::AFTER_DRAIN) { E.fused(acc, cur, wr, wc, fr, fq, lds, wid, lane); S.done(cur); }
#undef PG8_SA
#undef PG8_SB
#undef PG8_STAGE
#undef PG8_LDA
#undef PG8_LDB
#undef PG8_MMA
#undef PG8_WAIT_V
#undef PG8_WAIT_L
#undef PG8_BAR
#undef PG8_SCHED
}
}

#ifndef PG8_SP2
#define PG8_SP2 true
#endif
#ifndef PG8_ALIGN
#define PG8_ALIGN true
#endif
namespace pg8 {
constexpr int OUT_KP = 17301504, OUT_VP = 34078720, OUT_KS = 51122176, OUT_VS = 51646464;
constexpr int NSSQ = 32;
__device__ __forceinline__ float row_rstd(const float* ssq, int row) {
    const f32x4* p = (const f32x4*)(ssq + (size_t)row * NSSQ); float s = 0.f;
#pragma unroll
    for (int i = 0; i < NSSQ / 4; ++i) { const f32x4 a = p[i]; s += (a[0] + a[1]) + (a[2] + a[3]); }
    return __builtin_amdgcn_rsqf(s * (1.0f / 1024.0f) + 1e-6f);
}
template <int ACT, bool KVF32> struct EpiAct {
    static constexpr bool PERM = true, AFTER_DRAIN = false;
    bf16_t* O; int ldc; const float* ssq; int split_cols; size_t split_stride; float* fout;
    template <int NA, int NB> __device__ __forceinline__ void run(const f32x4 (&acc)[NA][NB][4][2], int rowt, int colt, bool sample, int wr, int wc, int fr, int fq) const {
        const int row0 = rowt + wr * 64 + fr; bf16_t* base = O; int t = 0;
        if (split_cols) { t = colt / split_cols; base += (size_t)t * split_stride; colt -= t * split_cols; }
        const int col0 = colt + wc * 32 + 8 * fq;
        float* fb = nullptr;
        if (KVF32) { if (t < 2) fb = fout + (!sample ? (size_t)(t == 0 ? OUT_KP : OUT_VP) : (size_t)(t == 0 ? OUT_KS : OUT_VS) - (size_t)16384 * 1024) + col0; }
        f32x4 pq[NA][4][2];
#pragma unroll
        for (int ai = 0; ai < NA; ++ai)
#pragma unroll
            for (int m = 0; m < 4; ++m) { const f32x4* p = (const f32x4*)(ssq + (size_t)(row0 + ai * HALF + m * 16) * NSSQ + 8 * fq); pq[ai][m][0] = p[0]; pq[ai][m][1] = p[1]; }
        float rsv[NA][4];
#pragma unroll
        for (int ai = 0; ai < NA; ++ai)
#pragma unroll
            for (int m = 0; m < 4; ++m) { const f32x4 a = pq[ai][m][0], b = pq[ai][m][1]; float sq = ((a[0] + a[1]) + (a[2] + a[3])) + ((b[0] + b[1]) + (b[2] + b[3]));
                sq += __shfl_xor(sq, 16); sq += __shfl_xor(sq, 32); rsv[ai][m] = __builtin_amdgcn_rsqf(sq * (1.0f / 1024.0f) + 1e-6f); }
#pragma unroll
        for (int ai = 0; ai < NA; ++ai)
#pragma unroll
            for (int m = 0; m < 4; ++m) { const int row = row0 + ai * HALF + m * 16; const float rs = rsv[ai][m];
                bf16_t* rowp = base + (size_t)row * ldc + col0;
#pragma unroll
                for (int bj = 0; bj < NB; ++bj) { f32x4 v0 = acc[ai][bj][m][0] * rs, v1 = acc[ai][bj][m][1] * rs;
                    if (ACT == 1) {
#pragma unroll
                        for (int e = 0; e < 4; ++e) { const float a = fmaxf(v0[e], 0.f), b = fmaxf(v1[e], 0.f); v0[e] = a * a; v1[e] = b * b; } }
                    if (KVF32) { if (fb) { float* fr_ = fb + (size_t)row * 1024 + bj * HALF; *(f32x4*)fr_ = v0; *(f32x4*)(fr_ + 4) = v1; } }
                    u32x4 w; w.x = cvt_pk_bf16(v0[0], v0[1]); w.y = cvt_pk_bf16(v0[2], v0[3]); w.z = cvt_pk_bf16(v1[0], v1[1]); w.w = cvt_pk_bf16(v1[2], v1[3]);
                    *(u32x4*)(rowp + bj * HALF) = w; } }
    }
    __device__ __forceinline__ void operator()(const f32x4 (&acc)[2][2][4][2], const Unit& u, int wr, int wc, int fr, int fq) const { run<2, 2>(acc, u.pm * BM, u.pn * BM, u.pm >= 64, wr, wc, fr, fq); }
};
struct EpiResid {
    static constexpr bool PERM = true, AFTER_DRAIN = false;
    float* X; bf16_t* XB; float* ssq; const float* Xp; const float* Xs;
    template <int NA, int NB> __device__ __forceinline__ void run(const f32x4 (&acc)[NA][NB][4][2], int rowt, int colt, bool sample, int wr, int wc, int fr, int fq) const {
        const int row0 = rowt + wr * 64 + fr; const int col0 = colt + wc * 32 + 8 * fq;
#pragma unroll
        for (int ai = 0; ai < NA; ++ai) {
            f32x4 xr[4][NB][2];
#pragma unroll
            for (int m = 0; m < 4; ++m) { const float* xp = (Xp ? (sample ? Xs - (size_t)16384 * 1024 : Xp) : (const float*)X) + (size_t)(row0 + ai * HALF + m * 16) * 1024 + col0;
#pragma unroll
                for (int bj = 0; bj < NB; ++bj) { xr[m][bj][0] = *(const f32x4*)(xp + bj * HALF); xr[m][bj][1] = *(const f32x4*)(xp + bj * HALF + 4); } }
#pragma unroll
            for (int m = 0; m < 4; ++m) { const int row = row0 + ai * HALF + m * 16; float* xp = X + (size_t)row * 1024 + col0; bf16_t* bp = XB + (size_t)row * 1024 + col0;
#pragma unroll
                for (int bj = 0; bj < NB; ++bj) { const f32x4 a0 = xr[m][bj][0] + acc[ai][bj][m][0], a1 = xr[m][bj][1] + acc[ai][bj][m][1];
                    *(f32x4*)(xp + bj * HALF) = a0; *(f32x4*)(xp + bj * HALF + 4) = a1;
                    float q = ((a0[0] * a0[0] + a0[1] * a0[1]) + (a0[2] * a0[2] + a0[3] * a0[3])) + ((a1[0] * a1[0] + a1[1] * a1[1]) + (a1[2] * a1[2] + a1[3] * a1[3]));
                    u32x4 w; w.x = cvt_pk_bf16(a0[0], a0[1]); w.y = cvt_pk_bf16(a0[2], a0[3]); w.z = cvt_pk_bf16(a1[0], a1[1]); w.w = cvt_pk_bf16(a1[2], a1[3]);
                    *(u32x4*)(bp + bj * HALF) = w;
                    q += __shfl_xor(q, 16); q += __shfl_xor(q, 32);
                    if (fq == 0) ssq[(size_t)row * NSSQ + ((colt + bj * HALF) >> 7) * 4 + wc] = q; } }
            asm volatile("" ::: "memory"); }
    }
    __device__ __forceinline__ void operator()(const f32x4 (&acc)[2][2][4][2], const Unit& u, int wr, int wc, int fr, int fq) const { run<2, 2>(acc, u.pm * BM, u.pn * BM, u.pm >= 64, wr, wc, fr, fq); }
};
__device__ __forceinline__ void glds16(const void* gsrc, unsigned lds_dst) { unsigned keep;
    asm volatile("s_mov_b32 %0, m0\n\ts_mov_b32 m0, %2\n\ts_nop 0\n\tglobal_load_lds_dwordx4 %1, off\n\ts_mov_b32 m0, %0" : "=&s"(keep) : "v"(gsrc), "s"(lds_dst) : "memory"); }
template <class Epi>
__device__ __forceinline__ void gemm128_tile(PG8_LAS unsigned char* lds, const bf16_t* A, const bf16_t* Bt, int K, const Epi& E, int rowt, int colt) {
    const int tid = opaque_tid(), wid = __builtin_amdgcn_readfirstlane(tid >> 6), lane = tid & 63, wr = wid >> 2, wc = wid & 3, fr = lane & 15, fq = lane >> 4;
    const int nt = K / BK;
    const char* gA[2]; const char* gB[2];
#pragma unroll
    for (int i = 0; i < 2; ++i) { int R, C; stage_rc(tid * 16 + i * 8192, R, C); const int Rb = (R & ~31) + perm32(R & 31);
        gA[i] = (const char*)A + (size_t)(R * K + C) * 2; gB[i] = (const char*)Bt + (size_t)(Rb * K + C) * 2; }
    const unsigned lds0 = (unsigned)(uintptr_t)lds + (unsigned)wid * 1024u;
    const int aoff = lds_byte(wr * 64 + fr, fq * 8), boff = lds_byte(wc * 32 + fr, fq * 8);
#define G128_STAGE(s, kt) do { _Pragma("unroll") for (int _i = 0; _i < 2; ++_i) { \
        glds16(gA[_i] + (size_t)(kt) * (BK * 2), (unsigned)__builtin_amdgcn_readfirstlane(lds0 + (unsigned)((s) * 2 * HTB + _i * 8192))); \
        glds16(gB[_i] + (size_t)(kt) * (BK * 2), (unsigned)__builtin_amdgcn_readfirstlane(lds0 + (unsigned)((s) * 2 * HTB + HTB + _i * 8192))); } } while (0)
    f32x4 acc[1][1][4][2];
#pragma unroll
    for (int m = 0; m < 4; ++m)
#pragma unroll
        for (int n = 0; n < 2; ++n) acc[0][0][m][n] = (f32x4){0.f, 0.f, 0.f, 0.f};
    G128_STAGE(0, 0); G128_STAGE(1, 1); G128_STAGE(2, 2);
    for (int t = 0; t < nt; ++t) {
        const int rem = nt - 1 - t;
        if (rem >= 2) asm volatile("s_waitcnt vmcnt(8)" ::: "memory"); else if (rem == 1) asm volatile("s_waitcnt vmcnt(4)" ::: "memory"); else asm volatile("s_waitcnt vmcnt(0)" ::: "memory");
        __builtin_amdgcn_s_barrier(); asm volatile("" ::: "memory");
        if (t + 3 < nt) G128_STAGE((t + 3) & 3, t + 3);
        const PG8_LAS unsigned char* sb = lds + (t & 3) * 2 * HTB;
        bf16x8 At[4][2], Bf[2][2];
#pragma unroll
        for (int m = 0; m < 4; ++m)
#pragma unroll
            for (int k = 0; k < 2; ++k) At[m][k] = *(const PG8_LAS bf16x8*)(sb + aoff + m * 2048 + k * 1024);
#pragma unroll
        for (int n = 0; n < 2; ++n)
#pragma unroll
            for (int k = 0; k < 2; ++k) Bf[n][k] = *(const PG8_LAS bf16x8*)(sb + HTB + boff + n * 2048 + k * 1024);
        asm volatile("s_waitcnt lgkmcnt(0)" ::: "memory");
#pragma unroll
        for (int m = 0; m < 4; ++m)
#pragma unroll
            for (int n = 0; n < 2; ++n)
#pragma unroll
                for (int k = 0; k < 2; ++k) acc[0][0][m][n] = __builtin_amdgcn_mfma_f32_16x16x32_bf16(Bf[n][k], At[m][k], acc[0][0][m][n], 0, 0, 0);
    }
#undef G128_STAGE
    E.template run<1, 1>(acc, rowt, colt, true, wr, wc, fr, fq);
    asm volatile("s_waitcnt lgkmcnt(0)" ::: "memory"); __builtin_amdgcn_s_barrier(); asm volatile("" ::: "memory");
}
}
#include <hip/hip_bf16.h>
#include <cmath>
namespace attn_body {
using bf16=__hip_bfloat16;
using bf16x8=__attribute__((ext_vector_type(8)))short;
using s16x4=__attribute__((ext_vector_type(4)))short;
using f32x16=__attribute__((ext_vector_type(16)))float;
using u32x4=__attribute__((ext_vector_type(4)))unsigned;
constexpr int BATCH=1,NHEAD=16,SEQ=16384,D=64,DM=NHEAD*D;
constexpr int NW=8,QBLK=32,QB=QBLK*NW,KVBLK=64,NQB=SEQ/QB;
constexpr int ATTN_PITCH=DM, ATTN_UNIT_ROWS=QB;
__device__ __forceinline__ int crow(int r,int hi){return (r&3)+8*(r>>2)+4*hi;}
#define SBAR() __builtin_amdgcn_sched_barrier(0)
__device__ __forceinline__ void cmask(f32x16&p0,f32x16&p1,int jb,int qrel,int hi){
  const float NEG=-INFINITY; int kb=64*jb+4*hi;
  #pragma unroll
  for(int r=0;r<16;++r){int kv=kb+(r&3)+8*(r>>2); if(kv>qrel)p0[r]=NEG; if(kv+32>qrel)p1[r]=NEG;}
}

constexpr int NSLOT=3, SLOTB=8192;
constexpr int LDS_K=0, LDS_V=NSLOT*SLOTB, LDS_WS=2*NSLOT*SLOTB, LDS_OST=LDS_WS+NW*64*4, LDS_CK=LDS_OST+NW*4096, LDS_BYTES=LDS_CK+SEQ*4;
constexpr float C2=0.125f*1.4426950408889634f;
__device__ __forceinline__ void glds16(const void*gsrc,unsigned lds_dst){unsigned keep;
  asm volatile("s_mov_b32 %0, m0\n\ts_mov_b32 m0, %2\n\ts_nop 0\n\tglobal_load_lds_dwordx4 %1, off\n\ts_mov_b32 m0, %0":"=&s"(keep):"v"(gsrc),"s"(lds_dst):"memory");}
__device__ __forceinline__ void glds16s(const void*sbase,unsigned voff,unsigned lds_dst){unsigned keep;
  asm volatile("s_mov_b32 %0, m0\n\ts_mov_b32 m0, %3\n\ts_nop 0\n\tglobal_load_lds_dwordx4 %1, %2\n\ts_mov_b32 m0, %0":"=&s"(keep):"v"(voff),"s"(sbase),"s"(lds_dst):"memory");}
__device__ __forceinline__ float max3f(float a,float b,float c){float r;asm("v_max3_f32 %0, %1, %2, %3":"=v"(r):"v"(a),"v"(b),"v"(c));return r;}
__device__ __forceinline__ float max2f(float a,float b){float r;asm("v_max_f32_e32 %0, %1, %2":"=v"(r):"v"(a),"v"(b));return r;}
__device__ __forceinline__ float fadd_s(float a,float b){float r;asm("v_add_f32_e32 %0, %1, %2":"=v"(r):"v"(a),"v"(b));return r;}
__device__ __forceinline__ float fsub_s(float a,float b){float r;asm("v_sub_f32_e32 %0, %1, %2":"=v"(r):"v"(a),"v"(b));return r;}
typedef float f32x2_t __attribute__((ext_vector_type(2))); typedef __bf16 bf16x2_t __attribute__((ext_vector_type(2)));
__device__ __forceinline__ unsigned cvtpk_s(float lo,float hi){f32x2_t v={lo,hi};bf16x2_t b=__builtin_convertvector(v,bf16x2_t);return __builtin_bit_cast(unsigned,b);}
#define WAIT_BAR(N) asm volatile("s_waitcnt vmcnt(" #N ") lgkmcnt(0)\n\ts_barrier":::"memory")

__device__ __forceinline__ void qkt(f32x16&p0,f32x16&p1,const char*Kslot,const bf16x8*qr,const f32x16&negm,int r32,int hi){
  const char*kb=Kslot+hi*1024+r32*16;
  #pragma unroll
  for(int d0=0;d0<4;++d0){
    const bf16x8 b0=*reinterpret_cast<const bf16x8*>(kb+d0*2048);
    const bf16x8 b1=*reinterpret_cast<const bf16x8*>(kb+d0*2048+512);
    if(d0==0){p0=__builtin_amdgcn_mfma_f32_32x32x16_bf16(b0,qr[0],negm,0,0,0);p1=__builtin_amdgcn_mfma_f32_32x32x16_bf16(b1,qr[0],negm,0,0,0);}
    else{p0=__builtin_amdgcn_mfma_f32_32x32x16_bf16(b0,qr[d0],p0,0,0,0);p1=__builtin_amdgcn_mfma_f32_32x32x16_bf16(b1,qr[d0],p1,0,0,0);}}
}
typedef __attribute__((address_space(3))) const char* lds_cptr;
typedef short v4i16_t __attribute__((ext_vector_type(4)));
__device__ __forceinline__ void kload8(bf16x8*kf,lds_cptr kp){
  kf[0]=*(const __attribute__((address_space(3))) bf16x8*)(kp);      kf[1]=*(const __attribute__((address_space(3))) bf16x8*)(kp+512);
  kf[2]=*(const __attribute__((address_space(3))) bf16x8*)(kp+2048); kf[3]=*(const __attribute__((address_space(3))) bf16x8*)(kp+2560);
  kf[4]=*(const __attribute__((address_space(3))) bf16x8*)(kp+4096); kf[5]=*(const __attribute__((address_space(3))) bf16x8*)(kp+4608);
  kf[6]=*(const __attribute__((address_space(3))) bf16x8*)(kp+6144); kf[7]=*(const __attribute__((address_space(3))) bf16x8*)(kp+6656);
}
__device__ __forceinline__ void kload2(bf16x8*kf,lds_cptr kp,int j){ kf[2*j]=*(const __attribute__((address_space(3))) bf16x8*)(kp+j*2048); kf[2*j+1]=*(const __attribute__((address_space(3))) bf16x8*)(kp+j*2048+512); }
__device__ __forceinline__ s16x4 vtr(lds_cptr p){ return __builtin_bit_cast(s16x4,__builtin_amdgcn_ds_read_tr16_b64_v4i16((__attribute__((address_space(3))) v4i16_t*)p)); }
__device__ __forceinline__ float rowmax(const f32x16&p0,const f32x16&p1){
  float a=max3f(p0[0],p0[1],p1[0]),b=max3f(p0[2],p0[3],p1[1]);a=max3f(a,p1[2],p1[3]);
  #pragma unroll
  for(int r=4;r<16;r+=4){a=max3f(a,p0[r],p0[r+1]);b=max3f(b,p0[r+2],p0[r+3]);a=max3f(a,p1[r],p1[r+1]);b=max3f(b,p1[r+2],p1[r+3]);}
  const float m=max2f(a,b);
  auto rr=__builtin_amdgcn_permlane32_swap(__float_as_uint(m),__float_as_uint(m),false,false);
  return max2f(__uint_as_float(rr[0]),__uint_as_float(rr[1]));
}
__device__ __forceinline__ void pv(f32x16*o,int vb,bf16x8 pa0,bf16x8 pa1,bf16x8 pa2,bf16x8 pa3){
  #pragma unroll
  for(int d0=0;d0<2;++d0){s16x4 lo[4],hi[4];
    #pragma unroll
    for(int ks=0;ks<4;++ks){
      asm volatile("ds_read_b64_tr_b16 %0,%1 offset:%c2":"=&v"(lo[ks]):"v"(vb),"i"(d0*4096+ks*1024):"memory");
      asm volatile("ds_read_b64_tr_b16 %0,%1 offset:%c2":"=&v"(hi[ks]):"v"(vb),"i"(d0*4096+ks*1024+512):"memory");}
    asm volatile("s_waitcnt lgkmcnt(0)":::"memory");SBAR();
    #define PK(k) (bf16x8){lo[k][0],lo[k][1],lo[k][2],lo[k][3],hi[k][0],hi[k][1],hi[k][2],hi[k][3]}
    o[d0]=__builtin_amdgcn_mfma_f32_32x32x16_bf16(pa0,PK(0),o[d0],0,0,0);
    o[d0]=__builtin_amdgcn_mfma_f32_32x32x16_bf16(pa1,PK(1),o[d0],0,0,0);
    o[d0]=__builtin_amdgcn_mfma_f32_32x32x16_bf16(pa2,PK(2),o[d0],0,0,0);
    o[d0]=__builtin_amdgcn_mfma_f32_32x32x16_bf16(pa3,PK(3),o[d0],0,0,0);
    #undef PK
  }
}

#ifndef ATTN_STORE16
#define ATTN_STORE16(p,v) (*(u32x4*)(p)=(v))
#endif
typedef float f32x4_t __attribute__((ext_vector_type(4)));
#define CKSUB(C0,C1,t) do{ const __attribute__((address_space(3))) f32x4_t* ck_=(const __attribute__((address_space(3))) f32x4_t*)(ckl+(t)*64+4*hi); \
   _Pragma("unroll") for(int g_=0;g_<4;++g_){ const f32x4_t a_=ck_[2*g_], b_=ck_[8+2*g_]; \
     _Pragma("unroll") for(int i_=0;i_<4;++i_){ C0[4*g_+i_]-=a_[i_]; C1[4*g_+i_]-=b_[i_]; } } }while(0)
template<int THRL> __device__ __forceinline__ void attn_unit(int b,int h,int qb,const bf16*Q,const bf16*__restrict__ K,const bf16*__restrict__ V,bf16*O,char*shm,const float*ckg,const float kmax2){
  const int tid=opaque_tid(),lane=tid&63,r32=lane&31,hi=lane>>5; const int wid=__builtin_amdgcn_readfirstlane(tid>>6);
  const long rowbase=(long)b*SEQ; const int q0=qb*QB;
  const bf16*Qw=Q+(rowbase+q0+wid*QBLK)*DM+h*D;
  const unsigned lds0=(unsigned)(uintptr_t)shm;
  float*wsf=(float*)(shm+LDS_WS)+wid*64;
  __attribute__((address_space(3))) float* ckl=(__attribute__((address_space(3))) float*)((__attribute__((address_space(3))) char*)shm+LDS_CK);
  const float cqv=ckg[q0+wid*QBLK+r32];
  bf16x8 qr[4];
  #pragma unroll
  for(int d0=0;d0<4;++d0)qr[d0]=*reinterpret_cast<const bf16x8*>(&Qw[(long)r32*DM+d0*16+hi*8]);
  int t0=0;
  if(qb>0){
    float*wsa=(float*)(shm+LDS_WS);
    float qs=0.f;
    #pragma unroll
    for(int d0=0;d0<4;++d0){
      #pragma unroll
      for(int e=0;e<8;++e){ const float v_=__builtin_bit_cast(float,((unsigned)(unsigned short)qr[d0][e])<<16); qs+=v_*v_; } }
    qs+=__shfl_xor(qs,32);
    #pragma unroll
    for(int o_=1;o_<32;o_<<=1) qs=fmaxf(qs,__shfl_xor(qs,o_));
    const int ncand=q0/KVBLK;
    float cend=0.f; if(tid<ncand) cend=ckg[tid*KVBLK+KVBLK-1];
    const float cq0=ckg[q0];
    if(lane==0) wsa[wid]=qs;
    __syncthreads();
    float qm=wsa[0];
    #pragma unroll
    for(int w_=1;w_<NW;++w_) qm=fmaxf(qm,wsa[w_]);
    const float thr=-40.f-2.f*sqrtf(qm*kmax2)*1.0001f;
    const bool skip_=(tid<ncand)&&((cq0-cend)<thr);
    const unsigned long long bal_=__ballot(skip_);
    if(lane==0) wsa[8+wid]=(float)__popcll(bal_);
    __syncthreads();
    float cnt_=0.f;
    #pragma unroll
    for(int w_=0;w_<NW;++w_) cnt_+=wsa[8+w_];
    t0=__builtin_amdgcn_readfirstlane(((int)cnt_)&~1);
    __syncthreads();
  }
  const bf16*Kh=K+(rowbase+(long)t0*KVBLK)*DM+h*D,*Vh=V+(rowbase+(long)t0*KVBLK)*DM+h*D;
  { const int nf4=(q0+QB-t0*KVBLK)>>2; const f32x4_t* src_=(const f32x4_t*)(ckg+t0*KVBLK); __attribute__((address_space(3))) f32x4_t* dst_=(__attribute__((address_space(3))) f32x4_t*)ckl;
    for(int i_=tid;i_<nf4;i_+=NW*64) dst_[i_]=src_[i_]; }
  const unsigned kvoff=(unsigned)((lane*DM+wid*8)*2);
  const unsigned vvoff=(unsigned)(((16*(wid&3)+(lane>>2))*DM+(wid>>2)*32+(lane&3)*8)*2);
  const unsigned kdst=lds0+LDS_K+wid*1024, vdst=lds0+LDS_V+wid*1024;
  #define DMA_K(t,slot) glds16s(Kh+(long)(t)*KVBLK*DM,kvoff,(unsigned)__builtin_amdgcn_readfirstlane(kdst+(slot)))
  #define DMA_V(t,slot) glds16s(Vh+(long)(t)*KVBLK*DM,vvoff,(unsigned)__builtin_amdgcn_readfirstlane(vdst+(slot)))
  const int vb0=(int)(lds0+LDS_V)+((lane>>4)&1)*32+(lane&3)*8+(4*hi+((lane&15)>>2))*64;
  const char*Kbase=shm+LDS_K; bf16x8 kf[8];
  const lds_cptr shm3=(lds_cptr)shm; const lds_cptr kp0=shm3+LDS_K+hi*1024+r32*16; const lds_cptr vp0=shm3+LDS_V+((lane>>4)&1)*32+(lane&3)*8+(4*hi+((lane&15)>>2))*64;
  const int NT=(q0+QB)/KVBLK-t0;
  DMA_K(0,0);DMA_V(0,0);DMA_K(1,SLOTB);
  float mhat=-cqv,l_reg=0.f;    f32x16 o[2];o[0]=f32x16{};o[1]=f32x16{};f32x16 negm;
  #pragma unroll
  for(int r=0;r<16;++r)negm[r]=cqv;
  asm volatile("":"+v"(negm));
  const int qrel=wid*QBLK+r32;
  #define CMASK(P0,P1,t) do{int jb_=(t)-(NT-4); if(jb_>=0)cmask(P0,P1,jb_,qrel,hi);}while(0)
  bool resc=false;
  #define START(P0,P1) do{ const float rm=rowmax(P0,P1); resc=false; \
    { const float dl=rm; mhat=fadd_s(mhat,dl); \
      _Pragma("unroll") for(int r=0;r<16;++r){P0[r]=fsub_s(P0[r],dl);P1[r]=fsub_s(P1[r],dl);} \
      _Pragma("unroll") for(int r=0;r<16;++r)negm[r]=-mhat; asm volatile("":"+v"(negm)); } \
    _Pragma("unroll") for(int r=0;r<16;++r)P0[r]=__builtin_amdgcn_exp2f(P0[r]); }while(0)
  #define RESC() do{ if(resc){ asm volatile("s_waitcnt lgkmcnt(0)":::"memory"); \
      _Pragma("unroll") for(int d_=0;d_<2;++d_) _Pragma("unroll") for(int r=0;r<16;++r)o[d_][r]*=wsf[crow(r,hi)]; } }while(0)
  f32x16 pA0,pA1,pB0,pB1;
  int sl_prev=0,sl_cur=0,sl_next=SLOTB;
  #define ROT() do{sl_prev=sl_cur;sl_cur=sl_next;sl_next=(sl_next==(NSLOT-1)*SLOTB)?0:sl_next+SLOTB;}while(0)
  DMA_K(2,2*SLOTB);
  WAIT_BAR(3);
  qkt(pA0,pA1,Kbase,qr,negm,r32,hi);asm volatile("s_nop 15\n\ts_nop 7":"+v"(pA0),"+v"(pA1));CKSUB(pA0,pA1,0);CMASK(pA0,pA1,0);
  START(pA0,pA1);
  _Pragma("unroll") for(int r=0;r<16;++r)pA1[r]=__builtin_amdgcn_exp2f(pA1[r]);
  WAIT_BAR(0);
  DMA_K(3,0);DMA_V(1,SLOTB);
  ROT();
  kload8(kf,kp0+sl_cur);
  WAIT_BAR(2);
  s16x4 vlo[8],vhi[8]; u32x4 pw0,pw1,pw2,pw3;
  #define PKW(P,B) cvtpk_s(P[B],P[B+1])
  #define PAF(k) __builtin_bit_cast(bf16x8,pw##k)
  #define VFR(i) (bf16x8){vlo[i][0],vlo[i][1],vlo[i][2],vlo[i][3],vhi[i][0],vhi[i][1],vhi[i][2],vhi[i][3]}
  #define PIN(x) asm volatile("":"+v"(x))
  #define MX3(a,b,c) __builtin_fmaxf(__builtin_fmaxf((a),(b)),(c))
  #define GAPA(MF,A0,A1,A2,A3,W0,W1,PW) do{ MF; sacc+=A0; sacc+=A1; sacc+=A2; sacc+=A3; PIN(sacc); W0; W1; PIN(PW); SBAR(); }while(0)
  #define EX(v) __builtin_amdgcn_exp2f(v)
  #define GAPB(MF,X,B) do{ MF; X[B]=EX(X[B]); X[B+1]=EX(X[B+1]); X[B+2]=EX(X[B+2]); X[B+3]=EX(X[B+3]); PIN(X); SBAR(); }while(0)
  #define VRD(i) do{ vlo[i]=vtr(vp_+(((i)>>2)*4096+((i)&3)*1024)); vhi[i]=vtr(vp_+(((i)>>2)*4096+((i)&3)*1024+512)); }while(0)
  #define KRD(G,j) do{ if(G){ kload2(kf,kp0+sl_next,j); SBAR(); } }while(0)
  #define STEP(C0,C1,P0,P1,t,GK,GV,GL) do{ SBAR(); \
    const lds_cptr vp_=vp0+sl_prev; \
    VRD(0); SBAR(); float sacc=(P0[0]+P0[1]); \
    GAPA(C0=__builtin_amdgcn_mfma_f32_32x32x16_bf16(kf[0],qr[0],negm,0,0,0), P0[2],P0[3],P0[4],P0[5],     pw0[0]=PKW(P0,0), pw0[1]=PKW(P0,2), pw0); \
    VRD(4); SBAR(); GAPA(C1=__builtin_amdgcn_mfma_f32_32x32x16_bf16(kf[1],qr[0],negm,0,0,0), P0[6],P0[7],P0[8],P0[9],     pw0[2]=PKW(P0,4), pw0[3]=PKW(P0,6), pw0); \
    VRD(1); SBAR(); GAPA(C0=__builtin_amdgcn_mfma_f32_32x32x16_bf16(kf[2],qr[1],C0,0,0,0),   P0[10],P0[11],P0[12],P0[13], pw1[0]=PKW(P0,8), pw1[1]=PKW(P0,10), pw1); \
    VRD(5); SBAR(); GAPA(C1=__builtin_amdgcn_mfma_f32_32x32x16_bf16(kf[3],qr[1],C1,0,0,0),   P0[14],P0[15],P1[0],P1[1],   pw1[2]=PKW(P0,12),pw1[3]=PKW(P0,14), pw1); \
    VRD(2); SBAR(); GAPA(C0=__builtin_amdgcn_mfma_f32_32x32x16_bf16(kf[4],qr[2],C0,0,0,0),   P1[2],P1[3],P1[4],P1[5],     pw2[0]=PKW(P1,0), pw2[1]=PKW(P1,2), pw2); \
    VRD(6); SBAR(); GAPA(C1=__builtin_amdgcn_mfma_f32_32x32x16_bf16(kf[5],qr[2],C1,0,0,0),   P1[6],P1[7],P1[8],P1[9],     pw2[2]=PKW(P1,4), pw2[3]=PKW(P1,6), pw2); \
    VRD(3); SBAR(); GAPA(C0=__builtin_amdgcn_mfma_f32_32x32x16_bf16(kf[6],qr[3],C0,0,0,0),   P1[10],P1[11],P1[12],P1[13], pw3[0]=PKW(P1,8), pw3[1]=PKW(P1,10), pw3); \
    VRD(7); SBAR(); GAPA(C1=__builtin_amdgcn_mfma_f32_32x32x16_bf16(kf[7],qr[3],C1,0,0,0),   P1[14],P1[15],0.f,0.f,       pw3[2]=PKW(P1,12),pw3[3]=PKW(P1,14), pw3); \
    l_reg+=sacc; \
    if(GK){DMA_K((t)+3,sl_cur);} if(GV){DMA_V((t)+1,sl_next);} \
    CKSUB(C0,C1,t); CMASK(C0,C1,t); \
    { float a=MX3(C0[0],C0[1],C1[0]),b=MX3(C0[2],C0[3],C1[1]); a=MX3(a,C1[2],C1[3]); \
      _Pragma("unroll") for(int r=4;r<16;r+=4){a=MX3(a,C0[r],C0[r+1]);b=MX3(b,C0[r+2],C0[r+3]);a=MX3(a,C1[r],C1[r+1]);b=MX3(b,C1[r+2],C1[r+3]);} \
      float rm=__builtin_fmaxf(a,b); { auto rr=__builtin_amdgcn_permlane32_swap(__float_as_uint(rm),__float_as_uint(rm),false,false); rm=__builtin_fmaxf(__uint_as_float(rr[0]),__uint_as_float(rr[1])); } \
      resc=false; \
      if(__builtin_expect(__any(rm>(float)THRL),0)){ const float dl=__builtin_fmaxf(rm,0.f); mhat+=dl; \
        _Pragma("unroll") for(int r=0;r<16;++r){C0[r]-=dl;C1[r]-=dl;} \
        _Pragma("unroll") for(int r=0;r<16;++r)negm[r]=-mhat; asm volatile("":"+v"(negm)); \
        const float f=__builtin_amdgcn_exp2f(-dl); l_reg*=f; if(hi==0)wsf[r32]=f; resc=true; } } \
    SBAR(); \
    GAPB(o[0]=__builtin_amdgcn_mfma_f32_32x32x16_bf16(PAF(0),VFR(0),o[0],0,0,0), C0,0); \
    GAPB(o[1]=__builtin_amdgcn_mfma_f32_32x32x16_bf16(PAF(0),VFR(4),o[1],0,0,0), C0,4); \
    KRD(GL,0); GAPB(o[0]=__builtin_amdgcn_mfma_f32_32x32x16_bf16(PAF(1),VFR(1),o[0],0,0,0), C0,8); \
    KRD(GL,1); GAPB(o[1]=__builtin_amdgcn_mfma_f32_32x32x16_bf16(PAF(1),VFR(5),o[1],0,0,0), C0,12); \
    KRD(GL,2); GAPB(o[0]=__builtin_amdgcn_mfma_f32_32x32x16_bf16(PAF(2),VFR(2),o[0],0,0,0), C1,0); \
    KRD(GL,3); GAPB(o[1]=__builtin_amdgcn_mfma_f32_32x32x16_bf16(PAF(2),VFR(6),o[1],0,0,0), C1,4); \
    GAPB(o[0]=__builtin_amdgcn_mfma_f32_32x32x16_bf16(PAF(3),VFR(3),o[0],0,0,0), C1,8); \
    GAPB(o[1]=__builtin_amdgcn_mfma_f32_32x32x16_bf16(PAF(3),VFR(7),o[1],0,0,0), C1,12); \
    }while(0)
  int t=1;
  #undef CMASK
  #define CMASK(P0,P1,t) do{}while(0)
  for(;t+5<NT;t+=2){
    STEP(pB0,pB1,pA0,pA1,t,true,true,true);     WAIT_BAR(2); RESC(); ROT();
    STEP(pA0,pA1,pB0,pB1,t+1,true,true,true);   WAIT_BAR(2); RESC(); ROT();
  }
  #undef CMASK
  #define CMASK(P0,P1,t) do{int jb_=(t)-(NT-4); if(jb_>=0)cmask(P0,P1,jb_,qrel,hi);}while(0)
  #define ENDW(tt) do{ if((tt)+3<NT){WAIT_BAR(2);} else if((tt)+2<NT){WAIT_BAR(1);} else {WAIT_BAR(0);} }while(0)
  for(;t+1<NT;t+=2){
    STEP(pB0,pB1,pA0,pA1,t,(t+3<NT),(t+1<NT),(t+1<NT));       ENDW(t);   RESC(); ROT();
    STEP(pA0,pA1,pB0,pB1,t+1,(t+4<NT),(t+2<NT),(t+2<NT));     ENDW(t+1); RESC(); ROT();
  }
  STEP(pB0,pB1,pA0,pA1,NT-1,false,false,false); RESC();
  { float sacc=pB0[0]+pB0[1]; _Pragma("unroll") for(int r=2;r<16;++r)sacc+=pB0[r]; _Pragma("unroll") for(int r=0;r<16;++r)sacc+=pB1[r]; l_reg+=sacc;
    pw0=(u32x4){PKW(pB0,0),PKW(pB0,2),PKW(pB0,4),PKW(pB0,6)};pw1=(u32x4){PKW(pB0,8),PKW(pB0,10),PKW(pB0,12),PKW(pB0,14)};pw2=(u32x4){PKW(pB1,0),PKW(pB1,2),PKW(pB1,4),PKW(pB1,6)};pw3=(u32x4){PKW(pB1,8),PKW(pB1,10),PKW(pB1,12),PKW(pB1,14)};
    SBAR(); pv(o,vb0+sl_cur,PAF(0),PAF(1),PAF(2),PAF(3)); }
  #undef PKW
  #undef PAF
  #undef VFR
  #undef PIN
  #undef MX3
  #undef GAPA
  #undef GAPB
  #undef EX
  #undef VRD
  #undef KRD
  #undef STEP
  #undef ENDW
  {auto rr=__builtin_amdgcn_permlane32_swap(__float_as_uint(l_reg),__float_as_uint(l_reg),false,false);l_reg=__uint_as_float(rr[0])+__uint_as_float(rr[1]);}
  if(hi==0)wsf[32+r32]=l_reg;asm volatile("s_waitcnt lgkmcnt(0)":::"memory");
  float rli[16];
  #pragma unroll
  for(int r=0;r<16;++r)rli[r]=__builtin_amdgcn_rcpf(wsf[32+crow(r,hi)]);
  bf16*Ow=O+(rowbase+q0+wid*QBLK)*DM+h*D;
  { bf16*stg=(bf16*)(shm+LDS_OST)+wid*2048;
    #pragma unroll
    for(int r=0;r<16;++r){const int orow=crow(r,hi);
      #pragma unroll
      for(int d0=0;d0<2;++d0)stg[orow*64+d0*32+r32]=__float2bfloat16(o[d0][r]*rli[r]);}
    asm volatile("s_waitcnt lgkmcnt(0)":::"memory");
    #pragma unroll
    for(int i=0;i<4;++i){const int row=i*8+(lane>>3),ch=lane&7; const u32x4 v=*(const u32x4*)(stg+row*64+ch*8); ATTN_STORE16(Ow+(long)row*DM+ch*8,v);} }
  asm volatile("s_waitcnt lgkmcnt(0)\n\ts_barrier":::"memory");
  #undef DMA_K
  #undef DMA_V
  #undef CMASK
  #undef START
  #undef RESC
  #undef ROT
}
constexpr int ATTN_LDS_BYTES=LDS_BYTES;
struct AttnTensors { const bf16* Q; const bf16* K; const bf16* V; bf16* O; const float* CL; const unsigned* KMAX; };
struct AttnUnit { int bh; int qb; };
template<int THRL=8> __device__ __forceinline__ void attn_phase_q(char*lds,const AttnTensors&T,unsigned*qctr,int block){
  volatile __attribute__((address_space(3))) int* tk=(volatile __attribute__((address_space(3))) int*)((__attribute__((address_space(3))) char*)lds+LDS_WS);
  for(;;){
    if(threadIdx.x==0){ int v=-1,q=block&7; for(int tried=0;tried<8;++tried){ const unsigned i_=__hip_atomic_fetch_add(qctr+64*q,1u,__ATOMIC_RELAXED,__HIP_MEMORY_SCOPE_AGENT); if(i_<128u){ v=(int)(q*128u+i_); break; } q=(q+1)&7; } tk[0]=v; }
    __syncthreads();
    const int u=__builtin_amdgcn_readfirstlane(tk[0]);
    __syncthreads();
    if(u<0)break;
    const int qq=u>>7,i_=u&127,h=2*qq+(i_&1),qb=63-(i_>>1);
    attn_unit<THRL>(0,h,qb,T.Q,T.K,T.V,T.O,lds,T.CL+(size_t)h*SEQ,__builtin_bit_cast(float,T.KMAX[h]));
  }
}
#undef SBAR
#undef WAIT_BAR
}
namespace sattn {
#define SLAS __attribute__((address_space(3)))
typedef short bf16x8 __attribute__((ext_vector_type(8)));
typedef float f32x4 __attribute__((ext_vector_type(4)));
typedef unsigned u32x4 __attribute__((ext_vector_type(4)));
typedef unsigned u32x2 __attribute__((ext_vector_type(2)));
typedef float f32x2_t __attribute__((ext_vector_type(2))); typedef __bf16 bf16x2_t __attribute__((ext_vector_type(2)));
__device__ __forceinline__ unsigned pk(float lo, float hi) { f32x2_t v = {lo, hi}; bf16x2_t b = __builtin_convertvector(v, bf16x2_t); return __builtin_bit_cast(unsigned, b); }
__device__ __forceinline__ bf16x8 cvt8(f32x4 a, f32x4 b) { u32x4 w; w.x = pk(a[0], a[1]); w.y = pk(a[2], a[3]); w.z = pk(b[0], b[1]); w.w = pk(b[2], b[3]); return __builtin_bit_cast(bf16x8, w); }
constexpr int PAST = 2048, NEWK = 16, LKEYS = PAST + NEWK, VT_STRIDE = 80, VT_BYTES = 64 * VT_STRIDE;
constexpr int L_VT = 0, L_CO = 8 * VT_BYTES, L_CM = L_CO + 8 * 16 * 64 * 4, L_CL = L_CM + 8 * 16 * 4, L_END = L_CL + 8 * 16 * 4;
constexpr float NEG = -1.0e30f;
struct Tensors { const float* ck; const float* cv; const unsigned short* QB; const unsigned short* KB; const unsigned short* VB; unsigned short* O; const float* CLS; };
__device__ __forceinline__ void tile_tail(f32x4 (&s)[2], const bf16x8 (&vw)[4], float& m, float& l, f32x4 (&o)[4], SLAS char* vt, int r, int g) {
    float mx = fmaxf(fmaxf(fmaxf(s[0][0], s[0][1]), fmaxf(s[0][2], s[0][3])), fmaxf(fmaxf(s[1][0], s[1][1]), fmaxf(s[1][2], s[1][3])));
    mx = fmaxf(mx, __shfl_xor(mx, 16)); mx = fmaxf(mx, __shfl_xor(mx, 32));
    const float mn = fmaxf(m, mx), alpha = __builtin_amdgcn_exp2f(m - mn); m = mn;
    float ps = 0.f;
#pragma unroll
    for (int j = 0; j < 2; ++j)
#pragma unroll
        for (int e = 0; e < 4; ++e) { s[j][e] = __builtin_amdgcn_exp2f(s[j][e] - mn); ps += s[j][e]; }
    l = l * alpha + ps;
#pragma unroll
    for (int db = 0; db < 4; ++db) o[db] *= alpha;
    const bf16x8 pb = cvt8(s[0], s[1]);
#pragma unroll
    for (int dd = 0; dd < 4; ++dd) *(SLAS bf16x8*)(vt + (4 * r + dd) * VT_STRIDE + g * 16) = vw[dd];
#pragma unroll
    for (int db = 0; db < 4; ++db) { const bf16x8 va = *(const SLAS bf16x8*)(vt + (16 * db + r) * VT_STRIDE + g * 16); o[db] = __builtin_amdgcn_mfma_f32_16x16x32_bf16(va, pb, o[db], 0, 0, 0); }
}
__device__ __forceinline__ void unit(int b, int h, const Tensors& T, SLAS char* lds) {
    const int tid = opaque_tid(), lane = tid & 63, r = lane & 15, g = lane >> 4; const int wid = __builtin_amdgcn_readfirstlane(tid >> 6);
    SLAS char* vt = lds + L_VT + wid * VT_BYTES;
    const size_t srow = (size_t)16384 + (size_t)b * 16;
    const float* cls = T.CLS + (size_t)(b * 16 + h) * LKEYS;
    const unsigned short* qp = T.QB + (srow + r) * 1024 + h * 64 + 8 * g;
    const bf16x8 qf0 = *(const bf16x8*)qp, qf1 = *(const bf16x8*)(qp + 32);
    const float cq = cls[PAST + r];
    float m = NEG, l = 0.f; f32x4 o[4];
#pragma unroll
    for (int db = 0; db < 4; ++db) o[db] = (f32x4){0.f, 0.f, 0.f, 0.f};
    const float* kc = T.ck + ((size_t)b * PAST * 16 + h) * 64; const float* vc = T.cv + ((size_t)b * PAST * 16 + h) * 64;
    for (int tI = 0; tI < 8; ++tI) {
        const int k0 = wid * 256 + tI * 32;
        bf16x8 ka[2][2];
#pragma unroll
        for (int j = 0; j < 2; ++j)
#pragma unroll
            for (int dh = 0; dh < 2; ++dh) { const float* p = kc + (size_t)(k0 + 16 * j + r) * 1024 + dh * 32 + 8 * g; ka[j][dh] = cvt8(*(const f32x4*)p, *(const f32x4*)(p + 4)); }
        f32x4 vv[2][4];
#pragma unroll
        for (int j = 0; j < 2; ++j)
#pragma unroll
            for (int e = 0; e < 4; ++e) vv[j][e] = *(const f32x4*)(vc + (size_t)(k0 + 16 * j + 4 * g + e) * 1024 + 4 * r);
        f32x4 ckv[2];
#pragma unroll
        for (int j = 0; j < 2; ++j) ckv[j] = *(const f32x4*)(cls + k0 + 16 * j + 4 * g);
        f32x4 s[2];
#pragma unroll
        for (int j = 0; j < 2; ++j) { s[j] = __builtin_amdgcn_mfma_f32_16x16x32_bf16(ka[j][0], qf0, (f32x4){0.f, 0.f, 0.f, 0.f}, 0, 0, 0); s[j] = __builtin_amdgcn_mfma_f32_16x16x32_bf16(ka[j][1], qf1, s[j], 0, 0, 0); }
#pragma unroll
        for (int j = 0; j < 2; ++j)
#pragma unroll
            for (int e = 0; e < 4; ++e) s[j][e] += cq - ckv[j][e];
        bf16x8 vw[4];
#pragma unroll
        for (int dd = 0; dd < 4; ++dd) { u32x4 w; w.x = pk(vv[0][0][dd], vv[0][1][dd]); w.y = pk(vv[0][2][dd], vv[0][3][dd]); w.z = pk(vv[1][0][dd], vv[1][1][dd]); w.w = pk(vv[1][2][dd], vv[1][3][dd]); vw[dd] = __builtin_bit_cast(bf16x8, w); }
        tile_tail(s, vw, m, l, o, vt, r, g);
    }
    if (wid == 0) {
        bf16x8 ka[2]; { const unsigned short* p = T.KB + (srow + r) * 1024 + h * 64 + 8 * g; ka[0] = *(const bf16x8*)p; ka[1] = *(const bf16x8*)(p + 32); }
        const f32x4 ckv = *(const f32x4*)(cls + PAST + 4 * g);
        f32x4 s[2];
        s[0] = __builtin_amdgcn_mfma_f32_16x16x32_bf16(ka[0], qf0, (f32x4){0.f, 0.f, 0.f, 0.f}, 0, 0, 0); s[0] = __builtin_amdgcn_mfma_f32_16x16x32_bf16(ka[1], qf1, s[0], 0, 0, 0);
#pragma unroll
        for (int e = 0; e < 4; ++e) { s[0][e] += cq - ckv[e]; if (4 * g + e > r) s[0][e] = NEG; s[1][e] = NEG; }
        unsigned short ve[4][4];
#pragma unroll
        for (int e = 0; e < 4; ++e) { const u32x2 w = *(const u32x2*)(T.VB + (srow + 4 * g + e) * 1024 + h * 64 + 4 * r); ve[e][0] = (unsigned short)(w.x & 0xffffu); ve[e][1] = (unsigned short)(w.x >> 16); ve[e][2] = (unsigned short)(w.y & 0xffffu); ve[e][3] = (unsigned short)(w.y >> 16); }
        bf16x8 vw[4];
#pragma unroll
        for (int dd = 0; dd < 4; ++dd) { u32x4 w; w.x = (unsigned)ve[0][dd] | ((unsigned)ve[1][dd] << 16); w.y = (unsigned)ve[2][dd] | ((unsigned)ve[3][dd] << 16); w.z = 0u; w.w = 0u; vw[dd] = __builtin_bit_cast(bf16x8, w); }
        tile_tail(s, vw, m, l, o, vt, r, g);
    }
    l += __shfl_xor(l, 16); l += __shfl_xor(l, 32);
    SLAS float* co = (SLAS float*)(lds + L_CO) + (wid * 16 + r) * 64; SLAS float* cm = (SLAS float*)(lds + L_CM); SLAS float* cl = (SLAS float*)(lds + L_CL);
#pragma unroll
    for (int db = 0; db < 4; ++db) *(SLAS f32x4*)(co + 16 * db + 4 * g) = o[db];
    if (g == 0) { cm[wid * 16 + r] = m; cl[wid * 16 + r] = l; }
    __syncthreads();
    { const int q = tid >> 5, d2 = (tid & 31) * 2; float mm = NEG;
#pragma unroll
      for (int w = 0; w < 8; ++w) mm = fmaxf(mm, cm[w * 16 + q]);
      float den = 0.f, n0 = 0.f, n1 = 0.f;
#pragma unroll
      for (int w = 0; w < 8; ++w) { const float f = __builtin_amdgcn_exp2f(cm[w * 16 + q] - mm); den += f * cl[w * 16 + q]; const SLAS float* c = (const SLAS float*)(lds + L_CO) + (w * 16 + q) * 64 + d2; n0 += f * c[0]; n1 += f * c[1]; }
      const float inv = 1.0f / den;
      *(unsigned*)(T.O + (srow + q) * 1024 + h * 64 + d2) = pk(n0 * inv, n1 * inv); }
    __syncthreads();
}
#undef SLAS
}
namespace cg = cooperative_groups;
constexpr int NWAVES = 8;
constexpr int D = 1024, H = 16, FF = 4096, MP = 16384, MS = 512, M = MP + MS, PAST = 2048, DBATCH = 32, DSEQ = 16, LKEYS = PAST + DSEQ;
constexpr float RMS_EPS = 1e-6f, L2E = 1.4426950408889634f, QSCALE = 0.125f * 1.4426950408889634f;
constexpr size_t OUT_Y = 0, OUT_KP = 17301504, OUT_VP = 34078720, OUT_LP = 50855936, OUT_CP = 51118080, OUT_KS = 51122176, OUT_VS = 51646464, OUT_LS = 52170752, OUT_CS = 52178944, OUT_END = 52310016;
static_assert(OUT_KP == (size_t)pg8::OUT_KP && OUT_VP == (size_t)pg8::OUT_VP && OUT_KS == (size_t)pg8::OUT_KS && OUT_VS == (size_t)pg8::OUT_VS, "d_out map");
constexpr size_t MiB = 1u << 20;
constexpr size_t WS_CTL = 0, CTL_ZERO_BYTES = 1 * MiB;
constexpr size_t WS_WIN = 2 * MiB, WS_WOUT = 14 * MiB, WS_WKVQ = 18 * MiB, WS_WQ1 = 24 * MiB, WS_WO = 26 * MiB, WS_WUP = 30 * MiB, WS_WDN = 62 * MiB, WS_WF = 94 * MiB;
constexpr size_t WS_X = 96 * MiB, WS_XB = 162 * MiB, WS_G = 195 * MiB, WS_KB = 228 * MiB, WS_VB = 261 * MiB, WS_QB = 294 * MiB, WS_HB = 327 * MiB, WS_SSQ = 459 * MiB, WS_CLP = 462 * MiB, WS_CLS = 463 * MiB, WS_END = 468 * MiB;
static_assert((size_t)M * D * 4 == 66 * MiB && (size_t)M * FF * 2 == 132 * MiB && (size_t)512 * LKEYS * 4 <= 5 * MiB && (size_t)M * pg8::NSSQ * 4 <= 3 * MiB, "d_ws map");
constexpr int CW_BAR = 4096, CW_KMAX = 2048, CW_ATQ = 2304  ;
constexpr int RING_OFF = 0, RING_BYTES = 131072;
constexpr int ATT_LDS = attn_body::LDS_BYTES;
constexpr int LDSCTL_OFF = (ATT_LDS > RING_BYTES ? ATT_LDS : RING_BYTES), MISC_OFF = LDSCTL_OFF + 320;
constexpr int LDS_BYTES = LDSCTL_OFF + 1024;
static_assert(LDS_BYTES <= 163840 && sattn::L_END <= RING_BYTES, "LDS map");

#define GAS __attribute__((address_space(1)))
#define LAS __attribute__((address_space(3)))
typedef unsigned short bf16;
typedef unsigned v4u __attribute__((ext_vector_type(4)));
typedef unsigned v2u __attribute__((ext_vector_type(2)));
typedef float f32x4 __attribute__((ext_vector_type(4)));
typedef short bf16x8 __attribute__((ext_vector_type(8)));
typedef GAS unsigned gu32;
#define RLX_AGENT __ATOMIC_RELAXED, __HIP_MEMORY_SCOPE_AGENT
#define LDS_WAIT() asm volatile("s_waitcnt lgkmcnt(0)" ::: "memory")
#define VM_WAIT() asm volatile("s_waitcnt vmcnt(0)" ::: "memory")
__device__ __forceinline__ unsigned pk2(float lo, float hi) { return sattn::pk(lo, hi); }
__device__ __forceinline__ float bflo(unsigned w) { return __builtin_bit_cast(float, w << 16); }
__device__ __forceinline__ float bfhi(unsigned w) { return __builtin_bit_cast(float, w & 0xffff0000u); }
#define XB_TMO      128
#define XB_XCNT(j)  (256  + 64 * (j))
#define XB_XSUB(j)  (1280 + 64 * (j))
#define XB_XGEN(j)  (2304 + 64 * (j))
#define XB_TOP      3328
#define XB_TOPGEN   3392
#define XCD_BAR_WORDS 3456
#define XB_SPIN_CAP (1u << 18)

__device__ __forceinline__ unsigned xb_ld(unsigned* p)              { return __hip_atomic_load(p, __ATOMIC_RELAXED, __HIP_MEMORY_SCOPE_AGENT); }
__device__ __forceinline__ unsigned xb_add(unsigned* p, unsigned v) { return __hip_atomic_fetch_add(p, v, __ATOMIC_RELAXED, __HIP_MEMORY_SCOPE_AGENT); }
__device__ __forceinline__ unsigned xb_xcc_id() { return (unsigned)__builtin_amdgcn_s_getreg((3 << 11) | 20) & 0xFu; }
#define XB_SPIN(cond, bar) do { unsigned _sp = 0; while (cond) { __builtin_amdgcn_s_sleep(1); \
    if ((++_sp & 255u) == 0u) { if (xb_ld(&(bar)[XB_TMO])) break; if (_sp > XB_SPIN_CAP) { atomicAdd(&(bar)[XB_TMO], 1u); break; } } } } while (0)

struct XcdBarrier {
    unsigned* bar; unsigned x;
    volatile LAS unsigned* st;
};

__device__ __forceinline__ XcdBarrier xcd_barrier_post(unsigned* bar, volatile LAS unsigned* st) {
    XcdBarrier b; b.bar = bar; b.x = xb_xcc_id(); b.st = st;
    if (threadIdx.x == 0) (void)xb_add(&bar[XB_XCNT(b.x)], 1u);
    return b;
}
__device__ __forceinline__ void xcd_barrier_complete(unsigned* bar, unsigned x, unsigned& nloc, unsigned& nx) {
    const unsigned G = gridDim.x * gridDim.y * gridDim.z;
    unsigned sum, cnt, mine, sp = 0u;
    for (;;) {
        sum = 0u; cnt = 0u; mine = 0u;
#pragma unroll
        for (unsigned j = 0; j < 16; ++j) { const unsigned c = xb_ld(&bar[XB_XCNT(j)]); sum += c; cnt += (c > 0u) ? 1u : 0u; mine = (j == x) ? c : mine; }
        if (sum == G) break;
        __builtin_amdgcn_s_sleep(1);
        if ((++sp & 255u) == 0u) { if (xb_ld(&bar[XB_TMO])) break; if (sp > XB_SPIN_CAP) { atomicAdd(&bar[XB_TMO], 1u); break; } }
    }
    nloc = mine > 0u ? mine : 1u; nx = cnt > 0u ? cnt : 1u;
}

__device__ __forceinline__ void xcd_barrier(const XcdBarrier& b) {
    asm volatile("s_waitcnt vmcnt(0)" ::: "memory");
    __syncthreads();
    if (threadIdx.x == 0) {
        unsigned* bar = b.bar;
        __builtin_amdgcn_s_waitcnt(0);
        unsigned nloc = b.st[0], nx = b.st[1];
        if (nloc == 0u) { xcd_barrier_complete(bar, b.x, nloc, nx); b.st[0] = nloc; b.st[1] = nx; }
        const unsigned old = xb_add(&bar[XB_XSUB(b.x)], 1u);
        const unsigned gen = old / nloc;
        if (old + 1u == (gen + 1u) * nloc) {
            __builtin_amdgcn_fence(__ATOMIC_RELEASE, "agent");
            asm volatile("s_waitcnt vmcnt(0)" ::: "memory");
            const unsigned og = xb_add(&bar[XB_TOP], 1u);
            const unsigned tg = og / nx;
            if (og + 1u == (tg + 1u) * nx) xb_add(&bar[XB_TOPGEN], 1u);
            else XB_SPIN(xb_ld(&bar[XB_TOPGEN]) == tg, bar);
            __builtin_amdgcn_fence(__ATOMIC_ACQUIRE, "agent");
            xb_add(&bar[XB_XGEN(b.x)], 1u);
            asm volatile("s_waitcnt vmcnt(0)" ::: "memory");
        } else {
            XB_SPIN(xb_ld(&bar[XB_XGEN(b.x)]) == gen, bar);
            __builtin_amdgcn_fence(__ATOMIC_ACQUIRE, "agent");
            asm volatile("s_waitcnt vmcnt(0)" ::: "memory");
        }
    }
    __syncthreads();
}
struct Args { const float* in[21]; float* out; unsigned char* ws; };
typedef const __attribute__((address_space(4))) Args* KArgs;
__device__ __forceinline__ KArgs kargs() { KArgs p = (KArgs)__builtin_amdgcn_kernarg_segment_ptr(); asm volatile("" : "+s"(p)); return p; }
struct Frame {
    LAS unsigned char* lds; volatile LAS unsigned* MISC; gu32* ctl;
    int tid, lane, wave, vcu, G;
};
__device__ __forceinline__ float wave_sum(float v) {
#pragma unroll
    for (int o = 1; o < 64; o <<= 1) v += __shfl_xor(v, o);
    return v;
}
constexpr int P0_TILE_FLOATS = 64 * 65;
__device__ __forceinline__ void p0_transpose_item(const float* W, int K, int N, bf16* WT, int row_off, LAS float* scr, int item, int lane, const float* gain, float scale) {
    const int nblk = N / 64, kb = item / nblk, nb = item % nblk, k0 = 64 * kb, n0 = 64 * nb;
    const int c4 = lane & 15, kr = lane >> 4;
    f32x4 v[16];
#pragma unroll
    for (int i = 0; i < 16; ++i) v[i] = *(const GAS f32x4*)(W + (size_t)(k0 + 4 * i + kr) * N + n0 + 4 * c4);
#pragma unroll
    for (int i = 0; i < 16; ++i) { const int kk = 4 * i + kr; const float gsc = gain ? gain[k0 + kk] * scale : scale; LAS float* d = scr + kk * 65 + 4 * c4;
        d[0] = v[i].x * gsc; d[1] = v[i].y * gsc; d[2] = v[i].z * gsc; d[3] = v[i].w * gsc; }
    LDS_WAIT(); asm volatile("" ::: "memory");
    const int c = lane & 7;
#pragma unroll
    for (int j = 0; j < 8; ++j) { const int n = (lane >> 3) + 8 * j; const LAS float* s = scr + (8 * c) * 65 + n;
        v4u o; o.x = pk2(s[0 * 65], s[1 * 65]); o.y = pk2(s[2 * 65], s[3 * 65]); o.z = pk2(s[4 * 65], s[5 * 65]); o.w = pk2(s[6 * 65], s[7 * 65]);
        *(GAS v4u*)(WT + (size_t)(row_off + n0 + n) * K + k0 + 8 * c) = o; }
    LDS_WAIT(); asm volatile("" ::: "memory");
}
enum { I_XP = 0, I_XS, I_CK, I_CV, I_CLF, I_SC, I_NMIX, I_NMLP, I_CIN, I_CW, I_COUT, I_NKV, I_WK, I_WV, I_WF, I_BF, I_WQ, I_WO, I_UP, I_DN, I_NF };

__device__ __forceinline__ void p0_prologue(const Frame& F, KArgs a, unsigned char* ws) {
    const int T_tid = opaque_tid(), T_lane = T_tid & 63, T_wave = __builtin_amdgcn_readfirstlane(T_tid >> 6);
    LAS float* scr = (LAS float*)(F.lds + RING_OFF) + T_wave * P0_TILE_FLOATS;
    const int gw = F.vcu * NWAVES + T_wave, NGW = F.G * NWAVES;
    constexpr int NCHUNK = 46;
    for (int it = gw; it < NCHUNK * 256; it += NGW) {
        int c = it >> 8, base = 0; const float* src = nullptr; const float* gain = nullptr; bf16* dst = nullptr; int roff = 0, K = D, N = D; float sc = 1.f;
        if (c < 6) { const int l = c / 3; src = a->in[I_CIN] + (size_t)l * D * 3 * D; gain = a->in[I_NMIX] + l * D; dst = (bf16*)(ws + WS_WIN) + (size_t)l * 3 * D * D; N = 3 * D; base = l * 3; }
        else if (c < 8) { const int l = c - 6; src = a->in[I_COUT] + (size_t)l * D * D; dst = (bf16*)(ws + WS_WOUT) + (size_t)l * D * D; base = c; }
        else if (c < 9) { src = a->in[I_WK]; gain = a->in[I_NKV]; dst = (bf16*)(ws + WS_WKVQ); base = c; }
        else if (c < 10) { src = a->in[I_WV]; gain = a->in[I_NKV]; dst = (bf16*)(ws + WS_WKVQ); roff = D; base = c; }
        else if (c < 11) { src = a->in[I_WQ]; gain = a->in[I_NMIX] + 2 * D; dst = (bf16*)(ws + WS_WKVQ); roff = 2 * D; sc = QSCALE; base = c; }
        else if (c < 12) { src = a->in[I_WQ] + (size_t)D * D; gain = a->in[I_NMIX] + 3 * D; dst = (bf16*)(ws + WS_WQ1); sc = QSCALE; base = c; }
        else if (c < 14) { const int j = c - 12; src = a->in[I_WO] + (size_t)j * D * D; dst = (bf16*)(ws + WS_WO) + (size_t)j * D * D; base = c; }
        else if (c < 30) { const int l = (c - 14) >> 2; src = a->in[I_UP] + (size_t)l * D * FF; gain = a->in[I_NMLP] + l * D; dst = (bf16*)(ws + WS_WUP) + (size_t)l * D * FF; N = FF; base = 14 + 4 * l; }
        else { const int l = (c - 30) >> 2; src = a->in[I_DN] + (size_t)l * D * FF; dst = (bf16*)(ws + WS_WDN) + (size_t)l * D * FF; K = FF; base = 30 + 4 * l; }
        p0_transpose_item(src, K, N, dst, roff, scr, it - base * 256, T_lane, gain, sc);
    }
    for (int i = (F.vcu * NWAVES + T_wave) * 64 + T_lane; i < D * H; i += NGW * 64) { const int k = i >> 4, h = i & 15; ((bf16*)(ws + WS_WF))[h * D + k] = (bf16)(pk2(a->in[I_NKV][k] * a->in[I_WF][i], 0.f) & 0xffffu); }
    bf16* XB = (bf16*)(ws + WS_XB); float* SSQ = (float*)(ws + WS_SSQ);
    for (int m = gw; m < M; m += NGW) {
        const float* xr = (m < MP) ? a->in[I_XP] + (size_t)m * D : a->in[I_XS] + (size_t)(m - MP) * D;
        const GAS f32x4* xp = (const GAS f32x4*)xr + T_lane; f32x4 v[4]; float s = 0.f;
#pragma unroll
        for (int j = 0; j < 4; ++j) { v[j] = xp[64 * j]; s += (v[j].x * v[j].x + v[j].y * v[j].y) + (v[j].z * v[j].z + v[j].w * v[j].w); }
        s = wave_sum(s);
        GAS v2u* bo = (GAS v2u*)(XB + (size_t)m * D) + T_lane;
#pragma unroll
        for (int j = 0; j < 4; ++j) { v2u w; w.x = pk2(v[j].x, v[j].y); w.y = pk2(v[j].z, v[j].w); bo[64 * j] = w; }
        if (T_lane < pg8::NSSQ) SSQ[(size_t)m * pg8::NSSQ + T_lane] = (T_lane == 0) ? s : 0.f;
    }
}
__device__ __forceinline__ void conv_gate_phase(const Frame& F, KArgs a, unsigned char* ws, int l) {
    const int T_tid = opaque_tid(), T_lane = T_tid & 63, T_wave = __builtin_amdgcn_readfirstlane(T_tid >> 6);
    const int gw = F.vcu * NWAVES + T_wave, NGW = F.G * NWAVES;
    const bf16* BCX = (const bf16*)(ws + WS_HB); bf16* Gm = (bf16*)(ws + WS_G);
    const float* cw = a->in[I_CW] + (size_t)l * 3 * D;
    for (int it = gw; it < (M / 8) * 2; it += NGW) {
        const int half = it & 1, row0 = (it >> 1) * 8, c0 = half * 512 + T_lane * 8;
        float w0[8], w1[8], w2[8], um2[8], um1[8];
        { const f32x4 a0 = *(const f32x4*)(cw + c0), a1 = *(const f32x4*)(cw + c0 + 4), b0 = *(const f32x4*)(cw + D + c0), b1 = *(const f32x4*)(cw + D + c0 + 4), d0 = *(const f32x4*)(cw + 2 * D + c0), d1 = *(const f32x4*)(cw + 2 * D + c0 + 4);
#pragma unroll
          for (int e = 0; e < 4; ++e) { w0[e] = a0[e]; w0[4 + e] = a1[e]; w1[e] = b0[e]; w1[4 + e] = b1[e]; w2[e] = d0[e]; w2[4 + e] = d1[e]; } }
        const bool sample = row0 >= MP; const int sb = sample ? (row0 - MP) >> 4 : 0; const int t0 = sample ? (row0 - MP) & 15 : row0;
        if (t0 == 0) {
            if (sample) { const float* st = a->in[I_SC] + ((size_t)(l * DBATCH + sb) * 2) * D + c0;
                const f32x4 p0 = *(const f32x4*)st, p1 = *(const f32x4*)(st + 4), q0 = *(const f32x4*)(st + D), q1 = *(const f32x4*)(st + D + 4);
#pragma unroll
                for (int e = 0; e < 4; ++e) { um2[e] = p0[e]; um2[4 + e] = p1[e]; um1[e] = q0[e]; um1[4 + e] = q1[e]; } }
            else {
#pragma unroll
                for (int e = 0; e < 8; ++e) { um2[e] = 0.f; um1[e] = 0.f; } }
        } else {
#pragma unroll
            for (int k = 0; k < 2; ++k) { const bf16* rp = BCX + (size_t)(row0 - 2 + k) * 3072 + c0; const v4u gc = *(const v4u*)(rp + D), xv = *(const v4u*)(rp + 2 * D);
#pragma unroll
                for (int e = 0; e < 4; ++e) { const float u0 = bflo(gc[e]) * bflo(xv[e]), u1 = bfhi(gc[e]) * bfhi(xv[e]); if (k == 0) { um2[2 * e] = u0; um2[2 * e + 1] = u1; } else { um1[2 * e] = u0; um1[2 * e + 1] = u1; } } }
        }
#pragma unroll
        for (int i = 0; i < 8; ++i) { const bf16* rp = BCX + (size_t)(row0 + i) * 3072 + c0; const v4u gb = *(const v4u*)rp, gc = *(const v4u*)(rp + D), xv = *(const v4u*)(rp + 2 * D);
            float u[8], o[8];
#pragma unroll
            for (int e = 0; e < 4; ++e) { u[2 * e] = bflo(gc[e]) * bflo(xv[e]); u[2 * e + 1] = bfhi(gc[e]) * bfhi(xv[e]); }
#pragma unroll
            for (int e = 0; e < 8; ++e) o[e] = w0[e] * um2[e] + w1[e] * um1[e] + w2[e] * u[e];
            v4u w;
#pragma unroll
            for (int e = 0; e < 4; ++e) w[e] = pk2(bflo(gb[e]) * o[2 * e], bfhi(gb[e]) * o[2 * e + 1]);
            *(v4u*)(Gm + (size_t)(row0 + i) * D + c0) = w;
#pragma unroll
            for (int e = 0; e < 8; ++e) { um2[e] = um1[e]; um1[e] = u[e]; } }
        const bool last = sample ? (t0 == 8) : (row0 + 8 == MP);
        if (last) { float* o = a->out + (sample ? OUT_CS + ((size_t)(l * DBATCH + sb) * 2) * D : OUT_CP + (size_t)l * 2 * D) + c0;
            *(f32x4*)o = (f32x4){um2[0], um2[1], um2[2], um2[3]}; *(f32x4*)(o + 4) = (f32x4){um2[4], um2[5], um2[6], um2[7]};
            *(f32x4*)(o + D) = (f32x4){um1[0], um1[1], um1[2], um1[3]}; *(f32x4*)(o + D + 4) = (f32x4){um1[4], um1[5], um1[6], um1[7]}; }
    }
}
__device__ __forceinline__ void logf_phase(const Frame& F, KArgs a, unsigned char* ws) {
    const int T_tid = opaque_tid(), T_lane = T_tid & 63, T_wave = __builtin_amdgcn_readfirstlane(T_tid >> 6);
    const int gw = F.vcu * NWAVES + T_wave, NGW = F.G * NWAVES; const int r = T_lane & 15, g = T_lane >> 4;
    const bf16* WF = (const bf16*)(ws + WS_WF); const bf16* XB = (const bf16*)(ws + WS_XB); const float* SSQ = (const float*)(ws + WS_SSQ);
    for (int blk = gw; blk < M / 16; blk += NGW) {
        const int row = blk * 16 + r; f32x4 acc = (f32x4){0.f, 0.f, 0.f, 0.f};
        const bf16* ap = WF + (size_t)r * D + 8 * g; const bf16* bp = XB + (size_t)row * D + 8 * g;
#pragma unroll 8
        for (int s = 0; s < 32; ++s) acc = __builtin_amdgcn_mfma_f32_16x16x32_bf16(*(const bf16x8*)(ap + 32 * s), *(const bf16x8*)(bp + 32 * s), acc, 0, 0, 0);
        const float rs = pg8::row_rstd(SSQ, row); const f32x4 bfv = *(const f32x4*)(a->in[I_BF] + 4 * g); f32x4 o;
#pragma unroll
        for (int e = 0; e < 4; ++e) { const float z = acc[e] * rs + bfv[e]; o[e] = fminf(z, 0.f) - log1pf(expf(-fabsf(z))); }
        float* op = a->out + ((row < MP) ? OUT_LP + (size_t)row * 16 : OUT_LS + (size_t)(row - MP) * 16) + 4 * g;
        *(f32x4*)op = o;
    }
}
__device__ __forceinline__ double wave_scan_incl(double v, int lane) {
#pragma unroll
    for (int o = 1; o < 64; o <<= 1) { const double t = __shfl_up(v, o); if (lane >= o) v += t; }
    return v;
}
__device__ __forceinline__ void scan_phase(const Frame& F, KArgs a, unsigned char* ws) {
    const int T_tid = opaque_tid(), T_lane = T_tid & 63, T_wave = __builtin_amdgcn_readfirstlane(T_tid >> 6);
    float* CLP = (float*)(ws + WS_CLP); float* CLS = (float*)(ws + WS_CLS);
    const int blk = blockIdx.x;
    if (blk < 16) {
        const int h = blk; const float* lf = a->out + OUT_LP; const int t0 = T_tid * 32; double s = 0.0;
#pragma unroll 8
        for (int i = 0; i < 32; ++i) s += (double)lf[(size_t)(t0 + i) * 16 + h];
        const double inc = wave_scan_incl(s, T_lane);
        LAS double* wt = (LAS double*)(F.lds + RING_OFF);
        if (T_lane == 63) wt[T_wave] = inc;
        __syncthreads();
        double run = inc - s;
        for (int w = 0; w < T_wave; ++w) run += wt[w];
#pragma unroll 8
        for (int i = 0; i < 32; ++i) { run += (double)lf[(size_t)(t0 + i) * 16 + h]; CLP[(size_t)h * MP + t0 + i] = (float)(run * (double)L2E); }
        __syncthreads();
    } else {
        const int nws = (F.G - 16) * NWAVES;
        for (int seq = (blk - 16) * NWAVES + T_wave; seq < DBATCH * H; seq += nws) {
            const int b = seq >> 4, h = seq & 15; const float* clf = a->in[I_CLF] + (size_t)b * PAST * 16 + h; const float* nlf = a->out + OUT_LS + (size_t)b * DSEQ * 16 + h;
            const int s0 = T_lane * 33; double s = 0.0;
            for (int i = 0; i < 33; ++i) { const int k = s0 + i; if (k < LKEYS) s += (double)(k < PAST ? clf[(size_t)k * 16] : nlf[(size_t)(k - PAST) * 16]); }
            double run = wave_scan_incl(s, T_lane) - s;
            for (int i = 0; i < 33; ++i) { const int k = s0 + i; if (k < LKEYS) { run += (double)(k < PAST ? clf[(size_t)k * 16] : nlf[(size_t)(k - PAST) * 16]); CLS[(size_t)seq * LKEYS + k] = (float)(run * (double)L2E); } }
        }
    }
    { const int gw = F.vcu * NWAVES + T_wave, NGW = F.G * NWAVES; const bf16* KB = (const bf16*)(ws + WS_KB); float mx = 0.f;
      for (int row = gw; row < MP; row += NGW) { const v4u p = *(const v4u*)(KB + (size_t)row * D + T_lane * 16), q = *(const v4u*)(KB + (size_t)row * D + T_lane * 16 + 8); float sq = 0.f;
#pragma unroll
          for (int e = 0; e < 4; ++e) { const float a0 = bflo(p[e]), a1 = bfhi(p[e]), b0 = bflo(q[e]), b1 = bfhi(q[e]); sq += (a0 * a0 + a1 * a1) + (b0 * b0 + b1 * b1); }
          sq += __shfl_xor(sq, 1); sq += __shfl_xor(sq, 2); mx = fmaxf(mx, sq); }
      __syncthreads();
      LAS float* km = (LAS float*)(F.lds + RING_OFF) + 64;
      if ((T_lane & 3) == 0) km[T_wave * 16 + (T_lane >> 2)] = mx;
      __syncthreads();
      if (T_tid < 16) { float m = km[T_tid];
#pragma unroll
          for (int w = 1; w < NWAVES; ++w) m = fmaxf(m, km[w * 16 + T_tid]);
          atomicMax((unsigned*)(ws + WS_CTL) + CW_KMAX + T_tid, __builtin_bit_cast(unsigned, m)); }
      __syncthreads(); }
}
__device__ __forceinline__ void final_norm_phase(const Frame& F, KArgs a, unsigned char* ws) {
    const int T_tid = opaque_tid(), T_lane = T_tid & 63, T_wave = __builtin_amdgcn_readfirstlane(T_tid >> 6);
    const int gw = F.vcu * NWAVES + T_wave, NGW = F.G * NWAVES; const float* X = (const float*)(ws + WS_X);
    const GAS f32x4* gp = (const GAS f32x4*)a->in[I_NF] + T_lane; f32x4 gn[4];
#pragma unroll
    for (int j = 0; j < 4; ++j) gn[j] = gp[64 * j];
    for (int m = gw; m < M; m += NGW) {
        const GAS f32x4* xp = (const GAS f32x4*)(X + (size_t)m * D) + T_lane; f32x4 v[4]; float s = 0.f;
#pragma unroll
        for (int j = 0; j < 4; ++j) { v[j] = xp[64 * j]; s += (v[j].x * v[j].x + v[j].y * v[j].y) + (v[j].z * v[j].z + v[j].w * v[j].w); }
        const float rs = 1.0f / sqrtf(wave_sum(s) * (1.0f / D) + RMS_EPS);
        GAS f32x4* op = (GAS f32x4*)(a->out + OUT_Y + (size_t)m * D) + T_lane;
#pragma unroll
        for (int j = 0; j < 4; ++j) op[64 * j] = v[j] * rs * gn[j];
    }
}

__global__ void __launch_bounds__(NWAVES * 64, 2) yoco_fwd(Args args) {
    extern __shared__ __attribute__((aligned(16))) unsigned char lds[];
    Frame F;
    F.lds = (LAS unsigned char*)lds;
    F.MISC = (volatile LAS unsigned*)(F.lds + MISC_OFF);
    F.tid = threadIdx.x; F.lane = F.tid & 63; F.wave = __builtin_amdgcn_readfirstlane(F.tid >> 6);
    F.G = gridDim.x; { const int bx = blockIdx.x; F.vcu = (F.G % 8 == 0) ? (bx % 8) * (F.G / 8) + bx / 8 : bx; }
    F.ctl = (gu32*)(kargs()->ws + WS_CTL);
    for (int u = F.tid; u < (LDS_BYTES - LDSCTL_OFF) / 4; u += NWAVES * 64) ((LAS unsigned*)(F.lds + LDSCTL_OFF))[u] = 0u;
    __syncthreads();
    XcdBarrier bar = xcd_barrier_post((unsigned*)(F.ctl + CW_BAR), F.MISC + 8);
#define GRID_BAR() xcd_barrier(bar)
#define WSP(T, off) ((T*)(kargs()->ws + (off)))

    p0_prologue(F, kargs(), kargs()->ws);
    if (kargs()->ws == nullptr) cg::this_grid().sync();
    GRID_BAR();

#define SAMPLE_TILES(g, E) do { const int id_ = opaque_bid(); if (id_ < 4 * ((g).N / 128)) { const int mi_ = id_ & 3, ni_ = id_ >> 2; \
        pg8::gemm128_tile(F.lds + RING_OFF, (g).A + (size_t)(MP + 128 * mi_) * (g).K, (g).Bt + (size_t)(128 * ni_) * (g).K, (g).K, E, MP + 128 * mi_, 128 * ni_); } } while (0)
#define LAYER(l) do { \
        if ((l) != 2) { \
            constexpr bool cv = (l) < 2; unsigned char* ws = kargs()->ws; \
            pg8::Gemm g{(const bf16*)(ws + WS_XB), cv ? (const bf16*)(ws + WS_WIN) + (size_t)(l) * 3 * D * D : (const bf16*)(ws + WS_WQ1), M, cv ? 3 * D : D, D}; \
            pg8::StaticOrder S; S.init(MP, cv ? 3 * D : D, F.G, opaque_bid()); \
            pg8::EpiAct<0, false> E{cv ? (bf16*)(ws + WS_HB) : (bf16*)(ws + WS_QB), cv ? 3 * D : D, (const float*)(ws + WS_SSQ), 0, 0, nullptr}; \
            pg8::gemm_phase<pg8::EpiAct<0, false>, pg8::StaticOrder, PG8_ALIGN, PG8_SP2>(F.lds + RING_OFF, g, S, E); \
            SAMPLE_TILES(g, E); \
            GRID_BAR(); \
        } \
        if ((l) < 2) { conv_gate_phase(F, kargs(), kargs()->ws, (l)); } \
        else { \
            { unsigned char* ws = kargs()->ws; \
            const attn_body::AttnTensors AT{(const attn_body::bf16*)(ws + WS_QB), (const attn_body::bf16*)(ws + WS_KB), (const attn_body::bf16*)(ws + WS_VB), (attn_body::bf16*)(ws + WS_G), (const float*)(ws + WS_CLP), (const unsigned*)(ws + WS_CTL) + CW_KMAX}; \
            attn_body::attn_phase_q<24>((char*)lds + RING_OFF, AT, (unsigned*)(ws + WS_CTL) + CW_ATQ + ((l) - 2) * 512, opaque_bid()); } \
            __syncthreads(); \
            KArgs ka = kargs(); unsigned char* ws = ka->ws; \
            const sattn::Tensors ST{ka->in[I_CK], ka->in[I_CV], (const bf16*)(ws + WS_QB), (const bf16*)(ws + WS_KB), (const bf16*)(ws + WS_VB), (bf16*)(ws + WS_G), (const float*)(ws + WS_CLS)}; \
            for (int u = F.vcu; u < DBATCH * H; u += F.G) sattn::unit(u >> 4, u & 15, ST, (LAS char*)(F.lds + RING_OFF)); \
        } \
        GRID_BAR(); \
        { unsigned char* ws = kargs()->ws; \
            pg8::Gemm g{(const bf16*)(ws + WS_G), ((l) < 2) ? (const bf16*)(ws + WS_WOUT) + (size_t)(l) * D * D : (const bf16*)(ws + WS_WO) + (size_t)((l) - 2) * D * D, M, D, D}; \
            pg8::StaticOrder S; S.init(MP, D, F.G, opaque_bid()); \
            pg8::EpiResid E{(float*)(ws + WS_X), (bf16*)(ws + WS_XB), (float*)(ws + WS_SSQ), ((l) == 0) ? kargs()->in[I_XP] : nullptr, ((l) == 0) ? kargs()->in[I_XS] : nullptr}; \
            pg8::gemm_phase<pg8::EpiResid, pg8::StaticOrder, PG8_ALIGN, PG8_SP2>(F.lds + RING_OFF, g, S, E); \
            SAMPLE_TILES(g, E); \
            GRID_BAR(); } \
        { unsigned char* ws = kargs()->ws; \
            pg8::Gemm g{(const bf16*)(ws + WS_XB), (const bf16*)(ws + WS_WUP) + (size_t)(l) * D * FF, M, FF, D}; \
            pg8::StaticOrder S; S.init(MP, FF, F.G, opaque_bid()); \
            pg8::EpiAct<1, false> E{(bf16*)(ws + WS_HB), FF, (const float*)(ws + WS_SSQ), 0, 0, nullptr}; \
            pg8::gemm_phase<pg8::EpiAct<1, false>, pg8::StaticOrder, PG8_ALIGN, PG8_SP2>(F.lds + RING_OFF, g, S, E); \
            SAMPLE_TILES(g, E); \
            GRID_BAR(); } \
        { unsigned char* ws = kargs()->ws; \
            pg8::Gemm g{(const bf16*)(ws + WS_HB), (const bf16*)(ws + WS_WDN) + (size_t)(l) * D * FF, M, D, FF}; \
            pg8::StaticOrder S; S.init(MP, D, F.G, opaque_bid()); \
            pg8::EpiResid E{(float*)(ws + WS_X), (bf16*)(ws + WS_XB), (float*)(ws + WS_SSQ), nullptr, nullptr}; \
            pg8::gemm_phase<pg8::EpiResid, pg8::StaticOrder, PG8_ALIGN, PG8_SP2>(F.lds + RING_OFF, g, S, E); \
            SAMPLE_TILES(g, E); \
            GRID_BAR(); } \
        if ((l) == 1) { \
            KArgs ka = kargs(); unsigned char* ws = ka->ws; \
            pg8::Gemm g{(const bf16*)(ws + WS_XB), (const bf16*)(ws + WS_WKVQ), M, 3 * D, D}; \
            pg8::StaticOrder S; S.init(MP, 3 * D, F.G, opaque_bid()); \
            pg8::EpiAct<0, true> E{(bf16*)(ws + WS_KB), D, (const float*)(ws + WS_SSQ), D, (size_t)(WS_VB - WS_KB) / 2, ka->out}; \
            pg8::gemm_phase<pg8::EpiAct<0, true>, pg8::StaticOrder, PG8_ALIGN, PG8_SP2>(F.lds + RING_OFF, g, S, E); \
            SAMPLE_TILES(g, E); \
            logf_phase(F, kargs(), kargs()->ws); \
            GRID_BAR(); \
            scan_phase(F, kargs(), kargs()->ws); \
            GRID_BAR(); \
        } } while (0)
    LAYER(0); LAYER(1); LAYER(2); LAYER(3);
    final_norm_phase(F, kargs(), kargs()->ws);
}

extern "C" void kernel_launch(void* const* d_in, const int* in_sizes, int n_in, void* d_out, int out_size, void* d_ws, size_t ws_size, hipStream_t stream) {
    static int grid = 0;
    if (grid == 0) {
        if (n_in != 21 || out_size != (int)OUT_END || ws_size < WS_END) { fprintf(stderr, "kernel_launch: unexpected sizes (n_in %d, out %d, ws %zu); nothing launched\n", n_in, out_size, ws_size); grid = -1; return; }
        int dev = 0, cus = 0, per_cu = 0;
        if (hipGetDevice(&dev) != hipSuccess || hipDeviceGetAttribute(&cus, hipDeviceAttributeMultiprocessorCount, dev) != hipSuccess) { grid = -1; return; }
        if (hipFuncSetAttribute((const void*)yoco_fwd, hipFuncAttributeMaxDynamicSharedMemorySize, LDS_BYTES) != hipSuccess) { fprintf(stderr, "kernel_launch: hipFuncSetAttribute failed\n"); grid = -1; return; }
        if (hipOccupancyMaxActiveBlocksPerMultiprocessor(&per_cu, (const void*)yoco_fwd, NWAVES * 64, LDS_BYTES) != hipSuccess || per_cu < 1) { fprintf(stderr, "kernel_launch: occupancy query says %d\n", per_cu); per_cu = 1; }
        (void)hipGetLastError();
        grid = cus;
    }
    if (grid < 0) return;
    if (hipMemsetAsync((char*)d_ws + WS_CTL, 0, CTL_ZERO_BYTES, stream) != hipSuccess) { fprintf(stderr, "kernel_launch: memset failed\n"); return; }
    Args a{};
    for (int i = 0; i < 21; ++i) a.in[i] = (const float*)d_in[i];
    a.out = (float*)d_out; a.ws = (unsigned char*)d_ws;
    void* kargv[] = {&a};
    const hipError_t e = hipLaunchCooperativeKernel((const void*)yoco_fwd, dim3(grid), dim3(NWAVES * 64), kargv, LDS_BYTES, stream);
    if (e != hipSuccess) fprintf(stderr, "kernel_launch: cooperative launch failed: %s (grid %d)\n", hipGetErrorString(e), grid);
}
```

```cpp
#include <hip/hip_runtime.h>
#include <hip/hip_cooperative_groups.h>
#include <cstdio>
#include <cstdint>
__device__ __forceinline__ int opaque_bid() { int b = (int)blockIdx.x; asm volatile("" : "+s"(b)); return b; }
__device__ __forceinline__ int opaque_tid() { int t = (int)threadIdx.x; asm volatile("" : "+v"(t)); return t; }
namespace pg8 {
#define PG8_LAS __attribute__((address_space(3)))
typedef unsigned short bf16_t;
typedef short bf16x8 __attribute__((ext_vector_type(8)));
typedef float f32x4 __attribute__((ext_vector_type(4)));
typedef unsigned u32x4 __attribute__((ext_vector_type(4)));
constexpr int BM = 256, BK = 64, HALF = 128, HTB = HALF * BK * 2  , STAGE_BYTES = 8 * HTB, NXCD = 8, WGM = 8;

__host__ __device__ __forceinline__ int lds_byte(int r, int c) { const int st = (r >> 4) * 2 + (c >> 5), rr = r & 15, cc = c & 31, ob = rr * 64 + cc * 2; return st * 1024 + (ob ^ (((ob >> 9) & 1) << 5)); }
__host__ __device__ __forceinline__ void stage_rc(int b, int& R, int& C) { const int st = b / 1024, sb = b % 1024, swz = sb ^ (((sb >> 9) & 1) << 5); R = (st >> 1) * 16 + swz / 64; C = (st & 1) * 32 + (swz % 64) / 2; }
__host__ __device__ __forceinline__ int perm32(int rho) { const int n = rho >> 4, i = rho & 15; return 8 * (i >> 2) + 4 * n + (i & 3); }

struct Unit { int pm, pn; };
struct Gemm { const bf16_t* A; const bf16_t* Bt; int M, N, K; };

struct StaticOrder {
    int nM, nN, nwg, G, c;
    __host__ __device__ void init(int M, int N, int G_, int c_) { nM = M / BM; nN = N / BM; nwg = nM * nN; G = G_; c = c_; }
    __host__ __device__ bool next(int i, Unit& u) const {
        const long L = (long)i * G + c; if (L >= nwg) return false;
        int wgid = (int)L; { const int q = nwg / NXCD, r = nwg % NXCD, xcd = wgid % NXCD, off = wgid / NXCD; wgid = (xcd < r ? xcd * (q + 1) : r * (q + 1) + (xcd - r) * q) + off; }
        const int nig = WGM * nN, gid = wgid / nig, fm = gid * WGM, gsz = (nM - fm) < WGM ? (nM - fm) : WGM;
        u.pm = fm + ((wgid % nig) % gsz); u.pn = (wgid % nig) / gsz; return true;
    }
    __device__ __forceinline__ void a_ready(const Unit&) const {}
    __device__ __forceinline__ void done(const Unit&) const {}
};

__device__ __forceinline__ unsigned cvt_pk_bf16(float lo, float hi) { unsigned r; asm volatile("v_cvt_pk_bf16_f32 %0, %1, %2" : "=v"(r) : "v"(lo), "v"(hi)); return r; }
typedef float f32x2 __attribute__((ext_vector_type(2)));
__device__ __forceinline__ f32x2 gelu_pk(f32x2 v) {
    const f32x2 av = __builtin_elementwise_abs(v), d = av * 0.2316418882f + 1.0f;
    f32x2 t; t.x = __builtin_amdgcn_rcpf(d.x); t.y = __builtin_amdgcn_rcpf(d.y);
    f32x2 q = t * 0.5307027145f + (-0.7265760135f); q = q * t + 0.7107068705f; q = q * t + (-0.142248368f); q = q * t + 0.127414796f; q = q * t;
    const f32x2 s = (v * v) * (-0.72134752044f);
    f32x2 e; e.x = __builtin_amdgcn_exp2f(s.x); e.y = __builtin_amdgcn_exp2f(s.y);
    const f32x2 m = v * (q * e), r = v - m;
    f32x2 o; o.x = v.x < 0.f ? m.x : r.x; o.y = v.y < 0.f ? m.y : r.y; return o;
}

template <int ACT  > struct EpiBf16 {
    static constexpr bool PERM = true, AFTER_DRAIN = false; static_assert(ACT == 0 || ACT == 1, "EpiBf16: ACT is 0 (none) or 1 (gelu_pk)");
    bf16_t* O; int ldc; const float* bias; int split_cols; size_t split_stride; float scale0;
    __device__ __forceinline__ void operator()(const f32x4 (&acc)[2][2][4][2], const Unit& u, int wr, int wc, int fr, int fq) const {
        const int row0 = u.pm * BM + wr * 64 + fr; int colt = u.pn * BM; bf16_t* base = O;
        float sc = 1.f; if (split_cols) { const int t = colt / split_cols; base += (size_t)t * split_stride; colt -= t * split_cols; if (t == 0) sc = scale0; }
        const int col0 = colt + wc * 32 + 8 * fq, bcol0 = u.pn * BM + wc * 32 + 8 * fq;
        f32x4 bv[2][2];
#pragma unroll
        for (int bj = 0; bj < 2; ++bj)
#pragma unroll
            for (int n = 0; n < 2; ++n) bv[bj][n] = bias ? *(const f32x4*)(bias + bcol0 + bj * HALF + 4 * n) : (f32x4){0.f, 0.f, 0.f, 0.f};
#pragma unroll
        for (int ai = 0; ai < 2; ++ai)
#pragma unroll
            for (int m = 0; m < 4; ++m) { bf16_t* rowp = base + (size_t)(row0 + ai * HALF + m * 16) * ldc + col0;
#pragma unroll
                for (int bj = 0; bj < 2; ++bj) { f32x4 v0 = acc[ai][bj][m][0] + bv[bj][0], v1 = acc[ai][bj][m][1] + bv[bj][1];
                    if (ACT == 1) { f32x2 a = gelu_pk((f32x2){v0[0], v0[1]}), b = gelu_pk((f32x2){v0[2], v0[3]}), c = gelu_pk((f32x2){v1[0], v1[1]}), d = gelu_pk((f32x2){v1[2], v1[3]});
                        v0 = (f32x4){a.x, a.y, b.x, b.y}; v1 = (f32x4){c.x, c.y, d.x, d.y}; }
                    v0 = v0 * sc; v1 = v1 * sc; u32x4 w; w.x = cvt_pk_bf16(v0[0], v0[1]); w.y = cvt_pk_bf16(v0[2], v0[3]); w.z = cvt_pk_bf16(v1[0], v1[1]); w.w = cvt_pk_bf16(v1[2], v1[3]);
                    *(u32x4*)(rowp + bj * HALF) = w; } }
    }
};

struct PanelStats {
    unsigned* xbuf;
    unsigned* cnt;
    unsigned* tmo;
    int ntn; float eps;
    unsigned code;
    __device__ __forceinline__ bool run(const f32x4 (&v)[2][2][4][2], const Unit& u, int wr, int wc, int fr, int fq, PG8_LAS unsigned char* lds, int wid, int lane) const {
        typedef float f32x2v __attribute__((ext_vector_type(2)));
        PG8_LAS f32x2v* P = (PG8_LAS f32x2v*)lds;
        PG8_LAS f32x2v* S = (PG8_LAS f32x2v*)(lds + 8192);
        PG8_LAS unsigned* flag = (PG8_LAS unsigned*)(lds + 8192 + 2048);
#pragma unroll
        for (int ai = 0; ai < 2; ++ai)
#pragma unroll
            for (int m = 0; m < 4; ++m) {
                float s = 0.f;
#pragma unroll
                for (int bj = 0; bj < 2; ++bj)
#pragma unroll
                    for (int n = 0; n < 2; ++n) { const f32x4 x = v[ai][bj][m][n]; s += (x[0] + x[1]) + (x[2] + x[3]); }
                s += __shfl_xor(s, 16); s += __shfl_xor(s, 32);
                const float mw = s * (1.0f / 64.0f); float q = 0.f;
#pragma unroll
                for (int bj = 0; bj < 2; ++bj)
#pragma unroll
                    for (int n = 0; n < 2; ++n) { const f32x4 d = v[ai][bj][m][n] - mw; q += (d[0] * d[0] + d[1] * d[1]) + (d[2] * d[2] + d[3] * d[3]); }
                q += __shfl_xor(q, 16); q += __shfl_xor(q, 32);
                if (fq == 0) P[(ai * HALF + wr * 64 + m * 16 + fr) * 4 + wc] = (f32x2v){mw, q};
            }
        asm volatile("s_waitcnt lgkmcnt(0)" ::: "memory"); __builtin_amdgcn_s_barrier(); asm volatile("" ::: "memory");
#if defined(BROKEN_EXCHANGE_NO_WAIT)
#warning BROKEN CONTROL BUILD: the row-statistics exchange does not wait; results are wrong by design
        if (blockIdx.x >= 64) { const long long t0_ = clock64(); while (clock64() - t0_ < 60000) __builtin_amdgcn_s_sleep(8); }
#endif
        const int row = wid * 32 + (lane & 31);
        if (lane < 32) {
            const f32x2v a = P[row * 4 + 0], b = P[row * 4 + 1], c = P[row * 4 + 2], d = P[row * 4 + 3];
            const float mt = (a.x + b.x + c.x + d.x) * 0.25f;
            const float da = a.x - mt, db = b.x - mt, dc = c.x - mt, dd = d.x - mt;
            const float m2 = (a.y + b.y) + (c.y + d.y) + 64.0f * ((da * da + db * db) + (dc * dc + dd * dd));
            unsigned long long* slot = (unsigned long long*)xbuf + ((size_t)(u.pm * BM + row) * 4 + u.pn);
            __hip_atomic_store(slot, ((unsigned long long)__float_as_uint(m2) << 32) | __float_as_uint(mt), __ATOMIC_RELAXED, __HIP_MEMORY_SCOPE_AGENT);
        }
        asm volatile("s_waitcnt vmcnt(0)" ::: "memory");
        if (lane == 0) __hip_atomic_fetch_add(cnt + 64 * u.pm, 1u, __ATOMIC_RELAXED, __HIP_MEMORY_SCOPE_AGENT);
        if (wid == 0) {
            bool dead = false; const unsigned long long t0 = __builtin_amdgcn_s_memrealtime(); const unsigned want = 8u * (unsigned)ntn;
            for (;;) {
#if defined(BROKEN_EXCHANGE_NO_WAIT)
                break;
#endif
                if ((unsigned)__builtin_amdgcn_readfirstlane(__hip_atomic_load(cnt + 64 * u.pm, __ATOMIC_RELAXED, __HIP_MEMORY_SCOPE_AGENT)) >= want) break;
                if (__builtin_amdgcn_s_memrealtime() - t0 > 2000000ull) {
                    if (lane == 0) { unsigned expect = 0u; __hip_atomic_compare_exchange_strong(tmo + 1, &expect, code | (unsigned)(u.pm & 0xff), __ATOMIC_RELAXED, __ATOMIC_RELAXED, __HIP_MEMORY_SCOPE_AGENT);
                                     __hip_atomic_store(tmo, 1u, __ATOMIC_RELAXED, __HIP_MEMORY_SCOPE_AGENT); }
                    dead = true; break; }
                __builtin_amdgcn_s_sleep(2);
            }
            __builtin_amdgcn_fence(__ATOMIC_ACQUIRE, "agent");
            if (lane == 0) flag[0] = dead ? 1u : 0u;
        }
        asm volatile("s_waitcnt vmcnt(0) lgkmcnt(0)" ::: "memory"); __builtin_amdgcn_s_barrier(); asm volatile("" ::: "memory");
        const bool bad = flag[0] != 0u;
        if (lane < 32) {
            const unsigned long long* slot = (const unsigned long long*)xbuf + (size_t)(u.pm * BM + row) * 4; float mt[4], m2[4]; float ms = 0.f;
#pragma unroll
            for (int t = 0; t < 4; ++t) { if (t < ntn) { const unsigned long long w = __hip_atomic_load(slot + t, __ATOMIC_RELAXED, __HIP_MEMORY_SCOPE_AGENT); mt[t] = __uint_as_float((unsigned)w); m2[t] = __uint_as_float((unsigned)(w >> 32)); } else { mt[t] = 0.f; m2[t] = 0.f; } ms += mt[t]; }
            const float mean = ms / (float)ntn; float q = 0.f;
#pragma unroll
            for (int t = 0; t < 4; ++t) if (t < ntn) { const float dm = mt[t] - mean; q += m2[t] + 256.0f * dm * dm; }
            S[row] = (f32x2v){mean, 1.0f / sqrtf(q / (256.0f * (float)ntn) + eps)};
        }
        asm volatile("s_waitcnt lgkmcnt(0)" ::: "memory"); __builtin_amdgcn_s_barrier(); asm volatile("" ::: "memory");
        return bad;
    }
};
struct EpiLnRes {
    static constexpr bool PERM = false, AFTER_DRAIN = true;
    const float* base; float* out; int ldc; const float* bias; PanelStats st; unsigned poison;
    __device__ __forceinline__ void fused(f32x4 (&acc)[2][2][4][2], const Unit& u, int wr, int wc, int fr, int fq, PG8_LAS unsigned char* lds, int wid, int lane) const {
        typedef float f32x2v __attribute__((ext_vector_type(2)));
        const PG8_LAS f32x2v* S = (const PG8_LAS f32x2v*)(lds + 8192);
        const int col0 = u.pn * BM + wc * 32 + 4 * fq;
#pragma unroll
        for (int bj = 0; bj < 2; ++bj)
#pragma unroll
            for (int n = 0; n < 2; ++n) { const f32x4 bv = bias ? *(const f32x4*)(bias + col0 + bj * HALF + n * 16) : (f32x4){0.f, 0.f, 0.f, 0.f};
#pragma unroll
                for (int ai = 0; ai < 2; ++ai)
#pragma unroll
                    for (int m = 0; m < 4; ++m) acc[ai][bj][m][n] += bv; }
        f32x4 pre[4][2][2];
#pragma unroll
        for (int m = 0; m < 4; ++m) { const size_t off = (size_t)(u.pm * BM + wr * 64 + m * 16 + fr) * ldc + col0;
#pragma unroll
            for (int bj = 0; bj < 2; ++bj)
#pragma unroll
                for (int n = 0; n < 2; ++n) pre[m][bj][n] = *(const f32x4*)(base + off + bj * HALF + n * 16); }
        const bool bad = st.run(acc, u, wr, wc, fr, fq, lds, wid, lane) || poison != 0u;
        const float qnan = __builtin_nanf("");
#pragma unroll
        for (int ai = 0; ai < 2; ++ai)
#pragma unroll
            for (int m = 0; m < 4; ++m) { const int r = ai * HALF + wr * 64 + m * 16 + fr; const f32x2v sr = S[r]; const size_t off = (size_t)(u.pm * BM + r) * ldc + col0;
#pragma unroll
                for (int bj = 0; bj < 2; ++bj)
#pragma unroll
                    for (int n = 0; n < 2; ++n) { const f32x4 bs = ai == 0 ? pre[m][bj][n] : *(const f32x4*)(base + off + bj * HALF + n * 16); f32x4 o = bs + (acc[ai][bj][m][n] - sr.x) * sr.y;
                        if (bad) o = (f32x4){qnan, qnan, qnan, qnan}; *(f32x4*)(out + off + bj * HALF + n * 16) = o; }
                if (m & 1) asm volatile("" ::: "memory"); }
    }
};
struct EpiLnResLn {
    static constexpr bool PERM = false, AFTER_DRAIN = true;
    const float* base; float* out; bf16_t* xn; int ldc; const float* bias; PanelStats st1, st2; unsigned poison;
    __device__ __forceinline__ void fused(f32x4 (&acc)[2][2][4][2], const Unit& u, int wr, int wc, int fr, int fq, PG8_LAS unsigned char* lds, int wid, int lane) const {
        typedef float f32x2v __attribute__((ext_vector_type(2))); typedef unsigned u32x2v __attribute__((ext_vector_type(2)));
        const PG8_LAS f32x2v* S = (const PG8_LAS f32x2v*)(lds + 8192);
        const int col0 = u.pn * BM + wc * 32 + 4 * fq;
#pragma unroll
        for (int bj = 0; bj < 2; ++bj)
#pragma unroll
            for (int n = 0; n < 2; ++n) { const f32x4 bv = bias ? *(const f32x4*)(bias + col0 + bj * HALF + n * 16) : (f32x4){0.f, 0.f, 0.f, 0.f};
#pragma unroll
                for (int ai = 0; ai < 2; ++ai)
#pragma unroll
                    for (int m = 0; m < 4; ++m) acc[ai][bj][m][n] += bv; }
        bool bad = st1.run(acc, u, wr, wc, fr, fq, lds, wid, lane) || poison != 0u;
        const float qnan = __builtin_nanf("");
#pragma unroll
        for (int ai = 0; ai < 2; ++ai)
#pragma unroll
            for (int m = 0; m < 4; ++m) { const int r = ai * HALF + wr * 64 + m * 16 + fr; const f32x2v sr = S[r]; const size_t off = (size_t)(u.pm * BM + r) * ldc + col0;
#pragma unroll
                for (int bj = 0; bj < 2; ++bj)
#pragma unroll
                    for (int n = 0; n < 2; ++n) { const f32x4 bs = *(const f32x4*)(base + off + bj * HALF + n * 16); acc[ai][bj][m][n] = bs + (acc[ai][bj][m][n] - sr.x) * sr.y; }
                asm volatile("" : "+v"(acc[ai][0][m][0]), "+v"(acc[ai][0][m][1]), "+v"(acc[ai][1][m][0]), "+v"(acc[ai][1][m][1]));
                if (m & 1) asm volatile("" ::: "memory"); }
        const bool bad1 = bad;
        bad = st2.run(acc, u, wr, wc, fr, fq, lds, wid, lane) || bad;
#pragma unroll
        for (int ai = 0; ai < 2; ++ai)
#pragma unroll
            for (int m = 0; m < 4; ++m) { const int r = ai * HALF + wr * 64 + m * 16 + fr; const f32x2v sr = S[r]; const size_t off = (size_t)(u.pm * BM + r) * ldc + col0;
#pragma unroll
                for (int bj = 0; bj < 2; ++bj)
#pragma unroll
                    for (int n = 0; n < 2; ++n) { const f32x4 x1 = acc[ai][bj][m][n]; *(f32x4*)(out + off + bj * HALF + n * 16) = bad1 ? (f32x4){qnan, qnan, qnan, qnan} : x1;
                        const f32x4 o = (x1 - sr.x) * sr.y; u32x2v w; w.x = cvt_pk_bf16(o[0], o[1]); w.y = cvt_pk_bf16(o[2], o[3]);
                        if (bad) { w.x = 0x7fc07fc0u; w.y = 0x7fc07fc0u; } *(u32x2v*)(xn + off + bj * HALF + n * 16) = w; }
                asm volatile("" ::: "memory"); }
    }
};

template <class Epi, class Sched, bool ALIGN_EPI = false, bool SP2 = false>
__device__ __forceinline__ void gemm_phase(PG8_LAS unsigned char* lds, const Gemm g, const Sched& S, const Epi& E) {
    const int tid = opaque_tid(), wid = __builtin_amdgcn_readfirstlane(tid >> 6), lane = tid & 63, wr = wid >> 2, wc = wid & 3, fr = lane & 15, fq = lane >> 4;
    const int K = g.K, nt = K / BK;
    unsigned voffA[2], voffB[2];
#pragma unroll
    for (int i = 0; i < 2; ++i) { int R, C; stage_rc(tid * 16 + i * 8192, R, C); const int Rb = Epi::PERM ? ((R & ~31) + perm32(R & 31)) : R;
        voffA[i] = (unsigned)(R * K + C) * 2u; voffB[i] = (unsigned)(Rb * K + C) * 2u; }
    const size_t kstep = (size_t)(BK * 2);
    const size_t hstep = (size_t)HALF * K * 2;
    const size_t tstep = 2 * hstep;
    const unsigned ldsw = (unsigned)wid * 1024u;
    const int aoff = lds_byte(wr * 64 + fr, fq * 8), boff = lds_byte(wc * 32 + fr, fq * 8);
#define PG8_SA(b, h) (((b) * 2 + (h)) * HTB)
#define PG8_SB(b, h) ((4 + (b) * 2 + (h)) * HTB)
#define PG8_STAGE(bufoff, gbase, voff) do { _Pragma("unroll") for (int _i = 0; _i < 2; ++_i) \
        __builtin_amdgcn_global_load_lds((const unsigned*)((const char*)(gbase) + (voff)[_i]), (PG8_LAS unsigned*)(lds + (bufoff) + ldsw + _i * 8192), 16, 0, 0); } while (0)
#define PG8_LDA(dst, b, h) do { _Pragma("unroll") for (int m = 0; m < 4; ++m) _Pragma("unroll") for (int k = 0; k < 2; ++k) dst[m][k] = *(const PG8_LAS bf16x8*)(lds + PG8_SA(b, h) + aoff + m * 2048 + k * 1024); } while (0)
#define PG8_LDB(dst, b, h) do { _Pragma("unroll") for (int n = 0; n < 2; ++n) _Pragma("unroll") for (int k = 0; k < 2; ++k) dst[n][k] = *(const PG8_LAS bf16x8*)(lds + PG8_SB(b, h) + boff + n * 2048 + k * 1024); } while (0)
#define PG8_MMA(ai, bj, At, Bt) do { __builtin_amdgcn_s_setprio(1); _Pragma("unroll") for (int m = 0; m < 4; ++m) _Pragma("unroll") for (int n = 0; n < 2; ++n) _Pragma("unroll") for (int k = 0; k < 2; ++k) \
        acc[ai][bj][m][n] = __builtin_amdgcn_mfma_f32_16x16x32_bf16(Bt[n][k], At[m][k], acc[ai][bj][m][n], 0, 0, 0); __builtin_amdgcn_s_setprio(0); } while (0)
#define PG8_WAIT_V(n) asm volatile("s_waitcnt vmcnt(" #n ")" ::: "memory")
#define PG8_WAIT_L(n) asm volatile("s_waitcnt lgkmcnt(" #n ")" ::: "memory")
#define PG8_BAR __builtin_amdgcn_s_barrier()
#define PG8_SCHED __builtin_amdgcn_sched_barrier(0)
    Unit cur, nxt; int ui = 0;
    if (!S.next(0, cur)) return;
    f32x4 acc[2][2][4][2];
#pragma unroll
    for (int a = 0; a < 2; ++a)
#pragma unroll
        for (int b = 0; b < 2; ++b)
#pragma unroll
            for (int m = 0; m < 4; ++m)
#pragma unroll
                for (int n = 0; n < 2; ++n) acc[a][b][m][n] = (f32x4){0.f, 0.f, 0.f, 0.f};
    bf16x8 At[4][2], B0[2][2], B1[2][2];
    const char* cA = (const char*)g.A + (size_t)cur.pm * tstep; const char* cB = (const char*)g.Bt + (size_t)cur.pn * tstep;
    S.a_ready(cur);
    if constexpr (SP2) {
        PG8_STAGE(PG8_SB(0, 0), cB, voffB); PG8_STAGE(PG8_SB(0, 1), cB + hstep, voffB); PG8_STAGE(PG8_SA(0, 0), cA, voffA); PG8_STAGE(PG8_SA(0, 1), cA + hstep, voffA);
        if (wr == 1) PG8_BAR;
        PG8_WAIT_V(2); PG8_BAR;
        PG8_STAGE(PG8_SB(1, 0), cB + kstep, voffB); PG8_STAGE(PG8_SA(1, 0), cA + kstep, voffA); PG8_STAGE(PG8_SB(1, 1), cB + hstep + kstep, voffB);
        PG8_WAIT_V(6); PG8_BAR;
    } else {
        PG8_STAGE(PG8_SB(0, 0), cB, voffB); PG8_STAGE(PG8_SA(0, 0), cA, voffA); PG8_STAGE(PG8_SB(0, 1), cB + hstep, voffB); PG8_STAGE(PG8_SA(0, 1), cA + hstep, voffA);
        if (wr == 1) PG8_BAR;
        PG8_WAIT_V(4); PG8_BAR;
        PG8_STAGE(PG8_SB(1, 0), cB + kstep, voffB); PG8_STAGE(PG8_SA(1, 0), cA + kstep, voffA); PG8_STAGE(PG8_SB(1, 1), cB + hstep + kstep, voffB);
        PG8_WAIT_V(6); PG8_BAR;
    }
    for (;;) {
        const bool has_next = S.next(ui + 1, nxt);
        const char* nA = has_next ? (const char*)g.A + (size_t)nxt.pm * tstep : cA; const char* nB = has_next ? (const char*)g.Bt + (size_t)nxt.pn * tstep : cB;
        for (int t = 0; t < nt; t += 2) {
            const bool last = (t == nt - 2);
            const char* a1 = cA + (size_t)(t + 1) * kstep;
            const char* a2 = last ? nA : cA + (size_t)(t + 2) * kstep; const char* b2 = last ? nB : cB + (size_t)(t + 2) * kstep;
            const char* a3 = a2 + kstep; const char* b3 = b2 + kstep;
            if (last && has_next) S.a_ready(nxt);
            if constexpr (SP2) {
            PG8_LDB(B0, 0, 0); PG8_LDB(B1, 0, 1); PG8_SCHED; PG8_LDA(At, 0, 0); PG8_STAGE(PG8_SA(1, 1), a1 + hstep, voffA);
            PG8_WAIT_V(8); PG8_WAIT_L(0); PG8_BAR; PG8_MMA(0, 0, At, B0); PG8_MMA(0, 1, At, B1); PG8_BAR; PG8_SCHED;
            PG8_LDA(At, 0, 1); PG8_STAGE(PG8_SB(0, 0), b2, voffB); PG8_STAGE(PG8_SB(0, 1), b2 + hstep, voffB); PG8_STAGE(PG8_SA(0, 0), a2, voffA);
            PG8_WAIT_V(8); PG8_WAIT_L(0); PG8_BAR; PG8_MMA(1, 0, At, B0); PG8_MMA(1, 1, At, B1); PG8_BAR; PG8_SCHED;
            PG8_LDB(B0, 1, 0); PG8_LDB(B1, 1, 1); PG8_SCHED; PG8_LDA(At, 1, 0); PG8_STAGE(PG8_SA(0, 1), a2 + hstep, voffA);
            PG8_WAIT_V(8); PG8_WAIT_L(0); PG8_BAR; PG8_MMA(0, 0, At, B0); PG8_MMA(0, 1, At, B1); PG8_BAR; PG8_SCHED;
            PG8_LDA(At, 1, 1); PG8_STAGE(PG8_SB(1, 0), b3, voffB); PG8_STAGE(PG8_SB(1, 1), b3 + hstep, voffB); PG8_STAGE(PG8_SA(1, 0), a3, voffA);
            PG8_WAIT_V(8); PG8_WAIT_L(0); PG8_BAR; PG8_MMA(1, 0, At, B0); PG8_MMA(1, 1, At, B1); PG8_BAR; PG8_SCHED;
            } else {
            PG8_LDB(B0, 0, 0); PG8_SCHED; PG8_LDA(At, 0, 0); PG8_STAGE(PG8_SA(1, 1), a1 + hstep, voffA);
            PG8_WAIT_L(8); PG8_BAR; PG8_WAIT_L(0); PG8_MMA(0, 0, At, B0); PG8_BAR; PG8_SCHED;
            PG8_LDB(B1, 0, 1); PG8_STAGE(PG8_SB(0, 0), b2, voffB);
            PG8_BAR; PG8_WAIT_L(0); PG8_MMA(0, 1, At, B1); PG8_BAR;
            PG8_LDA(At, 0, 1); PG8_STAGE(PG8_SA(0, 0), a2, voffA);
            PG8_BAR; PG8_WAIT_L(0); PG8_MMA(1, 0, At, B0); PG8_BAR; PG8_SCHED;
            PG8_STAGE(PG8_SB(0, 1), b2 + hstep, voffB);
            PG8_WAIT_V(6); PG8_BAR; PG8_MMA(1, 1, At, B1); PG8_BAR;
            PG8_LDB(B0, 1, 0); PG8_SCHED; PG8_LDA(At, 1, 0); PG8_STAGE(PG8_SA(0, 1), a2 + hstep, voffA);
            PG8_WAIT_L(8); PG8_BAR; PG8_WAIT_L(0); PG8_MMA(0, 0, At, B0); PG8_BAR; PG8_SCHED;
            PG8_LDB(B1, 1, 1); PG8_STAGE(PG8_SB(1, 0), b3, voffB);
            PG8_BAR; PG8_WAIT_L(0); PG8_MMA(0, 1, At, B1); PG8_BAR;
            PG8_LDA(At, 1, 1); PG8_STAGE(PG8_SA(1, 0), a3, voffA);
            PG8_BAR; PG8_WAIT_L(0); PG8_MMA(1, 0, At, B0); PG8_BAR; PG8_SCHED;
            PG8_STAGE(PG8_SB(1, 1), b3 + hstep, voffB);
            PG8_WAIT_V(6); PG8_BAR; PG8_MMA(1, 1, At, B1); PG8_BAR;
            }
        }
        if constexpr (ALIGN_EPI) { if (wr == 0) PG8_BAR; }
        if constexpr (!Epi::AFTER_DRAIN) { E(acc, cur, wr, wc, fr, fq); S.done(cur); }
        if (!has_next) break;
#pragma unroll
        for (int a = 0; a < 2; ++a)
#pragma unroll
            for (int b = 0; b < 2; ++b)
#pragma unroll
                for (int m = 0; m < 4; ++m)
#pragma unroll
                    for (int n = 0; n < 2; ++n) acc[a][b][m][n] = (f32x4){0.f, 0.f, 0.f, 0.f};
        cur = nxt; cA = nA; cB = nB; ++ui;
        if constexpr (ALIGN_EPI) { if (wr == 1) PG8_BAR; }
    }
    PG8_WAIT_V(0);
    if constexpr (!ALIGN_EPI) { if (wr == 0) PG8_BAR; }
    PG8_BAR;
    if constexpr (Epi::AFTER_DRAIN) { E.fused(acc, cur, wr, wc, fr, fq, lds, wid, lane); S.done(cur); }
#undef PG8_SA
#undef PG8_SB
#undef PG8_STAGE
#undef PG8_LDA
#undef PG8_LDB
#undef PG8_MMA
#undef PG8_WAIT_V
#undef PG8_WAIT_L
#undef PG8_BAR
#undef PG8_SCHED
}
}

#ifndef PG8_SP2
#define PG8_SP2 true
#endif
#ifndef PG8_ALIGN
#define PG8_ALIGN true
#endif
namespace pg8 {
constexpr int OUT_KP = 17301504, OUT_VP = 34078720, OUT_KS = 51122176, OUT_VS = 51646464;
constexpr int NSSQ = 32;
__device__ __forceinline__ float row_rstd(const float* ssq, int row) {
    const f32x4* p = (const f32x4*)(ssq + (size_t)row * NSSQ); float s = 0.f;
#pragma unroll
    for (int i = 0; i < NSSQ / 4; ++i) { const f32x4 a = p[i]; s += (a[0] + a[1]) + (a[2] + a[3]); }
    return __builtin_amdgcn_rsqf(s * (1.0f / 1024.0f) + 1e-6f);
}
template <int ACT, bool KVF32> struct EpiAct {
    static constexpr bool PERM = true, AFTER_DRAIN = false;
    bf16_t* O; int ldc; const float* ssq; int split_cols; size_t split_stride; float* fout;
    template <int NA, int NB> __device__ __forceinline__ void run(const f32x4 (&acc)[NA][NB][4][2], int rowt, int colt, bool sample, int wr, int wc, int fr, int fq) const {
        const int row0 = rowt + wr * 64 + fr; bf16_t* base = O; int t = 0;
        if (split_cols) { t = colt / split_cols; base += (size_t)t * split_stride; colt -= t * split_cols; }
        const int col0 = colt + wc * 32 + 8 * fq;
        float* fb = nullptr;
        if (KVF32) { if (t < 2) fb = fout + (!sample ? (size_t)(t == 0 ? OUT_KP : OUT_VP) : (size_t)(t == 0 ? OUT_KS : OUT_VS) - (size_t)16384 * 1024) + col0; }
        f32x4 pq[NA][4][2];
#pragma unroll
        for (int ai = 0; ai < NA; ++ai)
#pragma unroll
            for (int m = 0; m < 4; ++m) { const f32x4* p = (const f32x4*)(ssq + (size_t)(row0 + ai * HALF + m * 16) * NSSQ + 8 * fq); pq[ai][m][0] = p[0]; pq[ai][m][1] = p[1]; }
        float rsv[NA][4];
#pragma unroll
        for (int ai = 0; ai < NA; ++ai)
#pragma unroll
            for (int m = 0; m < 4; ++m) { const f32x4 a = pq[ai][m][0], b = pq[ai][m][1]; float sq = ((a[0] + a[1]) + (a[2] + a[3])) + ((b[0] + b[1]) + (b[2] + b[3]));
                sq += __shfl_xor(sq, 16); sq += __shfl_xor(sq, 32); rsv[ai][m] = __builtin_amdgcn_rsqf(sq * (1.0f / 1024.0f) + 1e-6f); }
#pragma unroll
        for (int ai = 0; ai < NA; ++ai)
#pragma unroll
            for (int m = 0; m < 4; ++m) { const int row = row0 + ai * HALF + m * 16; const float rs = rsv[ai][m];
                bf16_t* rowp = base + (size_t)row * ldc + col0;
#pragma unroll
                for (int bj = 0; bj < NB; ++bj) { f32x4 v0 = acc[ai][bj][m][0] * rs, v1 = acc[ai][bj][m][1] * rs;
                    if (ACT == 1) {
#pragma unroll
                        for (int e = 0; e < 4; ++e) { const float a = fmaxf(v0[e], 0.f), b = fmaxf(v1[e], 0.f); v0[e] = a * a; v1[e] = b * b; } }
                    if (KVF32) { if (fb) { float* fr_ = fb + (size_t)row * 1024 + bj * HALF; *(f32x4*)fr_ = v0; *(f32x4*)(fr_ + 4) = v1; } }
                    u32x4 w; w.x = cvt_pk_bf16(v0[0], v0[1]); w.y = cvt_pk_bf16(v0[2], v0[3]); w.z = cvt_pk_bf16(v1[0], v1[1]); w.w = cvt_pk_bf16(v1[2], v1[3]);
                    *(u32x4*)(rowp + bj * HALF) = w; } }
    }
    __device__ __forceinline__ void operator()(const f32x4 (&acc)[2][2][4][2], const Unit& u, int wr, int wc, int fr, int fq) const { run<2, 2>(acc, u.pm * BM, u.pn * BM, u.pm >= 64, wr, wc, fr, fq); }
};
struct EpiResid {
    static constexpr bool PERM = true, AFTER_DRAIN = false;
    float* X; bf16_t* XB; float* ssq; const float* Xp; const float* Xs;
    template <int NA, int NB> __device__ __forceinline__ void run(const f32x4 (&acc)[NA][NB][4][2], int rowt, int colt, bool sample, int wr, int wc, int fr, int fq) const {
        const int row0 = rowt + wr * 64 + fr; const int col0 = colt + wc * 32 + 8 * fq;
#pragma unroll
        for (int ai = 0; ai < NA; ++ai) {
            f32x4 xr[4][NB][2];
#pragma unroll
            for (int m = 0; m < 4; ++m) { const float* xp = (Xp ? (sample ? Xs - (size_t)16384 * 1024 : Xp) : (const float*)X) + (size_t)(row0 + ai * HALF + m * 16) * 1024 + col0;
#pragma unroll
                for (int bj = 0; bj < NB; ++bj) { xr[m][bj][0] = *(const f32x4*)(xp + bj * HALF); xr[m][bj][1] = *(const f32x4*)(xp + bj * HALF + 4); } }
#pragma unroll
            for (int m = 0; m < 4; ++m) { const int row = row0 + ai * HALF + m * 16; float* xp = X + (size_t)row * 1024 + col0; bf16_t* bp = XB + (size_t)row * 1024 + col0;
#pragma unroll
                for (int bj = 0; bj < NB; ++bj) { const f32x4 a0 = xr[m][bj][0] + acc[ai][bj][m][0], a1 = xr[m][bj][1] + acc[ai][bj][m][1];
                    *(f32x4*)(xp + bj * HALF) = a0; *(f32x4*)(xp + bj * HALF + 4) = a1;
                    float q = ((a0[0] * a0[0] + a0[1] * a0[1]) + (a0[2] * a0[2] + a0[3] * a0[3])) + ((a1[0] * a1[0] + a1[1] * a1[1]) + (a1[2] * a1[2] + a1[3] * a1[3]));
                    u32x4 w; w.x = cvt_pk_bf16(a0[0], a0[1]); w.y = cvt_pk_bf16(a0[2], a0[3]); w.z = cvt_pk_bf16(a1[0], a1[1]); w.w = cvt_pk_bf16(a1[2], a1[3]);
                    *(u32x4*)(bp + bj * HALF) = w;
                    q += __shfl_xor(q, 16); q += __shfl_xor(q, 32);
                    if (fq == 0) ssq[(size_t)row * NSSQ + ((colt + bj * HALF) >> 7) * 4 + wc] = q; } }
            asm volatile("" ::: "memory"); }
    }
    __device__ __forceinline__ void operator()(const f32x4 (&acc)[2][2][4][2], const Unit& u, int wr, int wc, int fr, int fq) const { run<2, 2>(acc, u.pm * BM, u.pn * BM, u.pm >= 64, wr, wc, fr, fq); }
};
__device__ __forceinline__ void glds16(const void* gsrc, unsigned lds_dst) { unsigned keep;
    asm volatile("s_mov_b32 %0, m0\n\ts_mov_b32 m0, %2\n\ts_nop 0\n\tglobal_load_lds_dwordx4 %1, off\n\ts_mov_b32 m0, %0" : "=&s"(keep) : "v"(gsrc), "s"(lds_dst) : "memory"); }
template <class Epi>
__device__ __forceinline__ void gemm128_tile(PG8_LAS unsigned char* lds, const bf16_t* A, const bf16_t* Bt, int K, const Epi& E, int rowt, int colt) {
    const int tid = opaque_tid(), wid = __builtin_amdgcn_readfirstlane(tid >> 6), lane = tid & 63, wr = wid >> 2, wc = wid & 3, fr = lane & 15, fq = lane >> 4;
    const int nt = K / BK;
    const char* gA[2]; const char* gB[2];
#pragma unroll
    for (int i = 0; i < 2; ++i) { int R, C; stage_rc(tid * 16 + i * 8192, R, C); const int Rb = (R & ~31) + perm32(R & 31);
        gA[i] = (const char*)A + (size_t)(R * K + C) * 2; gB[i] = (const char*)Bt + (size_t)(Rb * K + C) * 2; }
    const unsigned lds0 = (unsigned)(uintptr_t)lds + (unsigned)wid * 1024u;
    const int aoff = lds_byte(wr * 64 + fr, fq * 8), boff = lds_byte(wc * 32 + fr, fq * 8);
#define G128_STAGE(s, kt) do { _Pragma("unroll") for (int _i = 0; _i < 2; ++_i) { \
        glds16(gA[_i] + (size_t)(kt) * (BK * 2), (unsigned)__builtin_amdgcn_readfirstlane(lds0 + (unsigned)((s) * 2 * HTB + _i * 8192))); \
        glds16(gB[_i] + (size_t)(kt) * (BK * 2), (unsigned)__builtin_amdgcn_readfirstlane(lds0 + (unsigned)((s) * 2 * HTB + HTB + _i * 8192))); } } while (0)
    f32x4 acc[1][1][4][2];
#pragma unroll
    for (int m = 0; m < 4; ++m)
#pragma unroll
        for (int n = 0; n < 2; ++n) acc[0][0][m][n] = (f32x4){0.f, 0.f, 0.f, 0.f};
    G128_STAGE(0, 0); G128_STAGE(1, 1); G128_STAGE(2, 2);
    for (int t = 0; t < nt; ++t) {
        const int rem = nt - 1 - t;
        if (rem >= 2) asm volatile("s_waitcnt vmcnt(8)" ::: "memory"); else if (rem == 1) asm volatile("s_waitcnt vmcnt(4)" ::: "memory"); else asm volatile("s_waitcnt vmcnt(0)" ::: "memory");
        __builtin_amdgcn_s_barrier(); asm volatile("" ::: "memory");
        if (t + 3 < nt) G128_STAGE((t + 3) & 3, t + 3);
        const PG8_LAS unsigned char* sb = lds + (t & 3) * 2 * HTB;
        bf16x8 At[4][2], Bf[2][2];
#pragma unroll
        for (int m = 0; m < 4; ++m)
#pragma unroll
            for (int k = 0; k < 2; ++k) At[m][k] = *(const PG8_LAS bf16x8*)(sb + aoff + m * 2048 + k * 1024);
#pragma unroll
        for (int n = 0; n < 2; ++n)
#pragma unroll
            for (int k = 0; k < 2; ++k) Bf[n][k] = *(const PG8_LAS bf16x8*)(sb + HTB + boff + n * 2048 + k * 1024);
        asm volatile("s_waitcnt lgkmcnt(0)" ::: "memory");
#pragma unroll
        for (int m = 0; m < 4; ++m)
#pragma unroll
            for (int n = 0; n < 2; ++n)
#pragma unroll
                for (int k = 0; k < 2; ++k) acc[0][0][m][n] = __builtin_amdgcn_mfma_f32_16x16x32_bf16(Bf[n][k], At[m][k], acc[0][0][m][n], 0, 0, 0);
    }
#undef G128_STAGE
    E.template run<1, 1>(acc, rowt, colt, true, wr, wc, fr, fq);
    asm volatile("s_waitcnt lgkmcnt(0)" ::: "memory"); __builtin_amdgcn_s_barrier(); asm volatile("" ::: "memory");
}
}
#include <hip/hip_bf16.h>
#include <cmath>
namespace attn_body {
using bf16=__hip_bfloat16;
using bf16x8=__attribute__((ext_vector_type(8)))short;
using s16x4=__attribute__((ext_vector_type(4)))short;
using f32x16=__attribute__((ext_vector_type(16)))float;
using u32x4=__attribute__((ext_vector_type(4)))unsigned;
constexpr int BATCH=1,NHEAD=16,SEQ=16384,D=64,DM=NHEAD*D;
constexpr int NW=8,QBLK=32,QB=QBLK*NW,KVBLK=64,NQB=SEQ/QB;
constexpr int ATTN_PITCH=DM, ATTN_UNIT_ROWS=QB;
__device__ __forceinline__ int crow(int r,int hi){return (r&3)+8*(r>>2)+4*hi;}
#define SBAR() __builtin_amdgcn_sched_barrier(0)
__device__ __forceinline__ void cmask(f32x16&p0,f32x16&p1,int jb,int qrel,int hi){
  const float NEG=-INFINITY; int kb=64*jb+4*hi;
  #pragma unroll
  for(int r=0;r<16;++r){int kv=kb+(r&3)+8*(r>>2); if(kv>qrel)p0[r]=NEG; if(kv+32>qrel)p1[r]=NEG;}
}

constexpr int NSLOT=3, SLOTB=8192;
constexpr int LDS_K=0, LDS_V=NSLOT*SLOTB, LDS_WS=2*NSLOT*SLOTB, LDS_OST=LDS_WS+NW*64*4, LDS_CK=LDS_OST+NW*4096, LDS_BYTES=LDS_CK+SEQ*4;
constexpr float C2=0.125f*1.4426950408889634f;
__device__ __forceinline__ void glds16(const void*gsrc,unsigned lds_dst){unsigned keep;
  asm volatile("s_mov_b32 %0, m0\n\ts_mov_b32 m0, %2\n\ts_nop 0\n\tglobal_load_lds_dwordx4 %1, off\n\ts_mov_b32 m0, %0":"=&s"(keep):"v"(gsrc),"s"(lds_dst):"memory");}
__device__ __forceinline__ void glds16s(const void*sbase,unsigned voff,unsigned lds_dst){unsigned keep;
  asm volatile("s_mov_b32 %0, m0\n\ts_mov_b32 m0, %3\n\ts_nop 0\n\tglobal_load_lds_dwordx4 %1, %2\n\ts_mov_b32 m0, %0":"=&s"(keep):"v"(voff),"s"(sbase),"s"(lds_dst):"memory");}
__device__ __forceinline__ float max3f(float a,float b,float c){float r;asm("v_max3_f32 %0, %1, %2, %3":"=v"(r):"v"(a),"v"(b),"v"(c));return r;}
__device__ __forceinline__ float max2f(float a,float b){float r;asm("v_max_f32_e32 %0, %1, %2":"=v"(r):"v"(a),"v"(b));return r;}
__device__ __forceinline__ float fadd_s(float a,float b){float r;asm("v_add_f32_e32 %0, %1, %2":"=v"(r):"v"(a),"v"(b));return r;}
__device__ __forceinline__ float fsub_s(float a,float b){float r;asm("v_sub_f32_e32 %0, %1, %2":"=v"(r):"v"(a),"v"(b));return r;}
typedef float f32x2_t __attribute__((ext_vector_type(2))); typedef __bf16 bf16x2_t __attribute__((ext_vector_type(2)));
__device__ __forceinline__ unsigned cvtpk_s(float lo,float hi){f32x2_t v={lo,hi};bf16x2_t b=__builtin_convertvector(v,bf16x2_t);return __builtin_bit_cast(unsigned,b);}
#define WAIT_BAR(N) asm volatile("s_waitcnt vmcnt(" #N ") lgkmcnt(0)\n\ts_barrier":::"memory")

__device__ __forceinline__ void qkt(f32x16&p0,f32x16&p1,const char*Kslot,const bf16x8*qr,const f32x16&negm,int r32,int hi){
  const char*kb=Kslot+hi*1024+r32*16;
  #pragma unroll
  for(int d0=0;d0<4;++d0){
    const bf16x8 b0=*reinterpret_cast<const bf16x8*>(kb+d0*2048);
    const bf16x8 b1=*reinterpret_cast<const bf16x8*>(kb+d0*2048+512);
    if(d0==0){p0=__builtin_amdgcn_mfma_f32_32x32x16_bf16(b0,qr[0],negm,0,0,0);p1=__builtin_amdgcn_mfma_f32_32x32x16_bf16(b1,qr[0],negm,0,0,0);}
    else{p0=__builtin_amdgcn_mfma_f32_32x32x16_bf16(b0,qr[d0],p0,0,0,0);p1=__builtin_amdgcn_mfma_f32_32x32x16_bf16(b1,qr[d0],p1,0,0,0);}}
}
typedef __attribute__((address_space(3))) const char* lds_cptr;
typedef short v4i16_t __attribute__((ext_vector_type(4)));
__device__ __forceinline__ void kload8(bf16x8*kf,lds_cptr kp){
  kf[0]=*(const __attribute__((address_space(3))) bf16x8*)(kp);      kf[1]=*(const __attribute__((address_space(3))) bf16x8*)(kp+512);
  kf[2]=*(const __attribute__((address_space(3))) bf16x8*)(kp+2048); kf[3]=*(const __attribute__((address_space(3))) bf16x8*)(kp+2560);
  kf[4]=*(const __attribute__((address_space(3))) bf16x8*)(kp+4096); kf[5]=*(const __attribute__((address_space(3))) bf16x8*)(kp+4608);
  kf[6]=*(const __attribute__((address_space(3))) bf16x8*)(kp+6144); kf[7]=*(const __attribute__((address_space(3))) bf16x8*)(kp+6656);
}
__device__ __forceinline__ void kload2(bf16x8*kf,lds_cptr kp,int j){ kf[2*j]=*(const __attribute__((address_space(3))) bf16x8*)(kp+j*2048); kf[2*j+1]=*(const __attribute__((address_space(3))) bf16x8*)(kp+j*2048+512); }
__device__ __forceinline__ s16x4 vtr(lds_cptr p){ return __builtin_bit_cast(s16x4,__builtin_amdgcn_ds_read_tr16_b64_v4i16((__attribute__((address_space(3))) v4i16_t*)p)); }
__device__ __forceinline__ float rowmax(const f32x16&p0,const f32x16&p1){
  float a=max3f(p0[0],p0[1],p1[0]),b=max3f(p0[2],p0[3],p1[1]);a=max3f(a,p1[2],p1[3]);
  #pragma unroll
  for(int r=4;r<16;r+=4){a=max3f(a,p0[r],p0[r+1]);b=max3f(b,p0[r+2],p0[r+3]);a=max3f(a,p1[r],p1[r+1]);b=max3f(b,p1[r+2],p1[r+3]);}
  const float m=max2f(a,b);
  auto rr=__builtin_amdgcn_permlane32_swap(__float_as_uint(m),__float_as_uint(m),false,false);
  return max2f(__uint_as_float(rr[0]),__uint_as_float(rr[1]));
}
__device__ __forceinline__ void pv(f32x16*o,int vb,bf16x8 pa0,bf16x8 pa1,bf16x8 pa2,bf16x8 pa3){
  #pragma unroll
  for(int d0=0;d0<2;++d0){s16x4 lo[4],hi[4];
    #pragma unroll
    for(int ks=0;ks<4;++ks){
      asm volatile("ds_read_b64_tr_b16 %0,%1 offset:%c2":"=&v"(lo[ks]):"v"(vb),"i"(d0*4096+ks*1024):"memory");
      asm volatile("ds_read_b64_tr_b16 %0,%1 offset:%c2":"=&v"(hi[ks]):"v"(vb),"i"(d0*4096+ks*1024+512):"memory");}
    asm volatile("s_waitcnt lgkmcnt(0)":::"memory");SBAR();
    #define PK(k) (bf16x8){lo[k][0],lo[k][1],lo[k][2],lo[k][3],hi[k][0],hi[k][1],hi[k][2],hi[k][3]}
    o[d0]=__builtin_amdgcn_mfma_f32_32x32x16_bf16(pa0,PK(0),o[d0],0,0,0);
    o[d0]=__builtin_amdgcn_mfma_f32_32x32x16_bf16(pa1,PK(1),o[d0],0,0,0);
    o[d0]=__builtin_amdgcn_mfma_f32_32x32x16_bf16(pa2,PK(2),o[d0],0,0,0);
    o[d0]=__builtin_amdgcn_mfma_f32_32x32x16_bf16(pa3,PK(3),o[d0],0,0,0);
    #undef PK
  }
}

#ifndef ATTN_STORE16
#define ATTN_STORE16(p,v) (*(u32x4*)(p)=(v))
#endif
typedef float f32x4_t __attribute__((ext_vector_type(4)));
#define CKSUB(C0,C1,t) do{ const __attribute__((address_space(3))) f32x4_t* ck_=(const __attribute__((address_space(3))) f32x4_t*)(ckl+(t)*64+4*hi); \
   _Pragma("unroll") for(int g_=0;g_<4;++g_){ const f32x4_t a_=ck_[2*g_], b_=ck_[8+2*g_]; \
     _Pragma("unroll") for(int i_=0;i_<4;++i_){ C0[4*g_+i_]-=a_[i_]; C1[4*g_+i_]-=b_[i_]; } } }while(0)
template<int THRL> __device__ __forceinline__ void attn_unit(int b,int h,int qb,const bf16*Q,const bf16*__restrict__ K,const bf16*__restrict__ V,bf16*O,char*shm,const float*ckg,const float kmax2){
  const int tid=opaque_tid(),lane=tid&63,r32=lane&31,hi=lane>>5; const int wid=__builtin_amdgcn_readfirstlane(tid>>6);
  const long rowbase=(long)b*SEQ; const int q0=qb*QB;
  const bf16*Qw=Q+(rowbase+q0+wid*QBLK)*DM+h*D;
  const unsigned lds0=(unsigned)(uintptr_t)shm;
  float*wsf=(float*)(shm+LDS_WS)+wid*64;
  __attribute__((address_space(3))) float* ckl=(__attribute__((address_space(3))) float*)((__attribute__((address_space(3))) char*)shm+LDS_CK);
  const float cqv=ckg[q0+wid*QBLK+r32];
  bf16x8 qr[4];
  #pragma unroll
  for(int d0=0;d0<4;++d0)qr[d0]=*reinterpret_cast<const bf16x8*>(&Qw[(long)r32*DM+d0*16+hi*8]);
  int t0=0;
  if(qb>0){
    float*wsa=(float*)(shm+LDS_WS);
    float qs=0.f;
    #pragma unroll
    for(int d0=0;d0<4;++d0){
      #pragma unroll
      for(int e=0;e<8;++e){ const float v_=__builtin_bit_cast(float,((unsigned)(unsigned short)qr[d0][e])<<16); qs+=v_*v_; } }
    qs+=__shfl_xor(qs,32);
    #pragma unroll
    for(int o_=1;o_<32;o_<<=1) qs=fmaxf(qs,__shfl_xor(qs,o_));
    float dg=0.f;
    { const bf16*Kq=K+(rowbase+q0+wid*QBLK)*DM+h*D;
      #pragma unroll
      for(int d0=0;d0<4;++d0){ const bf16x8 kd_=*reinterpret_cast<const bf16x8*>(&Kq[(long)r32*DM+d0*16+hi*8]);
        #pragma unroll
        for(int e=0;e<8;++e){ dg+=__builtin_bit_cast(float,((unsigned)(unsigned short)qr[d0][e])<<16)*__builtin_bit_cast(float,((unsigned)(unsigned short)kd_[e])<<16); } } }
    dg+=__shfl_xor(dg,32);
    #pragma unroll
    for(int o_=1;o_<32;o_<<=1) dg=fminf(dg,__shfl_xor(dg,o_));
    const int ncand=q0/KVBLK;
    float cend=0.f; if(tid<ncand) cend=ckg[tid*KVBLK+KVBLK-1];
    const float cq0=ckg[q0];
    if(lane==0){ wsa[wid]=qs; wsa[16+wid]=dg; }
    __syncthreads();
    float qm=wsa[0];
    #pragma unroll
    for(int w_=1;w_<NW;++w_) qm=fmaxf(qm,wsa[w_]);
    float dmn=wsa[16];
    #pragma unroll
    for(int w_=1;w_<NW;++w_) dmn=fminf(dmn,wsa[16+w_]);
    const float thr=dmn-40.05f-sqrtf(qm*kmax2)*1.0001f;
    const bool skip_=(tid<ncand)&&((cq0-cend)<thr);
    const unsigned long long bal_=__ballot(skip_);
    if(lane==0) wsa[8+wid]=(float)__popcll(bal_);
    __syncthreads();
    float cnt_=0.f;
    #pragma unroll
    for(int w_=0;w_<NW;++w_) cnt_+=wsa[8+w_];
    t0=__builtin_amdgcn_readfirstlane(((int)cnt_)&~1);
    __syncthreads();
  }
  const bf16*Kh=K+(rowbase+(long)t0*KVBLK)*DM+h*D,*Vh=V+(rowbase+(long)t0*KVBLK)*DM+h*D;
  { const int nf4=(q0+QB-t0*KVBLK)>>2; const f32x4_t* src_=(const f32x4_t*)(ckg+t0*KVBLK); __attribute__((address_space(3))) f32x4_t* dst_=(__attribute__((address_space(3))) f32x4_t*)ckl;
    for(int i_=tid;i_<nf4;i_+=NW*64) dst_[i_]=src_[i_]; }
  const unsigned kvoff=(unsigned)((lane*DM+wid*8)*2);
  const unsigned vvoff=(unsigned)(((16*(wid&3)+(lane>>2))*DM+(wid>>2)*32+(lane&3)*8)*2);
  const unsigned kdst=lds0+LDS_K+wid*1024, vdst=lds0+LDS_V+wid*1024;
  #define DMA_K(t,slot) glds16s(Kh+(long)(t)*KVBLK*DM,kvoff,(unsigned)__builtin_amdgcn_readfirstlane(kdst+(slot)))
  #define DMA_V(t,slot) glds16s(Vh+(long)(t)*KVBLK*DM,vvoff,(unsigned)__builtin_amdgcn_readfirstlane(vdst+(slot)))
  const int vb0=(int)(lds0+LDS_V)+((lane>>4)&1)*32+(lane&3)*8+(4*hi+((lane&15)>>2))*64;
  const char*Kbase=shm+LDS_K; bf16x8 kf[8];
  const lds_cptr shm3=(lds_cptr)shm; const lds_cptr kp0=shm3+LDS_K+hi*1024+r32*16; const lds_cptr vp0=shm3+LDS_V+((lane>>4)&1)*32+(lane&3)*8+(4*hi+((lane&15)>>2))*64;
  const int NT=(q0+QB)/KVBLK-t0;
  DMA_K(0,0);DMA_V(0,0);DMA_K(1,SLOTB);
  float mhat=-cqv,l_reg=0.f;    f32x16 o[2];o[0]=f32x16{};o[1]=f32x16{};f32x16 negm;
  #pragma unroll
  for(int r=0;r<16;++r)negm[r]=cqv;
  asm volatile("":"+v"(negm));
  const int qrel=wid*QBLK+r32;
  #define CMASK(P0,P1,t) do{int jb_=(t)-(NT-4); if(jb_>=0)cmask(P0,P1,jb_,qrel,hi);}while(0)
  bool resc=false;
  #define START(P0,P1) do{ const float rm=rowmax(P0,P1); resc=false; \
    { const float dl=rm; mhat=fadd_s(mhat,dl); \
      _Pragma("unroll") for(int r=0;r<16;++r){P0[r]=fsub_s(P0[r],dl);P1[r]=fsub_s(P1[r],dl);} \
      _Pragma("unroll") for(int r=0;r<16;++r)negm[r]=-mhat; asm volatile("":"+v"(negm)); } \
    _Pragma("unroll") for(int r=0;r<16;++r)P0[r]=__builtin_amdgcn_exp2f(P0[r]); }while(0)
  #define RESC() do{ if(resc){ asm volatile("s_waitcnt lgkmcnt(0)":::"memory"); \
      _Pragma("unroll") for(int d_=0;d_<2;++d_) _Pragma("unroll") for(int r=0;r<16;++r)o[d_][r]*=wsf[crow(r,hi)]; } }while(0)
  f32x16 pA0,pA1,pB0,pB1;
  int sl_prev=0,sl_cur=0,sl_next=SLOTB;
  #define ROT() do{sl_prev=sl_cur;sl_cur=sl_next;sl_next=(sl_next==(NSLOT-1)*SLOTB)?0:sl_next+SLOTB;}while(0)
  DMA_K(2,2*SLOTB);
  WAIT_BAR(3);
  qkt(pA0,pA1,Kbase,qr,negm,r32,hi);asm volatile("s_nop 15\n\ts_nop 7":"+v"(pA0),"+v"(pA1));CKSUB(pA0,pA1,0);CMASK(pA0,pA1,0);
  START(pA0,pA1);
  _Pragma("unroll") for(int r=0;r<16;++r)pA1[r]=__builtin_amdgcn_exp2f(pA1[r]);
  WAIT_BAR(0);
  DMA_K(3,0);DMA_V(1,SLOTB);
  ROT();
  kload8(kf,kp0+sl_cur);
  WAIT_BAR(2);
  s16x4 vlo[8],vhi[8]; u32x4 pw0,pw1,pw2,pw3;
  #define PKW(P,B) cvtpk_s(P[B],P[B+1])
  #define PAF(k) __builtin_bit_cast(bf16x8,pw##k)
  #define VFR(i) (bf16x8){vlo[i][0],vlo[i][1],vlo[i][2],vlo[i][3],vhi[i][0],vhi[i][1],vhi[i][2],vhi[i][3]}
  #define PIN(x) asm volatile("":"+v"(x))
  #define MX3(a,b,c) __builtin_fmaxf(__builtin_fmaxf((a),(b)),(c))
  #define GAPA(MF,A0,A1,A2,A3,W0,W1,PW) do{ MF; sacc+=A0; sacc+=A1; sacc+=A2; sacc+=A3; PIN(sacc); W0; W1; PIN(PW); SBAR(); }while(0)
  #define EX(v) __builtin_amdgcn_exp2f(v)
  #define GAPB(MF,X,B) do{ MF; X[B]=EX(X[B]); X[B+1]=EX(X[B+1]); X[B+2]=EX(X[B+2]); X[B+3]=EX(X[B+3]); PIN(X); SBAR(); }while(0)
  #define VRD(i) do{ vlo[i]=vtr(vp_+(((i)>>2)*4096+((i)&3)*1024)); vhi[i]=vtr(vp_+(((i)>>2)*4096+((i)&3)*1024+512)); }while(0)
  #define KRD(G,j) do{ if(G){ kload2(kf,kp0+sl_next,j); SBAR(); } }while(0)
  #define STEP(C0,C1,P0,P1,t,GK,GV,GL) do{ SBAR(); \
    const lds_cptr vp_=vp0+sl_prev; \
    VRD(0); SBAR(); float sacc=(P0[0]+P0[1]); \
    GAPA(C0=__builtin_amdgcn_mfma_f32_32x32x16_bf16(kf[0],qr[0],negm,0,0,0), P0[2],P0[3],P0[4],P0[5],     pw0[0]=PKW(P0,0), pw0[1]=PKW(P0,2), pw0); \
    VRD(4); SBAR(); GAPA(C1=__builtin_amdgcn_mfma_f32_32x32x16_bf16(kf[1],qr[0],negm,0,0,0), P0[6],P0[7],P0[8],P0[9],     pw0[2]=PKW(P0,4), pw0[3]=PKW(P0,6), pw0); \
    VRD(1); SBAR(); GAPA(C0=__builtin_amdgcn_mfma_f32_32x32x16_bf16(kf[2],qr[1],C0,0,0,0),   P0[10],P0[11],P0[12],P0[13], pw1[0]=PKW(P0,8), pw1[1]=PKW(P0,10), pw1); \
    VRD(5); SBAR(); GAPA(C1=__builtin_amdgcn_mfma_f32_32x32x16_bf16(kf[3],qr[1],C1,0,0,0),   P0[14],P0[15],P1[0],P1[1],   pw1[2]=PKW(P0,12),pw1[3]=PKW(P0,14), pw1); \
    VRD(2); SBAR(); GAPA(C0=__builtin_amdgcn_mfma_f32_32x32x16_bf16(kf[4],qr[2],C0,0,0,0),   P1[2],P1[3],P1[4],P1[5],     pw2[0]=PKW(P1,0), pw2[1]=PKW(P1,2), pw2); \
    VRD(6); SBAR(); GAPA(C1=__builtin_amdgcn_mfma_f32_32x32x16_bf16(kf[5],qr[2],C1,0,0,0),   P1[6],P1[7],P1[8],P1[9],     pw2[2]=PKW(P1,4), pw2[3]=PKW(P1,6), pw2); \
    VRD(3); SBAR(); GAPA(C0=__builtin_amdgcn_mfma_f32_32x32x16_bf16(kf[6],qr[3],C0,0,0,0),   P1[10],P1[11],P1[12],P1[13], pw3[0]=PKW(P1,8), pw3[1]=PKW(P1,10), pw3); \
    VRD(7); SBAR(); GAPA(C1=__builtin_amdgcn_mfma_f32_32x32x16_bf16(kf[7],qr[3],C1,0,0,0),   P1[14],P1[15],0.f,0.f,       pw3[2]=PKW(P1,12),pw3[3]=PKW(P1,14), pw3); \
    l_reg+=sacc; \
    if(GK){DMA_K((t)+3,sl_cur);} if(GV){DMA_V((t)+1,sl_next);} \
    CKSUB(C0,C1,t); CMASK(C0,C1,t); \
    { float a=MX3(C0[0],C0[1],C1[0]),b=MX3(C0[2],C0[3],C1[1]); a=MX3(a,C1[2],C1[3]); \
      _Pragma("unroll") for(int r=4;r<16;r+=4){a=MX3(a,C0[r],C0[r+1]);b=MX3(b,C0[r+2],C0[r+3]);a=MX3(a,C1[r],C1[r+1]);b=MX3(b,C1[r+2],C1[r+3]);} \
      float rm=__builtin_fmaxf(a,b); { auto rr=__builtin_amdgcn_permlane32_swap(__float_as_uint(rm),__float_as_uint(rm),false,false); rm=__builtin_fmaxf(__uint_as_float(rr[0]),__uint_as_float(rr[1])); } \
      resc=false; \
      if(__builtin_expect(__any(rm>(float)THRL),0)){ const float dl=__builtin_fmaxf(rm,0.f); mhat+=dl; \
        _Pragma("unroll") for(int r=0;r<16;++r){C0[r]-=dl;C1[r]-=dl;} \
        _Pragma("unroll") for(int r=0;r<16;++r)negm[r]=-mhat; asm volatile("":"+v"(negm)); \
        const float f=__builtin_amdgcn_exp2f(-dl); l_reg*=f; if(hi==0)wsf[r32]=f; resc=true; } } \
    SBAR(); \
    GAPB(o[0]=__builtin_amdgcn_mfma_f32_32x32x16_bf16(PAF(0),VFR(0),o[0],0,0,0), C0,0); \
    GAPB(o[1]=__builtin_amdgcn_mfma_f32_32x32x16_bf16(PAF(0),VFR(4),o[1],0,0,0), C0,4); \
    KRD(GL,0); GAPB(o[0]=__builtin_amdgcn_mfma_f32_32x32x16_bf16(PAF(1),VFR(1),o[0],0,0,0), C0,8); \
    KRD(GL,1); GAPB(o[1]=__builtin_amdgcn_mfma_f32_32x32x16_bf16(PAF(1),VFR(5),o[1],0,0,0), C0,12); \
    KRD(GL,2); GAPB(o[0]=__builtin_amdgcn_mfma_f32_32x32x16_bf16(PAF(2),VFR(2),o[0],0,0,0), C1,0); \
    KRD(GL,3); GAPB(o[1]=__builtin_amdgcn_mfma_f32_32x32x16_bf16(PAF(2),VFR(6),o[1],0,0,0), C1,4); \
    GAPB(o[0]=__builtin_amdgcn_mfma_f32_32x32x16_bf16(PAF(3),VFR(3),o[0],0,0,0), C1,8); \
    GAPB(o[1]=__builtin_amdgcn_mfma_f32_32x32x16_bf16(PAF(3),VFR(7),o[1],0,0,0), C1,12); \
    }while(0)
  int t=1;
  #undef CMASK
  #define CMASK(P0,P1,t) do{}while(0)
  for(;t+5<NT;t+=2){
    STEP(pB0,pB1,pA0,pA1,t,true,true,true);     WAIT_BAR(2); RESC(); ROT();
    STEP(pA0,pA1,pB0,pB1,t+1,true,true,true);   WAIT_BAR(2); RESC(); ROT();
  }
  #undef CMASK
  #define CMASK(P0,P1,t) do{int jb_=(t)-(NT-4); if(jb_>=0)cmask(P0,P1,jb_,qrel,hi);}while(0)
  #define ENDW(tt) do{ if((tt)+3<NT){WAIT_BAR(2);} else if((tt)+2<NT){WAIT_BAR(1);} else {WAIT_BAR(0);} }while(0)
  for(;t+1<NT;t+=2){
    STEP(pB0,pB1,pA0,pA1,t,(t+3<NT),(t+1<NT),(t+1<NT));       ENDW(t);   RESC(); ROT();
    STEP(pA0,pA1,pB0,pB1,t+1,(t+4<NT),(t+2<NT),(t+2<NT));     ENDW(t+1); RESC(); ROT();
  }
  STEP(pB0,pB1,pA0,pA1,NT-1,false,false,false); RESC();
  { float sacc=pB0[0]+pB0[1]; _Pragma("unroll") for(int r=2;r<16;++r)sacc+=pB0[r]; _Pragma("unroll") for(int r=0;r<16;++r)sacc+=pB1[r]; l_reg+=sacc;
    pw0=(u32x4){PKW(pB0,0),PKW(pB0,2),PKW(pB0,4),PKW(pB0,6)};pw1=(u32x4){PKW(pB0,8),PKW(pB0,10),PKW(pB0,12),PKW(pB0,14)};pw2=(u32x4){PKW(pB1,0),PKW(pB1,2),PKW(pB1,4),PKW(pB1,6)};pw3=(u32x4){PKW(pB1,8),PKW(pB1,10),PKW(pB1,12),PKW(pB1,14)};
    SBAR(); pv(o,vb0+sl_cur,PAF(0),PAF(1),PAF(2),PAF(3)); }
  #undef PKW
  #undef PAF
  #undef VFR
  #undef PIN
  #undef MX3
  #undef GAPA
  #undef GAPB
  #undef EX
  #undef VRD
  #undef KRD
  #undef STEP
  #undef ENDW
  {auto rr=__builtin_amdgcn_permlane32_swap(__float_as_uint(l_reg),__float_as_uint(l_reg),false,false);l_reg=__uint_as_float(rr[0])+__uint_as_float(rr[1]);}
  if(hi==0)wsf[32+r32]=l_reg;asm volatile("s_waitcnt lgkmcnt(0)":::"memory");
  float rli[16];
  #pragma unroll
  for(int r=0;r<16;++r)rli[r]=__builtin_amdgcn_rcpf(wsf[32+crow(r,hi)]);
  bf16*Ow=O+(rowbase+q0+wid*QBLK)*DM+h*D;
  { bf16*stg=(bf16*)(shm+LDS_OST)+wid*2048;
    #pragma unroll
    for(int r=0;r<16;++r){const int orow=crow(r,hi);
      #pragma unroll
      for(int d0=0;d0<2;++d0)stg[orow*64+d0*32+r32]=__float2bfloat16(o[d0][r]*rli[r]);}
    asm volatile("s_waitcnt lgkmcnt(0)":::"memory");
    #pragma unroll
    for(int i=0;i<4;++i){const int row=i*8+(lane>>3),ch=lane&7; const u32x4 v=*(const u32x4*)(stg+row*64+ch*8); ATTN_STORE16(Ow+(long)row*DM+ch*8,v);} }
  asm volatile("s_waitcnt lgkmcnt(0)\n\ts_barrier":::"memory");
  #undef DMA_K
  #undef DMA_V
  #undef CMASK
  #undef START
  #undef RESC
  #undef ROT
}
constexpr int ATTN_LDS_BYTES=LDS_BYTES;
struct AttnTensors { const bf16* Q; const bf16* K; const bf16* V; bf16* O; const float* CL; const unsigned* KMAX; };
struct AttnUnit { int bh; int qb; };
template<int THRL=8> __device__ __forceinline__ void attn_phase_q(char*lds,const AttnTensors&T,unsigned*qctr,int block){
  volatile __attribute__((address_space(3))) int* tk=(volatile __attribute__((address_space(3))) int*)((__attribute__((address_space(3))) char*)lds+LDS_WS);
  for(;;){
    if(threadIdx.x==0){ int v=-1,q=block&7; for(int tried=0;tried<8;++tried){ const unsigned i_=__hip_atomic_fetch_add(qctr+64*q,1u,__ATOMIC_RELAXED,__HIP_MEMORY_SCOPE_AGENT); if(i_<128u){ v=(int)(q*128u+i_); break; } q=(q+1)&7; } tk[0]=v; }
    __syncthreads();
    const int u=__builtin_amdgcn_readfirstlane(tk[0]);
    __syncthreads();
    if(u<0)break;
    const int qq=u>>7,i_=u&127,h=2*qq+(i_&1),qb=63-(i_>>1);
    attn_unit<THRL>(0,h,qb,T.Q,T.K,T.V,T.O,lds,T.CL+(size_t)h*SEQ,__builtin_bit_cast(float,T.KMAX[h]));
  }
}
#undef SBAR
#undef WAIT_BAR
}
namespace sattn {
#define SLAS __attribute__((address_space(3)))
typedef short bf16x8 __attribute__((ext_vector_type(8)));
typedef float f32x4 __attribute__((ext_vector_type(4)));
typedef unsigned u32x4 __attribute__((ext_vector_type(4)));
typedef unsigned u32x2 __attribute__((ext_vector_type(2)));
typedef float f32x2_t __attribute__((ext_vector_type(2))); typedef __bf16 bf16x2_t __attribute__((ext_vector_type(2)));
__device__ __forceinline__ unsigned pk(float lo, float hi) { f32x2_t v = {lo, hi}; bf16x2_t b = __builtin_convertvector(v, bf16x2_t); return __builtin_bit_cast(unsigned, b); }
__device__ __forceinline__ bf16x8 cvt8(f32x4 a, f32x4 b) { u32x4 w; w.x = pk(a[0], a[1]); w.y = pk(a[2], a[3]); w.z = pk(b[0], b[1]); w.w = pk(b[2], b[3]); return __builtin_bit_cast(bf16x8, w); }
constexpr int PAST = 2048, NEWK = 16, LKEYS = PAST + NEWK, VT_STRIDE = 80, VT_BYTES = 64 * VT_STRIDE;
constexpr int L_VT = 0, L_CO = 8 * VT_BYTES, L_CM = L_CO + 8 * 16 * 64 * 4, L_CL = L_CM + 8 * 16 * 4, L_END = L_CL + 8 * 16 * 4;
constexpr float NEG = -1.0e30f;
struct Tensors { const float* ck; const float* cv; const unsigned short* QB; const unsigned short* KB; const unsigned short* VB; unsigned short* O; const float* CLS; };
__device__ __forceinline__ void tile_tail(f32x4 (&s)[2], const bf16x8 (&vw)[4], float& m, float& l, f32x4 (&o)[4], SLAS char* vt, int r, int g) {
    float mx = fmaxf(fmaxf(fmaxf(s[0][0], s[0][1]), fmaxf(s[0][2], s[0][3])), fmaxf(fmaxf(s[1][0], s[1][1]), fmaxf(s[1][2], s[1][3])));
    mx = fmaxf(mx, __shfl_xor(mx, 16)); mx = fmaxf(mx, __shfl_xor(mx, 32));
    const float mn = fmaxf(m, mx), alpha = __builtin_amdgcn_exp2f(m - mn); m = mn;
    float ps = 0.f;
#pragma unroll
    for (int j = 0; j < 2; ++j)
#pragma unroll
        for (int e = 0; e < 4; ++e) { s[j][e] = __builtin_amdgcn_exp2f(s[j][e] - mn); ps += s[j][e]; }
    l = l * alpha + ps;
#pragma unroll
    for (int db = 0; db < 4; ++db) o[db] *= alpha;
    const bf16x8 pb = cvt8(s[0], s[1]);
#pragma unroll
    for (int dd = 0; dd < 4; ++dd) *(SLAS bf16x8*)(vt + (4 * r + dd) * VT_STRIDE + g * 16) = vw[dd];
#pragma unroll
    for (int db = 0; db < 4; ++db) { const bf16x8 va = *(const SLAS bf16x8*)(vt + (16 * db + r) * VT_STRIDE + g * 16); o[db] = __builtin_amdgcn_mfma_f32_16x16x32_bf16(va, pb, o[db], 0, 0, 0); }
}
__device__ __forceinline__ void unit(int b, int h, const Tensors& T, SLAS char* lds) {
    const int tid = opaque_tid(), lane = tid & 63, r = lane & 15, g = lane >> 4; const int wid = __builtin_amdgcn_readfirstlane(tid >> 6);
    SLAS char* vt = lds + L_VT + wid * VT_BYTES;
    const size_t srow = (size_t)16384 + (size_t)b * 16;
    const float* cls = T.CLS + (size_t)(b * 16 + h) * LKEYS;
    const unsigned short* qp = T.QB + (srow + r) * 1024 + h * 64 + 8 * g;
    const bf16x8 qf0 = *(const bf16x8*)qp, qf1 = *(const bf16x8*)(qp + 32);
    const float cq = cls[PAST + r];
    float m = NEG, l = 0.f; f32x4 o[4];
#pragma unroll
    for (int db = 0; db < 4; ++db) o[db] = (f32x4){0.f, 0.f, 0.f, 0.f};
    const float* kc = T.ck + ((size_t)b * PAST * 16 + h) * 64; const float* vc = T.cv + ((size_t)b * PAST * 16 + h) * 64;
    for (int tI = 0; tI < 8; ++tI) {
        const int k0 = wid * 256 + tI * 32;
        bf16x8 ka[2][2];
#pragma unroll
        for (int j = 0; j < 2; ++j)
#pragma unroll
            for (int dh = 0; dh < 2; ++dh) { const float* p = kc + (size_t)(k0 + 16 * j + r) * 1024 + dh * 32 + 8 * g; ka[j][dh] = cvt8(*(const f32x4*)p, *(const f32x4*)(p + 4)); }
        f32x4 vv[2][4];
#pragma unroll
        for (int j = 0; j < 2; ++j)
#pragma unroll
            for (int e = 0; e < 4; ++e) vv[j][e] = *(const f32x4*)(vc + (size_t)(k0 + 16 * j + 4 * g + e) * 1024 + 4 * r);
        f32x4 ckv[2];
#pragma unroll
        for (int j = 0; j < 2; ++j) ckv[j] = *(const f32x4*)(cls + k0 + 16 * j + 4 * g);
        f32x4 s[2];
#pragma unroll
        for (int j = 0; j < 2; ++j) { s[j] = __builtin_amdgcn_mfma_f32_16x16x32_bf16(ka[j][0], qf0, (f32x4){0.f, 0.f, 0.f, 0.f}, 0, 0, 0); s[j] = __builtin_amdgcn_mfma_f32_16x16x32_bf16(ka[j][1], qf1, s[j], 0, 0, 0); }
#pragma unroll
        for (int j = 0; j < 2; ++j)
#pragma unroll
            for (int e = 0; e < 4; ++e) s[j][e] += cq - ckv[j][e];
        bf16x8 vw[4];
#pragma unroll
        for (int dd = 0; dd < 4; ++dd) { u32x4 w; w.x = pk(vv[0][0][dd], vv[0][1][dd]); w.y = pk(vv[0][2][dd], vv[0][3][dd]); w.z = pk(vv[1][0][dd], vv[1][1][dd]); w.w = pk(vv[1][2][dd], vv[1][3][dd]); vw[dd] = __builtin_bit_cast(bf16x8, w); }
        tile_tail(s, vw, m, l, o, vt, r, g);
    }
    if (wid == 0) {
        bf16x8 ka[2]; { const unsigned short* p = T.KB + (srow + r) * 1024 + h * 64 + 8 * g; ka[0] = *(const bf16x8*)p; ka[1] = *(const bf16x8*)(p + 32); }
        const f32x4 ckv = *(const f32x4*)(cls + PAST + 4 * g);
        f32x4 s[2];
        s[0] = __builtin_amdgcn_mfma_f32_16x16x32_bf16(ka[0], qf0, (f32x4){0.f, 0.f, 0.f, 0.f}, 0, 0, 0); s[0] = __builtin_amdgcn_mfma_f32_16x16x32_bf16(ka[1], qf1, s[0], 0, 0, 0);
#pragma unroll
        for (int e = 0; e < 4; ++e) { s[0][e] += cq - ckv[e]; if (4 * g + e > r) s[0][e] = NEG; s[1][e] = NEG; }
        unsigned short ve[4][4];
#pragma unroll
        for (int e = 0; e < 4; ++e) { const u32x2 w = *(const u32x2*)(T.VB + (srow + 4 * g + e) * 1024 + h * 64 + 4 * r); ve[e][0] = (unsigned short)(w.x & 0xffffu); ve[e][1] = (unsigned short)(w.x >> 16); ve[e][2] = (unsigned short)(w.y & 0xffffu); ve[e][3] = (unsigned short)(w.y >> 16); }
        bf16x8 vw[4];
#pragma unroll
        for (int dd = 0; dd < 4; ++dd) { u32x4 w; w.x = (unsigned)ve[0][dd] | ((unsigned)ve[1][dd] << 16); w.y = (unsigned)ve[2][dd] | ((unsigned)ve[3][dd] << 16); w.z = 0u; w.w = 0u; vw[dd] = __builtin_bit_cast(bf16x8, w); }
        tile_tail(s, vw, m, l, o, vt, r, g);
    }
    l += __shfl_xor(l, 16); l += __shfl_xor(l, 32);
    SLAS float* co = (SLAS float*)(lds + L_CO) + (wid * 16 + r) * 64; SLAS float* cm = (SLAS float*)(lds + L_CM); SLAS float* cl = (SLAS float*)(lds + L_CL);
#pragma unroll
    for (int db = 0; db < 4; ++db) *(SLAS f32x4*)(co + 16 * db + 4 * g) = o[db];
    if (g == 0) { cm[wid * 16 + r] = m; cl[wid * 16 + r] = l; }
    __syncthreads();
    { const int q = tid >> 5, d2 = (tid & 31) * 2; float mm = NEG;
#pragma unroll
      for (int w = 0; w < 8; ++w) mm = fmaxf(mm, cm[w * 16 + q]);
      float den = 0.f, n0 = 0.f, n1 = 0.f;
#pragma unroll
      for (int w = 0; w < 8; ++w) { const float f = __builtin_amdgcn_exp2f(cm[w * 16 + q] - mm); den += f * cl[w * 16 + q]; const SLAS float* c = (const SLAS float*)(lds + L_CO) + (w * 16 + q) * 64 + d2; n0 += f * c[0]; n1 += f * c[1]; }
      const float inv = 1.0f / den;
      *(unsigned*)(T.O + (srow + q) * 1024 + h * 64 + d2) = pk(n0 * inv, n1 * inv); }
    __syncthreads();
}
#undef SLAS
}
namespace cg = cooperative_groups;
constexpr int NWAVES = 8;
constexpr int D = 1024, H = 16, FF = 4096, MP = 16384, MS = 512, M = MP + MS, PAST = 2048, DBATCH = 32, DSEQ = 16, LKEYS = PAST + DSEQ;
constexpr float RMS_EPS = 1e-6f, L2E = 1.4426950408889634f, QSCALE = 0.125f * 1.4426950408889634f;
constexpr size_t OUT_Y = 0, OUT_KP = 17301504, OUT_VP = 34078720, OUT_LP = 50855936, OUT_CP = 51118080, OUT_KS = 51122176, OUT_VS = 51646464, OUT_LS = 52170752, OUT_CS = 52178944, OUT_END = 52310016;
static_assert(OUT_KP == (size_t)pg8::OUT_KP && OUT_VP == (size_t)pg8::OUT_VP && OUT_KS == (size_t)pg8::OUT_KS && OUT_VS == (size_t)pg8::OUT_VS, "d_out map");
constexpr size_t MiB = 1u << 20;
constexpr size_t WS_CTL = 0, CTL_ZERO_BYTES = 1 * MiB;
constexpr size_t WS_WIN = 2 * MiB, WS_WOUT = 14 * MiB, WS_WKVQ = 18 * MiB, WS_WQ1 = 24 * MiB, WS_WO = 26 * MiB, WS_WUP = 30 * MiB, WS_WDN = 62 * MiB, WS_WF = 94 * MiB;
constexpr size_t WS_X = 96 * MiB, WS_XB = 162 * MiB, WS_G = 195 * MiB, WS_KB = 228 * MiB, WS_VB = 261 * MiB, WS_QB = 294 * MiB, WS_HB = 327 * MiB, WS_SSQ = 459 * MiB, WS_CLP = 462 * MiB, WS_CLS = 463 * MiB, WS_END = 468 * MiB;
static_assert((size_t)M * D * 4 == 66 * MiB && (size_t)M * FF * 2 == 132 * MiB && (size_t)512 * LKEYS * 4 <= 5 * MiB && (size_t)M * pg8::NSSQ * 4 <= 3 * MiB, "d_ws map");
constexpr int CW_BAR = 4096, CW_KMAX = 2048, CW_ATQ = 2304  ;
constexpr int RING_OFF = 0, RING_BYTES = 131072;
constexpr int ATT_LDS = attn_body::LDS_BYTES;
constexpr int LDSCTL_OFF = (ATT_LDS > RING_BYTES ? ATT_LDS : RING_BYTES), MISC_OFF = LDSCTL_OFF + 320;
constexpr int LDS_BYTES = LDSCTL_OFF + 1024;
static_assert(LDS_BYTES <= 163840 && sattn::L_END <= RING_BYTES, "LDS map");

#define GAS __attribute__((address_space(1)))
#define LAS __attribute__((address_space(3)))
typedef unsigned short bf16;
typedef unsigned v4u __attribute__((ext_vector_type(4)));
typedef unsigned v2u __attribute__((ext_vector_type(2)));
typedef float f32x4 __attribute__((ext_vector_type(4)));
typedef short bf16x8 __attribute__((ext_vector_type(8)));
typedef GAS unsigned gu32;
#define RLX_AGENT __ATOMIC_RELAXED, __HIP_MEMORY_SCOPE_AGENT
#define LDS_WAIT() asm volatile("s_waitcnt lgkmcnt(0)" ::: "memory")
#define VM_WAIT() asm volatile("s_waitcnt vmcnt(0)" ::: "memory")
__device__ __forceinline__ unsigned pk2(float lo, float hi) { return sattn::pk(lo, hi); }
__device__ __forceinline__ float bflo(unsigned w) { return __builtin_bit_cast(float, w << 16); }
__device__ __forceinline__ float bfhi(unsigned w) { return __builtin_bit_cast(float, w & 0xffff0000u); }
#define XB_TMO      128
#define XB_XCNT(j)  (256  + 64 * (j))
#define XB_XSUB(j)  (1280 + 64 * (j))
#define XB_XGEN(j)  (2304 + 64 * (j))
#define XB_TOP      3328
#define XB_TOPGEN   3392
#define XCD_BAR_WORDS 3456
#define XB_SPIN_CAP (1u << 18)

__device__ __forceinline__ unsigned xb_ld(unsigned* p)              { return __hip_atomic_load(p, __ATOMIC_RELAXED, __HIP_MEMORY_SCOPE_AGENT); }
__device__ __forceinline__ unsigned xb_add(unsigned* p, unsigned v) { return __hip_atomic_fetch_add(p, v, __ATOMIC_RELAXED, __HIP_MEMORY_SCOPE_AGENT); }
__device__ __forceinline__ unsigned xb_xcc_id() { return (unsigned)__builtin_amdgcn_s_getreg((3 << 11) | 20) & 0xFu; }
#define XB_SPIN(cond, bar) do { unsigned _sp = 0; while (cond) { __builtin_amdgcn_s_sleep(1); \
    if ((++_sp & 255u) == 0u) { if (xb_ld(&(bar)[XB_TMO])) break; if (_sp > XB_SPIN_CAP) { atomicAdd(&(bar)[XB_TMO], 1u); break; } } } } while (0)

struct XcdBarrier {
    unsigned* bar; unsigned x;
    volatile LAS unsigned* st;
};

__device__ __forceinline__ XcdBarrier xcd_barrier_post(unsigned* bar, volatile LAS unsigned* st) {
    XcdBarrier b; b.bar = bar; b.x = xb_xcc_id(); b.st = st;
    if (threadIdx.x == 0) (void)xb_add(&bar[XB_XCNT(b.x)], 1u);
    return b;
}
__device__ __forceinline__ void xcd_barrier_complete(unsigned* bar, unsigned x, unsigned& nloc, unsigned& nx) {
    const unsigned G = gridDim.x * gridDim.y * gridDim.z;
    unsigned sum, cnt, mine, sp = 0u;
    for (;;) {
        sum = 0u; cnt = 0u; mine = 0u;
#pragma unroll
        for (unsigned j = 0; j < 16; ++j) { const unsigned c = xb_ld(&bar[XB_XCNT(j)]); sum += c; cnt += (c > 0u) ? 1u : 0u; mine = (j == x) ? c : mine; }
        if (sum == G) break;
        __builtin_amdgcn_s_sleep(1);
        if ((++sp & 255u) == 0u) { if (xb_ld(&bar[XB_TMO])) break; if (sp > XB_SPIN_CAP) { atomicAdd(&bar[XB_TMO], 1u); break; } }
    }
    nloc = mine > 0u ? mine : 1u; nx = cnt > 0u ? cnt : 1u;
}

__device__ __forceinline__ void xcd_barrier(const XcdBarrier& b) {
    asm volatile("s_waitcnt vmcnt(0)" ::: "memory");
    __syncthreads();
    if (threadIdx.x == 0) {
        unsigned* bar = b.bar;
        __builtin_amdgcn_s_waitcnt(0);
        unsigned nloc = b.st[0], nx = b.st[1];
        if (nloc == 0u) { xcd_barrier_complete(bar, b.x, nloc, nx); b.st[0] = nloc; b.st[1] = nx; }
        const unsigned old = xb_add(&bar[XB_XSUB(b.x)], 1u);
        const unsigned gen = old / nloc;
        if (old + 1u == (gen + 1u) * nloc) {
            __builtin_amdgcn_fence(__ATOMIC_RELEASE, "agent");
            asm volatile("s_waitcnt vmcnt(0)" ::: "memory");
            const unsigned og = xb_add(&bar[XB_TOP], 1u);
            const unsigned tg = og / nx;
            if (og + 1u == (tg + 1u) * nx) xb_add(&bar[XB_TOPGEN], 1u);
            else XB_SPIN(xb_ld(&bar[XB_TOPGEN]) == tg, bar);
            __builtin_amdgcn_fence(__ATOMIC_ACQUIRE, "agent");
            xb_add(&bar[XB_XGEN(b.x)], 1u);
            asm volatile("s_waitcnt vmcnt(0)" ::: "memory");
        } else {
            XB_SPIN(xb_ld(&bar[XB_XGEN(b.x)]) == gen, bar);
            __builtin_amdgcn_fence(__ATOMIC_ACQUIRE, "agent");
            asm volatile("s_waitcnt vmcnt(0)" ::: "memory");
        }
    }
    __syncthreads();
}
struct Args { const float* in[21]; float* out; unsigned char* ws; };
typedef const __attribute__((address_space(4))) Args* KArgs;
__device__ __forceinline__ KArgs kargs() { KArgs p = (KArgs)__builtin_amdgcn_kernarg_segment_ptr(); asm volatile("" : "+s"(p)); return p; }
struct Frame {
    LAS unsigned char* lds; volatile LAS unsigned* MISC; gu32* ctl;
    int tid, lane, wave, vcu, G;
};
__device__ __forceinline__ float wave_sum(float v) {
#pragma unroll
    for (int o = 1; o < 64; o <<= 1) v += __shfl_xor(v, o);
    return v;
}
constexpr int P0_TILE_FLOATS = 64 * 65;
__device__ __forceinline__ void p0_transpose_item(const float* W, int K, int N, bf16* WT, int row_off, LAS float* scr, int item, int lane, const float* gain, float scale) {
    const int nblk = N / 64, kb = item / nblk, nb = item % nblk, k0 = 64 * kb, n0 = 64 * nb;
    const int c4 = lane & 15, kr = lane >> 4;
    f32x4 v[16];
#pragma unroll
    for (int i = 0; i < 16; ++i) v[i] = *(const GAS f32x4*)(W + (size_t)(k0 + 4 * i + kr) * N + n0 + 4 * c4);
#pragma unroll
    for (int i = 0; i < 16; ++i) { const int kk = 4 * i + kr; const float gsc = gain ? gain[k0 + kk] * scale : scale; LAS float* d = scr + kk * 65 + 4 * c4;
        d[0] = v[i].x * gsc; d[1] = v[i].y * gsc; d[2] = v[i].z * gsc; d[3] = v[i].w * gsc; }
    LDS_WAIT(); asm volatile("" ::: "memory");
    const int c = lane & 7;
#pragma unroll
    for (int j = 0; j < 8; ++j) { const int n = (lane >> 3) + 8 * j; const LAS float* s = scr + (8 * c) * 65 + n;
        v4u o; o.x = pk2(s[0 * 65], s[1 * 65]); o.y = pk2(s[2 * 65], s[3 * 65]); o.z = pk2(s[4 * 65], s[5 * 65]); o.w = pk2(s[6 * 65], s[7 * 65]);
        *(GAS v4u*)(WT + (size_t)(row_off + n0 + n) * K + k0 + 8 * c) = o; }
    LDS_WAIT(); asm volatile("" ::: "memory");
}
enum { I_XP = 0, I_XS, I_CK, I_CV, I_CLF, I_SC, I_NMIX, I_NMLP, I_CIN, I_CW, I_COUT, I_NKV, I_WK, I_WV, I_WF, I_BF, I_WQ, I_WO, I_UP, I_DN, I_NF };

__device__ __forceinline__ void p0_prologue(const Frame& F, KArgs a, unsigned char* ws) {
    const int T_tid = opaque_tid(), T_lane = T_tid & 63, T_wave = __builtin_amdgcn_readfirstlane(T_tid >> 6);
    LAS float* scr = (LAS float*)(F.lds + RING_OFF) + T_wave * P0_TILE_FLOATS;
    const int gw = F.vcu * NWAVES + T_wave, NGW = F.G * NWAVES;
    constexpr int NCHUNK = 46;
    for (int it = gw; it < NCHUNK * 256; it += NGW) {
        int c = it >> 8, base = 0; const float* src = nullptr; const float* gain = nullptr; bf16* dst = nullptr; int roff = 0, K = D, N = D; float sc = 1.f;
        if (c < 6) { const int l = c / 3; src = a->in[I_CIN] + (size_t)l * D * 3 * D; gain = a->in[I_NMIX] + l * D; dst = (bf16*)(ws + WS_WIN) + (size_t)l * 3 * D * D; N = 3 * D; base = l * 3; }
        else if (c < 8) { const int l = c - 6; src = a->in[I_COUT] + (size_t)l * D * D; dst = (bf16*)(ws + WS_WOUT) + (size_t)l * D * D; base = c; }
        else if (c < 9) { src = a->in[I_WK]; gain = a->in[I_NKV]; dst = (bf16*)(ws + WS_WKVQ); base = c; }
        else if (c < 10) { src = a->in[I_WV]; gain = a->in[I_NKV]; dst = (bf16*)(ws + WS_WKVQ); roff = D; base = c; }
        else if (c < 11) { src = a->in[I_WQ]; gain = a->in[I_NMIX] + 2 * D; dst = (bf16*)(ws + WS_WKVQ); roff = 2 * D; sc = QSCALE; base = c; }
        else if (c < 12) { src = a->in[I_WQ] + (size_t)D * D; gain = a->in[I_NMIX] + 3 * D; dst = (bf16*)(ws + WS_WQ1); sc = QSCALE; base = c; }
        else if (c < 14) { const int j = c - 12; src = a->in[I_WO] + (size_t)j * D * D; dst = (bf16*)(ws + WS_WO) + (size_t)j * D * D; base = c; }
        else if (c < 30) { const int l = (c - 14) >> 2; src = a->in[I_UP] + (size_t)l * D * FF; gain = a->in[I_NMLP] + l * D; dst = (bf16*)(ws + WS_WUP) + (size_t)l * D * FF; N = FF; base = 14 + 4 * l; }
        else { const int l = (c - 30) >> 2; src = a->in[I_DN] + (size_t)l * D * FF; dst = (bf16*)(ws + WS_WDN) + (size_t)l * D * FF; K = FF; base = 30 + 4 * l; }
        p0_transpose_item(src, K, N, dst, roff, scr, it - base * 256, T_lane, gain, sc);
    }
    for (int i = (F.vcu * NWAVES + T_wave) * 64 + T_lane; i < D * H; i += NGW * 64) { const int k = i >> 4, h = i & 15; ((bf16*)(ws + WS_WF))[h * D + k] = (bf16)(pk2(a->in[I_NKV][k] * a->in[I_WF][i], 0.f) & 0xffffu); }
    bf16* XB = (bf16*)(ws + WS_XB); float* SSQ = (float*)(ws + WS_SSQ);
    for (int m = gw; m < M; m += NGW) {
        const float* xr = (m < MP) ? a->in[I_XP] + (size_t)m * D : a->in[I_XS] + (size_t)(m - MP) * D;
        const GAS f32x4* xp = (const GAS f32x4*)xr + T_lane; f32x4 v[4]; float s = 0.f;
#pragma unroll
        for (int j = 0; j < 4; ++j) { v[j] = xp[64 * j]; s += (v[j].x * v[j].x + v[j].y * v[j].y) + (v[j].z * v[j].z + v[j].w * v[j].w); }
        s = wave_sum(s);
        GAS v2u* bo = (GAS v2u*)(XB + (size_t)m * D) + T_lane;
#pragma unroll
        for (int j = 0; j < 4; ++j) { v2u w; w.x = pk2(v[j].x, v[j].y); w.y = pk2(v[j].z, v[j].w); bo[64 * j] = w; }
        if (T_lane < pg8::NSSQ) SSQ[(size_t)m * pg8::NSSQ + T_lane] = (T_lane == 0) ? s : 0.f;
    }
}
__device__ __forceinline__ void conv_gate_phase(const Frame& F, KArgs a, unsigned char* ws, int l) {
    const int T_tid = opaque_tid(), T_lane = T_tid & 63, T_wave = __builtin_amdgcn_readfirstlane(T_tid >> 6);
    const int gw = F.vcu * NWAVES + T_wave, NGW = F.G * NWAVES;
    const bf16* BCX = (const bf16*)(ws + WS_HB); bf16* Gm = (bf16*)(ws + WS_G);
    const float* cw = a->in[I_CW] + (size_t)l * 3 * D;
    for (int it = gw; it < (M / 4) * 2; it += NGW) {
        const int half = it & 1, row0 = (it >> 1) * 4, c0 = half * 512 + T_lane * 8;
        float w0[8], w1[8], w2[8], um2[8], um1[8];
        { const f32x4 a0 = *(const f32x4*)(cw + c0), a1 = *(const f32x4*)(cw + c0 + 4), b0 = *(const f32x4*)(cw + D + c0), b1 = *(const f32x4*)(cw + D + c0 + 4), d0 = *(const f32x4*)(cw + 2 * D + c0), d1 = *(const f32x4*)(cw + 2 * D + c0 + 4);
#pragma unroll
          for (int e = 0; e < 4; ++e) { w0[e] = a0[e]; w0[4 + e] = a1[e]; w1[e] = b0[e]; w1[4 + e] = b1[e]; w2[e] = d0[e]; w2[4 + e] = d1[e]; } }
        const bool sample = row0 >= MP; const int sb = sample ? (row0 - MP) >> 4 : 0; const int t0 = sample ? (row0 - MP) & 15 : row0;
        if (t0 == 0) {
            if (sample) { const float* st = a->in[I_SC] + ((size_t)(l * DBATCH + sb) * 2) * D + c0;
                const f32x4 p0 = *(const f32x4*)st, p1 = *(const f32x4*)(st + 4), q0 = *(const f32x4*)(st + D), q1 = *(const f32x4*)(st + D + 4);
#pragma unroll
                for (int e = 0; e < 4; ++e) { um2[e] = p0[e]; um2[4 + e] = p1[e]; um1[e] = q0[e]; um1[4 + e] = q1[e]; } }
            else {
#pragma unroll
                for (int e = 0; e < 8; ++e) { um2[e] = 0.f; um1[e] = 0.f; } }
        } else {
#pragma unroll
            for (int k = 0; k < 2; ++k) { const bf16* rp = BCX + (size_t)(row0 - 2 + k) * 3072 + c0; const v4u gc = *(const v4u*)(rp + D), xv = *(const v4u*)(rp + 2 * D);
#pragma unroll
                for (int e = 0; e < 4; ++e) { const float u0 = bflo(gc[e]) * bflo(xv[e]), u1 = bfhi(gc[e]) * bfhi(xv[e]); if (k == 0) { um2[2 * e] = u0; um2[2 * e + 1] = u1; } else { um1[2 * e] = u0; um1[2 * e + 1] = u1; } } }
        }
#pragma unroll
        for (int i = 0; i < 4; ++i) { const bf16* rp = BCX + (size_t)(row0 + i) * 3072 + c0; const v4u gb = *(const v4u*)rp, gc = *(const v4u*)(rp + D), xv = *(const v4u*)(rp + 2 * D);
            float u[8], o[8];
#pragma unroll
            for (int e = 0; e < 4; ++e) { u[2 * e] = bflo(gc[e]) * bflo(xv[e]); u[2 * e + 1] = bfhi(gc[e]) * bfhi(xv[e]); }
#pragma unroll
            for (int e = 0; e < 8; ++e) o[e] = w0[e] * um2[e] + w1[e] * um1[e] + w2[e] * u[e];
            v4u w;
#pragma unroll
            for (int e = 0; e < 4; ++e) w[e] = pk2(bflo(gb[e]) * o[2 * e], bfhi(gb[e]) * o[2 * e + 1]);
            *(v4u*)(Gm + (size_t)(row0 + i) * D + c0) = w;
#pragma unroll
            for (int e = 0; e < 8; ++e) { um2[e] = um1[e]; um1[e] = u[e]; } }
        const bool last = sample ? (t0 == 12) : (row0 + 4 == MP);
        if (last) { float* o = a->out + (sample ? OUT_CS + ((size_t)(l * DBATCH + sb) * 2) * D : OUT_CP + (size_t)l * 2 * D) + c0;
            *(f32x4*)o = (f32x4){um2[0], um2[1], um2[2], um2[3]}; *(f32x4*)(o + 4) = (f32x4){um2[4], um2[5], um2[6], um2[7]};
            *(f32x4*)(o + D) = (f32x4){um1[0], um1[1], um1[2], um1[3]}; *(f32x4*)(o + D + 4) = (f32x4){um1[4], um1[5], um1[6], um1[7]}; }
    }
}
__device__ __forceinline__ void logf_phase(const Frame& F, KArgs a, unsigned char* ws) {
    const int T_tid = opaque_tid(), T_lane = T_tid & 63, T_wave = __builtin_amdgcn_readfirstlane(T_tid >> 6);
    const int gw = F.vcu * NWAVES + T_wave, NGW = F.G * NWAVES; const int r = T_lane & 15, g = T_lane >> 4;
    const bf16* WF = (const bf16*)(ws + WS_WF); const bf16* XB = (const bf16*)(ws + WS_XB); const float* SSQ = (const float*)(ws + WS_SSQ);
    for (int blk = gw; blk < M / 16; blk += NGW) {
        const int row = blk * 16 + r; f32x4 acc = (f32x4){0.f, 0.f, 0.f, 0.f};
        const bf16* ap = WF + (size_t)r * D + 8 * g; const bf16* bp = XB + (size_t)row * D + 8 * g;
#pragma unroll 8
        for (int s = 0; s < 32; ++s) acc = __builtin_amdgcn_mfma_f32_16x16x32_bf16(*(const bf16x8*)(ap + 32 * s), *(const bf16x8*)(bp + 32 * s), acc, 0, 0, 0);
        const float rs = pg8::row_rstd(SSQ, row); const f32x4 bfv = *(const f32x4*)(a->in[I_BF] + 4 * g); f32x4 o;
#pragma unroll
        for (int e = 0; e < 4; ++e) { const float z = acc[e] * rs + bfv[e]; o[e] = fminf(z, 0.f) - log1pf(expf(-fabsf(z))); }
        float* op = a->out + ((row < MP) ? OUT_LP + (size_t)row * 16 : OUT_LS + (size_t)(row - MP) * 16) + 4 * g;
        *(f32x4*)op = o;
    }
}
__device__ __forceinline__ double wave_scan_incl(double v, int lane) {
#pragma unroll
    for (int o = 1; o < 64; o <<= 1) { const double t = __shfl_up(v, o); if (lane >= o) v += t; }
    return v;
}
__device__ __forceinline__ void scan_phase(const Frame& F, KArgs a, unsigned char* ws) {
    const int T_tid = opaque_tid(), T_lane = T_tid & 63, T_wave = __builtin_amdgcn_readfirstlane(T_tid >> 6);
    float* CLP = (float*)(ws + WS_CLP); float* CLS = (float*)(ws + WS_CLS);
    const int blk = blockIdx.x;
    if (blk < 16) {
        const int h = blk; const float* lf = a->out + OUT_LP; const int t0 = T_tid * 32; double s = 0.0; float lv[32];
#pragma unroll
        for (int i = 0; i < 32; ++i) lv[i] = lf[(size_t)(t0 + i) * 16 + h];
#pragma unroll
        for (int i = 0; i < 32; ++i) s += (double)lv[i];
        const double inc = wave_scan_incl(s, T_lane);
        LAS double* wt = (LAS double*)(F.lds + RING_OFF);
        if (T_lane == 63) wt[T_wave] = inc;
        __syncthreads();
        double run = inc - s;
        for (int w = 0; w < T_wave; ++w) run += wt[w];
#pragma unroll
        for (int i = 0; i < 32; ++i) { run += (double)lv[i]; lv[i] = (float)(run * (double)L2E); }
#pragma unroll
        for (int i = 0; i < 8; ++i) *(f32x4*)(CLP + (size_t)h * MP + t0 + 4 * i) = (f32x4){lv[4 * i], lv[4 * i + 1], lv[4 * i + 2], lv[4 * i + 3]};
        __syncthreads();
    } else {
        const int nws = (F.G - 16) * NWAVES;
        for (int seq = (blk - 16) * NWAVES + T_wave; seq < DBATCH * H; seq += nws) {
            const int b = seq >> 4, h = seq & 15; const float* clf = a->in[I_CLF] + (size_t)b * PAST * 16 + h; const float* nlf = a->out + OUT_LS + (size_t)b * DSEQ * 16 + h;
            const int s0 = T_lane * 33; double s = 0.0; float lv[33];
#pragma unroll
            for (int i = 0; i < 33; ++i) { const int k = s0 + i; const int kc = k < LKEYS ? k : LKEYS - 1; const float* p = kc < PAST ? clf + (size_t)kc * 16 : nlf + (size_t)(kc - PAST) * 16; const float v = *p; lv[i] = (k < LKEYS) ? v : 0.f; }
#pragma unroll
            for (int i = 0; i < 33; ++i) s += (double)lv[i];
            double run = wave_scan_incl(s, T_lane) - s;
#pragma unroll
            for (int i = 0; i < 33; ++i) { const int k = s0 + i; run += (double)lv[i]; if (k < LKEYS) CLS[(size_t)seq * LKEYS + k] = (float)(run * (double)L2E); }
        }
    }
    { const int gw = F.vcu * NWAVES + T_wave, NGW = F.G * NWAVES; const bf16* KB = (const bf16*)(ws + WS_KB); float mx = 0.f;
      for (int row = gw; row < MP; row += NGW) { const v4u p = *(const v4u*)(KB + (size_t)row * D + T_lane * 16), q = *(const v4u*)(KB + (size_t)row * D + T_lane * 16 + 8); float sq = 0.f;
#pragma unroll
          for (int e = 0; e < 4; ++e) { const float a0 = bflo(p[e]), a1 = bfhi(p[e]), b0 = bflo(q[e]), b1 = bfhi(q[e]); sq += (a0 * a0 + a1 * a1) + (b0 * b0 + b1 * b1); }
          sq += __shfl_xor(sq, 1); sq += __shfl_xor(sq, 2); mx = fmaxf(mx, sq); }
      __syncthreads();
      LAS float* km = (LAS float*)(F.lds + RING_OFF) + 64;
      if ((T_lane & 3) == 0) km[T_wave * 16 + (T_lane >> 2)] = mx;
      __syncthreads();
      if (T_tid < 16) { float m = km[T_tid];
#pragma unroll
          for (int w = 1; w < NWAVES; ++w) m = fmaxf(m, km[w * 16 + T_tid]);
          atomicMax((unsigned*)(ws + WS_CTL) + CW_KMAX + T_tid, __builtin_bit_cast(unsigned, m)); }
      __syncthreads(); }
}
__device__ __forceinline__ void final_norm_phase(const Frame& F, KArgs a, unsigned char* ws) {
    const int T_tid = opaque_tid(), T_lane = T_tid & 63, T_wave = __builtin_amdgcn_readfirstlane(T_tid >> 6);
    const int gw = F.vcu * NWAVES + T_wave, NGW = F.G * NWAVES; const float* X = (const float*)(ws + WS_X);
    const GAS f32x4* gp = (const GAS f32x4*)a->in[I_NF] + T_lane; f32x4 gn[4];
#pragma unroll
    for (int j = 0; j < 4; ++j) gn[j] = gp[64 * j];
    for (int m = gw; m < M; m += NGW) {
        const GAS f32x4* xp = (const GAS f32x4*)(X + (size_t)m * D) + T_lane; f32x4 v[4]; float s = 0.f;
#pragma unroll
        for (int j = 0; j < 4; ++j) { v[j] = xp[64 * j]; s += (v[j].x * v[j].x + v[j].y * v[j].y) + (v[j].z * v[j].z + v[j].w * v[j].w); }
        const float rs = 1.0f / sqrtf(wave_sum(s) * (1.0f / D) + RMS_EPS);
        GAS f32x4* op = (GAS f32x4*)(a->out + OUT_Y + (size_t)m * D) + T_lane;
#pragma unroll
        for (int j = 0; j < 4; ++j) op[64 * j] = v[j] * rs * gn[j];
    }
}

__global__ void __launch_bounds__(NWAVES * 64, 2) yoco_fwd(Args args) {
    extern __shared__ __attribute__((aligned(16))) unsigned char lds[];
    Frame F;
    F.lds = (LAS unsigned char*)lds;
    F.MISC = (volatile LAS unsigned*)(F.lds + MISC_OFF);
    F.tid = threadIdx.x; F.lane = F.tid & 63; F.wave = __builtin_amdgcn_readfirstlane(F.tid >> 6);
    F.G = gridDim.x; { const int bx = blockIdx.x; F.vcu = (F.G % 8 == 0) ? (bx % 8) * (F.G / 8) + bx / 8 : bx; }
    F.ctl = (gu32*)(kargs()->ws + WS_CTL);
    for (int u = F.tid; u < (LDS_BYTES - LDSCTL_OFF) / 4; u += NWAVES * 64) ((LAS unsigned*)(F.lds + LDSCTL_OFF))[u] = 0u;
    __syncthreads();
    XcdBarrier bar = xcd_barrier_post((unsigned*)(F.ctl + CW_BAR), F.MISC + 8);
#define GRID_BAR() xcd_barrier(bar)
#define WSP(T, off) ((T*)(kargs()->ws + (off)))

    p0_prologue(F, kargs(), kargs()->ws);
    if (kargs()->ws == nullptr) cg::this_grid().sync();
    GRID_BAR();

#define SAMPLE_TILES(g, E) do { const int id_ = opaque_bid(); if (id_ < 4 * ((g).N / 128)) { const int mi_ = id_ & 3, ni_ = id_ >> 2; \
        pg8::gemm128_tile(F.lds + RING_OFF, (g).A + (size_t)(MP + 128 * mi_) * (g).K, (g).Bt + (size_t)(128 * ni_) * (g).K, (g).K, E, MP + 128 * mi_, 128 * ni_); } } while (0)
#define LAYER(l) do { \
        if ((l) != 2) { \
            constexpr bool cv = (l) < 2; unsigned char* ws = kargs()->ws; \
            pg8::Gemm g{(const bf16*)(ws + WS_XB), cv ? (const bf16*)(ws + WS_WIN) + (size_t)(l) * 3 * D * D : (const bf16*)(ws + WS_WQ1), M, cv ? 3 * D : D, D}; \
            pg8::StaticOrder S; S.init(MP, cv ? 3 * D : D, F.G, opaque_bid()); \
            pg8::EpiAct<0, false> E{cv ? (bf16*)(ws + WS_HB) : (bf16*)(ws + WS_QB), cv ? 3 * D : D, (const float*)(ws + WS_SSQ), 0, 0, nullptr}; \
            pg8::gemm_phase<pg8::EpiAct<0, false>, pg8::StaticOrder, PG8_ALIGN, PG8_SP2>(F.lds + RING_OFF, g, S, E); \
            SAMPLE_TILES(g, E); \
            GRID_BAR(); \
        } \
        if ((l) < 2) { conv_gate_phase(F, kargs(), kargs()->ws, (l)); } \
        else { \
            { unsigned char* ws = kargs()->ws; \
            const attn_body::AttnTensors AT{(const attn_body::bf16*)(ws + WS_QB), (const attn_body::bf16*)(ws + WS_KB), (const attn_body::bf16*)(ws + WS_VB), (attn_body::bf16*)(ws + WS_G), (const float*)(ws + WS_CLP), (const unsigned*)(ws + WS_CTL) + CW_KMAX}; \
            attn_body::attn_phase_q<24>((char*)lds + RING_OFF, AT, (unsigned*)(ws + WS_CTL) + CW_ATQ + ((l) - 2) * 512, opaque_bid()); } \
            __syncthreads(); \
            KArgs ka = kargs(); unsigned char* ws = ka->ws; \
            const sattn::Tensors ST{ka->in[I_CK], ka->in[I_CV], (const bf16*)(ws + WS_QB), (const bf16*)(ws + WS_KB), (const bf16*)(ws + WS_VB), (bf16*)(ws + WS_G), (const float*)(ws + WS_CLS)}; \
            for (int u = F.vcu; u < DBATCH * H; u += F.G) sattn::unit(u >> 4, u & 15, ST, (LAS char*)(F.lds + RING_OFF)); \
        } \
        GRID_BAR(); \
        { unsigned char* ws = kargs()->ws; \
            pg8::Gemm g{(const bf16*)(ws + WS_G), ((l) < 2) ? (const bf16*)(ws + WS_WOUT) + (size_t)(l) * D * D : (const bf16*)(ws + WS_WO) + (size_t)((l) - 2) * D * D, M, D, D}; \
            pg8::StaticOrder S; S.init(MP, D, F.G, opaque_bid()); \
            pg8::EpiResid E{(float*)(ws + WS_X), (bf16*)(ws + WS_XB), (float*)(ws + WS_SSQ), ((l) == 0) ? kargs()->in[I_XP] : nullptr, ((l) == 0) ? kargs()->in[I_XS] : nullptr}; \
            pg8::gemm_phase<pg8::EpiResid, pg8::StaticOrder, PG8_ALIGN, PG8_SP2>(F.lds + RING_OFF, g, S, E); \
            SAMPLE_TILES(g, E); \
            GRID_BAR(); } \
        { unsigned char* ws = kargs()->ws; \
            pg8::Gemm g{(const bf16*)(ws + WS_XB), (const bf16*)(ws + WS_WUP) + (size_t)(l) * D * FF, M, FF, D}; \
            pg8::StaticOrder S; S.init(MP, FF, F.G, opaque_bid()); \
            pg8::EpiAct<1, false> E{(bf16*)(ws + WS_HB), FF, (const float*)(ws + WS_SSQ), 0, 0, nullptr}; \
            pg8::gemm_phase<pg8::EpiAct<1, false>, pg8::StaticOrder, PG8_ALIGN, PG8_SP2>(F.lds + RING_OFF, g, S, E); \
            SAMPLE_TILES(g, E); \
            GRID_BAR(); } \
        { unsigned char* ws = kargs()->ws; \
            pg8::Gemm g{(const bf16*)(ws + WS_HB), (const bf16*)(ws + WS_WDN) + (size_t)(l) * D * FF, M, D, FF}; \
            pg8::StaticOrder S; S.init(MP, D, F.G, opaque_bid()); \
            pg8::EpiResid E{(float*)(ws + WS_X), (bf16*)(ws + WS_XB), (float*)(ws + WS_SSQ), nullptr, nullptr}; \
            pg8::gemm_phase<pg8::EpiResid, pg8::StaticOrder, PG8_ALIGN, PG8_SP2>(F.lds + RING_OFF, g, S, E); \
            SAMPLE_TILES(g, E); \
            GRID_BAR(); } \
        if ((l) == 1) { \
            KArgs ka = kargs(); unsigned char* ws = ka->ws; \
            pg8::Gemm g{(const bf16*)(ws + WS_XB), (const bf16*)(ws + WS_WKVQ), M, 3 * D, D}; \
            pg8::StaticOrder S; S.init(MP, 3 * D, F.G, opaque_bid()); \
            pg8::EpiAct<0, true> E{(bf16*)(ws + WS_KB), D, (const float*)(ws + WS_SSQ), D, (size_t)(WS_VB - WS_KB) / 2, ka->out}; \
            pg8::gemm_phase<pg8::EpiAct<0, true>, pg8::StaticOrder, PG8_ALIGN, PG8_SP2>(F.lds + RING_OFF, g, S, E); \
            SAMPLE_TILES(g, E); \
            logf_phase(F, kargs(), kargs()->ws); \
            GRID_BAR(); \
            scan_phase(F, kargs(), kargs()->ws); \
            GRID_BAR(); \
        } } while (0)
    LAYER(0); LAYER(1); LAYER(2); LAYER(3);
    final_norm_phase(F, kargs(), kargs()->ws);
}

extern "C" void kernel_launch(void* const* d_in, const int* in_sizes, int n_in, void* d_out, int out_size, void* d_ws, size_t ws_size, hipStream_t stream) {
    static int grid = 0;
    if (grid == 0) {
        if (n_in != 21 || out_size != (int)OUT_END || ws_size < WS_END) { fprintf(stderr, "kernel_launch: unexpected sizes (n_in %d, out %d, ws %zu); nothing launched\n", n_in, out_size, ws_size); grid = -1; return; }
        int dev = 0, cus = 0, per_cu = 0;
        if (hipGetDevice(&dev) != hipSuccess || hipDeviceGetAttribute(&cus, hipDeviceAttributeMultiprocessorCount, dev) != hipSuccess) { grid = -1; return; }
        if (hipFuncSetAttribute((const void*)yoco_fwd, hipFuncAttributeMaxDynamicSharedMemorySize, LDS_BYTES) != hipSuccess) { fprintf(stderr, "kernel_launch: hipFuncSetAttribute failed\n"); grid = -1; return; }
        if (hipOccupancyMaxActiveBlocksPerMultiprocessor(&per_cu, (const void*)yoco_fwd, NWAVES * 64, LDS_BYTES) != hipSuccess || per_cu < 1) { fprintf(stderr, "kernel_launch: occupancy query says %d\n", per_cu); per_cu = 1; }
        (void)hipGetLastError();
        grid = cus;
    }
    if (grid < 0) return;
    if (hipMemsetAsync((char*)d_ws + WS_CTL, 0, CTL_ZERO_BYTES, stream) != hipSuccess) { fprintf(stderr, "kernel_launch: memset failed\n"); return; }
    Args a{};
    for (int i = 0; i < 21; ++i) a.in[i] = (const float*)d_in[i];
    a.out = (float*)d_out; a.ws = (unsigned char*)d_ws;
    void* kargv[] = {&a};
    const hipError_t e = hipLaunchCooperativeKernel((const void*)yoco_fwd, dim3(grid), dim3(NWAVES * 64), kargv, LDS_BYTES, stream);
    if (e != hipSuccess) fprintf(stderr, "kernel_launch: cooperative launch failed: %s (grid %d)\n", hipGetErrorString(e), grid);
}
```

```cpp
#include <hip/hip_runtime.h>
#include <hip/hip_cooperative_groups.h>
#include <cstdio>
#include <cstdint>
__device__ __forceinline__ int opaque_bid() { int b = (int)blockIdx.x; asm volatile("" : "+s"(b)); return b; }
__device__ __forceinline__ int opaque_tid() { int t = (int)threadIdx.x; asm volatile("" : "+v"(t)); return t; }
namespace pg8 {
#define PG8_LAS __attribute__((address_space(3)))
typedef unsigned short bf16_t;
typedef short bf16x8 __attribute__((ext_vector_type(8)));
typedef float f32x4 __attribute__((ext_vector_type(4)));
typedef unsigned u32x4 __attribute__((ext_vector_type(4)));
constexpr int BM = 256, BK = 64, HALF = 128, HTB = HALF * BK * 2  , STAGE_BYTES = 8 * HTB, NXCD = 8, WGM = 8;

__host__ __device__ __forceinline__ int lds_byte(int r, int c) { const int st = (r >> 4) * 2 + (c >> 5), rr = r & 15, cc = c & 31, ob = rr * 64 + cc * 2; return st * 1024 + (ob ^ (((ob >> 9) & 1) << 5)); }
__host__ __device__ __forceinline__ void stage_rc(int b, int& R, int& C) { const int st = b / 1024, sb = b % 1024, swz = sb ^ (((sb >> 9) & 1) << 5); R = (st >> 1) * 16 + swz / 64; C = (st & 1) * 32 + (swz % 64) / 2; }
__host__ __device__ __forceinline__ int perm32(int rho) { const int n = rho >> 4, i = rho & 15; return 8 * (i >> 2) + 4 * n + (i & 3); }

struct Unit { int pm, pn; };
struct Gemm { const bf16_t* A; const bf16_t* Bt; int M, N, K; };

struct StaticOrder {
    int nM, nN, nwg, G, c;
    __host__ __device__ void init(int M, int N, int G_, int c_) { nM = M / BM; nN = N / BM; nwg = nM * nN; G = G_; c = c_; }
    __host__ __device__ bool next(int i, Unit& u) const {
        const long L = (long)i * G + c; if (L >= nwg) return false;
        int wgid = (int)L; { const int q = nwg / NXCD, r = nwg % NXCD, xcd = wgid % NXCD, off = wgid / NXCD; wgid = (xcd < r ? xcd * (q + 1) : r * (q + 1) + (xcd - r) * q) + off; }
        const int nig = WGM * nN, gid = wgid / nig, fm = gid * WGM, gsz = (nM - fm) < WGM ? (nM - fm) : WGM;
        u.pm = fm + ((wgid % nig) % gsz); u.pn = (wgid % nig) / gsz; return true;
    }
    __device__ __forceinline__ void a_ready(const Unit&) const {}
    __device__ __forceinline__ void done(const Unit&) const {}
};

__device__ __forceinline__ unsigned cvt_pk_bf16(float lo, float hi) { unsigned r; asm volatile("v_cvt_pk_bf16_f32 %0, %1, %2" : "=v"(r) : "v"(lo), "v"(hi)); return r; }
typedef float f32x2 __attribute__((ext_vector_type(2)));
__device__ __forceinline__ f32x2 gelu_pk(f32x2 v) {
    const f32x2 av = __builtin_elementwise_abs(v), d = av * 0.2316418882f + 1.0f;
    f32x2 t; t.x = __builtin_amdgcn_rcpf(d.x); t.y = __builtin_amdgcn_rcpf(d.y);
    f32x2 q = t * 0.5307027145f + (-0.7265760135f); q = q * t + 0.7107068705f; q = q * t + (-0.142248368f); q = q * t + 0.127414796f; q = q * t;
    const f32x2 s = (v * v) * (-0.72134752044f);
    f32x2 e; e.x = __builtin_amdgcn_exp2f(s.x); e.y = __builtin_amdgcn_exp2f(s.y);
    const f32x2 m = v * (q * e), r = v - m;
    f32x2 o; o.x = v.x < 0.f ? m.x : r.x; o.y = v.y < 0.f ? m.y : r.y; return o;
}

template <int ACT  > struct EpiBf16 {
    static constexpr bool PERM = true, AFTER_DRAIN = false; static_assert(ACT == 0 || ACT == 1, "EpiBf16: ACT is 0 (none) or 1 (gelu_pk)");
    bf16_t* O; int ldc; const float* bias; int split_cols; size_t split_stride; float scale0;
    __device__ __forceinline__ void operator()(const f32x4 (&acc)[2][2][4][2], const Unit& u, int wr, int wc, int fr, int fq) const {
        const int row0 = u.pm * BM + wr * 64 + fr; int colt = u.pn * BM; bf16_t* base = O;
        float sc = 1.f; if (split_cols) { const int t = colt / split_cols; base += (size_t)t * split_stride; colt -= t * split_cols; if (t == 0) sc = scale0; }
        const int col0 = colt + wc * 32 + 8 * fq, bcol0 = u.pn * BM + wc * 32 + 8 * fq;
        f32x4 bv[2][2];
#pragma unroll
        for (int bj = 0; bj < 2; ++bj)
#pragma unroll
            for (int n = 0; n < 2; ++n) bv[bj][n] = bias ? *(const f32x4*)(bias + bcol0 + bj * HALF + 4 * n) : (f32x4){0.f, 0.f, 0.f, 0.f};
#pragma unroll
        for (int ai = 0; ai < 2; ++ai)
#pragma unroll
            for (int m = 0; m < 4; ++m) { bf16_t* rowp = base + (size_t)(row0 + ai * HALF + m * 16) * ldc + col0;
#pragma unroll
                for (int bj = 0; bj < 2; ++bj) { f32x4 v0 = acc[ai][bj][m][0] + bv[bj][0], v1 = acc[ai][bj][m][1] + bv[bj][1];
                    if (ACT == 1) { f32x2 a = gelu_pk((f32x2){v0[0], v0[1]}), b = gelu_pk((f32x2){v0[2], v0[3]}), c = gelu_pk((f32x2){v1[0], v1[1]}), d = gelu_pk((f32x2){v1[2], v1[3]});
                        v0 = (f32x4){a.x, a.y, b.x, b.y}; v1 = (f32x4){c.x, c.y, d.x, d.y}; }
                    v0 = v0 * sc; v1 = v1 * sc; u32x4 w; w.x = cvt_pk_bf16(v0[0], v0[1]); w.y = cvt_pk_bf16(v0[2], v0[3]); w.z = cvt_pk_bf16(v1[0], v1[1]); w.w = cvt_pk_bf16(v1[2], v1[3]);
                    *(u32x4*)(rowp + bj * HALF) = w; } }
    }
};

struct PanelStats {
    unsigned* xbuf;
    unsigned* cnt;
    unsigned* tmo;
    int ntn; float eps;
    unsigned code;
    __device__ __forceinline__ bool run(const f32x4 (&v)[2][2][4][2], const Unit& u, int wr, int wc, int fr, int fq, PG8_LAS unsigned char* lds, int wid, int lane) const {
        typedef float f32x2v __attribute__((ext_vector_type(2)));
        PG8_LAS f32x2v* P = (PG8_LAS f32x2v*)lds;
        PG8_LAS f32x2v* S = (PG8_LAS f32x2v*)(lds + 8192);
        PG8_LAS unsigned* flag = (PG8_LAS unsigned*)(lds + 8192 + 2048);
#pragma unroll
        for (int ai = 0; ai < 2; ++ai)
#pragma unroll
            for (int m = 0; m < 4; ++m) {
                float s = 0.f;
#pragma unroll
                for (int bj = 0; bj < 2; ++bj)
#pragma unroll
                    for (int n = 0; n < 2; ++n) { const f32x4 x = v[ai][bj][m][n]; s += (x[0] + x[1]) + (x[2] + x[3]); }
                s += __shfl_xor(s, 16); s += __shfl_xor(s, 32);
                const float mw = s * (1.0f / 64.0f); float q = 0.f;
#pragma unroll
                for (int bj = 0; bj < 2; ++bj)
#pragma unroll
                    for (int n = 0; n < 2; ++n) { const f32x4 d = v[ai][bj][m][n] - mw; q += (d[0] * d[0] + d[1] * d[1]) + (d[2] * d[2] + d[3] * d[3]); }
                q += __shfl_xor(q, 16); q += __shfl_xor(q, 32);
                if (fq == 0) P[(ai * HALF + wr * 64 + m * 16 + fr) * 4 + wc] = (f32x2v){mw, q};
            }
        asm volatile("s_waitcnt lgkmcnt(0)" ::: "memory"); __builtin_amdgcn_s_barrier(); asm volatile("" ::: "memory");
#if defined(BROKEN_EXCHANGE_NO_WAIT)
#warning BROKEN CONTROL BUILD: the row-statistics exchange does not wait; results are wrong by design
        if (blockIdx.x >= 64) { const long long t0_ = clock64(); while (clock64() - t0_ < 60000) __builtin_amdgcn_s_sleep(8); }
#endif
        const int row = wid * 32 + (lane & 31);
        if (lane < 32) {
            const f32x2v a = P[row * 4 + 0], b = P[row * 4 + 1], c = P[row * 4 + 2], d = P[row * 4 + 3];
            const float mt = (a.x + b.x + c.x + d.x) * 0.25f;
            const float da = a.x - mt, db = b.x - mt, dc = c.x - mt, dd = d.x - mt;
            const float m2 = (a.y + b.y) + (c.y + d.y) + 64.0f * ((da * da + db * db) + (dc * dc + dd * dd));
            unsigned long long* slot = (unsigned long long*)xbuf + ((size_t)(u.pm * BM + row) * 4 + u.pn);
            __hip_atomic_store(slot, ((unsigned long long)__float_as_uint(m2) << 32) | __float_as_uint(mt), __ATOMIC_RELAXED, __HIP_MEMORY_SCOPE_AGENT);
        }
        asm volatile("s_waitcnt vmcnt(0)" ::: "memory");
        if (lane == 0) __hip_atomic_fetch_add(cnt + 64 * u.pm, 1u, __ATOMIC_RELAXED, __HIP_MEMORY_SCOPE_AGENT);
        if (wid == 0) {
            bool dead = false; const unsigned long long t0 = __builtin_amdgcn_s_memrealtime(); const unsigned want = 8u * (unsigned)ntn;
            for (;;) {
#if defined(BROKEN_EXCHANGE_NO_WAIT)
                break;
#endif
                if ((unsigned)__builtin_amdgcn_readfirstlane(__hip_atomic_load(cnt + 64 * u.pm, __ATOMIC_RELAXED, __HIP_MEMORY_SCOPE_AGENT)) >= want) break;
                if (__builtin_amdgcn_s_memrealtime() - t0 > 2000000ull) {
                    if (lane == 0) { unsigned expect = 0u; __hip_atomic_compare_exchange_strong(tmo + 1, &expect, code | (unsigned)(u.pm & 0xff), __ATOMIC_RELAXED, __ATOMIC_RELAXED, __HIP_MEMORY_SCOPE_AGENT);
                                     __hip_atomic_store(tmo, 1u, __ATOMIC_RELAXED, __HIP_MEMORY_SCOPE_AGENT); }
                    dead = true; break; }
                __builtin_amdgcn_s_sleep(2);
            }
            __builtin_amdgcn_fence(__ATOMIC_ACQUIRE, "agent");
            if (lane == 0) flag[0] = dead ? 1u : 0u;
        }
        asm volatile("s_waitcnt vmcnt(0) lgkmcnt(0)" ::: "memory"); __builtin_amdgcn_s_barrier(); asm volatile("" ::: "memory");
        const bool bad = flag[0] != 0u;
        if (lane < 32) {
            const unsigned long long* slot = (const unsigned long long*)xbuf + (size_t)(u.pm * BM + row) * 4; float mt[4], m2[4]; float ms = 0.f;
#pragma unroll
            for (int t = 0; t < 4; ++t) { if (t < ntn) { const unsigned long long w = __hip_atomic_load(slot + t, __ATOMIC_RELAXED, __HIP_MEMORY_SCOPE_AGENT); mt[t] = __uint_as_float((unsigned)w); m2[t] = __uint_as_float((unsigned)(w >> 32)); } else { mt[t] = 0.f; m2[t] = 0.f; } ms += mt[t]; }
            const float mean = ms / (float)ntn; float q = 0.f;
#pragma unroll
            for (int t = 0; t < 4; ++t) if (t < ntn) { const float dm = mt[t] - mean; q += m2[t] + 256.0f * dm * dm; }
            S[row] = (f32x2v){mean, 1.0f / sqrtf(q / (256.0f * (float)ntn) + eps)};
        }
        asm volatile("s_waitcnt lgkmcnt(0)" ::: "memory"); __builtin_amdgcn_s_barrier(); asm volatile("" ::: "memory");
        return bad;
    }
};
struct EpiLnRes {
    static constexpr bool PERM = false, AFTER_DRAIN = true;
    const float* base; float* out; int ldc; const float* bias; PanelStats st; unsigned poison;
    __device__ __forceinline__ void fused(f32x4 (&acc)[2][2][4][2], const Unit& u, int wr, int wc, int fr, int fq, PG8_LAS unsigned char* lds, int wid, int lane) const {
        typedef float f32x2v __attribute__((ext_vector_type(2)));
        const PG8_LAS f32x2v* S = (const PG8_LAS f32x2v*)(lds + 8192);
        const int col0 = u.pn * BM + wc * 32 + 4 * fq;
#pragma unroll
        for (int bj = 0; bj < 2; ++bj)
#pragma unroll
            for (int n = 0; n < 2; ++n) { const f32x4 bv = bias ? *(const f32x4*)(bias + col0 + bj * HALF + n * 16) : (f32x4){0.f, 0.f, 0.f, 0.f};
#pragma unroll
                for (int ai = 0; ai < 2; ++ai)
#pragma unroll
                    for (int m = 0; m < 4; ++m) acc[ai][bj][m][n] += bv; }
        f32x4 pre[4][2][2];
#pragma unroll
        for (int m = 0; m < 4; ++m) { const size_t off = (size_t)(u.pm * BM + wr * 64 + m * 16 + fr) * ldc + col0;
#pragma unroll
            for (int bj = 0; bj < 2; ++bj)
#pragma unroll
                for (int n = 0; n < 2; ++n) pre[m][bj][n] = *(const f32x4*)(base + off + bj * HALF + n * 16); }
        const bool bad = st.run(acc, u, wr, wc, fr, fq, lds, wid, lane) || poison != 0u;
        const float qnan = __builtin_nanf("");
#pragma unroll
        for (int ai = 0; ai < 2; ++ai)
#pragma unroll
            for (int m = 0; m < 4; ++m) { const int r = ai * HALF + wr * 64 + m * 16 + fr; const f32x2v sr = S[r]; const size_t off = (size_t)(u.pm * BM + r) * ldc + col0;
#pragma unroll
                for (int bj = 0; bj < 2; ++bj)
#pragma unroll
                    for (int n = 0; n < 2; ++n) { const f32x4 bs = ai == 0 ? pre[m][bj][n] : *(const f32x4*)(base + off + bj * HALF + n * 16); f32x4 o = bs + (acc[ai][bj][m][n] - sr.x) * sr.y;
                        if (bad) o = (f32x4){qnan, qnan, qnan, qnan}; *(f32x4*)(out + off + bj * HALF + n * 16) = o; }
                if (m & 1) asm volatile("" ::: "memory"); }
    }
};
struct EpiLnResLn {
    static constexpr bool PERM = false, AFTER_DRAIN = true;
    const float* base; float* out; bf16_t* xn; int ldc; const float* bias; PanelStats st1, st2; unsigned poison;
    __device__ __forceinline__ void fused(f32x4 (&acc)[2][2][4][2], const Unit& u, int wr, int wc, int fr, int fq, PG8_LAS unsigned char* lds, int wid, int lane) const {
        typedef float f32x2v __attribute__((ext_vector_type(2))); typedef unsigned u32x2v __attribute__((ext_vector_type(2)));
        const PG8_LAS f32x2v* S = (const PG8_LAS f32x2v*)(lds + 8192);
        const int col0 = u.pn * BM + wc * 32 + 4 * fq;
#pragma unroll
        for (int bj = 0; bj < 2; ++bj)
#pragma unroll
            for (int n = 0; n < 2; ++n) { const f32x4 bv = bias ? *(const f32x4*)(bias + col0 + bj * HALF + n * 16) : (f32x4){0.f, 0.f, 0.f, 0.f};
#pragma unroll
                for (int ai = 0; ai < 2; ++ai)
#pragma unroll
                    for (int m = 0; m < 4; ++m) acc[ai][bj][m][n] += bv; }
        bool bad = st1.run(acc, u, wr, wc, fr, fq, lds, wid, lane) || poison != 0u;
        const float qnan = __builtin_nanf("");
#pragma unroll
        for (int ai = 0; ai < 2; ++ai)
#pragma unroll
            for (int m = 0; m < 4; ++m) { const int r = ai * HALF + wr * 64 + m * 16 + fr; const f32x2v sr = S[r]; const size_t off = (size_t)(u.pm * BM + r) * ldc + col0;
#pragma unroll
                for (int bj = 0; bj < 2; ++bj)
#pragma unroll
                    for (int n = 0; n < 2; ++n) { const f32x4 bs = *(const f32x4*)(base + off + bj * HALF + n * 16); acc[ai][bj][m][n] = bs + (acc[ai][bj][m][n] - sr.x) * sr.y; }
                asm volatile("" : "+v"(acc[ai][0][m][0]), "+v"(acc[ai][0][m][1]), "+v"(acc[ai][1][m][0]), "+v"(acc[ai][1][m][1]));
                if (m & 1) asm volatile("" ::: "memory"); }
        const bool bad1 = bad;
        bad = st2.run(acc, u, wr, wc, fr, fq, lds, wid, lane) || bad;
#pragma unroll
        for (int ai = 0; ai < 2; ++ai)
#pragma unroll
            for (int m = 0; m < 4; ++m) { const int r = ai * HALF + wr * 64 + m * 16 + fr; const f32x2v sr = S[r]; const size_t off = (size_t)(u.pm * BM + r) * ldc + col0;
#pragma unroll
                for (int bj = 0; bj < 2; ++bj)
#pragma unroll
                    for (int n = 0; n < 2; ++n) { const f32x4 x1 = acc[ai][bj][m][n]; *(f32x4*)(out + off + bj * HALF + n * 16) = bad1 ? (f32x4){qnan, qnan, qnan, qnan} : x1;
                        const f32x4 o = (x1 - sr.x) * sr.y; u32x2v w; w.x = cvt_pk_bf16(o[0], o[1]); w.y = cvt_pk_bf16(o[2], o[3]);
                        if (bad) { w.x = 0x7fc07fc0u; w.y = 0x7fc07fc0u; } *(u32x2v*)(xn + off + bj * HALF + n * 16) = w; }
                asm volatile("" ::: "memory"); }
    }
};

template <class Epi, class Sched, bool ALIGN_EPI = false, bool SP2 = false>
__device__ __forceinline__ void gemm_phase(PG8_LAS unsigned char* lds, const Gemm g, const Sched& S, const Epi& E) {
    const int tid = opaque_tid(), wid = __builtin_amdgcn_readfirstlane(tid >> 6), lane = tid & 63, wr = wid >> 2, wc = wid & 3, fr = lane & 15, fq = lane >> 4;
    const int K = g.K, nt = K / BK;
    unsigned voffA[2], voffB[2];
#pragma unroll
    for (int i = 0; i < 2; ++i) { int R, C; stage_rc(tid * 16 + i * 8192, R, C); const int Rb = Epi::PERM ? ((R & ~31) + perm32(R & 31)) : R;
        voffA[i] = (unsigned)(R * K + C) * 2u; voffB[i] = (unsigned)(Rb * K + C) * 2u; }
    const size_t kstep = (size_t)(BK * 2);
    const size_t hstep = (size_t)HALF * K * 2;
    const size_t tstep = 2 * hstep;
    const unsigned ldsw = (unsigned)wid * 1024u;
    const int aoff = lds_byte(wr * 64 + fr, fq * 8), boff = lds_byte(wc * 32 + fr, fq * 8);
#define PG8_SA(b, h) (((b) * 2 + (h)) * HTB)
#define PG8_SB(b, h) ((4 + (b) * 2 + (h)) * HTB)
#define PG8_STAGE(bufoff, gbase, voff) do { _Pragma("unroll") for (int _i = 0; _i < 2; ++_i) \
        __builtin_amdgcn_global_load_lds((const unsigned*)((const char*)(gbase) + (voff)[_i]), (PG8_LAS unsigned*)(lds + (bufoff) + ldsw + _i * 8192), 16, 0, 0); } while (0)
#define PG8_LDA(dst, b, h) do { _Pragma("unroll") for (int m = 0; m < 4; ++m) _Pragma("unroll") for (int k = 0; k < 2; ++k) dst[m][k] = *(const PG8_LAS bf16x8*)(lds + PG8_SA(b, h) + aoff + m * 2048 + k * 1024); } while (0)
#define PG8_LDB(dst, b, h) do { _Pragma("unroll") for (int n = 0; n < 2; ++n) _Pragma("unroll") for (int k = 0; k < 2; ++k) dst[n][k] = *(const PG8_LAS bf16x8*)(lds + PG8_SB(b, h) + boff + n * 2048 + k * 1024); } while (0)
#define PG8_MMA(ai, bj, At, Bt) do { __builtin_amdgcn_s_setprio(1); _Pragma("unroll") for (int m = 0; m < 4; ++m) _Pragma("unroll") for (int n = 0; n < 2; ++n) _Pragma("unroll") for (int k = 0; k < 2; ++k) \
        acc[ai][bj][m][n] = __builtin_amdgcn_mfma_f32_16x16x32_bf16(Bt[n][k], At[m][k], acc[ai][bj][m][n], 0, 0, 0); __builtin_amdgcn_s_setprio(0); } while (0)
#define PG8_WAIT_V(n) asm volatile("s_waitcnt vmcnt(" #n ")" ::: "memory")
#define PG8_WAIT_L(n) asm volatile("s_waitcnt lgkmcnt(" #n ")" ::: "memory")
#define PG8_BAR __builtin_amdgcn_s_barrier()
#define PG8_SCHED __builtin_amdgcn_sched_barrier(0)
    Unit cur, nxt; int ui = 0;
    if (!S.next(0, cur)) return;
    f32x4 acc[2][2][4][2];
#pragma unroll
    for (int a = 0; a < 2; ++a)
#pragma unroll
        for (int b = 0; b < 2; ++b)
#pragma unroll
            for (int m = 0; m < 4; ++m)
#pragma unroll
                for (int n = 0; n < 2; ++n) acc[a][b][m][n] = (f32x4){0.f, 0.f, 0.f, 0.f};
    bf16x8 At[4][2], B0[2][2], B1[2][2];
    const char* cA = (const char*)g.A + (size_t)cur.pm * tstep; const char* cB = (const char*)g.Bt + (size_t)cur.pn * tstep;
    S.a_ready(cur);
    if constexpr (SP2) {
        PG8_STAGE(PG8_SB(0, 0), cB, voffB); PG8_STAGE(PG8_SB(0, 1), cB + hstep, voffB); PG8_STAGE(PG8_SA(0, 0), cA, voffA); PG8_STAGE(PG8_SA(0, 1), cA + hstep, voffA);
        if (wr == 1) PG8_BAR;
        PG8_WAIT_V(2); PG8_BAR;
        PG8_STAGE(PG8_SB(1, 0), cB + kstep, voffB); PG8_STAGE(PG8_SA(1, 0), cA + kstep, voffA); PG8_STAGE(PG8_SB(1, 1), cB + hstep + kstep, voffB);
        PG8_WAIT_V(6); PG8_BAR;
    } else {
        PG8_STAGE(PG8_SB(0, 0), cB, voffB); PG8_STAGE(PG8_SA(0, 0), cA, voffA); PG8_STAGE(PG8_SB(0, 1), cB + hstep, voffB); PG8_STAGE(PG8_SA(0, 1), cA + hstep, voffA);
        if (wr == 1) PG8_BAR;
        PG8_WAIT_V(4); PG8_BAR;
        PG8_STAGE(PG8_SB(1, 0), cB + kstep, voffB); PG8_STAGE(PG8_SA(1, 0), cA + kstep, voffA); PG8_STAGE(PG8_SB(1, 1), cB + hstep + kstep, voffB);
        PG8_WAIT_V(6); PG8_BAR;
    }
    for (;;) {
        const bool has_next = S.next(ui + 1, nxt);
        const char* nA = has_next ? (const char*)g.A + (size_t)nxt.pm * tstep : cA; const char* nB = has_next ? (const char*)g.Bt + (size_t)nxt.pn * tstep : cB;
        for (int t = 0; t < nt; t += 2) {
            const bool last = (t == nt - 2);
            const char* a1 = cA + (size_t)(t + 1) * kstep;
            const char* a2 = last ? nA : cA + (size_t)(t + 2) * kstep; const char* b2 = last ? nB : cB + (size_t)(t + 2) * kstep;
            const char* a3 = a2 + kstep; const char* b3 = b2 + kstep;
            if (last && has_next) S.a_ready(nxt);
            if constexpr (SP2) {
            PG8_LDB(B0, 0, 0); PG8_LDB(B1, 0, 1); PG8_SCHED; PG8_LDA(At, 0, 0); PG8_STAGE(PG8_SA(1, 1), a1 + hstep, voffA);
            PG8_WAIT_V(8); PG8_WAIT_L(0); PG8_BAR; PG8_MMA(0, 0, At, B0); PG8_MMA(0, 1, At, B1); PG8_BAR; PG8_SCHED;
            PG8_LDA(At, 0, 1); PG8_STAGE(PG8_SB(0, 0), b2, voffB); PG8_STAGE(PG8_SB(0, 1), b2 + hstep, voffB); PG8_STAGE(PG8_SA(0, 0), a2, voffA);
            PG8_WAIT_V(8); PG8_WAIT_L(0); PG8_BAR; PG8_MMA(1, 0, At, B0); PG8_MMA(1, 1, At, B1); PG8_BAR; PG8_SCHED;
            PG8_LDB(B0, 1, 0); PG8_LDB(B1, 1, 1); PG8_SCHED; PG8_LDA(At, 1, 0); PG8_STAGE(PG8_SA(0, 1), a2 + hstep, voffA);
            PG8_WAIT_V(8); PG8_WAIT_L(0); PG8_BAR; PG8_MMA(0, 0, At, B0); PG8_MMA(0, 1, At, B1); PG8_BAR; PG8_SCHED;
            PG8_LDA(At, 1, 1); PG8_STAGE(PG8_SB(1, 0), b3, voffB); PG8_STAGE(PG8_SB(1, 1), b3 + hstep, voffB); PG8_STAGE(PG8_SA(1, 0), a3, voffA);
            PG8_WAIT_V(8); PG8_WAIT_L(0); PG8_BAR; PG8_MMA(1, 0, At, B0); PG8_MMA(1, 1, At, B1); PG8_BAR; PG8_SCHED;
            } else {
            PG8_LDB(B0, 0, 0); PG8_SCHED; PG8_LDA(At, 0, 0); PG8_STAGE(PG8_SA(1, 1), a1 + hstep, voffA);
            PG8_WAIT_L(8); PG8_BAR; PG8_WAIT_L(0); PG8_MMA(0, 0, At, B0); PG8_BAR; PG8_SCHED;
            PG8_LDB(B1, 0, 1); PG8_STAGE(PG8_SB(0, 0), b2, voffB);
            PG8_BAR; PG8_WAIT_L(0); PG8_MMA(0, 1, At, B1); PG8_BAR;
            PG8_LDA(At, 0, 1); PG8_STAGE(PG8_SA(0, 0), a2, voffA);
            PG8_BAR; PG8_WAIT_L(0); PG8_MMA(1, 0, At, B0); PG8_BAR; PG8_SCHED;
            PG8_STAGE(PG8_SB(0, 1), b2 + hstep, voffB);
            PG8_WAIT_V(6); PG8_BAR; PG8_MMA(1, 1, At, B1); PG8_BAR;
            PG8_LDB(B0, 1, 0); PG8_SCHED; PG8_LDA(At, 1, 0); PG8_STAGE(PG8_SA(0, 1), a2 + hstep, voffA);
            PG8_WAIT_L(8); PG8_BAR; PG8_WAIT_L(0); PG8_MMA(0, 0, At, B0); PG8_BAR; PG8_SCHED;
            PG8_LDB(B1, 1, 1); PG8_STAGE(PG8_SB(1, 0), b3, voffB);
            PG8_BAR; PG8_WAIT_L(0); PG8_MMA(0, 1, At, B1); PG8_BAR;
            PG8_LDA(At, 1, 1); PG8_STAGE(PG8_SA(1, 0), a3, voffA);
            PG8_BAR; PG8_WAIT_L(0); PG8_MMA(1, 0, At, B0); PG8_BAR; PG8_SCHED;
            PG8_STAGE(PG8_SB(1, 1), b3 + hstep, voffB);
            PG8_WAIT_V(6); PG8_BAR; PG8_MMA(1, 1, At, B1); PG8_BAR;
            }
        }
        if constexpr (ALIGN_EPI) { if (wr == 0) PG8_BAR; }
        if constexpr (!Epi::AFTER_DRAIN) { E(acc, cur, wr, wc, fr, fq); S.done(cur); }
        if (!has_next) break;
#pragma unroll
        for (int a = 0; a < 2; ++a)
#pragma unroll
            for (int b = 0; b < 2; ++b)
#pragma unroll
                for (int m = 0; m < 4; ++m)
#pragma unroll
                    for (int n = 0; n < 2; ++n) acc[a][b][m][n] = (f32x4){0.f, 0.f, 0.f, 0.f};
        cur = nxt; cA = nA; cB = nB; ++ui;
        if constexpr (ALIGN_EPI) { if (wr == 1) PG8_BAR; }
    }
    PG8_WAIT_V(0);
    if constexpr (!ALIGN_EPI) { if (wr == 0) PG8_BAR; }
    PG8_BAR;
    if constexpr (Epi::AFTER_DRAIN) { E.fused(acc, cur, wr, wc, fr, fq, lds, wid, lane); S.done(cur); }
#undef PG8_SA
#undef PG8_SB
#undef PG8_STAGE
#undef PG8_LDA
#undef PG8_LDB
#undef PG8_MMA
#undef PG8_WAIT_V
#undef PG8_WAIT_L
#undef PG8_BAR
#undef PG8_SCHED
}
}

#ifndef PG8_SP2
#define PG8_SP2 true
#endif
#ifndef PG8_ALIGN
#define PG8_ALIGN true
#endif
namespace pg8 {
constexpr int OUT_KP = 17301504, OUT_VP = 34078720, OUT_KS = 51122176, OUT_VS = 51646464;
typedef unsigned u32x2 __attribute__((ext_vector_type(2)));
constexpr int NSSQ = 32;
__device__ __forceinline__ float row_rstd(const float* ssq, int row) {
    const f32x4* p = (const f32x4*)(ssq + (size_t)row * NSSQ); float s = 0.f;
#pragma unroll
    for (int i = 0; i < NSSQ / 4; ++i) { const f32x4 a = p[i]; s += (a[0] + a[1]) + (a[2] + a[3]); }
    return __builtin_amdgcn_rsqf(s * (1.0f / 1024.0f) + 1e-6f);
}
template <int ACT, bool KVF32> struct EpiAct {
    static constexpr bool PERM = true, AFTER_DRAIN = false;
    bf16_t* O; int ldc; const float* ssq; int split_cols; size_t split_stride; float* fout;
    template <int NA, int NB> __device__ __forceinline__ void run(const f32x4 (&acc)[NA][NB][4][2], int rowt, int colt, bool sample, int wr, int wc, int fr, int fq) const {
        const int row0 = rowt + wr * 64 + fr; bf16_t* base = O; int t = 0;
        if (split_cols) { t = colt / split_cols; base += (size_t)t * split_stride; colt -= t * split_cols; }
        const int col0 = colt + wc * 32 + 8 * fq;
        float* fb = nullptr;
        if (KVF32) { if (t < 2) fb = fout + (!sample ? (size_t)(t == 0 ? OUT_KP : OUT_VP) : (size_t)(t == 0 ? OUT_KS : OUT_VS) - (size_t)16384 * 1024) + col0; }
        f32x4 pq[NA][4][2];
#pragma unroll
        for (int ai = 0; ai < NA; ++ai)
#pragma unroll
            for (int m = 0; m < 4; ++m) { const f32x4* p = (const f32x4*)(ssq + (size_t)(row0 + ai * HALF + m * 16) * NSSQ + 8 * fq); pq[ai][m][0] = p[0]; pq[ai][m][1] = p[1]; }
        float rsv[NA][4];
#pragma unroll
        for (int ai = 0; ai < NA; ++ai)
#pragma unroll
            for (int m = 0; m < 4; ++m) { const f32x4 a = pq[ai][m][0], b = pq[ai][m][1]; float sq = ((a[0] + a[1]) + (a[2] + a[3])) + ((b[0] + b[1]) + (b[2] + b[3]));
                sq += __shfl_xor(sq, 16); sq += __shfl_xor(sq, 32); rsv[ai][m] = __builtin_amdgcn_rsqf(sq * (1.0f / 1024.0f) + 1e-6f); }
#pragma unroll
        for (int ai = 0; ai < NA; ++ai)
#pragma unroll
            for (int m = 0; m < 4; ++m) { const int row = row0 + ai * HALF + m * 16; const float rs = rsv[ai][m];
                bf16_t* rowp = base + (size_t)row * ldc + col0;
#pragma unroll
                for (int bj = 0; bj < NB; ++bj) { f32x4 v0 = acc[ai][bj][m][0] * rs, v1 = acc[ai][bj][m][1] * rs;
                    if (ACT == 1) {
#pragma unroll
                        for (int e = 0; e < 4; ++e) { const float a = fmaxf(v0[e], 0.f), b = fmaxf(v1[e], 0.f); v0[e] = a * a; v1[e] = b * b; } }
                    if (KVF32) { if (fb) { float* fr_ = fb + (size_t)row * 1024 + bj * HALF; *(f32x4*)fr_ = v0; *(f32x4*)(fr_ + 4) = v1; } }
                    u32x4 w; w.x = cvt_pk_bf16(v0[0], v0[1]); w.y = cvt_pk_bf16(v0[2], v0[3]); w.z = cvt_pk_bf16(v1[0], v1[1]); w.w = cvt_pk_bf16(v1[2], v1[3]);
                    *(u32x4*)(rowp + bj * HALF) = w; } }
    }
    __device__ __forceinline__ void operator()(const f32x4 (&acc)[2][2][4][2], const Unit& u, int wr, int wc, int fr, int fq) const { run<2, 2>(acc, u.pm * BM, u.pn * BM, u.pm >= 64, wr, wc, fr, fq); }
};
struct EpiResid {
    static constexpr bool PERM = true, AFTER_DRAIN = false;
    float* X; bf16_t* XB; float* ssq; const float* Xp; const float* Xs;
    template <int NA, int NB> __device__ __forceinline__ void run(const f32x4 (&acc)[NA][NB][4][2], int rowt, int colt, bool sample, int wr, int wc, int fr, int fq) const {
        const int row0 = rowt + wr * 64 + fr; const int col0 = colt + wc * 32 + 8 * fq;
#pragma unroll
        for (int ai = 0; ai < NA; ++ai) {
            f32x4 xr[4][NB][2];
#pragma unroll
            for (int m = 0; m < 4; ++m) { const float* xp = (Xp ? (sample ? Xs - (size_t)16384 * 1024 : Xp) : (const float*)X) + (size_t)(row0 + ai * HALF + m * 16) * 1024 + col0;
#pragma unroll
                for (int bj = 0; bj < NB; ++bj) { xr[m][bj][0] = *(const f32x4*)(xp + bj * HALF); xr[m][bj][1] = *(const f32x4*)(xp + bj * HALF + 4); } }
#pragma unroll
            for (int m = 0; m < 4; ++m) { const int row = row0 + ai * HALF + m * 16; float* xp = X + (size_t)row * 1024 + col0; bf16_t* bp = XB + (size_t)row * 1024 + col0;
#pragma unroll
                for (int bj = 0; bj < NB; ++bj) { const f32x4 a0 = xr[m][bj][0] + acc[ai][bj][m][0], a1 = xr[m][bj][1] + acc[ai][bj][m][1];
                    *(f32x4*)(xp + bj * HALF) = a0; *(f32x4*)(xp + bj * HALF + 4) = a1;
                    float q = ((a0[0] * a0[0] + a0[1] * a0[1]) + (a0[2] * a0[2] + a0[3] * a0[3])) + ((a1[0] * a1[0] + a1[1] * a1[1]) + (a1[2] * a1[2] + a1[3] * a1[3]));
                    u32x4 w; w.x = cvt_pk_bf16(a0[0], a0[1]); w.y = cvt_pk_bf16(a0[2], a0[3]); w.z = cvt_pk_bf16(a1[0], a1[1]); w.w = cvt_pk_bf16(a1[2], a1[3]);
                    *(u32x4*)(bp + bj * HALF) = w;
                    q += __shfl_xor(q, 16); q += __shfl_xor(q, 32);
                    if (fq == 0) ssq[(size_t)row * NSSQ + ((colt + bj * HALF) >> 7) * 4 + wc] = q; } }
            asm volatile("" ::: "memory"); }
    }
    __device__ __forceinline__ void operator()(const f32x4 (&acc)[2][2][4][2], const Unit& u, int wr, int wc, int fr, int fq) const { run<2, 2>(acc, u.pm * BM, u.pn * BM, u.pm >= 64, wr, wc, fr, fq); }
};
__device__ __forceinline__ void glds16(const void* gsrc, unsigned lds_dst) { unsigned keep;
    asm volatile("s_mov_b32 %0, m0\n\ts_mov_b32 m0, %2\n\ts_nop 0\n\tglobal_load_lds_dwordx4 %1, off\n\ts_mov_b32 m0, %0" : "=&s"(keep) : "v"(gsrc), "s"(lds_dst) : "memory"); }
template <class Epi>
__device__ __forceinline__ void gemm128_tile(PG8_LAS unsigned char* lds, const bf16_t* A, const bf16_t* Bt, int K, const Epi& E, int rowt, int colt) {
    const int tid = opaque_tid(), wid = __builtin_amdgcn_readfirstlane(tid >> 6), lane = tid & 63, wr = wid >> 2, wc = wid & 3, fr = lane & 15, fq = lane >> 4;
    const int nt = K / BK;
    const char* gA[2]; const char* gB[2];
#pragma unroll
    for (int i = 0; i < 2; ++i) { int R, C; stage_rc(tid * 16 + i * 8192, R, C); const int Rb = (R & ~31) + perm32(R & 31);
        gA[i] = (const char*)A + (size_t)(R * K + C) * 2; gB[i] = (const char*)Bt + (size_t)(Rb * K + C) * 2; }
    const unsigned lds0 = (unsigned)(uintptr_t)lds + (unsigned)wid * 1024u;
    const int aoff = lds_byte(wr * 64 + fr, fq * 8), boff = lds_byte(wc * 32 + fr, fq * 8);
#define G128_STAGE(s, kt) do { _Pragma("unroll") for (int _i = 0; _i < 2; ++_i) { \
        glds16(gA[_i] + (size_t)(kt) * (BK * 2), (unsigned)__builtin_amdgcn_readfirstlane(lds0 + (unsigned)((s) * 2 * HTB + _i * 8192))); \
        glds16(gB[_i] + (size_t)(kt) * (BK * 2), (unsigned)__builtin_amdgcn_readfirstlane(lds0 + (unsigned)((s) * 2 * HTB + HTB + _i * 8192))); } } while (0)
    f32x4 acc[1][1][4][2];
#pragma unroll
    for (int m = 0; m < 4; ++m)
#pragma unroll
        for (int n = 0; n < 2; ++n) acc[0][0][m][n] = (f32x4){0.f, 0.f, 0.f, 0.f};
    G128_STAGE(0, 0); G128_STAGE(1, 1); G128_STAGE(2, 2);
    for (int t = 0; t < nt; ++t) {
        const int rem = nt - 1 - t;
        if (rem >= 2) asm volatile("s_waitcnt vmcnt(8)" ::: "memory"); else if (rem == 1) asm volatile("s_waitcnt vmcnt(4)" ::: "memory"); else asm volatile("s_waitcnt vmcnt(0)" ::: "memory");
        __builtin_amdgcn_s_barrier(); asm volatile("" ::: "memory");
        if (t + 3 < nt) G128_STAGE((t + 3) & 3, t + 3);
        const PG8_LAS unsigned char* sb = lds + (t & 3) * 2 * HTB;
        bf16x8 At[4][2], Bf[2][2];
#pragma unroll
        for (int m = 0; m < 4; ++m)
#pragma unroll
            for (int k = 0; k < 2; ++k) At[m][k] = *(const PG8_LAS bf16x8*)(sb + aoff + m * 2048 + k * 1024);
#pragma unroll
        for (int n = 0; n < 2; ++n)
#pragma unroll
            for (int k = 0; k < 2; ++k) Bf[n][k] = *(const PG8_LAS bf16x8*)(sb + HTB + boff + n * 2048 + k * 1024);
        asm volatile("s_waitcnt lgkmcnt(0)" ::: "memory");
#pragma unroll
        for (int m = 0; m < 4; ++m)
#pragma unroll
            for (int n = 0; n < 2; ++n)
#pragma unroll
                for (int k = 0; k < 2; ++k) acc[0][0][m][n] = __builtin_amdgcn_mfma_f32_16x16x32_bf16(Bf[n][k], At[m][k], acc[0][0][m][n], 0, 0, 0);
    }
#undef G128_STAGE
    E.template run<1, 1>(acc, rowt, colt, true, wr, wc, fr, fq);
    asm volatile("s_waitcnt lgkmcnt(0)" ::: "memory"); __builtin_amdgcn_s_barrier(); asm volatile("" ::: "memory");
}
__device__ __forceinline__ void gemm64_resid_tile(PG8_LAS unsigned char* lds, const bf16_t* A, const bf16_t* Bt, int K, const EpiResid& E, int rowt, int colt) {
    const int tid = opaque_tid(), wid = __builtin_amdgcn_readfirstlane(tid >> 6), lane = tid & 63, wr = wid >> 2, wc = wid & 3, fr = lane & 15, fq = lane >> 4;
    const int nt = K / BK;
    const char* gA; const char* gB;
    { int R, C; stage_rc(tid * 16, R, C); gA = (const char*)A + (size_t)(R * K + C) * 2; gB = (const char*)Bt + (size_t)(R * K + C) * 2; }
    const unsigned lds0 = (unsigned)(uintptr_t)lds + (unsigned)wid * 1024u;
    const int aoff = lds_byte(wr * 32 + fr, fq * 8), boff = lds_byte(wc * 16 + fr, fq * 8);
#define G64_STAGE(s, kt) do { glds16(gA + (size_t)(kt) * (BK * 2), (unsigned)__builtin_amdgcn_readfirstlane(lds0 + (unsigned)((s) * 16384))); \
        glds16(gB + (size_t)(kt) * (BK * 2), (unsigned)__builtin_amdgcn_readfirstlane(lds0 + (unsigned)((s) * 16384 + 8192))); } while (0)
    f32x4 acc[2];
    acc[0] = (f32x4){0.f, 0.f, 0.f, 0.f}; acc[1] = (f32x4){0.f, 0.f, 0.f, 0.f};
#pragma unroll
    for (int s = 0; s < 6; ++s) G64_STAGE(s, s);
    for (int t = 0; t < nt; ++t) {
        const int rem = nt - 1 - t;
        if (rem >= 5) asm volatile("s_waitcnt vmcnt(10)" ::: "memory"); else if (rem == 4) asm volatile("s_waitcnt vmcnt(8)" ::: "memory"); else if (rem == 3) asm volatile("s_waitcnt vmcnt(6)" ::: "memory");
        else if (rem == 2) asm volatile("s_waitcnt vmcnt(4)" ::: "memory"); else if (rem == 1) asm volatile("s_waitcnt vmcnt(2)" ::: "memory"); else asm volatile("s_waitcnt vmcnt(0)" ::: "memory");
        __builtin_amdgcn_s_barrier(); asm volatile("" ::: "memory");
        if (t + 6 < nt) G64_STAGE((t + 6) & 7, t + 6);
        const PG8_LAS unsigned char* sb = lds + (t & 7) * 16384;
        bf16x8 At[2][2], Bf[2];
#pragma unroll
        for (int m = 0; m < 2; ++m)
#pragma unroll
            for (int k = 0; k < 2; ++k) At[m][k] = *(const PG8_LAS bf16x8*)(sb + aoff + m * 2048 + k * 1024);
#pragma unroll
        for (int k = 0; k < 2; ++k) Bf[k] = *(const PG8_LAS bf16x8*)(sb + 8192 + boff + k * 1024);
        asm volatile("s_waitcnt lgkmcnt(0)" ::: "memory");
#pragma unroll
        for (int m = 0; m < 2; ++m)
#pragma unroll
            for (int k = 0; k < 2; ++k) acc[m] = __builtin_amdgcn_mfma_f32_16x16x32_bf16(Bf[k], At[m][k], acc[m], 0, 0, 0);
    }
#undef G64_STAGE
    asm volatile("s_waitcnt lgkmcnt(0)" ::: "memory"); __builtin_amdgcn_s_barrier(); asm volatile("" ::: "memory");
    PG8_LAS float* part = (PG8_LAS float*)lds;
    const int col0 = colt + wc * 16 + 4 * fq;
    const float* xsrc = E.Xp ? E.Xs - (size_t)16384 * 1024 : (const float*)E.X;
#pragma unroll
    for (int m = 0; m < 2; ++m) { const int rl = wr * 32 + m * 16 + fr, row = rowt + rl;
        const f32x4 a0 = *(const f32x4*)(xsrc + (size_t)row * 1024 + col0) + acc[m];
        *(f32x4*)(E.X + (size_t)row * 1024 + col0) = a0;
        u32x2 w; w.x = cvt_pk_bf16(a0[0], a0[1]); w.y = cvt_pk_bf16(a0[2], a0[3]);
        *(u32x2*)(E.XB + (size_t)row * 1024 + col0) = w;
        float q = (a0[0] * a0[0] + a0[1] * a0[1]) + (a0[2] * a0[2] + a0[3] * a0[3]);
        q += __shfl_xor(q, 16); q += __shfl_xor(q, 32);
        if (fq == 0) part[rl * 4 + wc] = q; }
    asm volatile("s_waitcnt lgkmcnt(0)" ::: "memory"); __builtin_amdgcn_s_barrier(); asm volatile("" ::: "memory");
    if (tid < 128) { const int rl = tid >> 1, pr = tid & 1; E.ssq[(size_t)(rowt + rl) * NSSQ + (colt >> 5) + pr] = part[rl * 4 + 2 * pr] + part[rl * 4 + 2 * pr + 1]; }
    asm volatile("s_waitcnt lgkmcnt(0)" ::: "memory"); __builtin_amdgcn_s_barrier(); asm volatile("" ::: "memory");
}
}
#include <hip/hip_bf16.h>
#include <cmath>
namespace attn_body {
using bf16=__hip_bfloat16;
using bf16x8=__attribute__((ext_vector_type(8)))short;
using s16x4=__attribute__((ext_vector_type(4)))short;
using f32x16=__attribute__((ext_vector_type(16)))float;
using u32x4=__attribute__((ext_vector_type(4)))unsigned;
constexpr int BATCH=1,NHEAD=16,SEQ=16384,D=64,DM=NHEAD*D;
constexpr int NW=8,QBLK=32,QB=QBLK*NW,KVBLK=64,NQB=SEQ/QB;
constexpr int ATTN_PITCH=DM, ATTN_UNIT_ROWS=QB;
__device__ __forceinline__ int crow(int r,int hi){return (r&3)+8*(r>>2)+4*hi;}
#define SBAR() __builtin_amdgcn_sched_barrier(0)
__device__ __forceinline__ void cmask(f32x16&p0,f32x16&p1,int jb,int qrel,int hi){
  const float NEG=-INFINITY; int kb=64*jb+4*hi;
  #pragma unroll
  for(int r=0;r<16;++r){int kv=kb+(r&3)+8*(r>>2); if(kv>qrel)p0[r]=NEG; if(kv+32>qrel)p1[r]=NEG;}
}

constexpr int NSLOT=3, SLOTB=8192;
constexpr int LDS_K=0, LDS_V=NSLOT*SLOTB, LDS_WS=2*NSLOT*SLOTB, LDS_OST=LDS_WS+NW*64*4, LDS_CK=LDS_OST+NW*4096, LDS_BYTES=LDS_CK+SEQ*4;
constexpr float C2=0.125f*1.4426950408889634f;
__device__ __forceinline__ void glds16(const void*gsrc,unsigned lds_dst){unsigned keep;
  asm volatile("s_mov_b32 %0, m0\n\ts_mov_b32 m0, %2\n\ts_nop 0\n\tglobal_load_lds_dwordx4 %1, off\n\ts_mov_b32 m0, %0":"=&s"(keep):"v"(gsrc),"s"(lds_dst):"memory");}
__device__ __forceinline__ void glds16s(const void*sbase,unsigned voff,unsigned lds_dst){unsigned keep;
  asm volatile("s_mov_b32 %0, m0\n\ts_mov_b32 m0, %3\n\ts_nop 0\n\tglobal_load_lds_dwordx4 %1, %2\n\ts_mov_b32 m0, %0":"=&s"(keep):"v"(voff),"s"(sbase),"s"(lds_dst):"memory");}
__device__ __forceinline__ float max3f(float a,float b,float c){float r;asm("v_max3_f32 %0, %1, %2, %3":"=v"(r):"v"(a),"v"(b),"v"(c));return r;}
__device__ __forceinline__ float max2f(float a,float b){float r;asm("v_max_f32_e32 %0, %1, %2":"=v"(r):"v"(a),"v"(b));return r;}
__device__ __forceinline__ float fadd_s(float a,float b){float r;asm("v_add_f32_e32 %0, %1, %2":"=v"(r):"v"(a),"v"(b));return r;}
__device__ __forceinline__ float fsub_s(float a,float b){float r;asm("v_sub_f32_e32 %0, %1, %2":"=v"(r):"v"(a),"v"(b));return r;}
typedef float f32x2_t __attribute__((ext_vector_type(2))); typedef __bf16 bf16x2_t __attribute__((ext_vector_type(2)));
__device__ __forceinline__ unsigned cvtpk_s(float lo,float hi){f32x2_t v={lo,hi};bf16x2_t b=__builtin_convertvector(v,bf16x2_t);return __builtin_bit_cast(unsigned,b);}
#define WAIT_BAR(N) asm volatile("s_waitcnt vmcnt(" #N ") lgkmcnt(0)\n\ts_barrier":::"memory")

__device__ __forceinline__ void qkt(f32x16&p0,f32x16&p1,const char*Kslot,const bf16x8*qr,const f32x16&negm,int r32,int hi){
  const char*kb=Kslot+hi*1024+r32*16;
  #pragma unroll
  for(int d0=0;d0<4;++d0){
    const bf16x8 b0=*reinterpret_cast<const bf16x8*>(kb+d0*2048);
    const bf16x8 b1=*reinterpret_cast<const bf16x8*>(kb+d0*2048+512);
    if(d0==0){p0=__builtin_amdgcn_mfma_f32_32x32x16_bf16(b0,qr[0],negm,0,0,0);p1=__builtin_amdgcn_mfma_f32_32x32x16_bf16(b1,qr[0],negm,0,0,0);}
    else{p0=__builtin_amdgcn_mfma_f32_32x32x16_bf16(b0,qr[d0],p0,0,0,0);p1=__builtin_amdgcn_mfma_f32_32x32x16_bf16(b1,qr[d0],p1,0,0,0);}}
}
typedef __attribute__((address_space(3))) const char* lds_cptr;
typedef short v4i16_t __attribute__((ext_vector_type(4)));
__device__ __forceinline__ void kload8(bf16x8*kf,lds_cptr kp){
  kf[0]=*(const __attribute__((address_space(3))) bf16x8*)(kp);      kf[1]=*(const __attribute__((address_space(3))) bf16x8*)(kp+512);
  kf[2]=*(const __attribute__((address_space(3))) bf16x8*)(kp+2048); kf[3]=*(const __attribute__((address_space(3))) bf16x8*)(kp+2560);
  kf[4]=*(const __attribute__((address_space(3))) bf16x8*)(kp+4096); kf[5]=*(const __attribute__((address_space(3))) bf16x8*)(kp+4608);
  kf[6]=*(const __attribute__((address_space(3))) bf16x8*)(kp+6144); kf[7]=*(const __attribute__((address_space(3))) bf16x8*)(kp+6656);
}
__device__ __forceinline__ void kload2(bf16x8*kf,lds_cptr kp,int j){ kf[2*j]=*(const __attribute__((address_space(3))) bf16x8*)(kp+j*2048); kf[2*j+1]=*(const __attribute__((address_space(3))) bf16x8*)(kp+j*2048+512); }
__device__ __forceinline__ s16x4 vtr(lds_cptr p){ return __builtin_bit_cast(s16x4,__builtin_amdgcn_ds_read_tr16_b64_v4i16((__attribute__((address_space(3))) v4i16_t*)p)); }
__device__ __forceinline__ float rowmax(const f32x16&p0,const f32x16&p1){
  float a=max3f(p0[0],p0[1],p1[0]),b=max3f(p0[2],p0[3],p1[1]);a=max3f(a,p1[2],p1[3]);
  #pragma unroll
  for(int r=4;r<16;r+=4){a=max3f(a,p0[r],p0[r+1]);b=max3f(b,p0[r+2],p0[r+3]);a=max3f(a,p1[r],p1[r+1]);b=max3f(b,p1[r+2],p1[r+3]);}
  const float m=max2f(a,b);
  auto rr=__builtin_amdgcn_permlane32_swap(__float_as_uint(m),__float_as_uint(m),false,false);
  return max2f(__uint_as_float(rr[0]),__uint_as_float(rr[1]));
}
__device__ __forceinline__ void pv(f32x16*o,int vb,bf16x8 pa0,bf16x8 pa1,bf16x8 pa2,bf16x8 pa3){
  #pragma unroll
  for(int d0=0;d0<2;++d0){s16x4 lo[4],hi[4];
    #pragma unroll
    for(int ks=0;ks<4;++ks){
      asm volatile("ds_read_b64_tr_b16 %0,%1 offset:%c2":"=&v"(lo[ks]):"v"(vb),"i"(d0*4096+ks*1024):"memory");
      asm volatile("ds_read_b64_tr_b16 %0,%1 offset:%c2":"=&v"(hi[ks]):"v"(vb),"i"(d0*4096+ks*1024+512):"memory");}
    asm volatile("s_waitcnt lgkmcnt(0)":::"memory");SBAR();
    #define PK(k) (bf16x8){lo[k][0],lo[k][1],lo[k][2],lo[k][3],hi[k][0],hi[k][1],hi[k][2],hi[k][3]}
    o[d0]=__builtin_amdgcn_mfma_f32_32x32x16_bf16(pa0,PK(0),o[d0],0,0,0);
    o[d0]=__builtin_amdgcn_mfma_f32_32x32x16_bf16(pa1,PK(1),o[d0],0,0,0);
    o[d0]=__builtin_amdgcn_mfma_f32_32x32x16_bf16(pa2,PK(2),o[d0],0,0,0);
    o[d0]=__builtin_amdgcn_mfma_f32_32x32x16_bf16(pa3,PK(3),o[d0],0,0,0);
    #undef PK
  }
}

#ifndef ATTN_STORE16
#define ATTN_STORE16(p,v) (*(u32x4*)(p)=(v))
#endif
typedef float f32x4_t __attribute__((ext_vector_type(4)));
#define CKSUB(C0,C1,t) do{ const __attribute__((address_space(3))) f32x4_t* ck_=(const __attribute__((address_space(3))) f32x4_t*)(ckl+(t)*64+4*hi); \
   _Pragma("unroll") for(int g_=0;g_<4;++g_){ const f32x4_t a_=ck_[2*g_], b_=ck_[8+2*g_]; \
     _Pragma("unroll") for(int i_=0;i_<4;++i_){ C0[4*g_+i_]-=a_[i_]; C1[4*g_+i_]-=b_[i_]; } } }while(0)
template<int THRL> __device__ __forceinline__ void attn_unit(int b,int h,int qb,const bf16*Q,const bf16*__restrict__ K,const bf16*__restrict__ V,bf16*O,char*shm,const float*ckg,const float kmax2){
  const int tid=opaque_tid(),lane=tid&63,r32=lane&31,hi=lane>>5; const int wid=__builtin_amdgcn_readfirstlane(tid>>6);
  const long rowbase=(long)b*SEQ; const int q0=qb*QB;
  const bf16*Qw=Q+(rowbase+q0+wid*QBLK)*DM+h*D;
  const unsigned lds0=(unsigned)(uintptr_t)shm;
  float*wsf=(float*)(shm+LDS_WS)+wid*64;
  __attribute__((address_space(3))) float* ckl=(__attribute__((address_space(3))) float*)((__attribute__((address_space(3))) char*)shm+LDS_CK);
  const float cqv=ckg[q0+wid*QBLK+r32];
  bf16x8 qr[4];
  #pragma unroll
  for(int d0=0;d0<4;++d0)qr[d0]=*reinterpret_cast<const bf16x8*>(&Qw[(long)r32*DM+d0*16+hi*8]);
  int t0=0;
  if(qb>0){
    float*wsa=(float*)(shm+LDS_WS);
    float qs=0.f;
    #pragma unroll
    for(int d0=0;d0<4;++d0){
      #pragma unroll
      for(int e=0;e<8;++e){ const float v_=__builtin_bit_cast(float,((unsigned)(unsigned short)qr[d0][e])<<16); qs+=v_*v_; } }
    qs+=__shfl_xor(qs,32);
    #pragma unroll
    for(int o_=1;o_<32;o_<<=1) qs=fmaxf(qs,__shfl_xor(qs,o_));
    float dg=0.f;
    { const bf16*Kq=K+(rowbase+q0+wid*QBLK)*DM+h*D;
      #pragma unroll
      for(int d0=0;d0<4;++d0){ const bf16x8 kd_=*reinterpret_cast<const bf16x8*>(&Kq[(long)r32*DM+d0*16+hi*8]);
        #pragma unroll
        for(int e=0;e<8;++e){ dg+=__builtin_bit_cast(float,((unsigned)(unsigned short)qr[d0][e])<<16)*__builtin_bit_cast(float,((unsigned)(unsigned short)kd_[e])<<16); } } }
    dg+=__shfl_xor(dg,32);
    #pragma unroll
    for(int o_=1;o_<32;o_<<=1) dg=fminf(dg,__shfl_xor(dg,o_));
    const int ncand=q0/KVBLK;
    float cend=0.f; if(tid<ncand) cend=ckg[tid*KVBLK+KVBLK-1];
    const float cq0=ckg[q0];
    if(lane==0){ wsa[wid]=qs; wsa[16+wid]=dg; }
    __syncthreads();
    float qm=wsa[0];
    #pragma unroll
    for(int w_=1;w_<NW;++w_) qm=fmaxf(qm,wsa[w_]);
    float dmn=wsa[16];
    #pragma unroll
    for(int w_=1;w_<NW;++w_) dmn=fminf(dmn,wsa[16+w_]);
    const float thr=dmn-40.05f-sqrtf(qm*kmax2)*1.0001f;
    const bool skip_=(tid<ncand)&&((cq0-cend)<thr);
    const unsigned long long bal_=__ballot(skip_);
    if(lane==0) wsa[8+wid]=(float)__popcll(bal_);
    __syncthreads();
    float cnt_=0.f;
    #pragma unroll
    for(int w_=0;w_<NW;++w_) cnt_+=wsa[8+w_];
    t0=__builtin_amdgcn_readfirstlane(((int)cnt_)&~1);
    __syncthreads();
  }
  const bf16*Kh=K+(rowbase+(long)t0*KVBLK)*DM+h*D,*Vh=V+(rowbase+(long)t0*KVBLK)*DM+h*D;
  { const int nf4=(q0+QB-t0*KVBLK)>>2; const f32x4_t* src_=(const f32x4_t*)(ckg+t0*KVBLK); __attribute__((address_space(3))) f32x4_t* dst_=(__attribute__((address_space(3))) f32x4_t*)ckl;
    for(int i_=tid;i_<nf4;i_+=NW*64) dst_[i_]=src_[i_]; }
  const unsigned kvoff=(unsigned)((lane*DM+wid*8)*2);
  const unsigned vvoff=(unsigned)(((16*(wid&3)+(lane>>2))*DM+(wid>>2)*32+(lane&3)*8)*2);
  const unsigned kdst=lds0+LDS_K+wid*1024, vdst=lds0+LDS_V+wid*1024;
  #define DMA_K(t,slot) glds16s(Kh+(long)(t)*KVBLK*DM,kvoff,(unsigned)__builtin_amdgcn_readfirstlane(kdst+(slot)))
  #define DMA_V(t,slot) glds16s(Vh+(long)(t)*KVBLK*DM,vvoff,(unsigned)__builtin_amdgcn_readfirstlane(vdst+(slot)))
  const int vb0=(int)(lds0+LDS_V)+((lane>>4)&1)*32+(lane&3)*8+(4*hi+((lane&15)>>2))*64;
  const char*Kbase=shm+LDS_K; bf16x8 kf[8];
  const lds_cptr shm3=(lds_cptr)shm; const lds_cptr kp0=shm3+LDS_K+hi*1024+r32*16; const lds_cptr vp0=shm3+LDS_V+((lane>>4)&1)*32+(lane&3)*8+(4*hi+((lane&15)>>2))*64;
  const int NT=(q0+QB)/KVBLK-t0;
  DMA_K(0,0);DMA_V(0,0);DMA_K(1,SLOTB);
  float mhat=-cqv,l_reg=0.f;    f32x16 o[2];o[0]=f32x16{};o[1]=f32x16{};f32x16 negm;
  #pragma unroll
  for(int r=0;r<16;++r)negm[r]=cqv;
  asm volatile("":"+v"(negm));
  const int qrel=wid*QBLK+r32;
  #define CMASK(P0,P1,t) do{int jb_=(t)-(NT-4); if(jb_>=0)cmask(P0,P1,jb_,qrel,hi);}while(0)
  bool resc=false;
  #define START(P0,P1) do{ const float rm=rowmax(P0,P1); resc=false; \
    { const float dl=rm; mhat=fadd_s(mhat,dl); \
      _Pragma("unroll") for(int r=0;r<16;++r){P0[r]=fsub_s(P0[r],dl);P1[r]=fsub_s(P1[r],dl);} \
      _Pragma("unroll") for(int r=0;r<16;++r)negm[r]=-mhat; asm volatile("":"+v"(negm)); } \
    _Pragma("unroll") for(int r=0;r<16;++r)P0[r]=__builtin_amdgcn_exp2f(P0[r]); }while(0)
  #define RESC() do{ if(resc){ asm volatile("s_waitcnt lgkmcnt(0)":::"memory"); \
      _Pragma("unroll") for(int d_=0;d_<2;++d_) _Pragma("unroll") for(int r=0;r<16;++r)o[d_][r]*=wsf[crow(r,hi)]; } }while(0)
  f32x16 pA0,pA1,pB0,pB1;
  int sl_prev=0,sl_cur=0,sl_next=SLOTB;
  #define ROT() do{sl_prev=sl_cur;sl_cur=sl_next;sl_next=(sl_next==(NSLOT-1)*SLOTB)?0:sl_next+SLOTB;}while(0)
  DMA_K(2,2*SLOTB);
  WAIT_BAR(3);
  qkt(pA0,pA1,Kbase,qr,negm,r32,hi);asm volatile("s_nop 15\n\ts_nop 7":"+v"(pA0),"+v"(pA1));CKSUB(pA0,pA1,0);CMASK(pA0,pA1,0);
  START(pA0,pA1);
  _Pragma("unroll") for(int r=0;r<16;++r)pA1[r]=__builtin_amdgcn_exp2f(pA1[r]);
  WAIT_BAR(0);
  DMA_K(3,0);DMA_V(1,SLOTB);
  ROT();
  kload8(kf,kp0+sl_cur);
  WAIT_BAR(2);
  s16x4 vlo[8],vhi[8]; u32x4 pw0,pw1,pw2,pw3;
  #define PKW(P,B) cvtpk_s(P[B],P[B+1])
  #define PAF(k) __builtin_bit_cast(bf16x8,pw##k)
  #define VFR(i) (bf16x8){vlo[i][0],vlo[i][1],vlo[i][2],vlo[i][3],vhi[i][0],vhi[i][1],vhi[i][2],vhi[i][3]}
  #define PIN(x) asm volatile("":"+v"(x))
  #define MX3(a,b,c) __builtin_fmaxf(__builtin_fmaxf((a),(b)),(c))
  #define GAPA(MF,A0,A1,A2,A3,W0,W1,PW) do{ MF; sacc+=A0; sacc+=A1; sacc+=A2; sacc+=A3; PIN(sacc); W0; W1; PIN(PW); SBAR(); }while(0)
  #define EX(v) __builtin_amdgcn_exp2f(v)
  #define GAPB(MF,X,B) do{ MF; X[B]=EX(X[B]); X[B+1]=EX(X[B+1]); X[B+2]=EX(X[B+2]); X[B+3]=EX(X[B+3]); PIN(X); SBAR(); }while(0)
  #define VRD(i) do{ vlo[i]=vtr(vp_+(((i)>>2)*4096+((i)&3)*1024)); vhi[i]=vtr(vp_+(((i)>>2)*4096+((i)&3)*1024+512)); }while(0)
  #define KRD(G,j) do{ if(G){ kload2(kf,kp0+sl_next,j); SBAR(); } }while(0)
  #define STEP(C0,C1,P0,P1,t,GK,GV,GL) do{ SBAR(); \
    const lds_cptr vp_=vp0+sl_prev; \
    VRD(0); SBAR(); float sacc=(P0[0]+P0[1]); \
    GAPA(C0=__builtin_amdgcn_mfma_f32_32x32x16_bf16(kf[0],qr[0],negm,0,0,0), P0[2],P0[3],P0[4],P0[5],     pw0[0]=PKW(P0,0), pw0[1]=PKW(P0,2), pw0); \
    VRD(4); SBAR(); GAPA(C1=__builtin_amdgcn_mfma_f32_32x32x16_bf16(kf[1],qr[0],negm,0,0,0), P0[6],P0[7],P0[8],P0[9],     pw0[2]=PKW(P0,4), pw0[3]=PKW(P0,6), pw0); \
    VRD(1); SBAR(); GAPA(C0=__builtin_amdgcn_mfma_f32_32x32x16_bf16(kf[2],qr[1],C0,0,0,0),   P0[10],P0[11],P0[12],P0[13], pw1[0]=PKW(P0,8), pw1[1]=PKW(P0,10), pw1); \
    VRD(5); SBAR(); GAPA(C1=__builtin_amdgcn_mfma_f32_32x32x16_bf16(kf[3],qr[1],C1,0,0,0),   P0[14],P0[15],P1[0],P1[1],   pw1[2]=PKW(P0,12),pw1[3]=PKW(P0,14), pw1); \
    VRD(2); SBAR(); GAPA(C0=__builtin_amdgcn_mfma_f32_32x32x16_bf16(kf[4],qr[2],C0,0,0,0),   P1[2],P1[3],P1[4],P1[5],     pw2[0]=PKW(P1,0), pw2[1]=PKW(P1,2), pw2); \
    VRD(6); SBAR(); GAPA(C1=__builtin_amdgcn_mfma_f32_32x32x16_bf16(kf[5],qr[2],C1,0,0,0),   P1[6],P1[7],P1[8],P1[9],     pw2[2]=PKW(P1,4), pw2[3]=PKW(P1,6), pw2); \
    VRD(3); SBAR(); GAPA(C0=__builtin_amdgcn_mfma_f32_32x32x16_bf16(kf[6],qr[3],C0,0,0,0),   P1[10],P1[11],P1[12],P1[13], pw3[0]=PKW(P1,8), pw3[1]=PKW(P1,10), pw3); \
    VRD(7); SBAR(); GAPA(C1=__builtin_amdgcn_mfma_f32_32x32x16_bf16(kf[7],qr[3],C1,0,0,0),   P1[14],P1[15],0.f,0.f,       pw3[2]=PKW(P1,12),pw3[3]=PKW(P1,14), pw3); \
    l_reg+=sacc; \
    if(GK){DMA_K((t)+3,sl_cur);} if(GV){DMA_V((t)+1,sl_next);} \
    CKSUB(C0,C1,t); CMASK(C0,C1,t); \
    { float a=MX3(C0[0],C0[1],C1[0]),b=MX3(C0[2],C0[3],C1[1]); a=MX3(a,C1[2],C1[3]); \
      _Pragma("unroll") for(int r=4;r<16;r+=4){a=MX3(a,C0[r],C0[r+1]);b=MX3(b,C0[r+2],C0[r+3]);a=MX3(a,C1[r],C1[r+1]);b=MX3(b,C1[r+2],C1[r+3]);} \
      float rm=__builtin_fmaxf(a,b); { auto rr=__builtin_amdgcn_permlane32_swap(__float_as_uint(rm),__float_as_uint(rm),false,false); rm=__builtin_fmaxf(__uint_as_float(rr[0]),__uint_as_float(rr[1])); } \
      resc=false; \
      if(__builtin_expect(__any(rm>(float)THRL),0)){ const float dl=__builtin_fmaxf(rm,0.f); mhat+=dl; \
        _Pragma("unroll") for(int r=0;r<16;++r){C0[r]-=dl;C1[r]-=dl;} \
        _Pragma("unroll") for(int r=0;r<16;++r)negm[r]=-mhat; asm volatile("":"+v"(negm)); \
        const float f=__builtin_amdgcn_exp2f(-dl); l_reg*=f; if(hi==0)wsf[r32]=f; resc=true; } } \
    SBAR(); \
    GAPB(o[0]=__builtin_amdgcn_mfma_f32_32x32x16_bf16(PAF(0),VFR(0),o[0],0,0,0), C0,0); \
    GAPB(o[1]=__builtin_amdgcn_mfma_f32_32x32x16_bf16(PAF(0),VFR(4),o[1],0,0,0), C0,4); \
    KRD(GL,0); GAPB(o[0]=__builtin_amdgcn_mfma_f32_32x32x16_bf16(PAF(1),VFR(1),o[0],0,0,0), C0,8); \
    KRD(GL,1); GAPB(o[1]=__builtin_amdgcn_mfma_f32_32x32x16_bf16(PAF(1),VFR(5),o[1],0,0,0), C0,12); \
    KRD(GL,2); GAPB(o[0]=__builtin_amdgcn_mfma_f32_32x32x16_bf16(PAF(2),VFR(2),o[0],0,0,0), C1,0); \
    KRD(GL,3); GAPB(o[1]=__builtin_amdgcn_mfma_f32_32x32x16_bf16(PAF(2),VFR(6),o[1],0,0,0), C1,4); \
    GAPB(o[0]=__builtin_amdgcn_mfma_f32_32x32x16_bf16(PAF(3),VFR(3),o[0],0,0,0), C1,8); \
    GAPB(o[1]=__builtin_amdgcn_mfma_f32_32x32x16_bf16(PAF(3),VFR(7),o[1],0,0,0), C1,12); \
    }while(0)
  int t=1;
  #undef CMASK
  #define CMASK(P0,P1,t) do{}while(0)
  for(;t+5<NT;t+=2){
    STEP(pB0,pB1,pA0,pA1,t,true,true,true);     WAIT_BAR(2); RESC(); ROT();
    STEP(pA0,pA1,pB0,pB1,t+1,true,true,true);   WAIT_BAR(2); RESC(); ROT();
  }
  #undef CMASK
  #define CMASK(P0,P1,t) do{int jb_=(t)-(NT-4); if(jb_>=0)cmask(P0,P1,jb_,qrel,hi);}while(0)
  #define ENDW(tt) do{ if((tt)+3<NT){WAIT_BAR(2);} else if((tt)+2<NT){WAIT_BAR(1);} else {WAIT_BAR(0);} }while(0)
  for(;t+1<NT;t+=2){
    STEP(pB0,pB1,pA0,pA1,t,(t+3<NT),(t+1<NT),(t+1<NT));       ENDW(t);   RESC(); ROT();
    STEP(pA0,pA1,pB0,pB1,t+1,(t+4<NT),(t+2<NT),(t+2<NT));     ENDW(t+1); RESC(); ROT();
  }
  STEP(pB0,pB1,pA0,pA1,NT-1,false,false,false); RESC();
  { float sacc=pB0[0]+pB0[1]; _Pragma("unroll") for(int r=2;r<16;++r)sacc+=pB0[r]; _Pragma("unroll") for(int r=0;r<16;++r)sacc+=pB1[r]; l_reg+=sacc;
    pw0=(u32x4){PKW(pB0,0),PKW(pB0,2),PKW(pB0,4),PKW(pB0,6)};pw1=(u32x4){PKW(pB0,8),PKW(pB0,10),PKW(pB0,12),PKW(pB0,14)};pw2=(u32x4){PKW(pB1,0),PKW(pB1,2),PKW(pB1,4),PKW(pB1,6)};pw3=(u32x4){PKW(pB1,8),PKW(pB1,10),PKW(pB1,12),PKW(pB1,14)};
    SBAR(); pv(o,vb0+sl_cur,PAF(0),PAF(1),PAF(2),PAF(3)); }
  #undef PKW
  #undef PAF
  #undef VFR
  #undef PIN
  #undef MX3
  #undef GAPA
  #undef GAPB
  #undef EX
  #undef VRD
  #undef KRD
  #undef STEP
  #undef ENDW
  {auto rr=__builtin_amdgcn_permlane32_swap(__float_as_uint(l_reg),__float_as_uint(l_reg),false,false);l_reg=__uint_as_float(rr[0])+__uint_as_float(rr[1]);}
  if(hi==0)wsf[32+r32]=l_reg;asm volatile("s_waitcnt lgkmcnt(0)":::"memory");
  float rli[16];
  #pragma unroll
  for(int r=0;r<16;++r)rli[r]=__builtin_amdgcn_rcpf(wsf[32+crow(r,hi)]);
  bf16*Ow=O+(rowbase+q0+wid*QBLK)*DM+h*D;
  { bf16*stg=(bf16*)(shm+LDS_OST)+wid*2048;
    #pragma unroll
    for(int r=0;r<16;++r){const int orow=crow(r,hi);
      #pragma unroll
      for(int d0=0;d0<2;++d0)stg[orow*64+d0*32+r32]=__float2bfloat16(o[d0][r]*rli[r]);}
    asm volatile("s_waitcnt lgkmcnt(0)":::"memory");
    #pragma unroll
    for(int i=0;i<4;++i){const int row=i*8+(lane>>3),ch=lane&7; const u32x4 v=*(const u32x4*)(stg+row*64+ch*8); ATTN_STORE16(Ow+(long)row*DM+ch*8,v);} }
  asm volatile("s_waitcnt lgkmcnt(0)\n\ts_barrier":::"memory");
  #undef DMA_K
  #undef DMA_V
  #undef CMASK
  #undef START
  #undef RESC
  #undef ROT
}
constexpr int ATTN_LDS_BYTES=LDS_BYTES;
struct AttnTensors { const bf16* Q; const bf16* K; const bf16* V; bf16* O; const float* CL; const unsigned* KMAX; };
struct AttnUnit { int bh; int qb; };
template<int THRL=8> __device__ __forceinline__ void attn_phase_q(char*lds,const AttnTensors&T,unsigned*qctr,int block){
  volatile __attribute__((address_space(3))) int* tk=(volatile __attribute__((address_space(3))) int*)((__attribute__((address_space(3))) char*)lds+LDS_WS);
  for(;;){
    if(threadIdx.x==0){ int v=-1,q=block&7; for(int tried=0;tried<8;++tried){ const unsigned i_=__hip_atomic_fetch_add(qctr+64*q,1u,__ATOMIC_RELAXED,__HIP_MEMORY_SCOPE_AGENT); if(i_<128u){ v=(int)(q*128u+i_); break; } q=(q+1)&7; } tk[0]=v; }
    __syncthreads();
    const int u=__builtin_amdgcn_readfirstlane(tk[0]);
    __syncthreads();
    if(u<0)break;
    const int qq=u>>7,i_=u&127,h=2*qq+(i_&1),qb=63-(i_>>1);
    attn_unit<THRL>(0,h,qb,T.Q,T.K,T.V,T.O,lds,T.CL+(size_t)h*SEQ,__builtin_bit_cast(float,T.KMAX[h]));
  }
}
#undef SBAR
#undef WAIT_BAR
}
namespace sattn {
#define SLAS __attribute__((address_space(3)))
typedef short bf16x8 __attribute__((ext_vector_type(8)));
typedef float f32x4 __attribute__((ext_vector_type(4)));
typedef unsigned u32x4 __attribute__((ext_vector_type(4)));
typedef unsigned u32x2 __attribute__((ext_vector_type(2)));
typedef float f32x2_t __attribute__((ext_vector_type(2))); typedef __bf16 bf16x2_t __attribute__((ext_vector_type(2)));
__device__ __forceinline__ unsigned pk(float lo, float hi) { f32x2_t v = {lo, hi}; bf16x2_t b = __builtin_convertvector(v, bf16x2_t); return __builtin_bit_cast(unsigned, b); }
__device__ __forceinline__ bf16x8 cvt8(f32x4 a, f32x4 b) { u32x4 w; w.x = pk(a[0], a[1]); w.y = pk(a[2], a[3]); w.z = pk(b[0], b[1]); w.w = pk(b[2], b[3]); return __builtin_bit_cast(bf16x8, w); }
constexpr int PAST = 2048, NEWK = 16, LKEYS = PAST + NEWK, VT_STRIDE = 80, VT_BYTES = 64 * VT_STRIDE;
constexpr int L_VT = 0, L_CO = 8 * VT_BYTES, L_CM = L_CO + 8 * 16 * 64 * 4, L_CL = L_CM + 8 * 16 * 4, L_END = L_CL + 8 * 16 * 4;
constexpr float NEG = -1.0e30f;
struct Tensors { const float* ck; const float* cv; const unsigned short* QB; const unsigned short* KB; const unsigned short* VB; unsigned short* O; const float* CLS; };
__device__ __forceinline__ void tile_tail(f32x4 (&s)[2], const bf16x8 (&vw)[4], float& m, float& l, f32x4 (&o)[4], SLAS char* vt, int r, int g) {
    float mx = fmaxf(fmaxf(fmaxf(s[0][0], s[0][1]), fmaxf(s[0][2], s[0][3])), fmaxf(fmaxf(s[1][0], s[1][1]), fmaxf(s[1][2], s[1][3])));
    mx = fmaxf(mx, __shfl_xor(mx, 16)); mx = fmaxf(mx, __shfl_xor(mx, 32));
    const float mn = fmaxf(m, mx), alpha = __builtin_amdgcn_exp2f(m - mn); m = mn;
    float ps = 0.f;
#pragma unroll
    for (int j = 0; j < 2; ++j)
#pragma unroll
        for (int e = 0; e < 4; ++e) { s[j][e] = __builtin_amdgcn_exp2f(s[j][e] - mn); ps += s[j][e]; }
    l = l * alpha + ps;
#pragma unroll
    for (int db = 0; db < 4; ++db) o[db] *= alpha;
    const bf16x8 pb = cvt8(s[0], s[1]);
#pragma unroll
    for (int dd = 0; dd < 4; ++dd) *(SLAS bf16x8*)(vt + (4 * r + dd) * VT_STRIDE + g * 16) = vw[dd];
#pragma unroll
    for (int db = 0; db < 4; ++db) { const bf16x8 va = *(const SLAS bf16x8*)(vt + (16 * db + r) * VT_STRIDE + g * 16); o[db] = __builtin_amdgcn_mfma_f32_16x16x32_bf16(va, pb, o[db], 0, 0, 0); }
}
__device__ __forceinline__ void unit(int b, int h, const Tensors& T, SLAS char* lds) {
    const int tid = opaque_tid(), lane = tid & 63, r = lane & 15, g = lane >> 4; const int wid = __builtin_amdgcn_readfirstlane(tid >> 6);
    SLAS char* vt = lds + L_VT + wid * VT_BYTES;
    const size_t srow = (size_t)16384 + (size_t)b * 16;
    const float* cls = T.CLS + (size_t)(b * 16 + h) * LKEYS;
    const unsigned short* qp = T.QB + (srow + r) * 1024 + h * 64 + 8 * g;
    const bf16x8 qf0 = *(const bf16x8*)qp, qf1 = *(const bf16x8*)(qp + 32);
    const float cq = cls[PAST + r];
    float m = NEG, l = 0.f; f32x4 o[4];
#pragma unroll
    for (int db = 0; db < 4; ++db) o[db] = (f32x4){0.f, 0.f, 0.f, 0.f};
    const float* kc = T.ck + ((size_t)b * PAST * 16 + h) * 64; const float* vc = T.cv + ((size_t)b * PAST * 16 + h) * 64;
    for (int tI = 0; tI < 8; ++tI) {
        const int k0 = wid * 256 + tI * 32;
        bf16x8 ka[2][2];
#pragma unroll
        for (int j = 0; j < 2; ++j)
#pragma unroll
            for (int dh = 0; dh < 2; ++dh) { const float* p = kc + (size_t)(k0 + 16 * j + r) * 1024 + dh * 32 + 8 * g; ka[j][dh] = cvt8(*(const f32x4*)p, *(const f32x4*)(p + 4)); }
        f32x4 vv[2][4];
#pragma unroll
        for (int j = 0; j < 2; ++j)
#pragma unroll
            for (int e = 0; e < 4; ++e) vv[j][e] = *(const f32x4*)(vc + (size_t)(k0 + 16 * j + 4 * g + e) * 1024 + 4 * r);
        f32x4 ckv[2];
#pragma unroll
        for (int j = 0; j < 2; ++j) ckv[j] = *(const f32x4*)(cls + k0 + 16 * j + 4 * g);
        f32x4 s[2];
#pragma unroll
        for (int j = 0; j < 2; ++j) { s[j] = __builtin_amdgcn_mfma_f32_16x16x32_bf16(ka[j][0], qf0, (f32x4){0.f, 0.f, 0.f, 0.f}, 0, 0, 0); s[j] = __builtin_amdgcn_mfma_f32_16x16x32_bf16(ka[j][1], qf1, s[j], 0, 0, 0); }
#pragma unroll
        for (int j = 0; j < 2; ++j)
#pragma unroll
            for (int e = 0; e < 4; ++e) s[j][e] += cq - ckv[j][e];
        bf16x8 vw[4];
#pragma unroll
        for (int dd = 0; dd < 4; ++dd) { u32x4 w; w.x = pk(vv[0][0][dd], vv[0][1][dd]); w.y = pk(vv[0][2][dd], vv[0][3][dd]); w.z = pk(vv[1][0][dd], vv[1][1][dd]); w.w = pk(vv[1][2][dd], vv[1][3][dd]); vw[dd] = __builtin_bit_cast(bf16x8, w); }
        tile_tail(s, vw, m, l, o, vt, r, g);
    }
    if (wid == 0) {
        bf16x8 ka[2]; { const unsigned short* p = T.KB + (srow + r) * 1024 + h * 64 + 8 * g; ka[0] = *(const bf16x8*)p; ka[1] = *(const bf16x8*)(p + 32); }
        const f32x4 ckv = *(const f32x4*)(cls + PAST + 4 * g);
        f32x4 s[2];
        s[0] = __builtin_amdgcn_mfma_f32_16x16x32_bf16(ka[0], qf0, (f32x4){0.f, 0.f, 0.f, 0.f}, 0, 0, 0); s[0] = __builtin_amdgcn_mfma_f32_16x16x32_bf16(ka[1], qf1, s[0], 0, 0, 0);
#pragma unroll
        for (int e = 0; e < 4; ++e) { s[0][e] += cq - ckv[e]; if (4 * g + e > r) s[0][e] = NEG; s[1][e] = NEG; }
        unsigned short ve[4][4];
#pragma unroll
        for (int e = 0; e < 4; ++e) { const u32x2 w = *(const u32x2*)(T.VB + (srow + 4 * g + e) * 1024 + h * 64 + 4 * r); ve[e][0] = (unsigned short)(w.x & 0xffffu); ve[e][1] = (unsigned short)(w.x >> 16); ve[e][2] = (unsigned short)(w.y & 0xffffu); ve[e][3] = (unsigned short)(w.y >> 16); }
        bf16x8 vw[4];
#pragma unroll
        for (int dd = 0; dd < 4; ++dd) { u32x4 w; w.x = (unsigned)ve[0][dd] | ((unsigned)ve[1][dd] << 16); w.y = (unsigned)ve[2][dd] | ((unsigned)ve[3][dd] << 16); w.z = 0u; w.w = 0u; vw[dd] = __builtin_bit_cast(bf16x8, w); }
        tile_tail(s, vw, m, l, o, vt, r, g);
    }
    l += __shfl_xor(l, 16); l += __shfl_xor(l, 32);
    SLAS float* co = (SLAS float*)(lds + L_CO) + (wid * 16 + r) * 64; SLAS float* cm = (SLAS float*)(lds + L_CM); SLAS float* cl = (SLAS float*)(lds + L_CL);
#pragma unroll
    for (int db = 0; db < 4; ++db) *(SLAS f32x4*)(co + 16 * db + 4 * g) = o[db];
    if (g == 0) { cm[wid * 16 + r] = m; cl[wid * 16 + r] = l; }
    __syncthreads();
    { const int q = tid >> 5, d2 = (tid & 31) * 2; float mm = NEG;
#pragma unroll
      for (int w = 0; w < 8; ++w) mm = fmaxf(mm, cm[w * 16 + q]);
      float den = 0.f, n0 = 0.f, n1 = 0.f;
#pragma unroll
      for (int w = 0; w < 8; ++w) { const float f = __builtin_amdgcn_exp2f(cm[w * 16 + q] - mm); den += f * cl[w * 16 + q]; const SLAS float* c = (const SLAS float*)(lds + L_CO) + (w * 16 + q) * 64 + d2; n0 += f * c[0]; n1 += f * c[1]; }
      const float inv = 1.0f / den;
      *(unsigned*)(T.O + (srow + q) * 1024 + h * 64 + d2) = pk(n0 * inv, n1 * inv); }
    __syncthreads();
}
#undef SLAS
}
namespace cg = cooperative_groups;
constexpr int NWAVES = 8;
constexpr int D = 1024, H = 16, FF = 4096, MP = 16384, MS = 512, M = MP + MS, PAST = 2048, DBATCH = 32, DSEQ = 16, LKEYS = PAST + DSEQ;
constexpr float RMS_EPS = 1e-6f, L2E = 1.4426950408889634f, QSCALE = 0.125f * 1.4426950408889634f;
constexpr size_t OUT_Y = 0, OUT_KP = 17301504, OUT_VP = 34078720, OUT_LP = 50855936, OUT_CP = 51118080, OUT_KS = 51122176, OUT_VS = 51646464, OUT_LS = 52170752, OUT_CS = 52178944, OUT_END = 52310016;
static_assert(OUT_KP == (size_t)pg8::OUT_KP && OUT_VP == (size_t)pg8::OUT_VP && OUT_KS == (size_t)pg8::OUT_KS && OUT_VS == (size_t)pg8::OUT_VS, "d_out map");
constexpr size_t MiB = 1u << 20;
constexpr size_t WS_CTL = 0, CTL_ZERO_BYTES = 1 * MiB;
constexpr size_t WS_WIN = 2 * MiB, WS_WOUT = 14 * MiB, WS_WKVQ = 18 * MiB, WS_WQ1 = 24 * MiB, WS_WO = 26 * MiB, WS_WUP = 30 * MiB, WS_WDN = 62 * MiB, WS_WF = 94 * MiB;
constexpr size_t WS_X = 96 * MiB, WS_XB = 162 * MiB, WS_G = 195 * MiB, WS_KB = 228 * MiB, WS_VB = 261 * MiB, WS_QB = 294 * MiB, WS_HB = 327 * MiB, WS_SSQ = 459 * MiB, WS_CLP = 462 * MiB, WS_CLS = 463 * MiB, WS_END = 468 * MiB;
static_assert((size_t)M * D * 4 == 66 * MiB && (size_t)M * FF * 2 == 132 * MiB && (size_t)512 * LKEYS * 4 <= 5 * MiB && (size_t)M * pg8::NSSQ * 4 <= 3 * MiB, "d_ws map");
constexpr int CW_BAR = 4096, CW_KMAX = 2048, CW_ATQ = 2304  ;
constexpr int RING_OFF = 0, RING_BYTES = 131072;
constexpr int ATT_LDS = attn_body::LDS_BYTES;
constexpr int LDSCTL_OFF = (ATT_LDS > RING_BYTES ? ATT_LDS : RING_BYTES), MISC_OFF = LDSCTL_OFF + 320;
constexpr int LDS_BYTES = LDSCTL_OFF + 1024;
static_assert(LDS_BYTES <= 163840 && sattn::L_END <= RING_BYTES, "LDS map");

#define GAS __attribute__((address_space(1)))
#define LAS __attribute__((address_space(3)))
typedef unsigned short bf16;
typedef unsigned v4u __attribute__((ext_vector_type(4)));
typedef unsigned v2u __attribute__((ext_vector_type(2)));
typedef float f32x4 __attribute__((ext_vector_type(4)));
typedef short bf16x8 __attribute__((ext_vector_type(8)));
typedef GAS unsigned gu32;
#define RLX_AGENT __ATOMIC_RELAXED, __HIP_MEMORY_SCOPE_AGENT
#define LDS_WAIT() asm volatile("s_waitcnt lgkmcnt(0)" ::: "memory")
#define VM_WAIT() asm volatile("s_waitcnt vmcnt(0)" ::: "memory")
__device__ __forceinline__ unsigned pk2(float lo, float hi) { return sattn::pk(lo, hi); }
__device__ __forceinline__ float bflo(unsigned w) { return __builtin_bit_cast(float, w << 16); }
__device__ __forceinline__ float bfhi(unsigned w) { return __builtin_bit_cast(float, w & 0xffff0000u); }
#define XB_TMO      128
#define XB_XCNT(j)  (256  + 64 * (j))
#define XB_XSUB(j)  (1280 + 64 * (j))
#define XB_XGEN(j)  (2304 + 64 * (j))
#define XB_TOP      3328
#define XB_TOPGEN   3392
#define XCD_BAR_WORDS 3456
#define XB_SPIN_CAP (1u << 18)

__device__ __forceinline__ unsigned xb_ld(unsigned* p)              { return __hip_atomic_load(p, __ATOMIC_RELAXED, __HIP_MEMORY_SCOPE_AGENT); }
__device__ __forceinline__ unsigned xb_add(unsigned* p, unsigned v) { return __hip_atomic_fetch_add(p, v, __ATOMIC_RELAXED, __HIP_MEMORY_SCOPE_AGENT); }
__device__ __forceinline__ unsigned xb_xcc_id() { return (unsigned)__builtin_amdgcn_s_getreg((3 << 11) | 20) & 0xFu; }
#define XB_SPIN(cond, bar) do { unsigned _sp = 0; while (cond) { __builtin_amdgcn_s_sleep(1); \
    if ((++_sp & 255u) == 0u) { if (xb_ld(&(bar)[XB_TMO])) break; if (_sp > XB_SPIN_CAP) { atomicAdd(&(bar)[XB_TMO], 1u); break; } } } } while (0)

struct XcdBarrier {
    unsigned* bar; unsigned x;
    volatile LAS unsigned* st;
};

__device__ __forceinline__ XcdBarrier xcd_barrier_post(unsigned* bar, volatile LAS unsigned* st) {
    XcdBarrier b; b.bar = bar; b.x = xb_xcc_id(); b.st = st;
    if (threadIdx.x == 0) (void)xb_add(&bar[XB_XCNT(b.x)], 1u);
    return b;
}
__device__ __forceinline__ void xcd_barrier_complete(unsigned* bar, unsigned x, unsigned& nloc, unsigned& nx) {
    const unsigned G = gridDim.x * gridDim.y * gridDim.z;
    unsigned sum, cnt, mine, sp = 0u;
    for (;;) {
        sum = 0u; cnt = 0u; mine = 0u;
#pragma unroll
        for (unsigned j = 0; j < 16; ++j) { const unsigned c = xb_ld(&bar[XB_XCNT(j)]); sum += c; cnt += (c > 0u) ? 1u : 0u; mine = (j == x) ? c : mine; }
        if (sum == G) break;
        __builtin_amdgcn_s_sleep(1);
        if ((++sp & 255u) == 0u) { if (xb_ld(&bar[XB_TMO])) break; if (sp > XB_SPIN_CAP) { atomicAdd(&bar[XB_TMO], 1u); break; } }
    }
    nloc = mine > 0u ? mine : 1u; nx = cnt > 0u ? cnt : 1u;
}

__device__ __forceinline__ void xcd_barrier(const XcdBarrier& b) {
    asm volatile("s_waitcnt vmcnt(0)" ::: "memory");
    __syncthreads();
    if (threadIdx.x == 0) {
        unsigned* bar = b.bar;
        __builtin_amdgcn_s_waitcnt(0);
        unsigned nloc = b.st[0], nx = b.st[1];
        if (nloc == 0u) { xcd_barrier_complete(bar, b.x, nloc, nx); b.st[0] = nloc; b.st[1] = nx; }
        const unsigned old = xb_add(&bar[XB_XSUB(b.x)], 1u);
        const unsigned gen = old / nloc;
        if (old + 1u == (gen + 1u) * nloc) {
            __builtin_amdgcn_fence(__ATOMIC_RELEASE, "agent");
            asm volatile("s_waitcnt vmcnt(0)" ::: "memory");
            const unsigned og = xb_add(&bar[XB_TOP], 1u);
            const unsigned tg = og / nx;
            if (og + 1u == (tg + 1u) * nx) xb_add(&bar[XB_TOPGEN], 1u);
            else XB_SPIN(xb_ld(&bar[XB_TOPGEN]) == tg, bar);
            __builtin_amdgcn_fence(__ATOMIC_ACQUIRE, "agent");
            xb_add(&bar[XB_XGEN(b.x)], 1u);
            asm volatile("s_waitcnt vmcnt(0)" ::: "memory");
        } else {
            XB_SPIN(xb_ld(&bar[XB_XGEN(b.x)]) == gen, bar);
            __builtin_amdgcn_fence(__ATOMIC_ACQUIRE, "agent");
            asm volatile("s_waitcnt vmcnt(0)" ::: "memory");
        }
    }
    __syncthreads();
}
struct Args { const float* in[21]; float* out; unsigned char* ws; };
typedef const __attribute__((address_space(4))) Args* KArgs;
__device__ __forceinline__ KArgs kargs() { KArgs p = (KArgs)__builtin_amdgcn_kernarg_segment_ptr(); asm volatile("" : "+s"(p)); return p; }
struct Frame {
    LAS unsigned char* lds; volatile LAS unsigned* MISC; gu32* ctl;
    int tid, lane, wave, vcu, G;
};
__device__ __forceinline__ float wave_sum(float v) {
#pragma unroll
    for (int o = 1; o < 64; o <<= 1) v += __shfl_xor(v, o);
    return v;
}
constexpr int P0_TILE_FLOATS = 64 * 65;
__device__ __forceinline__ void p0_transpose_item(const float* W, int K, int N, bf16* WT, int row_off, LAS float* scr, int item, int lane, const float* gain, float scale) {
    const int nblk = N / 64, kb = item / nblk, nb = item % nblk, k0 = 64 * kb, n0 = 64 * nb;
    const int c4 = lane & 15, kr = lane >> 4;
    f32x4 v[16];
#pragma unroll
    for (int i = 0; i < 16; ++i) v[i] = *(const GAS f32x4*)(W + (size_t)(k0 + 4 * i + kr) * N + n0 + 4 * c4);
#pragma unroll
    for (int i = 0; i < 16; ++i) { const int kk = 4 * i + kr; const float gsc = gain ? gain[k0 + kk] * scale : scale; LAS float* d = scr + kk * 65 + 4 * c4;
        d[0] = v[i].x * gsc; d[1] = v[i].y * gsc; d[2] = v[i].z * gsc; d[3] = v[i].w * gsc; }
    LDS_WAIT(); asm volatile("" ::: "memory");
    const int c = lane & 7;
#pragma unroll
    for (int j = 0; j < 8; ++j) { const int n = (lane >> 3) + 8 * j; const LAS float* s = scr + (8 * c) * 65 + n;
        v4u o; o.x = pk2(s[0 * 65], s[1 * 65]); o.y = pk2(s[2 * 65], s[3 * 65]); o.z = pk2(s[4 * 65], s[5 * 65]); o.w = pk2(s[6 * 65], s[7 * 65]);
        *(GAS v4u*)(WT + (size_t)(row_off + n0 + n) * K + k0 + 8 * c) = o; }
    LDS_WAIT(); asm volatile("" ::: "memory");
}
enum { I_XP = 0, I_XS, I_CK, I_CV, I_CLF, I_SC, I_NMIX, I_NMLP, I_CIN, I_CW, I_COUT, I_NKV, I_WK, I_WV, I_WF, I_BF, I_WQ, I_WO, I_UP, I_DN, I_NF };

__device__ __forceinline__ void p0_prologue(const Frame& F, KArgs a, unsigned char* ws) {
    const int T_tid = opaque_tid(), T_lane = T_tid & 63, T_wave = __builtin_amdgcn_readfirstlane(T_tid >> 6);
    LAS float* scr = (LAS float*)(F.lds + RING_OFF) + T_wave * P0_TILE_FLOATS;
    const int gw = F.vcu * NWAVES + T_wave, NGW = F.G * NWAVES;
    constexpr int NCHUNK = 46;
    for (int it = gw; it < NCHUNK * 256; it += NGW) {
        int c = it >> 8, base = 0; const float* src = nullptr; const float* gain = nullptr; bf16* dst = nullptr; int roff = 0, K = D, N = D; float sc = 1.f;
        if (c < 6) { const int l = c / 3; src = a->in[I_CIN] + (size_t)l * D * 3 * D; gain = a->in[I_NMIX] + l * D; dst = (bf16*)(ws + WS_WIN) + (size_t)l * 3 * D * D; N = 3 * D; base = l * 3; }
        else if (c < 8) { const int l = c - 6; src = a->in[I_COUT] + (size_t)l * D * D; dst = (bf16*)(ws + WS_WOUT) + (size_t)l * D * D; base = c; }
        else if (c < 9) { src = a->in[I_WK]; gain = a->in[I_NKV]; dst = (bf16*)(ws + WS_WKVQ); base = c; }
        else if (c < 10) { src = a->in[I_WV]; gain = a->in[I_NKV]; dst = (bf16*)(ws + WS_WKVQ); roff = D; base = c; }
        else if (c < 11) { src = a->in[I_WQ]; gain = a->in[I_NMIX] + 2 * D; dst = (bf16*)(ws + WS_WKVQ); roff = 2 * D; sc = QSCALE; base = c; }
        else if (c < 12) { src = a->in[I_WQ] + (size_t)D * D; gain = a->in[I_NMIX] + 3 * D; dst = (bf16*)(ws + WS_WQ1); sc = QSCALE; base = c; }
        else if (c < 14) { const int j = c - 12; src = a->in[I_WO] + (size_t)j * D * D; dst = (bf16*)(ws + WS_WO) + (size_t)j * D * D; base = c; }
        else if (c < 30) { const int l = (c - 14) >> 2; src = a->in[I_UP] + (size_t)l * D * FF; gain = a->in[I_NMLP] + l * D; dst = (bf16*)(ws + WS_WUP) + (size_t)l * D * FF; N = FF; base = 14 + 4 * l; }
        else { const int l = (c - 30) >> 2; src = a->in[I_DN] + (size_t)l * D * FF; dst = (bf16*)(ws + WS_WDN) + (size_t)l * D * FF; K = FF; base = 30 + 4 * l; }
        p0_transpose_item(src, K, N, dst, roff, scr, it - base * 256, T_lane, gain, sc);
    }
    for (int i = (F.vcu * NWAVES + T_wave) * 64 + T_lane; i < D * H; i += NGW * 64) { const int k = i >> 4, h = i & 15; ((bf16*)(ws + WS_WF))[h * D + k] = (bf16)(pk2(a->in[I_NKV][k] * a->in[I_WF][i], 0.f) & 0xffffu); }
    bf16* XB = (bf16*)(ws + WS_XB); float* SSQ = (float*)(ws + WS_SSQ);
    for (int m = gw; m < M; m += NGW) {
        const float* xr = (m < MP) ? a->in[I_XP] + (size_t)m * D : a->in[I_XS] + (size_t)(m - MP) * D;
        const GAS f32x4* xp = (const GAS f32x4*)xr + T_lane; f32x4 v[4]; float s = 0.f;
#pragma unroll
        for (int j = 0; j < 4; ++j) { v[j] = xp[64 * j]; s += (v[j].x * v[j].x + v[j].y * v[j].y) + (v[j].z * v[j].z + v[j].w * v[j].w); }
        s = wave_sum(s);
        GAS v2u* bo = (GAS v2u*)(XB + (size_t)m * D) + T_lane;
#pragma unroll
        for (int j = 0; j < 4; ++j) { v2u w; w.x = pk2(v[j].x, v[j].y); w.y = pk2(v[j].z, v[j].w); bo[64 * j] = w; }
        if (T_lane < pg8::NSSQ) SSQ[(size_t)m * pg8::NSSQ + T_lane] = (T_lane == 0) ? s : 0.f;
    }
}
__device__ __forceinline__ void conv_gate_phase(const Frame& F, KArgs a, unsigned char* ws, int l) {
    const int T_tid = opaque_tid(), T_lane = T_tid & 63, T_wave = __builtin_amdgcn_readfirstlane(T_tid >> 6);
    const int gw = F.vcu * NWAVES + T_wave, NGW = F.G * NWAVES;
    const bf16* BCX = (const bf16*)(ws + WS_HB); bf16* Gm = (bf16*)(ws + WS_G);
    const float* cw = a->in[I_CW] + (size_t)l * 3 * D;
    for (int it = gw; it < (M / 4) * 2; it += NGW) {
        const int half = it & 1, row0 = (it >> 1) * 4, c0 = half * 512 + T_lane * 8;
        float w0[8], w1[8], w2[8], um2[8], um1[8];
        { const f32x4 a0 = *(const f32x4*)(cw + c0), a1 = *(const f32x4*)(cw + c0 + 4), b0 = *(const f32x4*)(cw + D + c0), b1 = *(const f32x4*)(cw + D + c0 + 4), d0 = *(const f32x4*)(cw + 2 * D + c0), d1 = *(const f32x4*)(cw + 2 * D + c0 + 4);
#pragma unroll
          for (int e = 0; e < 4; ++e) { w0[e] = a0[e]; w0[4 + e] = a1[e]; w1[e] = b0[e]; w1[4 + e] = b1[e]; w2[e] = d0[e]; w2[4 + e] = d1[e]; } }
        const bool sample = row0 >= MP; const int sb = sample ? (row0 - MP) >> 4 : 0; const int t0 = sample ? (row0 - MP) & 15 : row0;
        if (t0 == 0) {
            if (sample) { const float* st = a->in[I_SC] + ((size_t)(l * DBATCH + sb) * 2) * D + c0;
                const f32x4 p0 = *(const f32x4*)st, p1 = *(const f32x4*)(st + 4), q0 = *(const f32x4*)(st + D), q1 = *(const f32x4*)(st + D + 4);
#pragma unroll
                for (int e = 0; e < 4; ++e) { um2[e] = p0[e]; um2[4 + e] = p1[e]; um1[e] = q0[e]; um1[4 + e] = q1[e]; } }
            else {
#pragma unroll
                for (int e = 0; e < 8; ++e) { um2[e] = 0.f; um1[e] = 0.f; } }
        } else {
#pragma unroll
            for (int k = 0; k < 2; ++k) { const bf16* rp = BCX + (size_t)(row0 - 2 + k) * 3072 + c0; const v4u gc = *(const v4u*)(rp + D), xv = *(const v4u*)(rp + 2 * D);
#pragma unroll
                for (int e = 0; e < 4; ++e) { const float u0 = bflo(gc[e]) * bflo(xv[e]), u1 = bfhi(gc[e]) * bfhi(xv[e]); if (k == 0) { um2[2 * e] = u0; um2[2 * e + 1] = u1; } else { um1[2 * e] = u0; um1[2 * e + 1] = u1; } } }
        }
#pragma unroll
        for (int i = 0; i < 4; ++i) { const bf16* rp = BCX + (size_t)(row0 + i) * 3072 + c0; const v4u gb = *(const v4u*)rp, gc = *(const v4u*)(rp + D), xv = *(const v4u*)(rp + 2 * D);
            float u[8], o[8];
#pragma unroll
            for (int e = 0; e < 4; ++e) { u[2 * e] = bflo(gc[e]) * bflo(xv[e]); u[2 * e + 1] = bfhi(gc[e]) * bfhi(xv[e]); }
#pragma unroll
            for (int e = 0; e < 8; ++e) o[e] = w0[e] * um2[e] + w1[e] * um1[e] + w2[e] * u[e];
            v4u w;
#pragma unroll
            for (int e = 0; e < 4; ++e) w[e] = pk2(bflo(gb[e]) * o[2 * e], bfhi(gb[e]) * o[2 * e + 1]);
            *(v4u*)(Gm + (size_t)(row0 + i) * D + c0) = w;
#pragma unroll
            for (int e = 0; e < 8; ++e) { um2[e] = um1[e]; um1[e] = u[e]; } }
        const bool last = sample ? (t0 == 12) : (row0 + 4 == MP);
        if (last) { float* o = a->out + (sample ? OUT_CS + ((size_t)(l * DBATCH + sb) * 2) * D : OUT_CP + (size_t)l * 2 * D) + c0;
            *(f32x4*)o = (f32x4){um2[0], um2[1], um2[2], um2[3]}; *(f32x4*)(o + 4) = (f32x4){um2[4], um2[5], um2[6], um2[7]};
            *(f32x4*)(o + D) = (f32x4){um1[0], um1[1], um1[2], um1[3]}; *(f32x4*)(o + D + 4) = (f32x4){um1[4], um1[5], um1[6], um1[7]}; }
    }
}
__device__ __forceinline__ void logf_phase(const Frame& F, KArgs a, unsigned char* ws) {
    const int T_tid = opaque_tid(), T_lane = T_tid & 63, T_wave = __builtin_amdgcn_readfirstlane(T_tid >> 6);
    const int gw = F.vcu * NWAVES + T_wave, NGW = F.G * NWAVES; const int r = T_lane & 15, g = T_lane >> 4;
    const bf16* WF = (const bf16*)(ws + WS_WF); const bf16* XB = (const bf16*)(ws + WS_XB); const float* SSQ = (const float*)(ws + WS_SSQ);
    for (int blk = gw; blk < M / 16; blk += NGW) {
        const int row = blk * 16 + r; f32x4 acc = (f32x4){0.f, 0.f, 0.f, 0.f};
        const bf16* ap = WF + (size_t)r * D + 8 * g; const bf16* bp = XB + (size_t)row * D + 8 * g;
#pragma unroll 8
        for (int s = 0; s < 32; ++s) acc = __builtin_amdgcn_mfma_f32_16x16x32_bf16(*(const bf16x8*)(ap + 32 * s), *(const bf16x8*)(bp + 32 * s), acc, 0, 0, 0);
        const float rs = pg8::row_rstd(SSQ, row); const f32x4 bfv = *(const f32x4*)(a->in[I_BF] + 4 * g); f32x4 o;
#pragma unroll
        for (int e = 0; e < 4; ++e) { const float z = acc[e] * rs + bfv[e]; o[e] = fminf(z, 0.f) - log1pf(expf(-fabsf(z))); }
        float* op = a->out + ((row < MP) ? OUT_LP + (size_t)row * 16 : OUT_LS + (size_t)(row - MP) * 16) + 4 * g;
        *(f32x4*)op = o;
    }
}
__device__ __forceinline__ double wave_scan_incl(double v, int lane) {
#pragma unroll
    for (int o = 1; o < 64; o <<= 1) { const double t = __shfl_up(v, o); if (lane >= o) v += t; }
    return v;
}
__device__ __forceinline__ void scan_phase(const Frame& F, KArgs a, unsigned char* ws) {
    const int T_tid = opaque_tid(), T_lane = T_tid & 63, T_wave = __builtin_amdgcn_readfirstlane(T_tid >> 6);
    float* CLP = (float*)(ws + WS_CLP); float* CLS = (float*)(ws + WS_CLS);
    const int blk = blockIdx.x;
    if (blk < 16) {
        const int h = blk; const float* lf = a->out + OUT_LP; const int t0 = T_tid * 32; double s = 0.0; float lv[32];
#pragma unroll
        for (int i = 0; i < 32; ++i) lv[i] = lf[(size_t)(t0 + i) * 16 + h];
#pragma unroll
        for (int i = 0; i < 32; ++i) s += (double)lv[i];
        const double inc = wave_scan_incl(s, T_lane);
        LAS double* wt = (LAS double*)(F.lds + RING_OFF);
        if (T_lane == 63) wt[T_wave] = inc;
        __syncthreads();
        double run = inc - s;
        for (int w = 0; w < T_wave; ++w) run += wt[w];
#pragma unroll
        for (int i = 0; i < 32; ++i) { run += (double)lv[i]; lv[i] = (float)(run * (double)L2E); }
#pragma unroll
        for (int i = 0; i < 8; ++i) *(f32x4*)(CLP + (size_t)h * MP + t0 + 4 * i) = (f32x4){lv[4 * i], lv[4 * i + 1], lv[4 * i + 2], lv[4 * i + 3]};
        __syncthreads();
    } else {
        const int nws = (F.G - 16) * NWAVES;
        for (int seq = (blk - 16) * NWAVES + T_wave; seq < DBATCH * H; seq += nws) {
            const int b = seq >> 4, h = seq & 15; const float* clf = a->in[I_CLF] + (size_t)b * PAST * 16 + h; const float* nlf = a->out + OUT_LS + (size_t)b * DSEQ * 16 + h;
            const int s0 = T_lane * 33; double s = 0.0; float lv[33];
#pragma unroll
            for (int i = 0; i < 33; ++i) { const int k = s0 + i; const int kc = k < LKEYS ? k : LKEYS - 1; const float* p = kc < PAST ? clf + (size_t)kc * 16 : nlf + (size_t)(kc - PAST) * 16; const float v = *p; lv[i] = (k < LKEYS) ? v : 0.f; }
#pragma unroll
            for (int i = 0; i < 33; ++i) s += (double)lv[i];
            double run = wave_scan_incl(s, T_lane) - s;
#pragma unroll
            for (int i = 0; i < 33; ++i) { const int k = s0 + i; run += (double)lv[i]; if (k < LKEYS) CLS[(size_t)seq * LKEYS + k] = (float)(run * (double)L2E); }
        }
    }
    { const int gw = F.vcu * NWAVES + T_wave, NGW = F.G * NWAVES; const bf16* KB = (const bf16*)(ws + WS_KB); float mx = 0.f;
      for (int row = gw; row < MP; row += NGW) { const v4u p = *(const v4u*)(KB + (size_t)row * D + T_lane * 16), q = *(const v4u*)(KB + (size_t)row * D + T_lane * 16 + 8); float sq = 0.f;
#pragma unroll
          for (int e = 0; e < 4; ++e) { const float a0 = bflo(p[e]), a1 = bfhi(p[e]), b0 = bflo(q[e]), b1 = bfhi(q[e]); sq += (a0 * a0 + a1 * a1) + (b0 * b0 + b1 * b1); }
          sq += __shfl_xor(sq, 1); sq += __shfl_xor(sq, 2); mx = fmaxf(mx, sq); }
      __syncthreads();
      LAS float* km = (LAS float*)(F.lds + RING_OFF) + 64;
      if ((T_lane & 3) == 0) km[T_wave * 16 + (T_lane >> 2)] = mx;
      __syncthreads();
      if (T_tid < 16) { float m = km[T_tid];
#pragma unroll
          for (int w = 1; w < NWAVES; ++w) m = fmaxf(m, km[w * 16 + T_tid]);
          atomicMax((unsigned*)(ws + WS_CTL) + CW_KMAX + T_tid, __builtin_bit_cast(unsigned, m)); }
      __syncthreads(); }
}
__device__ __forceinline__ void final_norm_phase(const Frame& F, KArgs a, unsigned char* ws) {
    const int T_tid = opaque_tid(), T_lane = T_tid & 63, T_wave = __builtin_amdgcn_readfirstlane(T_tid >> 6);
    const int gw = F.vcu * NWAVES + T_wave, NGW = F.G * NWAVES; const float* X = (const float*)(ws + WS_X);
    const GAS f32x4* gp = (const GAS f32x4*)a->in[I_NF] + T_lane; f32x4 gn[4];
#pragma unroll
    for (int j = 0; j < 4; ++j) gn[j] = gp[64 * j];
    for (int m = gw; m < M; m += NGW) {
        const GAS f32x4* xp = (const GAS f32x4*)(X + (size_t)m * D) + T_lane; f32x4 v[4]; float s = 0.f;
#pragma unroll
        for (int j = 0; j < 4; ++j) { v[j] = xp[64 * j]; s += (v[j].x * v[j].x + v[j].y * v[j].y) + (v[j].z * v[j].z + v[j].w * v[j].w); }
        const float rs = 1.0f / sqrtf(wave_sum(s) * (1.0f / D) + RMS_EPS);
        GAS f32x4* op = (GAS f32x4*)(a->out + OUT_Y + (size_t)m * D) + T_lane;
#pragma unroll
        for (int j = 0; j < 4; ++j) op[64 * j] = v[j] * rs * gn[j];
    }
}

__global__ void __launch_bounds__(NWAVES * 64, 2) yoco_fwd(Args args) {
    extern __shared__ __attribute__((aligned(16))) unsigned char lds[];
    Frame F;
    F.lds = (LAS unsigned char*)lds;
    F.MISC = (volatile LAS unsigned*)(F.lds + MISC_OFF);
    F.tid = threadIdx.x; F.lane = F.tid & 63; F.wave = __builtin_amdgcn_readfirstlane(F.tid >> 6);
    F.G = gridDim.x; { const int bx = blockIdx.x; F.vcu = (F.G % 8 == 0) ? (bx % 8) * (F.G / 8) + bx / 8 : bx; }
    F.ctl = (gu32*)(kargs()->ws + WS_CTL);
    for (int u = F.tid; u < (LDS_BYTES - LDSCTL_OFF) / 4; u += NWAVES * 64) ((LAS unsigned*)(F.lds + LDSCTL_OFF))[u] = 0u;
    __syncthreads();
    XcdBarrier bar = xcd_barrier_post((unsigned*)(F.ctl + CW_BAR), F.MISC + 8);
#define GRID_BAR() xcd_barrier(bar)
#define WSP(T, off) ((T*)(kargs()->ws + (off)))

    p0_prologue(F, kargs(), kargs()->ws);
    if (kargs()->ws == nullptr) cg::this_grid().sync();
    GRID_BAR();

#define SAMPLE_TILES(g, E) do { const int id_ = opaque_bid(); if (id_ < 4 * ((g).N / 128)) { const int mi_ = id_ & 3, ni_ = id_ >> 2; \
        pg8::gemm128_tile(F.lds + RING_OFF, (g).A + (size_t)(MP + 128 * mi_) * (g).K, (g).Bt + (size_t)(128 * ni_) * (g).K, (g).K, E, MP + 128 * mi_, 128 * ni_); } } while (0)
#define SAMPLE_TILES64(g, E) do { const int id_ = opaque_bid(); if (id_ < 8 * ((g).N / 64)) { const int mi_ = id_ & 7, ni_ = id_ >> 3; \
        pg8::gemm64_resid_tile(F.lds + RING_OFF, (g).A + (size_t)(MP + 64 * mi_) * (g).K, (g).Bt + (size_t)(64 * ni_) * (g).K, (g).K, E, MP + 64 * mi_, 64 * ni_); } } while (0)
#define LAYER(l) do { \
        if ((l) != 2) { \
            constexpr bool cv = (l) < 2; unsigned char* ws = kargs()->ws; \
            pg8::Gemm g{(const bf16*)(ws + WS_XB), cv ? (const bf16*)(ws + WS_WIN) + (size_t)(l) * 3 * D * D : (const bf16*)(ws + WS_WQ1), M, cv ? 3 * D : D, D}; \
            pg8::StaticOrder S; S.init(MP, cv ? 3 * D : D, F.G, opaque_bid()); \
            pg8::EpiAct<0, false> E{cv ? (bf16*)(ws + WS_HB) : (bf16*)(ws + WS_QB), cv ? 3 * D : D, (const float*)(ws + WS_SSQ), 0, 0, nullptr}; \
            pg8::gemm_phase<pg8::EpiAct<0, false>, pg8::StaticOrder, PG8_ALIGN, PG8_SP2>(F.lds + RING_OFF, g, S, E); \
            SAMPLE_TILES(g, E); \
            GRID_BAR(); \
        } \
        if ((l) < 2) { conv_gate_phase(F, kargs(), kargs()->ws, (l)); } \
        else { \
            { unsigned char* ws = kargs()->ws; \
            const attn_body::AttnTensors AT{(const attn_body::bf16*)(ws + WS_QB), (const attn_body::bf16*)(ws + WS_KB), (const attn_body::bf16*)(ws + WS_VB), (attn_body::bf16*)(ws + WS_G), (const float*)(ws + WS_CLP), (const unsigned*)(ws + WS_CTL) + CW_KMAX}; \
            attn_body::attn_phase_q<24>((char*)lds + RING_OFF, AT, (unsigned*)(ws + WS_CTL) + CW_ATQ + ((l) - 2) * 512, opaque_bid()); } \
            __syncthreads(); \
            KArgs ka = kargs(); unsigned char* ws = ka->ws; \
            const sattn::Tensors ST{ka->in[I_CK], ka->in[I_CV], (const bf16*)(ws + WS_QB), (const bf16*)(ws + WS_KB), (const bf16*)(ws + WS_VB), (bf16*)(ws + WS_G), (const float*)(ws + WS_CLS)}; \
            for (int u = F.vcu; u < DBATCH * H; u += F.G) sattn::unit(u >> 4, u & 15, ST, (LAS char*)(F.lds + RING_OFF)); \
        } \
        GRID_BAR(); \
        { unsigned char* ws = kargs()->ws; \
            pg8::Gemm g{(const bf16*)(ws + WS_G), ((l) < 2) ? (const bf16*)(ws + WS_WOUT) + (size_t)(l) * D * D : (const bf16*)(ws + WS_WO) + (size_t)((l) - 2) * D * D, M, D, D}; \
            pg8::StaticOrder S; S.init(MP, D, F.G, opaque_bid()); \
            pg8::EpiResid E{(float*)(ws + WS_X), (bf16*)(ws + WS_XB), (float*)(ws + WS_SSQ), ((l) == 0) ? kargs()->in[I_XP] : nullptr, ((l) == 0) ? kargs()->in[I_XS] : nullptr}; \
            pg8::gemm_phase<pg8::EpiResid, pg8::StaticOrder, PG8_ALIGN, PG8_SP2>(F.lds + RING_OFF, g, S, E); \
            SAMPLE_TILES64(g, E); \
            GRID_BAR(); } \
        { unsigned char* ws = kargs()->ws; \
            pg8::Gemm g{(const bf16*)(ws + WS_XB), (const bf16*)(ws + WS_WUP) + (size_t)(l) * D * FF, M, FF, D}; \
            pg8::StaticOrder S; S.init(MP, FF, F.G, opaque_bid()); \
            pg8::EpiAct<1, false> E{(bf16*)(ws + WS_HB), FF, (const float*)(ws + WS_SSQ), 0, 0, nullptr}; \
            pg8::gemm_phase<pg8::EpiAct<1, false>, pg8::StaticOrder, PG8_ALIGN, PG8_SP2>(F.lds + RING_OFF, g, S, E); \
            SAMPLE_TILES(g, E); \
            GRID_BAR(); } \
        { unsigned char* ws = kargs()->ws; \
            pg8::Gemm g{(const bf16*)(ws + WS_HB), (const bf16*)(ws + WS_WDN) + (size_t)(l) * D * FF, M, D, FF}; \
            pg8::StaticOrder S; S.init(MP, D, F.G, opaque_bid()); \
            pg8::EpiResid E{(float*)(ws + WS_X), (bf16*)(ws + WS_XB), (float*)(ws + WS_SSQ), nullptr, nullptr}; \
            pg8::gemm_phase<pg8::EpiResid, pg8::StaticOrder, PG8_ALIGN, PG8_SP2>(F.lds + RING_OFF, g, S, E); \
            SAMPLE_TILES64(g, E); \
            GRID_BAR(); } \
        if ((l) == 1) { \
            KArgs ka = kargs(); unsigned char* ws = ka->ws; \
            pg8::Gemm g{(const bf16*)(ws + WS_XB), (const bf16*)(ws + WS_WKVQ), M, 3 * D, D}; \
            pg8::StaticOrder S; S.init(MP, 3 * D, F.G, opaque_bid()); \
            pg8::EpiAct<0, true> E{(bf16*)(ws + WS_KB), D, (const float*)(ws + WS_SSQ), D, (size_t)(WS_VB - WS_KB) / 2, ka->out}; \
            pg8::gemm_phase<pg8::EpiAct<0, true>, pg8::StaticOrder, PG8_ALIGN, PG8_SP2>(F.lds + RING_OFF, g, S, E); \
            SAMPLE_TILES(g, E); \
            logf_phase(F, kargs(), kargs()->ws); \
            GRID_BAR(); \
            scan_phase(F, kargs(), kargs()->ws); \
            GRID_BAR(); \
        } } while (0)
    LAYER(0); LAYER(1); LAYER(2); LAYER(3);
    final_norm_phase(F, kargs(), kargs()->ws);
}

extern "C" void kernel_launch(void* const* d_in, const int* in_sizes, int n_in, void* d_out, int out_size, void* d_ws, size_t ws_size, hipStream_t stream) {
    static int grid = 0;
    if (grid == 0) {
        if (n_in != 21 || out_size != (int)OUT_END || ws_size < WS_END) { fprintf(stderr, "kernel_launch: unexpected sizes (n_in %d, out %d, ws %zu); nothing launched\n", n_in, out_size, ws_size); grid = -1; return; }
        int dev = 0, cus = 0, per_cu = 0;
        if (hipGetDevice(&dev) != hipSuccess || hipDeviceGetAttribute(&cus, hipDeviceAttributeMultiprocessorCount, dev) != hipSuccess) { grid = -1; return; }
        if (hipFuncSetAttribute((const void*)yoco_fwd, hipFuncAttributeMaxDynamicSharedMemorySize, LDS_BYTES) != hipSuccess) { fprintf(stderr, "kernel_launch: hipFuncSetAttribute failed\n"); grid = -1; return; }
        if (hipOccupancyMaxActiveBlocksPerMultiprocessor(&per_cu, (const void*)yoco_fwd, NWAVES * 64, LDS_BYTES) != hipSuccess || per_cu < 1) { fprintf(stderr, "kernel_launch: occupancy query says %d\n", per_cu); per_cu = 1; }
        (void)hipGetLastError();
        grid = cus;
    }
    if (grid < 0) return;
    if (hipMemsetAsync((char*)d_ws + WS_CTL, 0, CTL_ZERO_BYTES, stream) != hipSuccess) { fprintf(stderr, "kernel_launch: memset failed\n"); return; }
    Args a{};
    for (int i = 0; i < 21; ++i) a.in[i] = (const float*)d_in[i];
    a.out = (float*)d_out; a.ws = (unsigned char*)d_ws;
    void* kargv[] = {&a};
    const hipError_t e = hipLaunchCooperativeKernel((const void*)yoco_fwd, dim3(grid), dim3(NWAVES * 64), kargv, LDS_BYTES, stream);
    if (e != hipSuccess) fprintf(stderr, "kernel_launch: cooperative launch failed: %s (grid %d)\n", hipGetErrorString(e), grid);
}
```

```cpp
#include <hip/hip_runtime.h>
#include <hip/hip_cooperative_groups.h>
#include <cstdio>
#include <cstdint>
__device__ __forceinline__ int opaque_bid() { int b = (int)blockIdx.x; asm volatile("" : "+s"(b)); return b; }
__device__ __forceinline__ int opaque_tid() { int t = (int)threadIdx.x; asm volatile("" : "+v"(t)); return t; }
namespace pg8 {
#define PG8_LAS __attribute__((address_space(3)))
typedef unsigned short bf16_t;
typedef short bf16x8 __attribute__((ext_vector_type(8)));
typedef float f32x4 __attribute__((ext_vector_type(4)));
typedef unsigned u32x4 __attribute__((ext_vector_type(4)));
constexpr int BM = 256, BK = 64, HALF = 128, HTB = HALF * BK * 2  , STAGE_BYTES = 8 * HTB, NXCD = 8, WGM = 8;

__host__ __device__ __forceinline__ int lds_byte(int r, int c) { const int st = (r >> 4) * 2 + (c >> 5), rr = r & 15, cc = c & 31, ob = rr * 64 + cc * 2; return st * 1024 + (ob ^ (((ob >> 9) & 1) << 5)); }
__host__ __device__ __forceinline__ void stage_rc(int b, int& R, int& C) { const int st = b / 1024, sb = b % 1024, swz = sb ^ (((sb >> 9) & 1) << 5); R = (st >> 1) * 16 + swz / 64; C = (st & 1) * 32 + (swz % 64) / 2; }
__host__ __device__ __forceinline__ int perm32(int rho) { const int n = rho >> 4, i = rho & 15; return 8 * (i >> 2) + 4 * n + (i & 3); }

struct Unit { int pm, pn; };
struct Gemm { const bf16_t* A; const bf16_t* Bt; int M, N, K; };

struct StaticOrder {
    int nM, nN, nwg, G, c;
    __host__ __device__ void init(int M, int N, int G_, int c_) { nM = M / BM; nN = N / BM; nwg = nM * nN; G = G_; c = c_; }
    __host__ __device__ bool next(int i, Unit& u) const {
        const long L = (long)i * G + c; if (L >= nwg) return false;
        int wgid = (int)L; { const int q = nwg / NXCD, r = nwg % NXCD, xcd = wgid % NXCD, off = wgid / NXCD; wgid = (xcd < r ? xcd * (q + 1) : r * (q + 1) + (xcd - r) * q) + off; }
        const int nig = WGM * nN, gid = wgid / nig, fm = gid * WGM, gsz = (nM - fm) < WGM ? (nM - fm) : WGM;
        u.pm = fm + ((wgid % nig) % gsz); u.pn = (wgid % nig) / gsz; return true;
    }
    __device__ __forceinline__ void a_ready(const Unit&) const {}
    __device__ __forceinline__ void done(const Unit&) const {}
};

__device__ __forceinline__ unsigned cvt_pk_bf16(float lo, float hi) { unsigned r; asm volatile("v_cvt_pk_bf16_f32 %0, %1, %2" : "=v"(r) : "v"(lo), "v"(hi)); return r; }
typedef float f32x2 __attribute__((ext_vector_type(2)));
__device__ __forceinline__ f32x2 gelu_pk(f32x2 v) {
    const f32x2 av = __builtin_elementwise_abs(v), d = av * 0.2316418882f + 1.0f;
    f32x2 t; t.x = __builtin_amdgcn_rcpf(d.x); t.y = __builtin_amdgcn_rcpf(d.y);
    f32x2 q = t * 0.5307027145f + (-0.7265760135f); q = q * t + 0.7107068705f; q = q * t + (-0.142248368f); q = q * t + 0.127414796f; q = q * t;
    const f32x2 s = (v * v) * (-0.72134752044f);
    f32x2 e; e.x = __builtin_amdgcn_exp2f(s.x); e.y = __builtin_amdgcn_exp2f(s.y);
    const f32x2 m = v * (q * e), r = v - m;
    f32x2 o; o.x = v.x < 0.f ? m.x : r.x; o.y = v.y < 0.f ? m.y : r.y; return o;
}

template <int ACT  > struct EpiBf16 {
    static constexpr bool PERM = true, AFTER_DRAIN = false; static_assert(ACT == 0 || ACT == 1, "EpiBf16: ACT is 0 (none) or 1 (gelu_pk)");
    bf16_t* O; int ldc; const float* bias; int split_cols; size_t split_stride; float scale0;
    __device__ __forceinline__ void operator()(const f32x4 (&acc)[2][2][4][2], const Unit& u, int wr, int wc, int fr, int fq) const {
        const int row0 = u.pm * BM + wr * 64 + fr; int colt = u.pn * BM; bf16_t* base = O;
        float sc = 1.f; if (split_cols) { const int t = colt / split_cols; base += (size_t)t * split_stride; colt -= t * split_cols; if (t == 0) sc = scale0; }
        const int col0 = colt + wc * 32 + 8 * fq, bcol0 = u.pn * BM + wc * 32 + 8 * fq;
        f32x4 bv[2][2];
#pragma unroll
        for (int bj = 0; bj < 2; ++bj)
#pragma unroll
            for (int n = 0; n < 2; ++n) bv[bj][n] = bias ? *(const f32x4*)(bias + bcol0 + bj * HALF + 4 * n) : (f32x4){0.f, 0.f, 0.f, 0.f};
#pragma unroll
        for (int ai = 0; ai < 2; ++ai)
#pragma unroll
            for (int m = 0; m < 4; ++m) { bf16_t* rowp = base + (size_t)(row0 + ai * HALF + m * 16) * ldc + col0;
#pragma unroll
                for (int bj = 0; bj < 2; ++bj) { f32x4 v0 = acc[ai][bj][m][0] + bv[bj][0], v1 = acc[ai][bj][m][1] + bv[bj][1];
                    if (ACT == 1) { f32x2 a = gelu_pk((f32x2){v0[0], v0[1]}), b = gelu_pk((f32x2){v0[2], v0[3]}), c = gelu_pk((f32x2){v1[0], v1[1]}), d = gelu_pk((f32x2){v1[2], v1[3]});
                        v0 = (f32x4){a.x, a.y, b.x, b.y}; v1 = (f32x4){c.x, c.y, d.x, d.y}; }
                    v0 = v0 * sc; v1 = v1 * sc; u32x4 w; w.x = cvt_pk_bf16(v0[0], v0[1]); w.y = cvt_pk_bf16(v0[2], v0[3]); w.z = cvt_pk_bf16(v1[0], v1[1]); w.w = cvt_pk_bf16(v1[2], v1[3]);
                    *(u32x4*)(rowp + bj * HALF) = w; } }
    }
};

struct PanelStats {
    unsigned* xbuf;
    unsigned* cnt;
    unsigned* tmo;
    int ntn; float eps;
    unsigned code;
    __device__ __forceinline__ bool run(const f32x4 (&v)[2][2][4][2], const Unit& u, int wr, int wc, int fr, int fq, PG8_LAS unsigned char* lds, int wid, int lane) const {
        typedef float f32x2v __attribute__((ext_vector_type(2)));
        PG8_LAS f32x2v* P = (PG8_LAS f32x2v*)lds;
        PG8_LAS f32x2v* S = (PG8_LAS f32x2v*)(lds + 8192);
        PG8_LAS unsigned* flag = (PG8_LAS unsigned*)(lds + 8192 + 2048);
#pragma unroll
        for (int ai = 0; ai < 2; ++ai)
#pragma unroll
            for (int m = 0; m < 4; ++m) {
                float s = 0.f;
#pragma unroll
                for (int bj = 0; bj < 2; ++bj)
#pragma unroll
                    for (int n = 0; n < 2; ++n) { const f32x4 x = v[ai][bj][m][n]; s += (x[0] + x[1]) + (x[2] + x[3]); }
                s += __shfl_xor(s, 16); s += __shfl_xor(s, 32);
                const float mw = s * (1.0f / 64.0f); float q = 0.f;
#pragma unroll
                for (int bj = 0; bj < 2; ++bj)
#pragma unroll
                    for (int n = 0; n < 2; ++n) { const f32x4 d = v[ai][bj][m][n] - mw; q += (d[0] * d[0] + d[1] * d[1]) + (d[2] * d[2] + d[3] * d[3]); }
                q += __shfl_xor(q, 16); q += __shfl_xor(q, 32);
                if (fq == 0) P[(ai * HALF + wr * 64 + m * 16 + fr) * 4 + wc] = (f32x2v){mw, q};
            }
        asm volatile("s_waitcnt lgkmcnt(0)" ::: "memory"); __builtin_amdgcn_s_barrier(); asm volatile("" ::: "memory");
#if defined(BROKEN_EXCHANGE_NO_WAIT)
#warning BROKEN CONTROL BUILD: the row-statistics exchange does not wait; results are wrong by design
        if (blockIdx.x >= 64) { const long long t0_ = clock64(); while (clock64() - t0_ < 60000) __builtin_amdgcn_s_sleep(8); }
#endif
        const int row = wid * 32 + (lane & 31);
        if (lane < 32) {
            const f32x2v a = P[row * 4 + 0], b = P[row * 4 + 1], c = P[row * 4 + 2], d = P[row * 4 + 3];
            const float mt = (a.x + b.x + c.x + d.x) * 0.25f;
            const float da = a.x - mt, db = b.x - mt, dc = c.x - mt, dd = d.x - mt;
            const float m2 = (a.y + b.y) + (c.y + d.y) + 64.0f * ((da * da + db * db) + (dc * dc + dd * dd));
            unsigned long long* slot = (unsigned long long*)xbuf + ((size_t)(u.pm * BM + row) * 4 + u.pn);
            __hip_atomic_store(slot, ((unsigned long long)__float_as_uint(m2) << 32) | __float_as_uint(mt), __ATOMIC_RELAXED, __HIP_MEMORY_SCOPE_AGENT);
        }
        asm volatile("s_waitcnt vmcnt(0)" ::: "memory");
        if (lane == 0) __hip_atomic_fetch_add(cnt + 64 * u.pm, 1u, __ATOMIC_RELAXED, __HIP_MEMORY_SCOPE_AGENT);
        if (wid == 0) {
            bool dead = false; const unsigned long long t0 = __builtin_amdgcn_s_memrealtime(); const unsigned want = 8u * (unsigned)ntn;
            for (;;) {
#if defined(BROKEN_EXCHANGE_NO_WAIT)
                break;
#endif
                if ((unsigned)__builtin_amdgcn_readfirstlane(__hip_atomic_load(cnt + 64 * u.pm, __ATOMIC_RELAXED, __HIP_MEMORY_SCOPE_AGENT)) >= want) break;
                if (__builtin_amdgcn_s_memrealtime() - t0 > 2000000ull) {
                    if (lane == 0) { unsigned expect = 0u; __hip_atomic_compare_exchange_strong(tmo + 1, &expect, code | (unsigned)(u.pm & 0xff), __ATOMIC_RELAXED, __ATOMIC_RELAXED, __HIP_MEMORY_SCOPE_AGENT);
                                     __hip_atomic_store(tmo, 1u, __ATOMIC_RELAXED, __HIP_MEMORY_SCOPE_AGENT); }
                    dead = true; break; }
                __builtin_amdgcn_s_sleep(2);
            }
            __builtin_amdgcn_fence(__ATOMIC_ACQUIRE, "agent");
            if (lane == 0) flag[0] = dead ? 1u : 0u;
        }
        asm volatile("s_waitcnt vmcnt(0) lgkmcnt(0)" ::: "memory"); __builtin_amdgcn_s_barrier(); asm volatile("" ::: "memory");
        const bool bad = flag[0] != 0u;
        if (lane < 32) {
            const unsigned long long* slot = (const unsigned long long*)xbuf + (size_t)(u.pm * BM + row) * 4; float mt[4], m2[4]; float ms = 0.f;
#pragma unroll
            for (int t = 0; t < 4; ++t) { if (t < ntn) { const unsigned long long w = __hip_atomic_load(slot + t, __ATOMIC_RELAXED, __HIP_MEMORY_SCOPE_AGENT); mt[t] = __uint_as_float((unsigned)w); m2[t] = __uint_as_float((unsigned)(w >> 32)); } else { mt[t] = 0.f; m2[t] = 0.f; } ms += mt[t]; }
            const float mean = ms / (float)ntn; float q = 0.f;
#pragma unroll
            for (int t = 0; t < 4; ++t) if (t < ntn) { const float dm = mt[t] - mean; q += m2[t] + 256.0f * dm * dm; }
            S[row] = (f32x2v){mean, 1.0f / sqrtf(q / (256.0f * (float)ntn) + eps)};
        }
        asm volatile("s_waitcnt lgkmcnt(0)" ::: "memory"); __builtin_amdgcn_s_barrier(); asm volatile("" ::: "memory");
        return bad;
    }
};
struct EpiLnRes {
    static constexpr bool PERM = false, AFTER_DRAIN = true;
    const float* base; float* out; int ldc; const float* bias; PanelStats st; unsigned poison;
    __device__ __forceinline__ void fused(f32x4 (&acc)[2][2][4][2], const Unit& u, int wr, int wc, int fr, int fq, PG8_LAS unsigned char* lds, int wid, int lane) const {
        typedef float f32x2v __attribute__((ext_vector_type(2)));
        const PG8_LAS f32x2v* S = (const PG8_LAS f32x2v*)(lds + 8192);
        const int col0 = u.pn * BM + wc * 32 + 4 * fq;
#pragma unroll
        for (int bj = 0; bj < 2; ++bj)
#pragma unroll
            for (int n = 0; n < 2; ++n) { const f32x4 bv = bias ? *(const f32x4*)(bias + col0 + bj * HALF + n * 16) : (f32x4){0.f, 0.f, 0.f, 0.f};
#pragma unroll
                for (int ai = 0; ai < 2; ++ai)
#pragma unroll
                    for (int m = 0; m < 4; ++m) acc[ai][bj][m][n] += bv; }
        f32x4 pre[4][2][2];
#pragma unroll
        for (int m = 0; m < 4; ++m) { const size_t off = (size_t)(u.pm * BM + wr * 64 + m * 16 + fr) * ldc + col0;
#pragma unroll
            for (int bj = 0; bj < 2; ++bj)
#pragma unroll
                for (int n = 0; n < 2; ++n) pre[m][bj][n] = *(const f32x4*)(base + off + bj * HALF + n * 16); }
        const bool bad = st.run(acc, u, wr, wc, fr, fq, lds, wid, lane) || poison != 0u;
        const float qnan = __builtin_nanf("");
#pragma unroll
        for (int ai = 0; ai < 2; ++ai)
#pragma unroll
            for (int m = 0; m < 4; ++m) { const int r = ai * HALF + wr * 64 + m * 16 + fr; const f32x2v sr = S[r]; const size_t off = (size_t)(u.pm * BM + r) * ldc + col0;
#pragma unroll
                for (int bj = 0; bj < 2; ++bj)
#pragma unroll
                    for (int n = 0; n < 2; ++n) { const f32x4 bs = ai == 0 ? pre[m][bj][n] : *(const f32x4*)(base + off + bj * HALF + n * 16); f32x4 o = bs + (acc[ai][bj][m][n] - sr.x) * sr.y;
                        if (bad) o = (f32x4){qnan, qnan, qnan, qnan}; *(f32x4*)(out + off + bj * HALF + n * 16) = o; }
                if (m & 1) asm volatile("" ::: "memory"); }
    }
};
struct EpiLnResLn {
    static constexpr bool PERM = false, AFTER_DRAIN = true;
    const float* base; float* out; bf16_t* xn; int ldc; const float* bias; PanelStats st1, st2; unsigned poison;
    __device__ __forceinline__ void fused(f32x4 (&acc)[2][2][4][2], const Unit& u, int wr, int wc, int fr, int fq, PG8_LAS unsigned char* lds, int wid, int lane) const {
        typedef float f32x2v __attribute__((ext_vector_type(2))); typedef unsigned u32x2v __attribute__((ext_vector_type(2)));
        const PG8_LAS f32x2v* S = (const PG8_LAS f32x2v*)(lds + 8192);
        const int col0 = u.pn * BM + wc * 32 + 4 * fq;
#pragma unroll
        for (int bj = 0; bj < 2; ++bj)
#pragma unroll
            for (int n = 0; n < 2; ++n) { const f32x4 bv = bias ? *(const f32x4*)(bias + col0 + bj * HALF + n * 16) : (f32x4){0.f, 0.f, 0.f, 0.f};
#pragma unroll
                for (int ai = 0; ai < 2; ++ai)
#pragma unroll
                    for (int m = 0; m < 4; ++m) acc[ai][bj][m][n] += bv; }
        bool bad = st1.run(acc, u, wr, wc, fr, fq, lds, wid, lane) || poison != 0u;
        const float qnan = __builtin_nanf("");
#pragma unroll
        for (int ai = 0; ai < 2; ++ai)
#pragma unroll
            for (int m = 0; m < 4; ++m) { const int r = ai * HALF + wr * 64 + m * 16 + fr; const f32x2v sr = S[r]; const size_t off = (size_t)(u.pm * BM + r) * ldc + col0;
#pragma unroll
                for (int bj = 0; bj < 2; ++bj)
#pragma unroll
                    for (int n = 0; n < 2; ++n) { const f32x4 bs = *(const f32x4*)(base + off + bj * HALF + n * 16); acc[ai][bj][m][n] = bs + (acc[ai][bj][m][n] - sr.x) * sr.y; }
                asm volatile("" : "+v"(acc[ai][0][m][0]), "+v"(acc[ai][0][m][1]), "+v"(acc[ai][1][m][0]), "+v"(acc[ai][1][m][1]));
                if (m & 1) asm volatile("" ::: "memory"); }
        const bool bad1 = bad;
        bad = st2.run(acc, u, wr, wc, fr, fq, lds, wid, lane) || bad;
#pragma unroll
        for (int ai = 0; ai < 2; ++ai)
#pragma unroll
            for (int m = 0; m < 4; ++m) { const int r = ai * HALF + wr * 64 + m * 16 + fr; const f32x2v sr = S[r]; const size_t off = (size_t)(u.pm * BM + r) * ldc + col0;
#pragma unroll
                for (int bj = 0; bj < 2; ++bj)
#pragma unroll
                    for (int n = 0; n < 2; ++n) { const f32x4 x1 = acc[ai][bj][m][n]; *(f32x4*)(out + off + bj * HALF + n * 16) = bad1 ? (f32x4){qnan, qnan, qnan, qnan} : x1;
                        const f32x4 o = (x1 - sr.x) * sr.y; u32x2v w; w.x = cvt_pk_bf16(o[0], o[1]); w.y = cvt_pk_bf16(o[2], o[3]);
                        if (bad) { w.x = 0x7fc07fc0u; w.y = 0x7fc07fc0u; } *(u32x2v*)(xn + off + bj * HALF + n * 16) = w; }
                asm volatile("" ::: "memory"); }
    }
};

template <class Epi, class Sched, bool ALIGN_EPI = false, bool SP2 = false>
__device__ __forceinline__ void gemm_phase(PG8_LAS unsigned char* lds, const Gemm g, const Sched& S, const Epi& E) {
    const int tid = opaque_tid(), wid = __builtin_amdgcn_readfirstlane(tid >> 6), lane = tid & 63, wr = wid >> 2, wc = wid & 3, fr = lane & 15, fq = lane >> 4;
    const int K = g.K, nt = K / BK;
    unsigned voffA[2], voffB[2];
#pragma unroll
    for (int i = 0; i < 2; ++i) { int R, C; stage_rc(tid * 16 + i * 8192, R, C); const int Rb = Epi::PERM ? ((R & ~31) + perm32(R & 31)) : R;
        voffA[i] = (unsigned)(R * K + C) * 2u; voffB[i] = (unsigned)(Rb * K + C) * 2u; }
    const size_t kstep = (size_t)(BK * 2);
    const size_t hstep = (size_t)HALF * K * 2;
    const size_t tstep = 2 * hstep;
    const unsigned ldsw = (unsigned)wid * 1024u;
    const int aoff = lds_byte(wr * 64 + fr, fq * 8), boff = lds_byte(wc * 32 + fr, fq * 8);
#define PG8_SA(b, h) (((b) * 2 + (h)) * HTB)
#define PG8_SB(b, h) ((4 + (b) * 2 + (h)) * HTB)
#define PG8_STAGE(bufoff, gbase, voff) do { _Pragma("unroll") for (int _i = 0; _i < 2; ++_i) \
        __builtin_amdgcn_global_load_lds((const unsigned*)((const char*)(gbase) + (voff)[_i]), (PG8_LAS unsigned*)(lds + (bufoff) + ldsw + _i * 8192), 16, 0, 0); } while (0)
#define PG8_LDA(dst, b, h) do { _Pragma("unroll") for (int m = 0; m < 4; ++m) _Pragma("unroll") for (int k = 0; k < 2; ++k) dst[m][k] = *(const PG8_LAS bf16x8*)(lds + PG8_SA(b, h) + aoff + m * 2048 + k * 1024); } while (0)
#define PG8_LDB(dst, b, h) do { _Pragma("unroll") for (int n = 0; n < 2; ++n) _Pragma("unroll") for (int k = 0; k < 2; ++k) dst[n][k] = *(const PG8_LAS bf16x8*)(lds + PG8_SB(b, h) + boff + n * 2048 + k * 1024); } while (0)
#define PG8_MMA(ai, bj, At, Bt) do { __builtin_amdgcn_s_setprio(1); _Pragma("unroll") for (int m = 0; m < 4; ++m) _Pragma("unroll") for (int n = 0; n < 2; ++n) _Pragma("unroll") for (int k = 0; k < 2; ++k) \
        acc[ai][bj][m][n] = __builtin_amdgcn_mfma_f32_16x16x32_bf16(Bt[n][k], At[m][k], acc[ai][bj][m][n], 0, 0, 0); __builtin_amdgcn_s_setprio(0); } while (0)
#define PG8_WAIT_V(n) asm volatile("s_waitcnt vmcnt(" #n ")" ::: "memory")
#define PG8_WAIT_L(n) asm volatile("s_waitcnt lgkmcnt(" #n ")" ::: "memory")
#define PG8_BAR __builtin_amdgcn_s_barrier()
#define PG8_SCHED __builtin_amdgcn_sched_barrier(0)
    Unit cur, nxt; int ui = 0;
    if (!S.next(0, cur)) return;
    f32x4 acc[2][2][4][2];
#pragma unroll
    for (int a = 0; a < 2; ++a)
#pragma unroll
        for (int b = 0; b < 2; ++b)
#pragma unroll
            for (int m = 0; m < 4; ++m)
#pragma unroll
                for (int n = 0; n < 2; ++n) acc[a][b][m][n] = (f32x4){0.f, 0.f, 0.f, 0.f};
    bf16x8 At[4][2], B0[2][2], B1[2][2];
    const char* cA = (const char*)g.A + (size_t)cur.pm * tstep; const char* cB = (const char*)g.Bt + (size_t)cur.pn * tstep;
    S.a_ready(cur);
    if constexpr (SP2) {
        PG8_STAGE(PG8_SB(0, 0), cB, voffB); PG8_STAGE(PG8_SB(0, 1), cB + hstep, voffB); PG8_STAGE(PG8_SA(0, 0), cA, voffA); PG8_STAGE(PG8_SA(0, 1), cA + hstep, voffA);
        if (wr == 1) PG8_BAR;
        PG8_WAIT_V(2); PG8_BAR;
        PG8_STAGE(PG8_SB(1, 0), cB + kstep, voffB); PG8_STAGE(PG8_SA(1, 0), cA + kstep, voffA); PG8_STAGE(PG8_SB(1, 1), cB + hstep + kstep, voffB);
        PG8_WAIT_V(6); PG8_BAR;
    } else {
        PG8_STAGE(PG8_SB(0, 0), cB, voffB); PG8_STAGE(PG8_SA(0, 0), cA, voffA); PG8_STAGE(PG8_SB(0, 1), cB + hstep, voffB); PG8_STAGE(PG8_SA(0, 1), cA + hstep, voffA);
        if (wr == 1) PG8_BAR;
        PG8_WAIT_V(4); PG8_BAR;
        PG8_STAGE(PG8_SB(1, 0), cB + kstep, voffB); PG8_STAGE(PG8_SA(1, 0), cA + kstep, voffA); PG8_STAGE(PG8_SB(1, 1), cB + hstep + kstep, voffB);
        PG8_WAIT_V(6); PG8_BAR;
    }
    for (;;) {
        const bool has_next = S.next(ui + 1, nxt);
        const char* nA = has_next ? (const char*)g.A + (size_t)nxt.pm * tstep : cA; const char* nB = has_next ? (const char*)g.Bt + (size_t)nxt.pn * tstep : cB;
        for (int t = 0; t < nt; t += 2) {
            const bool last = (t == nt - 2);
            const char* a1 = cA + (size_t)(t + 1) * kstep;
            const char* a2 = last ? nA : cA + (size_t)(t + 2) * kstep; const char* b2 = last ? nB : cB + (size_t)(t + 2) * kstep;
            const char* a3 = a2 + kstep; const char* b3 = b2 + kstep;
            if (last && has_next) S.a_ready(nxt);
            if constexpr (SP2) {
            PG8_LDB(B0, 0, 0); PG8_LDB(B1, 0, 1); PG8_SCHED; PG8_LDA(At, 0, 0); PG8_STAGE(PG8_SA(1, 1), a1 + hstep, voffA);
            PG8_WAIT_V(8); PG8_WAIT_L(0); PG8_BAR; PG8_MMA(0, 0, At, B0); PG8_MMA(0, 1, At, B1); PG8_BAR; PG8_SCHED;
            PG8_LDA(At, 0, 1); PG8_STAGE(PG8_SB(0, 0), b2, voffB); PG8_STAGE(PG8_SB(0, 1), b2 + hstep, voffB); PG8_STAGE(PG8_SA(0, 0), a2, voffA);
            PG8_WAIT_V(8); PG8_WAIT_L(0); PG8_BAR; PG8_MMA(1, 0, At, B0); PG8_MMA(1, 1, At, B1); PG8_BAR; PG8_SCHED;
            PG8_LDB(B0, 1, 0); PG8_LDB(B1, 1, 1); PG8_SCHED; PG8_LDA(At, 1, 0); PG8_STAGE(PG8_SA(0, 1), a2 + hstep, voffA);
            PG8_WAIT_V(8); PG8_WAIT_L(0); PG8_BAR; PG8_MMA(0, 0, At, B0); PG8_MMA(0, 1, At, B1); PG8_BAR; PG8_SCHED;
            PG8_LDA(At, 1, 1); PG8_STAGE(PG8_SB(1, 0), b3, voffB); PG8_STAGE(PG8_SB(1, 1), b3 + hstep, voffB); PG8_STAGE(PG8_SA(1, 0), a3, voffA);
            PG8_WAIT_V(8); PG8_WAIT_L(0); PG8_BAR; PG8_MMA(1, 0, At, B0); PG8_MMA(1, 1, At, B1); PG8_BAR; PG8_SCHED;
            } else {
            PG8_LDB(B0, 0, 0); PG8_SCHED; PG8_LDA(At, 0, 0); PG8_STAGE(PG8_SA(1, 1), a1 + hstep, voffA);
            PG8_WAIT_L(8); PG8_BAR; PG8_WAIT_L(0); PG8_MMA(0, 0, At, B0); PG8_BAR; PG8_SCHED;
            PG8_LDB(B1, 0, 1); PG8_STAGE(PG8_SB(0, 0), b2, voffB);
            PG8_BAR; PG8_WAIT_L(0); PG8_MMA(0, 1, At, B1); PG8_BAR;
            PG8_LDA(At, 0, 1); PG8_STAGE(PG8_SA(0, 0), a2, voffA);
            PG8_BAR; PG8_WAIT_L(0); PG8_MMA(1, 0, At, B0); PG8_BAR; PG8_SCHED;
            PG8_STAGE(PG8_SB(0, 1), b2 + hstep, voffB);
            PG8_WAIT_V(6); PG8_BAR; PG8_MMA(1, 1, At, B1); PG8_BAR;
            PG8_LDB(B0, 1, 0); PG8_SCHED; PG8_LDA(At, 1, 0); PG8_STAGE(PG8_SA(0, 1), a2 + hstep, voffA);
            PG8_WAIT_L(8); PG8_BAR; PG8_WAIT_L(0); PG8_MMA(0, 0, At, B0); PG8_BAR; PG8_SCHED;
            PG8_LDB(B1, 1, 1); PG8_STAGE(PG8_SB(1, 0), b3, voffB);
            PG8_BAR; PG8_WAIT_L(0); PG8_MMA(0, 1, At, B1); PG8_BAR;
            PG8_LDA(At, 1, 1); PG8_STAGE(PG8_SA(1, 0), a3, voffA);
            PG8_BAR; PG8_WAIT_L(0); PG8_MMA(1, 0, At, B0); PG8_BAR; PG8_SCHED;
            PG8_STAGE(PG8_SB(1, 1), b3 + hstep, voffB);
            PG8_WAIT_V(6); PG8_BAR; PG8_MMA(1, 1, At, B1); PG8_BAR;
            }
        }
        if constexpr (ALIGN_EPI) { if (wr == 0) PG8_BAR; }
        if constexpr (!Epi::AFTER_DRAIN) { E(acc, cur, wr, wc, fr, fq); S.done(cur); }
        if (!has_next) break;
#pragma unroll
        for (int a = 0; a < 2; ++a)
#pragma unroll
            for (int b = 0; b < 2; ++b)
#pragma unroll
                for (int m = 0; m < 4; ++m)
#pragma unroll
                    for (int n = 0; n < 2; ++n) acc[a][b][m][n] = (f32x4){0.f, 0.f, 0.f, 0.f};
        cur = nxt; cA = nA; cB = nB; ++ui;
        if constexpr (ALIGN_EPI) { if (wr == 1) PG8_BAR; }
    }
    PG8_WAIT_V(0);
    if constexpr (!ALIGN_EPI) { if (wr == 0) PG8_BAR; }
    PG8_BAR;
    if constexpr (Epi::AFTER_DRAIN) { E.fused(acc, cur, wr, wc, fr, fq, lds, wid, lane); S.done(cur); }
#undef PG8_SA
#undef PG8_SB
#undef PG8_STAGE
#undef PG8_LDA
#undef PG8_LDB
#undef PG8_MMA
#undef PG8_WAIT_V
#undef PG8_WAIT_L
#undef PG8_BAR
#undef PG8_SCHED
}
}

#ifndef PG8_SP2
#define PG8_SP2 true
#endif
#ifndef PG8_ALIGN
#define PG8_ALIGN true
#endif
namespace pg8 {
constexpr int OUT_KP = 17301504, OUT_VP = 34078720, OUT_KS = 51122176, OUT_VS = 51646464;
typedef unsigned u32x2 __attribute__((ext_vector_type(2)));
constexpr int NSSQ = 32;
__device__ __forceinline__ float row_rstd(const float* ssq, int row) {
    const f32x4* p = (const f32x4*)(ssq + (size_t)row * NSSQ); float s = 0.f;
#pragma unroll
    for (int i = 0; i < NSSQ / 4; ++i) { const f32x4 a = p[i]; s += (a[0] + a[1]) + (a[2] + a[3]); }
    return __builtin_amdgcn_rsqf(s * (1.0f / 1024.0f) + 1e-6f);
}
template <int ACT, bool KVF32> struct EpiAct {
    static constexpr bool PERM = true, AFTER_DRAIN = false;
    bf16_t* O; int ldc; const float* ssq; int split_cols; size_t split_stride; float* fout;
    template <int NA, int NB> __device__ __forceinline__ void run(const f32x4 (&acc)[NA][NB][4][2], int rowt, int colt, bool sample, int wr, int wc, int fr, int fq) const {
        const int row0 = rowt + wr * 64 + fr; bf16_t* base = O; int t = 0;
        if (split_cols) { t = colt / split_cols; base += (size_t)t * split_stride; colt -= t * split_cols; }
        const int col0 = colt + wc * 32 + 8 * fq;
        float* fb = nullptr;
        if (KVF32) { if (t < 2) fb = fout + (!sample ? (size_t)(t == 0 ? OUT_KP : OUT_VP) : (size_t)(t == 0 ? OUT_KS : OUT_VS) - (size_t)16384 * 1024) + col0; }
        f32x4 pq[NA][4][2];
#pragma unroll
        for (int ai = 0; ai < NA; ++ai)
#pragma unroll
            for (int m = 0; m < 4; ++m) { const f32x4* p = (const f32x4*)(ssq + (size_t)(row0 + ai * HALF + m * 16) * NSSQ + 8 * fq); pq[ai][m][0] = p[0]; pq[ai][m][1] = p[1]; }
        float rsv[NA][4];
#pragma unroll
        for (int ai = 0; ai < NA; ++ai)
#pragma unroll
            for (int m = 0; m < 4; ++m) { const f32x4 a = pq[ai][m][0], b = pq[ai][m][1]; float sq = ((a[0] + a[1]) + (a[2] + a[3])) + ((b[0] + b[1]) + (b[2] + b[3]));
                sq += __shfl_xor(sq, 16); sq += __shfl_xor(sq, 32); rsv[ai][m] = __builtin_amdgcn_rsqf(sq * (1.0f / 1024.0f) + 1e-6f); }
#pragma unroll
        for (int ai = 0; ai < NA; ++ai)
#pragma unroll
            for (int m = 0; m < 4; ++m) { const int row = row0 + ai * HALF + m * 16; const float rs = rsv[ai][m];
                bf16_t* rowp = base + (size_t)row * ldc + col0;
#pragma unroll
                for (int bj = 0; bj < NB; ++bj) { f32x4 v0 = acc[ai][bj][m][0] * rs, v1 = acc[ai][bj][m][1] * rs;
                    if (ACT == 1) {
#pragma unroll
                        for (int e = 0; e < 4; ++e) { const float a = fmaxf(v0[e], 0.f), b = fmaxf(v1[e], 0.f); v0[e] = a * a; v1[e] = b * b; } }
                    if (KVF32) { if (fb) { float* fr_ = fb + (size_t)row * 1024 + bj * HALF; *(f32x4*)fr_ = v0; *(f32x4*)(fr_ + 4) = v1; } }
                    u32x4 w; w.x = cvt_pk_bf16(v0[0], v0[1]); w.y = cvt_pk_bf16(v0[2], v0[3]); w.z = cvt_pk_bf16(v1[0], v1[1]); w.w = cvt_pk_bf16(v1[2], v1[3]);
                    *(u32x4*)(rowp + bj * HALF) = w; } }
    }
    __device__ __forceinline__ void operator()(const f32x4 (&acc)[2][2][4][2], const Unit& u, int wr, int wc, int fr, int fq) const { run<2, 2>(acc, u.pm * BM, u.pn * BM, u.pm >= 64, wr, wc, fr, fq); }
};
struct EpiResid {
    static constexpr bool PERM = true, AFTER_DRAIN = false;
    float* X; bf16_t* XB; float* ssq; const float* Xp; const float* Xs;
    template <int NA, int NB> __device__ __forceinline__ void run(const f32x4 (&acc)[NA][NB][4][2], int rowt, int colt, bool sample, int wr, int wc, int fr, int fq) const {
        const int row0 = rowt + wr * 64 + fr; const int col0 = colt + wc * 32 + 8 * fq;
#pragma unroll
        for (int ai = 0; ai < NA; ++ai) {
            f32x4 xr[4][NB][2];
#pragma unroll
            for (int m = 0; m < 4; ++m) { const float* xp = (Xp ? (sample ? Xs - (size_t)16384 * 1024 : Xp) : (const float*)X) + (size_t)(row0 + ai * HALF + m * 16) * 1024 + col0;
#pragma unroll
                for (int bj = 0; bj < NB; ++bj) { xr[m][bj][0] = *(const f32x4*)(xp + bj * HALF); xr[m][bj][1] = *(const f32x4*)(xp + bj * HALF + 4); } }
#pragma unroll
            for (int m = 0; m < 4; ++m) { const int row = row0 + ai * HALF + m * 16; float* xp = X + (size_t)row * 1024 + col0; bf16_t* bp = XB + (size_t)row * 1024 + col0;
#pragma unroll
                for (int bj = 0; bj < NB; ++bj) { const f32x4 a0 = xr[m][bj][0] + acc[ai][bj][m][0], a1 = xr[m][bj][1] + acc[ai][bj][m][1];
                    *(f32x4*)(xp + bj * HALF) = a0; *(f32x4*)(xp + bj * HALF + 4) = a1;
                    float q = ((a0[0] * a0[0] + a0[1] * a0[1]) + (a0[2] * a0[2] + a0[3] * a0[3])) + ((a1[0] * a1[0] + a1[1] * a1[1]) + (a1[2] * a1[2] + a1[3] * a1[3]));
                    u32x4 w; w.x = cvt_pk_bf16(a0[0], a0[1]); w.y = cvt_pk_bf16(a0[2], a0[3]); w.z = cvt_pk_bf16(a1[0], a1[1]); w.w = cvt_pk_bf16(a1[2], a1[3]);
                    *(u32x4*)(bp + bj * HALF) = w;
                    q += __shfl_xor(q, 16); q += __shfl_xor(q, 32);
                    if (fq == 0) ssq[(size_t)row * NSSQ + ((colt + bj * HALF) >> 7) * 4 + wc] = q; } }
            asm volatile("" ::: "memory"); }
    }
    __device__ __forceinline__ void operator()(const f32x4 (&acc)[2][2][4][2], const Unit& u, int wr, int wc, int fr, int fq) const { run<2, 2>(acc, u.pm * BM, u.pn * BM, u.pm >= 64, wr, wc, fr, fq); }
};
__device__ __forceinline__ void glds16(const void* gsrc, unsigned lds_dst) { unsigned keep;
    asm volatile("s_mov_b32 %0, m0\n\ts_mov_b32 m0, %2\n\ts_nop 0\n\tglobal_load_lds_dwordx4 %1, off\n\ts_mov_b32 m0, %0" : "=&s"(keep) : "v"(gsrc), "s"(lds_dst) : "memory"); }
template <class Epi>
__device__ __forceinline__ void gemm128_tile(PG8_LAS unsigned char* lds, const bf16_t* A, const bf16_t* Bt, int K, const Epi& E, int rowt, int colt) {
    const int tid = opaque_tid(), wid = __builtin_amdgcn_readfirstlane(tid >> 6), lane = tid & 63, wr = wid >> 2, wc = wid & 3, fr = lane & 15, fq = lane >> 4;
    const int nt = K / BK;
    const char* gA[2]; const char* gB[2];
#pragma unroll
    for (int i = 0; i < 2; ++i) { int R, C; stage_rc(tid * 16 + i * 8192, R, C); const int Rb = (R & ~31) + perm32(R & 31);
        gA[i] = (const char*)A + (size_t)(R * K + C) * 2; gB[i] = (const char*)Bt + (size_t)(Rb * K + C) * 2; }
    const unsigned lds0 = (unsigned)(uintptr_t)lds + (unsigned)wid * 1024u;
    const int aoff = lds_byte(wr * 64 + fr, fq * 8), boff = lds_byte(wc * 32 + fr, fq * 8);
#define G128_STAGE(s, kt) do { _Pragma("unroll") for (int _i = 0; _i < 2; ++_i) { \
        glds16(gA[_i] + (size_t)(kt) * (BK * 2), (unsigned)__builtin_amdgcn_readfirstlane(lds0 + (unsigned)((s) * 2 * HTB + _i * 8192))); \
        glds16(gB[_i] + (size_t)(kt) * (BK * 2), (unsigned)__builtin_amdgcn_readfirstlane(lds0 + (unsigned)((s) * 2 * HTB + HTB + _i * 8192))); } } while (0)
    f32x4 acc[1][1][4][2];
#pragma unroll
    for (int m = 0; m < 4; ++m)
#pragma unroll
        for (int n = 0; n < 2; ++n) acc[0][0][m][n] = (f32x4){0.f, 0.f, 0.f, 0.f};
    G128_STAGE(0, 0); G128_STAGE(1, 1); G128_STAGE(2, 2);
    for (int t = 0; t < nt; ++t) {
        const int rem = nt - 1 - t;
        if (rem >= 2) asm volatile("s_waitcnt vmcnt(8)" ::: "memory"); else if (rem == 1) asm volatile("s_waitcnt vmcnt(4)" ::: "memory"); else asm volatile("s_waitcnt vmcnt(0)" ::: "memory");
        __builtin_amdgcn_s_barrier(); asm volatile("" ::: "memory");
        if (t + 3 < nt) G128_STAGE((t + 3) & 3, t + 3);
        const PG8_LAS unsigned char* sb = lds + (t & 3) * 2 * HTB;
        bf16x8 At[4][2], Bf[2][2];
#pragma unroll
        for (int m = 0; m < 4; ++m)
#pragma unroll
            for (int k = 0; k < 2; ++k) At[m][k] = *(const PG8_LAS bf16x8*)(sb + aoff + m * 2048 + k * 1024);
#pragma unroll
        for (int n = 0; n < 2; ++n)
#pragma unroll
            for (int k = 0; k < 2; ++k) Bf[n][k] = *(const PG8_LAS bf16x8*)(sb + HTB + boff + n * 2048 + k * 1024);
        asm volatile("s_waitcnt lgkmcnt(0)" ::: "memory");
#pragma unroll
        for (int m = 0; m < 4; ++m)
#pragma unroll
            for (int n = 0; n < 2; ++n)
#pragma unroll
                for (int k = 0; k < 2; ++k) acc[0][0][m][n] = __builtin_amdgcn_mfma_f32_16x16x32_bf16(Bf[n][k], At[m][k], acc[0][0][m][n], 0, 0, 0);
    }
#undef G128_STAGE
    E.template run<1, 1>(acc, rowt, colt, true, wr, wc, fr, fq);
    asm volatile("s_waitcnt lgkmcnt(0)" ::: "memory"); __builtin_amdgcn_s_barrier(); asm volatile("" ::: "memory");
}
__device__ __forceinline__ void gemm64_resid_tile(PG8_LAS unsigned char* lds, const bf16_t* A, const bf16_t* Bt, int K, const EpiResid& E, int rowt, int colt) {
    const int tid = opaque_tid(), wid = __builtin_amdgcn_readfirstlane(tid >> 6), lane = tid & 63, wr = wid >> 2, wc = wid & 3, fr = lane & 15, fq = lane >> 4;
    const int nt = K / BK;
    const char* gA; const char* gB;
    { int R, C; stage_rc(tid * 16, R, C); gA = (const char*)A + (size_t)(R * K + C) * 2; gB = (const char*)Bt + (size_t)(R * K + C) * 2; }
    const unsigned lds0 = (unsigned)(uintptr_t)lds + (unsigned)wid * 1024u;
    const int aoff = lds_byte(wr * 32 + fr, fq * 8), boff = lds_byte(wc * 16 + fr, fq * 8);
#define G64_STAGE(s, kt) do { glds16(gA + (size_t)(kt) * (BK * 2), (unsigned)__builtin_amdgcn_readfirstlane(lds0 + (unsigned)((s) * 16384))); \
        glds16(gB + (size_t)(kt) * (BK * 2), (unsigned)__builtin_amdgcn_readfirstlane(lds0 + (unsigned)((s) * 16384 + 8192))); } while (0)
    f32x4 acc[2];
    acc[0] = (f32x4){0.f, 0.f, 0.f, 0.f}; acc[1] = (f32x4){0.f, 0.f, 0.f, 0.f};
#pragma unroll
    for (int s = 0; s < 6; ++s) G64_STAGE(s, s);
    for (int t = 0; t < nt; ++t) {
        const int rem = nt - 1 - t;
        if (rem >= 5) asm volatile("s_waitcnt vmcnt(10)" ::: "memory"); else if (rem == 4) asm volatile("s_waitcnt vmcnt(8)" ::: "memory"); else if (rem == 3) asm volatile("s_waitcnt vmcnt(6)" ::: "memory");
        else if (rem == 2) asm volatile("s_waitcnt vmcnt(4)" ::: "memory"); else if (rem == 1) asm volatile("s_waitcnt vmcnt(2)" ::: "memory"); else asm volatile("s_waitcnt vmcnt(0)" ::: "memory");
        __builtin_amdgcn_s_barrier(); asm volatile("" ::: "memory");
        if (t + 6 < nt) G64_STAGE((t + 6) & 7, t + 6);
        const PG8_LAS unsigned char* sb = lds + (t & 7) * 16384;
        bf16x8 At[2][2], Bf[2];
#pragma unroll
        for (int m = 0; m < 2; ++m)
#pragma unroll
            for (int k = 0; k < 2; ++k) At[m][k] = *(const PG8_LAS bf16x8*)(sb + aoff + m * 2048 + k * 1024);
#pragma unroll
        for (int k = 0; k < 2; ++k) Bf[k] = *(const PG8_LAS bf16x8*)(sb + 8192 + boff + k * 1024);
        asm volatile("s_waitcnt lgkmcnt(0)" ::: "memory");
#pragma unroll
        for (int m = 0; m < 2; ++m)
#pragma unroll
            for (int k = 0; k < 2; ++k) acc[m] = __builtin_amdgcn_mfma_f32_16x16x32_bf16(Bf[k], At[m][k], acc[m], 0, 0, 0);
    }
#undef G64_STAGE
    asm volatile("s_waitcnt lgkmcnt(0)" ::: "memory"); __builtin_amdgcn_s_barrier(); asm volatile("" ::: "memory");
    PG8_LAS float* part = (PG8_LAS float*)lds;
    const int col0 = colt + wc * 16 + 4 * fq;
    const float* xsrc = E.Xp ? E.Xs - (size_t)16384 * 1024 : (const float*)E.X;
#pragma unroll
    for (int m = 0; m < 2; ++m) { const int rl = wr * 32 + m * 16 + fr, row = rowt + rl;
        const f32x4 a0 = *(const f32x4*)(xsrc + (size_t)row * 1024 + col0) + acc[m];
        *(f32x4*)(E.X + (size_t)row * 1024 + col0) = a0;
        u32x2 w; w.x = cvt_pk_bf16(a0[0], a0[1]); w.y = cvt_pk_bf16(a0[2], a0[3]);
        *(u32x2*)(E.XB + (size_t)row * 1024 + col0) = w;
        float q = (a0[0] * a0[0] + a0[1] * a0[1]) + (a0[2] * a0[2] + a0[3] * a0[3]);
        q += __shfl_xor(q, 16); q += __shfl_xor(q, 32);
        if (fq == 0) part[rl * 4 + wc] = q; }
    asm volatile("s_waitcnt lgkmcnt(0)" ::: "memory"); __builtin_amdgcn_s_barrier(); asm volatile("" ::: "memory");
    if (tid < 128) { const int rl = tid >> 1, pr = tid & 1; E.ssq[(size_t)(rowt + rl) * NSSQ + (colt >> 5) + pr] = part[rl * 4 + 2 * pr] + part[rl * 4 + 2 * pr + 1]; }
    asm volatile("s_waitcnt lgkmcnt(0)" ::: "memory"); __builtin_amdgcn_s_barrier(); asm volatile("" ::: "memory");
}
}
#include <hip/hip_bf16.h>
#include <cmath>
namespace attn_body {
using bf16=__hip_bfloat16;
using bf16x8=__attribute__((ext_vector_type(8)))short;
using s16x4=__attribute__((ext_vector_type(4)))short;
using f32x16=__attribute__((ext_vector_type(16)))float;
using u32x4=__attribute__((ext_vector_type(4)))unsigned;
constexpr int BATCH=1,NHEAD=16,SEQ=16384,D=64,DM=NHEAD*D;
constexpr int NW=8,QBLK=32,QB=QBLK*NW,KVBLK=64,NQB=SEQ/QB;
constexpr int ATTN_PITCH=DM, ATTN_UNIT_ROWS=QB;
__device__ __forceinline__ int crow(int r,int hi){return (r&3)+8*(r>>2)+4*hi;}
#define SBAR() __builtin_amdgcn_sched_barrier(0)
__device__ __forceinline__ void cmask(f32x16&p0,f32x16&p1,int jb,int qrel,int hi){
  const float NEG=-INFINITY; int kb=64*jb+4*hi;
  #pragma unroll
  for(int r=0;r<16;++r){int kv=kb+(r&3)+8*(r>>2); if(kv>qrel)p0[r]=NEG; if(kv+32>qrel)p1[r]=NEG;}
}

constexpr int NSLOT=3, SLOTB=8192;
constexpr int LDS_K=0, LDS_V=NSLOT*SLOTB, LDS_WS=2*NSLOT*SLOTB, LDS_OST=LDS_WS+NW*64*4, LDS_CK=LDS_OST+NW*4096, LDS_BYTES=LDS_CK+SEQ*4;
constexpr float C2=0.125f*1.4426950408889634f;
__device__ __forceinline__ void glds16(const void*gsrc,unsigned lds_dst){unsigned keep;
  asm volatile("s_mov_b32 %0, m0\n\ts_mov_b32 m0, %2\n\ts_nop 0\n\tglobal_load_lds_dwordx4 %1, off\n\ts_mov_b32 m0, %0":"=&s"(keep):"v"(gsrc),"s"(lds_dst):"memory");}
__device__ __forceinline__ void glds16s(const void*sbase,unsigned voff,unsigned lds_dst){unsigned keep;
  asm volatile("s_mov_b32 %0, m0\n\ts_mov_b32 m0, %3\n\ts_nop 0\n\tglobal_load_lds_dwordx4 %1, %2\n\ts_mov_b32 m0, %0":"=&s"(keep):"v"(voff),"s"(sbase),"s"(lds_dst):"memory");}
__device__ __forceinline__ float max3f(float a,float b,float c){float r;asm("v_max3_f32 %0, %1, %2, %3":"=v"(r):"v"(a),"v"(b),"v"(c));return r;}
__device__ __forceinline__ float max2f(float a,float b){float r;asm("v_max_f32_e32 %0, %1, %2":"=v"(r):"v"(a),"v"(b));return r;}
__device__ __forceinline__ float fadd_s(float a,float b){float r;asm("v_add_f32_e32 %0, %1, %2":"=v"(r):"v"(a),"v"(b));return r;}
__device__ __forceinline__ float fsub_s(float a,float b){float r;asm("v_sub_f32_e32 %0, %1, %2":"=v"(r):"v"(a),"v"(b));return r;}
typedef float f32x2_t __attribute__((ext_vector_type(2))); typedef __bf16 bf16x2_t __attribute__((ext_vector_type(2)));
__device__ __forceinline__ unsigned cvtpk_s(float lo,float hi){f32x2_t v={lo,hi};bf16x2_t b=__builtin_convertvector(v,bf16x2_t);return __builtin_bit_cast(unsigned,b);}
#define WAIT_BAR(N) asm volatile("s_waitcnt vmcnt(" #N ") lgkmcnt(0)\n\ts_barrier":::"memory")

__device__ __forceinline__ void qkt(f32x16&p0,f32x16&p1,const char*Kslot,const bf16x8*qr,const f32x16&negm,int r32,int hi){
  const char*kb=Kslot+hi*1024+r32*16;
  #pragma unroll
  for(int d0=0;d0<4;++d0){
    const bf16x8 b0=*reinterpret_cast<const bf16x8*>(kb+d0*2048);
    const bf16x8 b1=*reinterpret_cast<const bf16x8*>(kb+d0*2048+512);
    if(d0==0){p0=__builtin_amdgcn_mfma_f32_32x32x16_bf16(b0,qr[0],negm,0,0,0);p1=__builtin_amdgcn_mfma_f32_32x32x16_bf16(b1,qr[0],negm,0,0,0);}
    else{p0=__builtin_amdgcn_mfma_f32_32x32x16_bf16(b0,qr[d0],p0,0,0,0);p1=__builtin_amdgcn_mfma_f32_32x32x16_bf16(b1,qr[d0],p1,0,0,0);}}
}
typedef __attribute__((address_space(3))) const char* lds_cptr;
typedef short v4i16_t __attribute__((ext_vector_type(4)));
__device__ __forceinline__ void kload8(bf16x8*kf,lds_cptr kp){
  kf[0]=*(const __attribute__((address_space(3))) bf16x8*)(kp);      kf[1]=*(const __attribute__((address_space(3))) bf16x8*)(kp+512);
  kf[2]=*(const __attribute__((address_space(3))) bf16x8*)(kp+2048); kf[3]=*(const __attribute__((address_space(3))) bf16x8*)(kp+2560);
  kf[4]=*(const __attribute__((address_space(3))) bf16x8*)(kp+4096); kf[5]=*(const __attribute__((address_space(3))) bf16x8*)(kp+4608);
  kf[6]=*(const __attribute__((address_space(3))) bf16x8*)(kp+6144); kf[7]=*(const __attribute__((address_space(3))) bf16x8*)(kp+6656);
}
__device__ __forceinline__ void kload2(bf16x8*kf,lds_cptr kp,int j){ kf[2*j]=*(const __attribute__((address_space(3))) bf16x8*)(kp+j*2048); kf[2*j+1]=*(const __attribute__((address_space(3))) bf16x8*)(kp+j*2048+512); }
__device__ __forceinline__ s16x4 vtr(lds_cptr p){ return __builtin_bit_cast(s16x4,__builtin_amdgcn_ds_read_tr16_b64_v4i16((__attribute__((address_space(3))) v4i16_t*)p)); }
__device__ __forceinline__ float rowmax(const f32x16&p0,const f32x16&p1){
  float a=max3f(p0[0],p0[1],p1[0]),b=max3f(p0[2],p0[3],p1[1]);a=max3f(a,p1[2],p1[3]);
  #pragma unroll
  for(int r=4;r<16;r+=4){a=max3f(a,p0[r],p0[r+1]);b=max3f(b,p0[r+2],p0[r+3]);a=max3f(a,p1[r],p1[r+1]);b=max3f(b,p1[r+2],p1[r+3]);}
  const float m=max2f(a,b);
  auto rr=__builtin_amdgcn_permlane32_swap(__float_as_uint(m),__float_as_uint(m),false,false);
  return max2f(__uint_as_float(rr[0]),__uint_as_float(rr[1]));
}
__device__ __forceinline__ void pv(f32x16*o,int vb,bf16x8 pa0,bf16x8 pa1,bf16x8 pa2,bf16x8 pa3){
  #pragma unroll
  for(int d0=0;d0<2;++d0){s16x4 lo[4],hi[4];
    #pragma unroll
    for(int ks=0;ks<4;++ks){
      asm volatile("ds_read_b64_tr_b16 %0,%1 offset:%c2":"=&v"(lo[ks]):"v"(vb),"i"(d0*4096+ks*1024):"memory");
      asm volatile("ds_read_b64_tr_b16 %0,%1 offset:%c2":"=&v"(hi[ks]):"v"(vb),"i"(d0*4096+ks*1024+512):"memory");}
    asm volatile("s_waitcnt lgkmcnt(0)":::"memory");SBAR();
    #define PK(k) (bf16x8){lo[k][0],lo[k][1],lo[k][2],lo[k][3],hi[k][0],hi[k][1],hi[k][2],hi[k][3]}
    o[d0]=__builtin_amdgcn_mfma_f32_32x32x16_bf16(pa0,PK(0),o[d0],0,0,0);
    o[d0]=__builtin_amdgcn_mfma_f32_32x32x16_bf16(pa1,PK(1),o[d0],0,0,0);
    o[d0]=__builtin_amdgcn_mfma_f32_32x32x16_bf16(pa2,PK(2),o[d0],0,0,0);
    o[d0]=__builtin_amdgcn_mfma_f32_32x32x16_bf16(pa3,PK(3),o[d0],0,0,0);
    #undef PK
  }
}

#ifndef ATTN_STORE16
#define ATTN_STORE16(p,v) (*(u32x4*)(p)=(v))
#endif
typedef float f32x4_t __attribute__((ext_vector_type(4)));
#define CKSUB(C0,C1,t) do{ const __attribute__((address_space(3))) f32x4_t* ck_=(const __attribute__((address_space(3))) f32x4_t*)(ckl+(t)*64+4*hi); \
   _Pragma("unroll") for(int g_=0;g_<4;++g_){ const f32x4_t a_=ck_[2*g_], b_=ck_[8+2*g_]; \
     _Pragma("unroll") for(int i_=0;i_<4;++i_){ C0[4*g_+i_]-=a_[i_]; C1[4*g_+i_]-=b_[i_]; } } }while(0)
template<int THRL> __device__ __forceinline__ void attn_unit(int b,int h,int qb,const bf16*Q,const bf16*__restrict__ K,const bf16*__restrict__ V,bf16*O,char*shm,const float*ckg,const float kmax2){
  const int tid=opaque_tid(),lane=tid&63,r32=lane&31,hi=lane>>5; const int wid=__builtin_amdgcn_readfirstlane(tid>>6);
  const long rowbase=(long)b*SEQ; const int q0=qb*QB;
  const bf16*Qw=Q+(rowbase+q0+wid*QBLK)*DM+h*D;
  const unsigned lds0=(unsigned)(uintptr_t)shm;
  float*wsf=(float*)(shm+LDS_WS)+wid*64;
  __attribute__((address_space(3))) float* ckl=(__attribute__((address_space(3))) float*)((__attribute__((address_space(3))) char*)shm+LDS_CK);
  const float cqv=ckg[q0+wid*QBLK+r32];
  bf16x8 qr[4];
  #pragma unroll
  for(int d0=0;d0<4;++d0)qr[d0]=*reinterpret_cast<const bf16x8*>(&Qw[(long)r32*DM+d0*16+hi*8]);
  int t0=0;
  if(qb>0){
    float*wsa=(float*)(shm+LDS_WS);
    float qs=0.f;
    #pragma unroll
    for(int d0=0;d0<4;++d0){
      #pragma unroll
      for(int e=0;e<8;++e){ const float v_=__builtin_bit_cast(float,((unsigned)(unsigned short)qr[d0][e])<<16); qs+=v_*v_; } }
    qs+=__shfl_xor(qs,32);
    #pragma unroll
    for(int o_=1;o_<32;o_<<=1) qs=fmaxf(qs,__shfl_xor(qs,o_));
    float dg=0.f;
    { const bf16*Kq=K+(rowbase+q0+wid*QBLK)*DM+h*D;
      #pragma unroll
      for(int d0=0;d0<4;++d0){ const bf16x8 kd_=*reinterpret_cast<const bf16x8*>(&Kq[(long)r32*DM+d0*16+hi*8]);
        #pragma unroll
        for(int e=0;e<8;++e){ dg+=__builtin_bit_cast(float,((unsigned)(unsigned short)qr[d0][e])<<16)*__builtin_bit_cast(float,((unsigned)(unsigned short)kd_[e])<<16); } } }
    dg+=__shfl_xor(dg,32);
    #pragma unroll
    for(int o_=1;o_<32;o_<<=1) dg=fminf(dg,__shfl_xor(dg,o_));
    const int ncand=q0/KVBLK;
    float cend=0.f; if(tid<ncand) cend=ckg[tid*KVBLK+KVBLK-1];
    const float cq0=ckg[q0];
    if(lane==0){ wsa[wid]=qs; wsa[16+wid]=dg; }
    __syncthreads();
    float qm=wsa[0];
    #pragma unroll
    for(int w_=1;w_<NW;++w_) qm=fmaxf(qm,wsa[w_]);
    float dmn=wsa[16];
    #pragma unroll
    for(int w_=1;w_<NW;++w_) dmn=fminf(dmn,wsa[16+w_]);
    const float thr=dmn-40.05f-sqrtf(qm*kmax2)*1.0001f;
    const bool skip_=(tid<ncand)&&((cq0-cend)<thr);
    const unsigned long long bal_=__ballot(skip_);
    if(lane==0) wsa[8+wid]=(float)__popcll(bal_);
    __syncthreads();
    float cnt_=0.f;
    #pragma unroll
    for(int w_=0;w_<NW;++w_) cnt_+=wsa[8+w_];
    t0=__builtin_amdgcn_readfirstlane(((int)cnt_)&~1);
    __syncthreads();
  }
  const bf16*Kh=K+(rowbase+(long)t0*KVBLK)*DM+h*D,*Vh=V+(rowbase+(long)t0*KVBLK)*DM+h*D;
  { const int nf4=(q0+QB-t0*KVBLK)>>2; const f32x4_t* src_=(const f32x4_t*)(ckg+t0*KVBLK); __attribute__((address_space(3))) f32x4_t* dst_=(__attribute__((address_space(3))) f32x4_t*)ckl;
    for(int i_=tid;i_<nf4;i_+=NW*64) dst_[i_]=src_[i_]; }
  const unsigned kvoff=(unsigned)((lane*DM+wid*8)*2);
  const unsigned vvoff=(unsigned)(((16*(wid&3)+(lane>>2))*DM+(wid>>2)*32+(lane&3)*8)*2);
  const unsigned kdst=lds0+LDS_K+wid*1024, vdst=lds0+LDS_V+wid*1024;
  #define DMA_K(t,slot) glds16s(Kh+(long)(t)*KVBLK*DM,kvoff,(unsigned)__builtin_amdgcn_readfirstlane(kdst+(slot)))
  #define DMA_V(t,slot) glds16s(Vh+(long)(t)*KVBLK*DM,vvoff,(unsigned)__builtin_amdgcn_readfirstlane(vdst+(slot)))
  const int vb0=(int)(lds0+LDS_V)+((lane>>4)&1)*32+(lane&3)*8+(4*hi+((lane&15)>>2))*64;
  const char*Kbase=shm+LDS_K; bf16x8 kf[8];
  const lds_cptr shm3=(lds_cptr)shm; const lds_cptr kp0=shm3+LDS_K+hi*1024+r32*16; const lds_cptr vp0=shm3+LDS_V+((lane>>4)&1)*32+(lane&3)*8+(4*hi+((lane&15)>>2))*64;
  const int NT=(q0+QB)/KVBLK-t0;
  DMA_K(0,0);DMA_V(0,0);DMA_K(1,SLOTB);
  float mhat=-cqv,l_reg=0.f;    f32x16 o[2];o[0]=f32x16{};o[1]=f32x16{};f32x16 negm;
  #pragma unroll
  for(int r=0;r<16;++r)negm[r]=cqv;
  asm volatile("":"+v"(negm));
  const int qrel=wid*QBLK+r32;
  #define CMASK(P0,P1,t) do{int jb_=(t)-(NT-4); if(jb_>=0)cmask(P0,P1,jb_,qrel,hi);}while(0)
  bool resc=false;
  #define START(P0,P1) do{ const float rm=rowmax(P0,P1); resc=false; \
    { const float dl=rm; mhat=fadd_s(mhat,dl); \
      _Pragma("unroll") for(int r=0;r<16;++r){P0[r]=fsub_s(P0[r],dl);P1[r]=fsub_s(P1[r],dl);} \
      _Pragma("unroll") for(int r=0;r<16;++r)negm[r]=-mhat; asm volatile("":"+v"(negm)); } \
    _Pragma("unroll") for(int r=0;r<16;++r)P0[r]=__builtin_amdgcn_exp2f(P0[r]); }while(0)
  #define RESC() do{ if(resc){ asm volatile("s_waitcnt lgkmcnt(0)":::"memory"); \
      _Pragma("unroll") for(int d_=0;d_<2;++d_) _Pragma("unroll") for(int r=0;r<16;++r)o[d_][r]*=wsf[crow(r,hi)]; } }while(0)
  f32x16 pA0,pA1,pB0,pB1;
  int sl_prev=0,sl_cur=0,sl_next=SLOTB;
  #define ROT() do{sl_prev=sl_cur;sl_cur=sl_next;sl_next=(sl_next==(NSLOT-1)*SLOTB)?0:sl_next+SLOTB;}while(0)
  DMA_K(2,2*SLOTB);
  WAIT_BAR(3);
  qkt(pA0,pA1,Kbase,qr,negm,r32,hi);asm volatile("s_nop 15\n\ts_nop 7":"+v"(pA0),"+v"(pA1));CKSUB(pA0,pA1,0);CMASK(pA0,pA1,0);
  START(pA0,pA1);
  _Pragma("unroll") for(int r=0;r<16;++r)pA1[r]=__builtin_amdgcn_exp2f(pA1[r]);
  WAIT_BAR(0);
  DMA_K(3,0);DMA_V(1,SLOTB);
  ROT();
  kload8(kf,kp0+sl_cur);
  WAIT_BAR(2);
  s16x4 vlo[8],vhi[8]; u32x4 pw0,pw1,pw2,pw3;
  #define PKW(P,B) cvtpk_s(P[B],P[B+1])
  #define PAF(k) __builtin_bit_cast(bf16x8,pw##k)
  #define VFR(i) (bf16x8){vlo[i][0],vlo[i][1],vlo[i][2],vlo[i][3],vhi[i][0],vhi[i][1],vhi[i][2],vhi[i][3]}
  #define PIN(x) asm volatile("":"+v"(x))
  #define MX3(a,b,c) __builtin_fmaxf(__builtin_fmaxf((a),(b)),(c))
  #define GAPA(MF,A0,A1,A2,A3,W0,W1,PW) do{ MF; sacc+=A0; sacc+=A1; sacc+=A2; sacc+=A3; PIN(sacc); W0; W1; PIN(PW); SBAR(); }while(0)
  #define EX(v) __builtin_amdgcn_exp2f(v)
  #define GAPB(MF,X,B) do{ MF; X[B]=EX(X[B]); X[B+1]=EX(X[B+1]); X[B+2]=EX(X[B+2]); X[B+3]=EX(X[B+3]); PIN(X); SBAR(); }while(0)
  #define VRD(i) do{ vlo[i]=vtr(vp_+(((i)>>2)*4096+((i)&3)*1024)); vhi[i]=vtr(vp_+(((i)>>2)*4096+((i)&3)*1024+512)); }while(0)
  #define KRD(G,j) do{ if(G){ kload2(kf,kp0+sl_next,j); SBAR(); } }while(0)
  #define STEP(C0,C1,P0,P1,t,GK,GV,GL) do{ SBAR(); \
    const lds_cptr vp_=vp0+sl_prev; \
    VRD(0); SBAR(); float sacc=(P0[0]+P0[1]); \
    GAPA(C0=__builtin_amdgcn_mfma_f32_32x32x16_bf16(kf[0],qr[0],negm,0,0,0), P0[2],P0[3],P0[4],P0[5],     pw0[0]=PKW(P0,0), pw0[1]=PKW(P0,2), pw0); \
    VRD(4); SBAR(); GAPA(C1=__builtin_amdgcn_mfma_f32_32x32x16_bf16(kf[1],qr[0],negm,0,0,0), P0[6],P0[7],P0[8],P0[9],     pw0[2]=PKW(P0,4), pw0[3]=PKW(P0,6), pw0); \
    VRD(1); SBAR(); GAPA(C0=__builtin_amdgcn_mfma_f32_32x32x16_bf16(kf[2],qr[1],C0,0,0,0),   P0[10],P0[11],P0[12],P0[13], pw1[0]=PKW(P0,8), pw1[1]=PKW(P0,10), pw1); \
    VRD(5); SBAR(); GAPA(C1=__builtin_amdgcn_mfma_f32_32x32x16_bf16(kf[3],qr[1],C1,0,0,0),   P0[14],P0[15],P1[0],P1[1],   pw1[2]=PKW(P0,12),pw1[3]=PKW(P0,14), pw1); \
    VRD(2); SBAR(); GAPA(C0=__builtin_amdgcn_mfma_f32_32x32x16_bf16(kf[4],qr[2],C0,0,0,0),   P1[2],P1[3],P1[4],P1[5],     pw2[0]=PKW(P1,0), pw2[1]=PKW(P1,2), pw2); \
    VRD(6); SBAR(); GAPA(C1=__builtin_amdgcn_mfma_f32_32x32x16_bf16(kf[5],qr[2],C1,0,0,0),   P1[6],P1[7],P1[8],P1[9],     pw2[2]=PKW(P1,4), pw2[3]=PKW(P1,6), pw2); \
    VRD(3); SBAR(); GAPA(C0=__builtin_amdgcn_mfma_f32_32x32x16_bf16(kf[6],qr[3],C0,0,0,0),   P1[10],P1[11],P1[12],P1[13], pw3[0]=PKW(P1,8), pw3[1]=PKW(P1,10), pw3); \
    VRD(7); SBAR(); GAPA(C1=__builtin_amdgcn_mfma_f32_32x32x16_bf16(kf[7],qr[3],C1,0,0,0),   P1[14],P1[15],0.f,0.f,       pw3[2]=PKW(P1,12),pw3[3]=PKW(P1,14), pw3); \
    l_reg+=sacc; \
    if(GK){DMA_K((t)+3,sl_cur);} if(GV){DMA_V((t)+1,sl_next);} \
    CKSUB(C0,C1,t); CMASK(C0,C1,t); \
    { float a=MX3(C0[0],C0[1],C1[0]),b=MX3(C0[2],C0[3],C1[1]); a=MX3(a,C1[2],C1[3]); \
      _Pragma("unroll") for(int r=4;r<16;r+=4){a=MX3(a,C0[r],C0[r+1]);b=MX3(b,C0[r+2],C0[r+3]);a=MX3(a,C1[r],C1[r+1]);b=MX3(b,C1[r+2],C1[r+3]);} \
      float rm=__builtin_fmaxf(a,b); { auto rr=__builtin_amdgcn_permlane32_swap(__float_as_uint(rm),__float_as_uint(rm),false,false); rm=__builtin_fmaxf(__uint_as_float(rr[0]),__uint_as_float(rr[1])); } \
      resc=false; \
      if(__builtin_expect(__any(rm>(float)THRL),0)){ const float dl=__builtin_fmaxf(rm,0.f); mhat+=dl; \
        _Pragma("unroll") for(int r=0;r<16;++r){C0[r]-=dl;C1[r]-=dl;} \
        _Pragma("unroll") for(int r=0;r<16;++r)negm[r]=-mhat; asm volatile("":"+v"(negm)); \
        const float f=__builtin_amdgcn_exp2f(-dl); l_reg*=f; if(hi==0)wsf[r32]=f; resc=true; } } \
    SBAR(); \
    GAPB(o[0]=__builtin_amdgcn_mfma_f32_32x32x16_bf16(PAF(0),VFR(0),o[0],0,0,0), C0,0); \
    GAPB(o[1]=__builtin_amdgcn_mfma_f32_32x32x16_bf16(PAF(0),VFR(4),o[1],0,0,0), C0,4); \
    KRD(GL,0); GAPB(o[0]=__builtin_amdgcn_mfma_f32_32x32x16_bf16(PAF(1),VFR(1),o[0],0,0,0), C0,8); \
    KRD(GL,1); GAPB(o[1]=__builtin_amdgcn_mfma_f32_32x32x16_bf16(PAF(1),VFR(5),o[1],0,0,0), C0,12); \
    KRD(GL,2); GAPB(o[0]=__builtin_amdgcn_mfma_f32_32x32x16_bf16(PAF(2),VFR(2),o[0],0,0,0), C1,0); \
    KRD(GL,3); GAPB(o[1]=__builtin_amdgcn_mfma_f32_32x32x16_bf16(PAF(2),VFR(6),o[1],0,0,0), C1,4); \
    GAPB(o[0]=__builtin_amdgcn_mfma_f32_32x32x16_bf16(PAF(3),VFR(3),o[0],0,0,0), C1,8); \
    GAPB(o[1]=__builtin_amdgcn_mfma_f32_32x32x16_bf16(PAF(3),VFR(7),o[1],0,0,0), C1,12); \
    }while(0)
  int t=1;
  #undef CMASK
  #define CMASK(P0,P1,t) do{}while(0)
  for(;t+5<NT;t+=2){
    STEP(pB0,pB1,pA0,pA1,t,true,true,true);     WAIT_BAR(2); RESC(); ROT();
    STEP(pA0,pA1,pB0,pB1,t+1,true,true,true);   WAIT_BAR(2); RESC(); ROT();
  }
  #undef CMASK
  #define CMASK(P0,P1,t) do{int jb_=(t)-(NT-4); if(jb_>=0)cmask(P0,P1,jb_,qrel,hi);}while(0)
  #define ENDW(tt) do{ if((tt)+3<NT){WAIT_BAR(2);} else if((tt)+2<NT){WAIT_BAR(1);} else {WAIT_BAR(0);} }while(0)
  for(;t+1<NT;t+=2){
    STEP(pB0,pB1,pA0,pA1,t,(t+3<NT),(t+1<NT),(t+1<NT));       ENDW(t);   RESC(); ROT();
    STEP(pA0,pA1,pB0,pB1,t+1,(t+4<NT),(t+2<NT),(t+2<NT));     ENDW(t+1); RESC(); ROT();
  }
  STEP(pB0,pB1,pA0,pA1,NT-1,false,false,false); RESC();
  { float sacc=pB0[0]+pB0[1]; _Pragma("unroll") for(int r=2;r<16;++r)sacc+=pB0[r]; _Pragma("unroll") for(int r=0;r<16;++r)sacc+=pB1[r]; l_reg+=sacc;
    pw0=(u32x4){PKW(pB0,0),PKW(pB0,2),PKW(pB0,4),PKW(pB0,6)};pw1=(u32x4){PKW(pB0,8),PKW(pB0,10),PKW(pB0,12),PKW(pB0,14)};pw2=(u32x4){PKW(pB1,0),PKW(pB1,2),PKW(pB1,4),PKW(pB1,6)};pw3=(u32x4){PKW(pB1,8),PKW(pB1,10),PKW(pB1,12),PKW(pB1,14)};
    SBAR(); pv(o,vb0+sl_cur,PAF(0),PAF(1),PAF(2),PAF(3)); }
  #undef PKW
  #undef PAF
  #undef VFR
  #undef PIN
  #undef MX3
  #undef GAPA
  #undef GAPB
  #undef EX
  #undef VRD
  #undef KRD
  #undef STEP
  #undef ENDW
  {auto rr=__builtin_amdgcn_permlane32_swap(__float_as_uint(l_reg),__float_as_uint(l_reg),false,false);l_reg=__uint_as_float(rr[0])+__uint_as_float(rr[1]);}
  if(hi==0)wsf[32+r32]=l_reg;asm volatile("s_waitcnt lgkmcnt(0)":::"memory");
  float rli[16];
  #pragma unroll
  for(int r=0;r<16;++r)rli[r]=__builtin_amdgcn_rcpf(wsf[32+crow(r,hi)]);
  bf16*Ow=O+(rowbase+q0+wid*QBLK)*DM+h*D;
  { bf16*stg=(bf16*)(shm+LDS_OST)+wid*2048;
    #pragma unroll
    for(int r=0;r<16;++r){const int orow=crow(r,hi);
      #pragma unroll
      for(int d0=0;d0<2;++d0)stg[orow*64+d0*32+r32]=__float2bfloat16(o[d0][r]*rli[r]);}
    asm volatile("s_waitcnt lgkmcnt(0)":::"memory");
    #pragma unroll
    for(int i=0;i<4;++i){const int row=i*8+(lane>>3),ch=lane&7; const u32x4 v=*(const u32x4*)(stg+row*64+ch*8); ATTN_STORE16(Ow+(long)row*DM+ch*8,v);} }
  asm volatile("s_waitcnt lgkmcnt(0)\n\ts_barrier":::"memory");
  #undef DMA_K
  #undef DMA_V
  #undef CMASK
  #undef START
  #undef RESC
  #undef ROT
}
constexpr int ATTN_LDS_BYTES=LDS_BYTES;
struct AttnTensors { const bf16* Q; const bf16* K; const bf16* V; bf16* O; const float* CL; const unsigned* KMAX; };
struct AttnUnit { int bh; int qb; };
template<int THRL=8> __device__ __forceinline__ void attn_phase_q(char*lds,const AttnTensors&T,unsigned*qctr,int block){
  volatile __attribute__((address_space(3))) int* tk=(volatile __attribute__((address_space(3))) int*)((__attribute__((address_space(3))) char*)lds+LDS_WS);
  for(;;){
    if(threadIdx.x==0){ int v=-1,q=block&7; for(int tried=0;tried<8;++tried){ const unsigned i_=__hip_atomic_fetch_add(qctr+64*q,1u,__ATOMIC_RELAXED,__HIP_MEMORY_SCOPE_AGENT); if(i_<128u){ v=(int)(q*128u+i_); break; } q=(q+1)&7; } tk[0]=v; }
    __syncthreads();
    const int u=__builtin_amdgcn_readfirstlane(tk[0]);
    __syncthreads();
    if(u<0)break;
    const int qq=u>>7,i_=u&127,h=2*qq+(i_&1),qb=63-(i_>>1);
    attn_unit<THRL>(0,h,qb,T.Q,T.K,T.V,T.O,lds,T.CL+(size_t)h*SEQ,__builtin_bit_cast(float,T.KMAX[h]));
  }
}
#undef SBAR
#undef WAIT_BAR
}
namespace sattn {
#define SLAS __attribute__((address_space(3)))
typedef short bf16x8 __attribute__((ext_vector_type(8)));
typedef float f32x4 __attribute__((ext_vector_type(4)));
typedef unsigned u32x4 __attribute__((ext_vector_type(4)));
typedef unsigned u32x2 __attribute__((ext_vector_type(2)));
typedef float f32x2_t __attribute__((ext_vector_type(2))); typedef __bf16 bf16x2_t __attribute__((ext_vector_type(2)));
__device__ __forceinline__ unsigned pk(float lo, float hi) { f32x2_t v = {lo, hi}; bf16x2_t b = __builtin_convertvector(v, bf16x2_t); return __builtin_bit_cast(unsigned, b); }
__device__ __forceinline__ bf16x8 cvt8(f32x4 a, f32x4 b) { u32x4 w; w.x = pk(a[0], a[1]); w.y = pk(a[2], a[3]); w.z = pk(b[0], b[1]); w.w = pk(b[2], b[3]); return __builtin_bit_cast(bf16x8, w); }
constexpr int PAST = 2048, NEWK = 16, LKEYS = PAST + NEWK, VT_STRIDE = 80, VT_BYTES = 64 * VT_STRIDE;
constexpr int L_VT = 0, L_CO = 8 * VT_BYTES, L_CM = L_CO + 8 * 16 * 64 * 4, L_CL = L_CM + 8 * 16 * 4, L_END = L_CL + 8 * 16 * 4;
constexpr float NEG = -1.0e30f;
struct Tensors { const float* ck; const float* cv; const unsigned short* QB; const unsigned short* KB; const unsigned short* VB; unsigned short* O; const float* CLS; };
__device__ __forceinline__ void tile_tail(f32x4 (&s)[2], const bf16x8 (&vw)[4], float& m, float& l, f32x4 (&o)[4], SLAS char* vt, int r, int g) {
    float mx = fmaxf(fmaxf(fmaxf(s[0][0], s[0][1]), fmaxf(s[0][2], s[0][3])), fmaxf(fmaxf(s[1][0], s[1][1]), fmaxf(s[1][2], s[1][3])));
    mx = fmaxf(mx, __shfl_xor(mx, 16)); mx = fmaxf(mx, __shfl_xor(mx, 32));
    const float mn = fmaxf(m, mx), alpha = __builtin_amdgcn_exp2f(m - mn); m = mn;
    float ps = 0.f;
#pragma unroll
    for (int j = 0; j < 2; ++j)
#pragma unroll
        for (int e = 0; e < 4; ++e) { s[j][e] = __builtin_amdgcn_exp2f(s[j][e] - mn); ps += s[j][e]; }
    l = l * alpha + ps;
#pragma unroll
    for (int db = 0; db < 4; ++db) o[db] *= alpha;
    const bf16x8 pb = cvt8(s[0], s[1]);
#pragma unroll
    for (int dd = 0; dd < 4; ++dd) *(SLAS bf16x8*)(vt + (4 * r + dd) * VT_STRIDE + g * 16) = vw[dd];
#pragma unroll
    for (int db = 0; db < 4; ++db) { const bf16x8 va = *(const SLAS bf16x8*)(vt + (16 * db + r) * VT_STRIDE + g * 16); o[db] = __builtin_amdgcn_mfma_f32_16x16x32_bf16(va, pb, o[db], 0, 0, 0); }
}
__device__ __forceinline__ void unit(int b, int h, const Tensors& T, SLAS char* lds) {
    const int tid = opaque_tid(), lane = tid & 63, r = lane & 15, g = lane >> 4; const int wid = __builtin_amdgcn_readfirstlane(tid >> 6);
    SLAS char* vt = lds + L_VT + wid * VT_BYTES;
    const size_t srow = (size_t)16384 + (size_t)b * 16;
    const float* cls = T.CLS + (size_t)(b * 16 + h) * LKEYS;
    const unsigned short* qp = T.QB + (srow + r) * 1024 + h * 64 + 8 * g;
    const bf16x8 qf0 = *(const bf16x8*)qp, qf1 = *(const bf16x8*)(qp + 32);
    const float cq = cls[PAST + r];
    float m = NEG, l = 0.f; f32x4 o[4];
#pragma unroll
    for (int db = 0; db < 4; ++db) o[db] = (f32x4){0.f, 0.f, 0.f, 0.f};
    const float* kc = T.ck + ((size_t)b * PAST * 16 + h) * 64; const float* vc = T.cv + ((size_t)b * PAST * 16 + h) * 64;
    for (int tI = 0; tI < 8; ++tI) {
        const int k0 = wid * 256 + tI * 32;
        bf16x8 ka[2][2];
#pragma unroll
        for (int j = 0; j < 2; ++j)
#pragma unroll
            for (int dh = 0; dh < 2; ++dh) { const float* p = kc + (size_t)(k0 + 16 * j + r) * 1024 + dh * 32 + 8 * g; ka[j][dh] = cvt8(*(const f32x4*)p, *(const f32x4*)(p + 4)); }
        f32x4 vv[2][4];
#pragma unroll
        for (int j = 0; j < 2; ++j)
#pragma unroll
            for (int e = 0; e < 4; ++e) vv[j][e] = *(const f32x4*)(vc + (size_t)(k0 + 16 * j + 4 * g + e) * 1024 + 4 * r);
        f32x4 ckv[2];
#pragma unroll
        for (int j = 0; j < 2; ++j) ckv[j] = *(const f32x4*)(cls + k0 + 16 * j + 4 * g);
        f32x4 s[2];
#pragma unroll
        for (int j = 0; j < 2; ++j) { s[j] = __builtin_amdgcn_mfma_f32_16x16x32_bf16(ka[j][0], qf0, (f32x4){0.f, 0.f, 0.f, 0.f}, 0, 0, 0); s[j] = __builtin_amdgcn_mfma_f32_16x16x32_bf16(ka[j][1], qf1, s[j], 0, 0, 0); }
#pragma unroll
        for (int j = 0; j < 2; ++j)
#pragma unroll
            for (int e = 0; e < 4; ++e) s[j][e] += cq - ckv[j][e];
        bf16x8 vw[4];
#pragma unroll
        for (int dd = 0; dd < 4; ++dd) { u32x4 w; w.x = pk(vv[0][0][dd], vv[0][1][dd]); w.y = pk(vv[0][2][dd], vv[0][3][dd]); w.z = pk(vv[1][0][dd], vv[1][1][dd]); w.w = pk(vv[1][2][dd], vv[1][3][dd]); vw[dd] = __builtin_bit_cast(bf16x8, w); }
        tile_tail(s, vw, m, l, o, vt, r, g);
    }
    if (wid == 0) {
        bf16x8 ka[2]; { const unsigned short* p = T.KB + (srow + r) * 1024 + h * 64 + 8 * g; ka[0] = *(const bf16x8*)p; ka[1] = *(const bf16x8*)(p + 32); }
        const f32x4 ckv = *(const f32x4*)(cls + PAST + 4 * g);
        f32x4 s[2];
        s[0] = __builtin_amdgcn_mfma_f32_16x16x32_bf16(ka[0], qf0, (f32x4){0.f, 0.f, 0.f, 0.f}, 0, 0, 0); s[0] = __builtin_amdgcn_mfma_f32_16x16x32_bf16(ka[1], qf1, s[0], 0, 0, 0);
#pragma unroll
        for (int e = 0; e < 4; ++e) { s[0][e] += cq - ckv[e]; if (4 * g + e > r) s[0][e] = NEG; s[1][e] = NEG; }
        unsigned short ve[4][4];
#pragma unroll
        for (int e = 0; e < 4; ++e) { const u32x2 w = *(const u32x2*)(T.VB + (srow + 4 * g + e) * 1024 + h * 64 + 4 * r); ve[e][0] = (unsigned short)(w.x & 0xffffu); ve[e][1] = (unsigned short)(w.x >> 16); ve[e][2] = (unsigned short)(w.y & 0xffffu); ve[e][3] = (unsigned short)(w.y >> 16); }
        bf16x8 vw[4];
#pragma unroll
        for (int dd = 0; dd < 4; ++dd) { u32x4 w; w.x = (unsigned)ve[0][dd] | ((unsigned)ve[1][dd] << 16); w.y = (unsigned)ve[2][dd] | ((unsigned)ve[3][dd] << 16); w.z = 0u; w.w = 0u; vw[dd] = __builtin_bit_cast(bf16x8, w); }
        tile_tail(s, vw, m, l, o, vt, r, g);
    }
    l += __shfl_xor(l, 16); l += __shfl_xor(l, 32);
    SLAS float* co = (SLAS float*)(lds + L_CO) + (wid * 16 + r) * 64; SLAS float* cm = (SLAS float*)(lds + L_CM); SLAS float* cl = (SLAS float*)(lds + L_CL);
#pragma unroll
    for (int db = 0; db < 4; ++db) *(SLAS f32x4*)(co + 16 * db + 4 * g) = o[db];
    if (g == 0) { cm[wid * 16 + r] = m; cl[wid * 16 + r] = l; }
    __syncthreads();
    { const int q = tid >> 5, d2 = (tid & 31) * 2; float mm = NEG;
#pragma unroll
      for (int w = 0; w < 8; ++w) mm = fmaxf(mm, cm[w * 16 + q]);
      float den = 0.f, n0 = 0.f, n1 = 0.f;
#pragma unroll
      for (int w = 0; w < 8; ++w) { const float f = __builtin_amdgcn_exp2f(cm[w * 16 + q] - mm); den += f * cl[w * 16 + q]; const SLAS float* c = (const SLAS float*)(lds + L_CO) + (w * 16 + q) * 64 + d2; n0 += f * c[0]; n1 += f * c[1]; }
      const float inv = 1.0f / den;
      *(unsigned*)(T.O + (srow + q) * 1024 + h * 64 + d2) = pk(n0 * inv, n1 * inv); }
    __syncthreads();
}
#undef SLAS
}
namespace cg = cooperative_groups;
constexpr int NWAVES = 8;
constexpr int D = 1024, H = 16, FF = 4096, MP = 16384, MS = 512, M = MP + MS, PAST = 2048, DBATCH = 32, DSEQ = 16, LKEYS = PAST + DSEQ;
constexpr float RMS_EPS = 1e-6f, L2E = 1.4426950408889634f, QSCALE = 0.125f * 1.4426950408889634f;
constexpr size_t OUT_Y = 0, OUT_KP = 17301504, OUT_VP = 34078720, OUT_LP = 50855936, OUT_CP = 51118080, OUT_KS = 51122176, OUT_VS = 51646464, OUT_LS = 52170752, OUT_CS = 52178944, OUT_END = 52310016;
static_assert(OUT_KP == (size_t)pg8::OUT_KP && OUT_VP == (size_t)pg8::OUT_VP && OUT_KS == (size_t)pg8::OUT_KS && OUT_VS == (size_t)pg8::OUT_VS, "d_out map");
constexpr size_t MiB = 1u << 20;
constexpr size_t WS_CTL = 0, CTL_ZERO_BYTES = 1 * MiB;
constexpr size_t WS_WIN = 2 * MiB, WS_WOUT = 14 * MiB, WS_WKVQ = 18 * MiB, WS_WQ1 = 24 * MiB, WS_WO = 26 * MiB, WS_WUP = 30 * MiB, WS_WDN = 62 * MiB, WS_WF = 94 * MiB;
constexpr size_t WS_X = 96 * MiB, WS_XB = 162 * MiB, WS_G = 195 * MiB, WS_KB = 228 * MiB, WS_VB = 261 * MiB, WS_QB = 294 * MiB, WS_HB = 327 * MiB, WS_SSQ = 459 * MiB, WS_CLP = 462 * MiB, WS_CLS = 463 * MiB, WS_END = 468 * MiB;
static_assert((size_t)M * D * 4 == 66 * MiB && (size_t)M * FF * 2 == 132 * MiB && (size_t)512 * LKEYS * 4 <= 5 * MiB && (size_t)M * pg8::NSSQ * 4 <= 3 * MiB, "d_ws map");
constexpr int CW_BAR = 4096, CW_KMAX = 2048, CW_ATQ = 2304  ;
constexpr int RING_OFF = 0, RING_BYTES = 131072;
constexpr int ATT_LDS = attn_body::LDS_BYTES;
constexpr int LDSCTL_OFF = (ATT_LDS > RING_BYTES ? ATT_LDS : RING_BYTES), MISC_OFF = LDSCTL_OFF + 320;
constexpr int LDS_BYTES = LDSCTL_OFF + 1024;
static_assert(LDS_BYTES <= 163840 && sattn::L_END <= RING_BYTES, "LDS map");

#define GAS __attribute__((address_space(1)))
#define LAS __attribute__((address_space(3)))
typedef unsigned short bf16;
typedef unsigned v4u __attribute__((ext_vector_type(4)));
typedef unsigned v2u __attribute__((ext_vector_type(2)));
typedef float f32x4 __attribute__((ext_vector_type(4)));
typedef short bf16x8 __attribute__((ext_vector_type(8)));
typedef GAS unsigned gu32;
#define RLX_AGENT __ATOMIC_RELAXED, __HIP_MEMORY_SCOPE_AGENT
#define LDS_WAIT() asm volatile("s_waitcnt lgkmcnt(0)" ::: "memory")
#define VM_WAIT() asm volatile("s_waitcnt vmcnt(0)" ::: "memory")
__device__ __forceinline__ unsigned pk2(float lo, float hi) { return sattn::pk(lo, hi); }
__device__ __forceinline__ float bflo(unsigned w) { return __builtin_bit_cast(float, w << 16); }
__device__ __forceinline__ float bfhi(unsigned w) { return __builtin_bit_cast(float, w & 0xffff0000u); }
#define XB_TMO      128
#define XB_XCNT(j)  (256  + 64 * (j))
#define XB_XSUB(j)  (1280 + 64 * (j))
#define XB_XGEN(j)  (2304 + 64 * (j))
#define XB_TOP      3328
#define XB_TOPGEN   3392
#define XCD_BAR_WORDS 3456
#define XB_SPIN_CAP (1u << 18)

__device__ __forceinline__ unsigned xb_ld(unsigned* p)              { return __hip_atomic_load(p, __ATOMIC_RELAXED, __HIP_MEMORY_SCOPE_AGENT); }
__device__ __forceinline__ unsigned xb_add(unsigned* p, unsigned v) { return __hip_atomic_fetch_add(p, v, __ATOMIC_RELAXED, __HIP_MEMORY_SCOPE_AGENT); }
__device__ __forceinline__ unsigned xb_xcc_id() { return (unsigned)__builtin_amdgcn_s_getreg((3 << 11) | 20) & 0xFu; }
#define XB_SPIN(cond, bar) do { unsigned _sp = 0; while (cond) { __builtin_amdgcn_s_sleep(1); \
    if ((++_sp & 255u) == 0u) { if (xb_ld(&(bar)[XB_TMO])) break; if (_sp > XB_SPIN_CAP) { atomicAdd(&(bar)[XB_TMO], 1u); break; } } } } while (0)

struct XcdBarrier {
    unsigned* bar; unsigned x;
    volatile LAS unsigned* st;
};

__device__ __forceinline__ XcdBarrier xcd_barrier_post(unsigned* bar, volatile LAS unsigned* st) {
    XcdBarrier b; b.bar = bar; b.x = xb_xcc_id(); b.st = st;
    if (threadIdx.x == 0) (void)xb_add(&bar[XB_XCNT(b.x)], 1u);
    return b;
}
__device__ __forceinline__ void xcd_barrier_complete(unsigned* bar, unsigned x, unsigned& nloc, unsigned& nx) {
    const unsigned G = gridDim.x * gridDim.y * gridDim.z;
    unsigned sum, cnt, mine, sp = 0u;
    for (;;) {
        sum = 0u; cnt = 0u; mine = 0u;
#pragma unroll
        for (unsigned j = 0; j < 16; ++j) { const unsigned c = xb_ld(&bar[XB_XCNT(j)]); sum += c; cnt += (c > 0u) ? 1u : 0u; mine = (j == x) ? c : mine; }
        if (sum == G) break;
        __builtin_amdgcn_s_sleep(1);
        if ((++sp & 255u) == 0u) { if (xb_ld(&bar[XB_TMO])) break; if (sp > XB_SPIN_CAP) { atomicAdd(&bar[XB_TMO], 1u); break; } }
    }
    nloc = mine > 0u ? mine : 1u; nx = cnt > 0u ? cnt : 1u;
}

__device__ __forceinline__ void xcd_barrier(const XcdBarrier& b) {
    asm volatile("s_waitcnt vmcnt(0)" ::: "memory");
    __syncthreads();
    if (threadIdx.x == 0) {
        unsigned* bar = b.bar;
        __builtin_amdgcn_s_waitcnt(0);
        unsigned nloc = b.st[0], nx = b.st[1];
        if (nloc == 0u) { xcd_barrier_complete(bar, b.x, nloc, nx); b.st[0] = nloc; b.st[1] = nx; }
        const unsigned old = xb_add(&bar[XB_XSUB(b.x)], 1u);
        const unsigned gen = old / nloc;
        if (old + 1u == (gen + 1u) * nloc) {
            __builtin_amdgcn_fence(__ATOMIC_RELEASE, "agent");
            asm volatile("s_waitcnt vmcnt(0)" ::: "memory");
            const unsigned og = xb_add(&bar[XB_TOP], 1u);
            const unsigned tg = og / nx;
            if (og + 1u == (tg + 1u) * nx) xb_add(&bar[XB_TOPGEN], 1u);
            else XB_SPIN(xb_ld(&bar[XB_TOPGEN]) == tg, bar);
            __builtin_amdgcn_fence(__ATOMIC_ACQUIRE, "agent");
            xb_add(&bar[XB_XGEN(b.x)], 1u);
            asm volatile("s_waitcnt vmcnt(0)" ::: "memory");
        } else {
            XB_SPIN(xb_ld(&bar[XB_XGEN(b.x)]) == gen, bar);
            __builtin_amdgcn_fence(__ATOMIC_ACQUIRE, "agent");
            asm volatile("s_waitcnt vmcnt(0)" ::: "memory");
        }
    }
    __syncthreads();
}
struct Args { const float* in[21]; float* out; unsigned char* ws; };
typedef const __attribute__((address_space(4))) Args* KArgs;
__device__ __forceinline__ KArgs kargs() { KArgs p = (KArgs)__builtin_amdgcn_kernarg_segment_ptr(); asm volatile("" : "+s"(p)); return p; }
struct Frame {
    LAS unsigned char* lds; volatile LAS unsigned* MISC; gu32* ctl;
    int tid, lane, wave, vcu, G;
};
__device__ __forceinline__ float wave_sum(float v) {
#pragma unroll
    for (int o = 1; o < 64; o <<= 1) v += __shfl_xor(v, o);
    return v;
}
constexpr int P0_TILE_FLOATS = 64 * 65;
__device__ __forceinline__ void p0_transpose_item(const float* W, int K, int N, bf16* WT, int row_off, LAS float* scr, int item, int lane, const float* gain, float scale) {
    const int nblk = N / 64, kb = item / nblk, nb = item % nblk, k0 = 64 * kb, n0 = 64 * nb;
    const int c4 = lane & 15, kr = lane >> 4;
    f32x4 v[16];
#pragma unroll
    for (int i = 0; i < 16; ++i) v[i] = *(const GAS f32x4*)(W + (size_t)(k0 + 4 * i + kr) * N + n0 + 4 * c4);
#pragma unroll
    for (int i = 0; i < 16; ++i) { const int kk = 4 * i + kr; const float gsc = gain ? gain[k0 + kk] * scale : scale; LAS float* d = scr + kk * 65 + 4 * c4;
        d[0] = v[i].x * gsc; d[1] = v[i].y * gsc; d[2] = v[i].z * gsc; d[3] = v[i].w * gsc; }
    LDS_WAIT(); asm volatile("" ::: "memory");
    const int c = lane & 7;
#pragma unroll
    for (int j = 0; j < 8; ++j) { const int n = (lane >> 3) + 8 * j; const LAS float* s = scr + (8 * c) * 65 + n;
        v4u o; o.x = pk2(s[0 * 65], s[1 * 65]); o.y = pk2(s[2 * 65], s[3 * 65]); o.z = pk2(s[4 * 65], s[5 * 65]); o.w = pk2(s[6 * 65], s[7 * 65]);
        *(GAS v4u*)(WT + (size_t)(row_off + n0 + n) * K + k0 + 8 * c) = o; }
    LDS_WAIT(); asm volatile("" ::: "memory");
}
enum { I_XP = 0, I_XS, I_CK, I_CV, I_CLF, I_SC, I_NMIX, I_NMLP, I_CIN, I_CW, I_COUT, I_NKV, I_WK, I_WV, I_WF, I_BF, I_WQ, I_WO, I_UP, I_DN, I_NF };

__device__ __forceinline__ void p0_prologue(const Frame& F, KArgs a, unsigned char* ws) {
    const int T_tid = opaque_tid(), T_lane = T_tid & 63, T_wave = __builtin_amdgcn_readfirstlane(T_tid >> 6);
    LAS float* scr = (LAS float*)(F.lds + RING_OFF) + T_wave * P0_TILE_FLOATS;
    const int gw = F.vcu * NWAVES + T_wave, NGW = F.G * NWAVES;
    constexpr int NCHUNK = 46;
    for (int it = gw; it < NCHUNK * 256; it += NGW) {
        int c = it >> 8, base = 0; const float* src = nullptr; const float* gain = nullptr; bf16* dst = nullptr; int roff = 0, K = D, N = D; float sc = 1.f;
        if (c < 6) { const int l = c / 3; src = a->in[I_CIN] + (size_t)l * D * 3 * D; gain = a->in[I_NMIX] + l * D; dst = (bf16*)(ws + WS_WIN) + (size_t)l * 3 * D * D; N = 3 * D; base = l * 3; }
        else if (c < 8) { const int l = c - 6; src = a->in[I_COUT] + (size_t)l * D * D; dst = (bf16*)(ws + WS_WOUT) + (size_t)l * D * D; base = c; }
        else if (c < 9) { src = a->in[I_WK]; gain = a->in[I_NKV]; dst = (bf16*)(ws + WS_WKVQ); base = c; }
        else if (c < 10) { src = a->in[I_WV]; gain = a->in[I_NKV]; dst = (bf16*)(ws + WS_WKVQ); roff = D; base = c; }
        else if (c < 11) { src = a->in[I_WQ]; gain = a->in[I_NMIX] + 2 * D; dst = (bf16*)(ws + WS_WKVQ); roff = 2 * D; sc = QSCALE; base = c; }
        else if (c < 12) { src = a->in[I_WQ] + (size_t)D * D; gain = a->in[I_NMIX] + 3 * D; dst = (bf16*)(ws + WS_WQ1); sc = QSCALE; base = c; }
        else if (c < 14) { const int j = c - 12; src = a->in[I_WO] + (size_t)j * D * D; dst = (bf16*)(ws + WS_WO) + (size_t)j * D * D; base = c; }
        else if (c < 30) { const int l = (c - 14) >> 2; src = a->in[I_UP] + (size_t)l * D * FF; gain = a->in[I_NMLP] + l * D; dst = (bf16*)(ws + WS_WUP) + (size_t)l * D * FF; N = FF; base = 14 + 4 * l; }
        else { const int l = (c - 30) >> 2; src = a->in[I_DN] + (size_t)l * D * FF; dst = (bf16*)(ws + WS_WDN) + (size_t)l * D * FF; K = FF; base = 30 + 4 * l; }
        p0_transpose_item(src, K, N, dst, roff, scr, it - base * 256, T_lane, gain, sc);
    }
    for (int i = (F.vcu * NWAVES + T_wave) * 64 + T_lane; i < D * H; i += NGW * 64) { const int k = i >> 4, h = i & 15; ((bf16*)(ws + WS_WF))[h * D + k] = (bf16)(pk2(a->in[I_NKV][k] * a->in[I_WF][i], 0.f) & 0xffffu); }
    bf16* XB = (bf16*)(ws + WS_XB); float* SSQ = (float*)(ws + WS_SSQ);
    for (int m = gw; m < M; m += NGW) {
        const float* xr = (m < MP) ? a->in[I_XP] + (size_t)m * D : a->in[I_XS] + (size_t)(m - MP) * D;
        const GAS f32x4* xp = (const GAS f32x4*)xr + T_lane; f32x4 v[4]; float s = 0.f;
#pragma unroll
        for (int j = 0; j < 4; ++j) { v[j] = xp[64 * j]; s += (v[j].x * v[j].x + v[j].y * v[j].y) + (v[j].z * v[j].z + v[j].w * v[j].w); }
        s = wave_sum(s);
        GAS v2u* bo = (GAS v2u*)(XB + (size_t)m * D) + T_lane;
#pragma unroll
        for (int j = 0; j < 4; ++j) { v2u w; w.x = pk2(v[j].x, v[j].y); w.y = pk2(v[j].z, v[j].w); bo[64 * j] = w; }
        if (T_lane < pg8::NSSQ) SSQ[(size_t)m * pg8::NSSQ + T_lane] = (T_lane == 0) ? s : 0.f;
    }
}
__device__ __forceinline__ void conv_gate_phase(const Frame& F, KArgs a, unsigned char* ws, int l) {
    const int T_tid = opaque_tid(), T_lane = T_tid & 63, T_wave = __builtin_amdgcn_readfirstlane(T_tid >> 6);
    const int gw = F.vcu * NWAVES + T_wave, NGW = F.G * NWAVES;
    const bf16* BCX = (const bf16*)(ws + WS_HB); bf16* Gm = (bf16*)(ws + WS_G);
    const float* cw = a->in[I_CW] + (size_t)l * 3 * D;
    for (int it = gw; it < (M / 4) * 2; it += NGW) {
        const int half = it & 1, row0 = (it >> 1) * 4, c0 = half * 512 + T_lane * 8;
        float w0[8], w1[8], w2[8], um2[8], um1[8];
        { const f32x4 a0 = *(const f32x4*)(cw + c0), a1 = *(const f32x4*)(cw + c0 + 4), b0 = *(const f32x4*)(cw + D + c0), b1 = *(const f32x4*)(cw + D + c0 + 4), d0 = *(const f32x4*)(cw + 2 * D + c0), d1 = *(const f32x4*)(cw + 2 * D + c0 + 4);
#pragma unroll
          for (int e = 0; e < 4; ++e) { w0[e] = a0[e]; w0[4 + e] = a1[e]; w1[e] = b0[e]; w1[4 + e] = b1[e]; w2[e] = d0[e]; w2[4 + e] = d1[e]; } }
        const bool sample = row0 >= MP; const int sb = sample ? (row0 - MP) >> 4 : 0; const int t0 = sample ? (row0 - MP) & 15 : row0;
        if (t0 == 0) {
            if (sample) { const float* st = a->in[I_SC] + ((size_t)(l * DBATCH + sb) * 2) * D + c0;
                const f32x4 p0 = *(const f32x4*)st, p1 = *(const f32x4*)(st + 4), q0 = *(const f32x4*)(st + D), q1 = *(const f32x4*)(st + D + 4);
#pragma unroll
                for (int e = 0; e < 4; ++e) { um2[e] = p0[e]; um2[4 + e] = p1[e]; um1[e] = q0[e]; um1[4 + e] = q1[e]; } }
            else {
#pragma unroll
                for (int e = 0; e < 8; ++e) { um2[e] = 0.f; um1[e] = 0.f; } }
        } else {
#pragma unroll
            for (int k = 0; k < 2; ++k) { const bf16* rp = BCX + (size_t)(row0 - 2 + k) * 3072 + c0; const v4u gc = *(const v4u*)(rp + D), xv = *(const v4u*)(rp + 2 * D);
#pragma unroll
                for (int e = 0; e < 4; ++e) { const float u0 = bflo(gc[e]) * bflo(xv[e]), u1 = bfhi(gc[e]) * bfhi(xv[e]); if (k == 0) { um2[2 * e] = u0; um2[2 * e + 1] = u1; } else { um1[2 * e] = u0; um1[2 * e + 1] = u1; } } }
        }
#pragma unroll
        for (int i = 0; i < 4; ++i) { const bf16* rp = BCX + (size_t)(row0 + i) * 3072 + c0; const v4u gb = *(const v4u*)rp, gc = *(const v4u*)(rp + D), xv = *(const v4u*)(rp + 2 * D);
            float u[8], o[8];
#pragma unroll
            for (int e = 0; e < 4; ++e) { u[2 * e] = bflo(gc[e]) * bflo(xv[e]); u[2 * e + 1] = bfhi(gc[e]) * bfhi(xv[e]); }
#pragma unroll
            for (int e = 0; e < 8; ++e) o[e] = w0[e] * um2[e] + w1[e] * um1[e] + w2[e] * u[e];
            v4u w;
#pragma unroll
            for (int e = 0; e < 4; ++e) w[e] = pk2(bflo(gb[e]) * o[2 * e], bfhi(gb[e]) * o[2 * e + 1]);
            *(v4u*)(Gm + (size_t)(row0 + i) * D + c0) = w;
#pragma unroll
            for (int e = 0; e < 8; ++e) { um2[e] = um1[e]; um1[e] = u[e]; } }
        const bool last = sample ? (t0 == 12) : (row0 + 4 == MP);
        if (last) { float* o = a->out + (sample ? OUT_CS + ((size_t)(l * DBATCH + sb) * 2) * D : OUT_CP + (size_t)l * 2 * D) + c0;
            *(f32x4*)o = (f32x4){um2[0], um2[1], um2[2], um2[3]}; *(f32x4*)(o + 4) = (f32x4){um2[4], um2[5], um2[6], um2[7]};
            *(f32x4*)(o + D) = (f32x4){um1[0], um1[1], um1[2], um1[3]}; *(f32x4*)(o + D + 4) = (f32x4){um1[4], um1[5], um1[6], um1[7]}; }
    }
}
__device__ __forceinline__ void logf_phase(const Frame& F, KArgs a, unsigned char* ws) {
    const int T_tid = opaque_tid(), T_lane = T_tid & 63, T_wave = __builtin_amdgcn_readfirstlane(T_tid >> 6);
    const int gw = F.vcu * NWAVES + T_wave, NGW = F.G * NWAVES; const int r = T_lane & 15, g = T_lane >> 4;
    const bf16* WF = (const bf16*)(ws + WS_WF); const bf16* XB = (const bf16*)(ws + WS_XB); const float* SSQ = (const float*)(ws + WS_SSQ);
    for (int blk = gw; blk < M / 16; blk += NGW) {
        const int row = blk * 16 + r; f32x4 acc = (f32x4){0.f, 0.f, 0.f, 0.f};
        const bf16* ap = WF + (size_t)r * D + 8 * g; const bf16* bp = XB + (size_t)row * D + 8 * g;
#pragma unroll 8
        for (int s = 0; s < 32; ++s) acc = __builtin_amdgcn_mfma_f32_16x16x32_bf16(*(const bf16x8*)(ap + 32 * s), *(const bf16x8*)(bp + 32 * s), acc, 0, 0, 0);
        const float rs = pg8::row_rstd(SSQ, row); const f32x4 bfv = *(const f32x4*)(a->in[I_BF] + 4 * g); f32x4 o;
#pragma unroll
        for (int e = 0; e < 4; ++e) { const float z = acc[e] * rs + bfv[e]; o[e] = fminf(z, 0.f) - log1pf(expf(-fabsf(z))); }
        float* op = a->out + ((row < MP) ? OUT_LP + (size_t)row * 16 : OUT_LS + (size_t)(row - MP) * 16) + 4 * g;
        *(f32x4*)op = o;
    }
}
__device__ __forceinline__ double wave_scan_incl(double v, int lane) {
#pragma unroll
    for (int o = 1; o < 64; o <<= 1) { const double t = __shfl_up(v, o); if (lane >= o) v += t; }
    return v;
}
__device__ __forceinline__ void scan_phase(const Frame& F, KArgs a, unsigned char* ws) {
    const int T_tid = opaque_tid(), T_lane = T_tid & 63, T_wave = __builtin_amdgcn_readfirstlane(T_tid >> 6);
    float* CLP = (float*)(ws + WS_CLP); float* CLS = (float*)(ws + WS_CLS);
    const int blk = blockIdx.x;
    if (blk < 16) {
        const int h = blk; const float* lf = a->out + OUT_LP; const int t0 = T_tid * 32; double s = 0.0; float lv[32];
#pragma unroll
        for (int i = 0; i < 32; ++i) lv[i] = lf[(size_t)(t0 + i) * 16 + h];
#pragma unroll
        for (int i = 0; i < 32; ++i) s += (double)lv[i];
        const double inc = wave_scan_incl(s, T_lane);
        LAS double* wt = (LAS double*)(F.lds + RING_OFF);
        if (T_lane == 63) wt[T_wave] = inc;
        __syncthreads();
        double run = inc - s;
        for (int w = 0; w < T_wave; ++w) run += wt[w];
#pragma unroll
        for (int i = 0; i < 32; ++i) { run += (double)lv[i]; lv[i] = (float)(run * (double)L2E); }
#pragma unroll
        for (int i = 0; i < 8; ++i) *(f32x4*)(CLP + (size_t)h * MP + t0 + 4 * i) = (f32x4){lv[4 * i], lv[4 * i + 1], lv[4 * i + 2], lv[4 * i + 3]};
        __syncthreads();
    } else {
        const int nws = (F.G - 16) * NWAVES;
        for (int seq = (blk - 16) * NWAVES + T_wave; seq < DBATCH * H; seq += nws) {
            const int b = seq >> 4, h = seq & 15; const float* clf = a->in[I_CLF] + (size_t)b * PAST * 16 + h; const float* nlf = a->out + OUT_LS + (size_t)b * DSEQ * 16 + h;
            const int s0 = T_lane * 33; double s = 0.0; float lv[33];
#pragma unroll
            for (int i = 0; i < 33; ++i) { const int k = s0 + i; const int kc = k < LKEYS ? k : LKEYS - 1; const float* p = kc < PAST ? clf + (size_t)kc * 16 : nlf + (size_t)(kc - PAST) * 16; const float v = *p; lv[i] = (k < LKEYS) ? v : 0.f; }
#pragma unroll
            for (int i = 0; i < 33; ++i) s += (double)lv[i];
            double run = wave_scan_incl(s, T_lane) - s;
#pragma unroll
            for (int i = 0; i < 33; ++i) { const int k = s0 + i; run += (double)lv[i]; if (k < LKEYS) CLS[(size_t)seq * LKEYS + k] = (float)(run * (double)L2E); }
        }
    }
    { const int gw = F.vcu * NWAVES + T_wave, NGW = F.G * NWAVES; const bf16* KB = (const bf16*)(ws + WS_KB); float mx = 0.f;
      for (int row = gw; row < MP; row += NGW) { const v4u p = *(const v4u*)(KB + (size_t)row * D + T_lane * 16), q = *(const v4u*)(KB + (size_t)row * D + T_lane * 16 + 8); float sq = 0.f;
#pragma unroll
          for (int e = 0; e < 4; ++e) { const float a0 = bflo(p[e]), a1 = bfhi(p[e]), b0 = bflo(q[e]), b1 = bfhi(q[e]); sq += (a0 * a0 + a1 * a1) + (b0 * b0 + b1 * b1); }
          sq += __shfl_xor(sq, 1); sq += __shfl_xor(sq, 2); mx = fmaxf(mx, sq); }
      __syncthreads();
      LAS float* km = (LAS float*)(F.lds + RING_OFF) + 64;
      if ((T_lane & 3) == 0) km[T_wave * 16 + (T_lane >> 2)] = mx;
      __syncthreads();
      if (T_tid < 16) { float m = km[T_tid];
#pragma unroll
          for (int w = 1; w < NWAVES; ++w) m = fmaxf(m, km[w * 16 + T_tid]);
          atomicMax((unsigned*)(ws + WS_CTL) + CW_KMAX + T_tid, __builtin_bit_cast(unsigned, m)); }
      __syncthreads(); }
}
__device__ __forceinline__ void final_norm_phase(const Frame& F, KArgs a, unsigned char* ws) {
    const int T_tid = opaque_tid(), T_lane = T_tid & 63, T_wave = __builtin_amdgcn_readfirstlane(T_tid >> 6);
    const int gw = F.vcu * NWAVES + T_wave, NGW = F.G * NWAVES; const float* X = (const float*)(ws + WS_X);
    const GAS f32x4* gp = (const GAS f32x4*)a->in[I_NF] + T_lane; f32x4 gn[4];
#pragma unroll
    for (int j = 0; j < 4; ++j) gn[j] = gp[64 * j];
    for (int m = gw; m < M; m += NGW) {
        const GAS f32x4* xp = (const GAS f32x4*)(X + (size_t)m * D) + T_lane; f32x4 v[4]; float s = 0.f;
#pragma unroll
        for (int j = 0; j < 4; ++j) { v[j] = xp[64 * j]; s += (v[j].x * v[j].x + v[j].y * v[j].y) + (v[j].z * v[j].z + v[j].w * v[j].w); }
        const float rs = 1.0f / sqrtf(wave_sum(s) * (1.0f / D) + RMS_EPS);
        GAS f32x4* op = (GAS f32x4*)(a->out + OUT_Y + (size_t)m * D) + T_lane;
#pragma unroll
        for (int j = 0; j < 4; ++j) op[64 * j] = v[j] * rs * gn[j];
    }
}

__device__ __forceinline__ void attention_phase(char* lds, const attn_body::AttnTensors& T, const sattn::Tensors& ST, unsigned* qctr, int block) {
    volatile LAS int* tk = (volatile LAS int*)((LAS char*)lds + attn_body::LDS_WS);
    for (;;) {
        if (threadIdx.x == 0) { int v = -1, q = block & 7; for (int tried = 0; tried < 8; ++tried) { const unsigned i_ = __hip_atomic_fetch_add(qctr + 64 * q, 1u, __ATOMIC_RELAXED, __HIP_MEMORY_SCOPE_AGENT); if (i_ < 192u) { v = (int)(q * 192u + i_); break; } q = (q + 1) & 7; } tk[0] = v; }
        __syncthreads();
        const int u = __builtin_amdgcn_readfirstlane(tk[0]);
        __syncthreads();
        if (u < 0) break;
        const int qq = u / 192, i_ = u - qq * 192, grp = i_ / 3, rem = i_ - grp * 3;
        if (rem == 2) { const int su = qq * 64 + grp; sattn::unit(su >> 4, su & 15, ST, (LAS char*)lds); }
        else { const int pi = grp * 2 + rem, h = 2 * qq + (pi & 1), qb = 63 - (pi >> 1);
            attn_body::attn_unit<24>(0, h, qb, T.Q, T.K, T.V, T.O, lds, T.CL + (size_t)h * attn_body::SEQ, __builtin_bit_cast(float, T.KMAX[h])); }
    }
}

__global__ void __launch_bounds__(NWAVES * 64, 2) yoco_fwd(Args args) {
    extern __shared__ __attribute__((aligned(16))) unsigned char lds[];
    Frame F;
    F.lds = (LAS unsigned char*)lds;
    F.MISC = (volatile LAS unsigned*)(F.lds + MISC_OFF);
    F.tid = threadIdx.x; F.lane = F.tid & 63; F.wave = __builtin_amdgcn_readfirstlane(F.tid >> 6);
    F.G = gridDim.x; { const int bx = blockIdx.x; F.vcu = (F.G % 8 == 0) ? (bx % 8) * (F.G / 8) + bx / 8 : bx; }
    F.ctl = (gu32*)(kargs()->ws + WS_CTL);
    for (int u = F.tid; u < (LDS_BYTES - LDSCTL_OFF) / 4; u += NWAVES * 64) ((LAS unsigned*)(F.lds + LDSCTL_OFF))[u] = 0u;
    __syncthreads();
    XcdBarrier bar = xcd_barrier_post((unsigned*)(F.ctl + CW_BAR), F.MISC + 8);
#define GRID_BAR() xcd_barrier(bar)
#define WSP(T, off) ((T*)(kargs()->ws + (off)))

    p0_prologue(F, kargs(), kargs()->ws);
    if (kargs()->ws == nullptr) cg::this_grid().sync();
    GRID_BAR();

#define SAMPLE_TILES(g, E) do { const int id_ = opaque_bid(); if (id_ < 4 * ((g).N / 128)) { const int mi_ = id_ & 3, ni_ = id_ >> 2; \
        pg8::gemm128_tile(F.lds + RING_OFF, (g).A + (size_t)(MP + 128 * mi_) * (g).K, (g).Bt + (size_t)(128 * ni_) * (g).K, (g).K, E, MP + 128 * mi_, 128 * ni_); } } while (0)
#define SAMPLE_TILES64(g, E) do { const int id_ = opaque_bid(); if (id_ < 8 * ((g).N / 64)) { const int mi_ = id_ & 7, ni_ = id_ >> 3; \
        pg8::gemm64_resid_tile(F.lds + RING_OFF, (g).A + (size_t)(MP + 64 * mi_) * (g).K, (g).Bt + (size_t)(64 * ni_) * (g).K, (g).K, E, MP + 64 * mi_, 64 * ni_); } } while (0)
#define LAYER(l) do { \
        if ((l) != 2) { \
            constexpr bool cv = (l) < 2; unsigned char* ws = kargs()->ws; \
            pg8::Gemm g{(const bf16*)(ws + WS_XB), cv ? (const bf16*)(ws + WS_WIN) + (size_t)(l) * 3 * D * D : (const bf16*)(ws + WS_WQ1), M, cv ? 3 * D : D, D}; \
            pg8::StaticOrder S; S.init(MP, cv ? 3 * D : D, F.G, opaque_bid()); \
            pg8::EpiAct<0, false> E{cv ? (bf16*)(ws + WS_HB) : (bf16*)(ws + WS_QB), cv ? 3 * D : D, (const float*)(ws + WS_SSQ), 0, 0, nullptr}; \
            pg8::gemm_phase<pg8::EpiAct<0, false>, pg8::StaticOrder, PG8_ALIGN, PG8_SP2>(F.lds + RING_OFF, g, S, E); \
            SAMPLE_TILES(g, E); \
            GRID_BAR(); \
        } \
        if ((l) < 2) { conv_gate_phase(F, kargs(), kargs()->ws, (l)); } \
        else { \
            { KArgs ka = kargs(); unsigned char* ws = ka->ws; \
            const attn_body::AttnTensors AT{(const attn_body::bf16*)(ws + WS_QB), (const attn_body::bf16*)(ws + WS_KB), (const attn_body::bf16*)(ws + WS_VB), (attn_body::bf16*)(ws + WS_G), (const float*)(ws + WS_CLP), (const unsigned*)(ws + WS_CTL) + CW_KMAX}; \
            const sattn::Tensors ST{ka->in[I_CK], ka->in[I_CV], (const bf16*)(ws + WS_QB), (const bf16*)(ws + WS_KB), (const bf16*)(ws + WS_VB), (bf16*)(ws + WS_G), (const float*)(ws + WS_CLS)}; \
            attention_phase((char*)lds + RING_OFF, AT, ST, (unsigned*)(ws + WS_CTL) + CW_ATQ + ((l) - 2) * 512, opaque_bid()); } \
        } \
        GRID_BAR(); \
        { unsigned char* ws = kargs()->ws; \
            pg8::Gemm g{(const bf16*)(ws + WS_G), ((l) < 2) ? (const bf16*)(ws + WS_WOUT) + (size_t)(l) * D * D : (const bf16*)(ws + WS_WO) + (size_t)((l) - 2) * D * D, M, D, D}; \
            pg8::StaticOrder S; S.init(MP, D, F.G, opaque_bid()); \
            pg8::EpiResid E{(float*)(ws + WS_X), (bf16*)(ws + WS_XB), (float*)(ws + WS_SSQ), ((l) == 0) ? kargs()->in[I_XP] : nullptr, ((l) == 0) ? kargs()->in[I_XS] : nullptr}; \
            pg8::gemm_phase<pg8::EpiResid, pg8::StaticOrder, PG8_ALIGN, PG8_SP2>(F.lds + RING_OFF, g, S, E); \
            SAMPLE_TILES64(g, E); \
            GRID_BAR(); } \
        { unsigned char* ws = kargs()->ws; \
            pg8::Gemm g{(const bf16*)(ws + WS_XB), (const bf16*)(ws + WS_WUP) + (size_t)(l) * D * FF, M, FF, D}; \
            pg8::StaticOrder S; S.init(MP, FF, F.G, opaque_bid()); \
            pg8::EpiAct<1, false> E{(bf16*)(ws + WS_HB), FF, (const float*)(ws + WS_SSQ), 0, 0, nullptr}; \
            pg8::gemm_phase<pg8::EpiAct<1, false>, pg8::StaticOrder, PG8_ALIGN, PG8_SP2>(F.lds + RING_OFF, g, S, E); \
            SAMPLE_TILES(g, E); \
            GRID_BAR(); } \
        { unsigned char* ws = kargs()->ws; \
            pg8::Gemm g{(const bf16*)(ws + WS_HB), (const bf16*)(ws + WS_WDN) + (size_t)(l) * D * FF, M, D, FF}; \
            pg8::StaticOrder S; S.init(MP, D, F.G, opaque_bid()); \
            pg8::EpiResid E{(float*)(ws + WS_X), (bf16*)(ws + WS_XB), (float*)(ws + WS_SSQ), nullptr, nullptr}; \
            pg8::gemm_phase<pg8::EpiResid, pg8::StaticOrder, PG8_ALIGN, PG8_SP2>(F.lds + RING_OFF, g, S, E); \
            SAMPLE_TILES64(g, E); \
            GRID_BAR(); } \
        if ((l) == 1) { \
            KArgs ka = kargs(); unsigned char* ws = ka->ws; \
            pg8::Gemm g{(const bf16*)(ws + WS_XB), (const bf16*)(ws + WS_WKVQ), M, 3 * D, D}; \
            pg8::StaticOrder S; S.init(MP, 3 * D, F.G, opaque_bid()); \
            pg8::EpiAct<0, true> E{(bf16*)(ws + WS_KB), D, (const float*)(ws + WS_SSQ), D, (size_t)(WS_VB - WS_KB) / 2, ka->out}; \
            pg8::gemm_phase<pg8::EpiAct<0, true>, pg8::StaticOrder, PG8_ALIGN, PG8_SP2>(F.lds + RING_OFF, g, S, E); \
            SAMPLE_TILES(g, E); \
            logf_phase(F, kargs(), kargs()->ws); \
            GRID_BAR(); \
            scan_phase(F, kargs(), kargs()->ws); \
            GRID_BAR(); \
        } } while (0)
    LAYER(0); LAYER(1); LAYER(2); LAYER(3);
    final_norm_phase(F, kargs(), kargs()->ws);
}

extern "C" void kernel_launch(void* const* d_in, const int* in_sizes, int n_in, void* d_out, int out_size, void* d_ws, size_t ws_size, hipStream_t stream) {
    static int grid = 0;
    if (grid == 0) {
        if (n_in != 21 || out_size != (int)OUT_END || ws_size < WS_END) { fprintf(stderr, "kernel_launch: unexpected sizes (n_in %d, out %d, ws %zu); nothing launched\n", n_in, out_size, ws_size); grid = -1; return; }
        int dev = 0, cus = 0, per_cu = 0;
        if (hipGetDevice(&dev) != hipSuccess || hipDeviceGetAttribute(&cus, hipDeviceAttributeMultiprocessorCount, dev) != hipSuccess) { grid = -1; return; }
        if (hipFuncSetAttribute((const void*)yoco_fwd, hipFuncAttributeMaxDynamicSharedMemorySize, LDS_BYTES) != hipSuccess) { fprintf(stderr, "kernel_launch: hipFuncSetAttribute failed\n"); grid = -1; return; }
        if (hipOccupancyMaxActiveBlocksPerMultiprocessor(&per_cu, (const void*)yoco_fwd, NWAVES * 64, LDS_BYTES) != hipSuccess || per_cu < 1) { fprintf(stderr, "kernel_launch: occupancy query says %d\n", per_cu); per_cu = 1; }
        (void)hipGetLastError();
        grid = cus;
    }
    if (grid < 0) return;
    if (hipMemsetAsync((char*)d_ws + WS_CTL, 0, CTL_ZERO_BYTES, stream) != hipSuccess) { fprintf(stderr, "kernel_launch: memset failed\n"); return; }
    Args a{};
    for (int i = 0; i < 21; ++i) a.in[i] = (const float*)d_in[i];
    a.out = (float*)d_out; a.ws = (unsigned char*)d_ws;
    void* kargv[] = {&a};
    const hipError_t e = hipLaunchCooperativeKernel((const void*)yoco_fwd, dim3(grid), dim3(NWAVES * 64), kargv, LDS_BYTES, stream);
    if (e != hipSuccess) fprintf(stderr, "kernel_launch: cooperative launch failed: %s (grid %d)\n", hipGetErrorString(e), grid);
}
```

```cpp
#include <hip/hip_runtime.h>
#include <hip/hip_cooperative_groups.h>
#include <cstdio>
#include <cstdint>
__device__ __forceinline__ int opaque_bid() { int b = (int)blockIdx.x; asm volatile("" : "+s"(b)); return b; }
__device__ __forceinline__ int opaque_tid() { int t = (int)threadIdx.x; asm volatile("" : "+v"(t)); return t; }
namespace pg8 {
#define PG8_LAS __attribute__((address_space(3)))
typedef unsigned short bf16_t;
typedef short bf16x8 __attribute__((ext_vector_type(8)));
typedef float f32x4 __attribute__((ext_vector_type(4)));
typedef unsigned u32x4 __attribute__((ext_vector_type(4)));
constexpr int BM = 256, BK = 64, HALF = 128, HTB = HALF * BK * 2  , STAGE_BYTES = 8 * HTB, NXCD = 8, WGM = 8;

__host__ __device__ __forceinline__ int lds_byte(int r, int c) { const int st = (r >> 4) * 2 + (c >> 5), rr = r & 15, cc = c & 31, ob = rr * 64 + cc * 2; return st * 1024 + (ob ^ (((ob >> 9) & 1) << 5)); }
__host__ __device__ __forceinline__ void stage_rc(int b, int& R, int& C) { const int st = b / 1024, sb = b % 1024, swz = sb ^ (((sb >> 9) & 1) << 5); R = (st >> 1) * 16 + swz / 64; C = (st & 1) * 32 + (swz % 64) / 2; }
__host__ __device__ __forceinline__ int perm32(int rho) { const int n = rho >> 4, i = rho & 15; return 8 * (i >> 2) + 4 * n + (i & 3); }

struct Unit { int pm, pn; };
struct Gemm { const bf16_t* A; const bf16_t* Bt; int M, N, K; };

struct StaticOrder {
    int nM, nN, nwg, G, c;
    __host__ __device__ void init(int M, int N, int G_, int c_) { nM = M / BM; nN = N / BM; nwg = nM * nN; G = G_; c = c_; }
    __host__ __device__ bool next(int i, Unit& u) const {
        const long L = (long)i * G + c; if (L >= nwg) return false;
        int wgid = (int)L; { const int q = nwg / NXCD, r = nwg % NXCD, xcd = wgid % NXCD, off = wgid / NXCD; wgid = (xcd < r ? xcd * (q + 1) : r * (q + 1) + (xcd - r) * q) + off; }
        const int nig = WGM * nN, gid = wgid / nig, fm = gid * WGM, gsz = (nM - fm) < WGM ? (nM - fm) : WGM;
        u.pm = fm + ((wgid % nig) % gsz); u.pn = (wgid % nig) / gsz; return true;
    }
    __device__ __forceinline__ void a_ready(const Unit&) const {}
    __device__ __forceinline__ void done(const Unit&) const {}
};

__device__ __forceinline__ unsigned cvt_pk_bf16(float lo, float hi) { unsigned r; asm volatile("v_cvt_pk_bf16_f32 %0, %1, %2" : "=v"(r) : "v"(lo), "v"(hi)); return r; }
typedef float f32x2 __attribute__((ext_vector_type(2)));
__device__ __forceinline__ f32x2 gelu_pk(f32x2 v) {
    const f32x2 av = __builtin_elementwise_abs(v), d = av * 0.2316418882f + 1.0f;
    f32x2 t; t.x = __builtin_amdgcn_rcpf(d.x); t.y = __builtin_amdgcn_rcpf(d.y);
    f32x2 q = t * 0.5307027145f + (-0.7265760135f); q = q * t + 0.7107068705f; q = q * t + (-0.142248368f); q = q * t + 0.127414796f; q = q * t;
    const f32x2 s = (v * v) * (-0.72134752044f);
    f32x2 e; e.x = __builtin_amdgcn_exp2f(s.x); e.y = __builtin_amdgcn_exp2f(s.y);
    const f32x2 m = v * (q * e), r = v - m;
    f32x2 o; o.x = v.x < 0.f ? m.x : r.x; o.y = v.y < 0.f ? m.y : r.y; return o;
}

template <int ACT  > struct EpiBf16 {
    static constexpr bool PERM = true, AFTER_DRAIN = false; static_assert(ACT == 0 || ACT == 1, "EpiBf16: ACT is 0 (none) or 1 (gelu_pk)");
    bf16_t* O; int ldc; const float* bias; int split_cols; size_t split_stride; float scale0;
    __device__ __forceinline__ void operator()(const f32x4 (&acc)[2][2][4][2], const Unit& u, int wr, int wc, int fr, int fq) const {
        const int row0 = u.pm * BM + wr * 64 + fr; int colt = u.pn * BM; bf16_t* base = O;
        float sc = 1.f; if (split_cols) { const int t = colt / split_cols; base += (size_t)t * split_stride; colt -= t * split_cols; if (t == 0) sc = scale0; }
        const int col0 = colt + wc * 32 + 8 * fq, bcol0 = u.pn * BM + wc * 32 + 8 * fq;
        f32x4 bv[2][2];
#pragma unroll
        for (int bj = 0; bj < 2; ++bj)
#pragma unroll
            for (int n = 0; n < 2; ++n) bv[bj][n] = bias ? *(const f32x4*)(bias + bcol0 + bj * HALF + 4 * n) : (f32x4){0.f, 0.f, 0.f, 0.f};
#pragma unroll
        for (int ai = 0; ai < 2; ++ai)
#pragma unroll
            for (int m = 0; m < 4; ++m) { bf16_t* rowp = base + (size_t)(row0 + ai * HALF + m * 16) * ldc + col0;
#pragma unroll
                for (int bj = 0; bj < 2; ++bj) { f32x4 v0 = acc[ai][bj][m][0] + bv[bj][0], v1 = acc[ai][bj][m][1] + bv[bj][1];
                    if (ACT == 1) { f32x2 a = gelu_pk((f32x2){v0[0], v0[1]}), b = gelu_pk((f32x2){v0[2], v0[3]}), c = gelu_pk((f32x2){v1[0], v1[1]}), d = gelu_pk((f32x2){v1[2], v1[3]});
                        v0 = (f32x4){a.x, a.y, b.x, b.y}; v1 = (f32x4){c.x, c.y, d.x, d.y}; }
                    v0 = v0 * sc; v1 = v1 * sc; u32x4 w; w.x = cvt_pk_bf16(v0[0], v0[1]); w.y = cvt_pk_bf16(v0[2], v0[3]); w.z = cvt_pk_bf16(v1[0], v1[1]); w.w = cvt_pk_bf16(v1[2], v1[3]);
                    *(u32x4*)(rowp + bj * HALF) = w; } }
    }
};

struct PanelStats {
    unsigned* xbuf;
    unsigned* cnt;
    unsigned* tmo;
    int ntn; float eps;
    unsigned code;
    __device__ __forceinline__ bool run(const f32x4 (&v)[2][2][4][2], const Unit& u, int wr, int wc, int fr, int fq, PG8_LAS unsigned char* lds, int wid, int lane) const {
        typedef float f32x2v __attribute__((ext_vector_type(2)));
        PG8_LAS f32x2v* P = (PG8_LAS f32x2v*)lds;
        PG8_LAS f32x2v* S = (PG8_LAS f32x2v*)(lds + 8192);
        PG8_LAS unsigned* flag = (PG8_LAS unsigned*)(lds + 8192 + 2048);
#pragma unroll
        for (int ai = 0; ai < 2; ++ai)
#pragma unroll
            for (int m = 0; m < 4; ++m) {
                float s = 0.f;
#pragma unroll
                for (int bj = 0; bj < 2; ++bj)
#pragma unroll
                    for (int n = 0; n < 2; ++n) { const f32x4 x = v[ai][bj][m][n]; s += (x[0] + x[1]) + (x[2] + x[3]); }
                s += __shfl_xor(s, 16); s += __shfl_xor(s, 32);
                const float mw = s * (1.0f / 64.0f); float q = 0.f;
#pragma unroll
                for (int bj = 0; bj < 2; ++bj)
#pragma unroll
                    for (int n = 0; n < 2; ++n) { const f32x4 d = v[ai][bj][m][n] - mw; q += (d[0] * d[0] + d[1] * d[1]) + (d[2] * d[2] + d[3] * d[3]); }
                q += __shfl_xor(q, 16); q += __shfl_xor(q, 32);
                if (fq == 0) P[(ai * HALF + wr * 64 + m * 16 + fr) * 4 + wc] = (f32x2v){mw, q};
            }
        asm volatile("s_waitcnt lgkmcnt(0)" ::: "memory"); __builtin_amdgcn_s_barrier(); asm volatile("" ::: "memory");
#if defined(BROKEN_EXCHANGE_NO_WAIT)
#warning BROKEN CONTROL BUILD: the row-statistics exchange does not wait; results are wrong by design
        if (blockIdx.x >= 64) { const long long t0_ = clock64(); while (clock64() - t0_ < 60000) __builtin_amdgcn_s_sleep(8); }
#endif
        const int row = wid * 32 + (lane & 31);
        if (lane < 32) {
            const f32x2v a = P[row * 4 + 0], b = P[row * 4 + 1], c = P[row * 4 + 2], d = P[row * 4 + 3];
            const float mt = (a.x + b.x + c.x + d.x) * 0.25f;
            const float da = a.x - mt, db = b.x - mt, dc = c.x - mt, dd = d.x - mt;
            const float m2 = (a.y + b.y) + (c.y + d.y) + 64.0f * ((da * da + db * db) + (dc * dc + dd * dd));
            unsigned long long* slot = (unsigned long long*)xbuf + ((size_t)(u.pm * BM + row) * 4 + u.pn);
            __hip_atomic_store(slot, ((unsigned long long)__float_as_uint(m2) << 32) | __float_as_uint(mt), __ATOMIC_RELAXED, __HIP_MEMORY_SCOPE_AGENT);
        }
        asm volatile("s_waitcnt vmcnt(0)" ::: "memory");
        if (lane == 0) __hip_atomic_fetch_add(cnt + 64 * u.pm, 1u, __ATOMIC_RELAXED, __HIP_MEMORY_SCOPE_AGENT);
        if (wid == 0) {
            bool dead = false; const unsigned long long t0 = __builtin_amdgcn_s_memrealtime(); const unsigned want = 8u * (unsigned)ntn;
            for (;;) {
#if defined(BROKEN_EXCHANGE_NO_WAIT)
                break;
#endif
                if ((unsigned)__builtin_amdgcn_readfirstlane(__hip_atomic_load(cnt + 64 * u.pm, __ATOMIC_RELAXED, __HIP_MEMORY_SCOPE_AGENT)) >= want) break;
                if (__builtin_amdgcn_s_memrealtime() - t0 > 2000000ull) {
                    if (lane == 0) { unsigned expect = 0u; __hip_atomic_compare_exchange_strong(tmo + 1, &expect, code | (unsigned)(u.pm & 0xff), __ATOMIC_RELAXED, __ATOMIC_RELAXED, __HIP_MEMORY_SCOPE_AGENT);
                                     __hip_atomic_store(tmo, 1u, __ATOMIC_RELAXED, __HIP_MEMORY_SCOPE_AGENT); }
                    dead = true; break; }
                __builtin_amdgcn_s_sleep(2);
            }
            __builtin_amdgcn_fence(__ATOMIC_ACQUIRE, "agent");
            if (lane == 0) flag[0] = dead ? 1u : 0u;
        }
        asm volatile("s_waitcnt vmcnt(0) lgkmcnt(0)" ::: "memory"); __builtin_amdgcn_s_barrier(); asm volatile("" ::: "memory");
        const bool bad = flag[0] != 0u;
        if (lane < 32) {
            const unsigned long long* slot = (const unsigned long long*)xbuf + (size_t)(u.pm * BM + row) * 4; float mt[4], m2[4]; float ms = 0.f;
#pragma unroll
            for (int t = 0; t < 4; ++t) { if (t < ntn) { const unsigned long long w = __hip_atomic_load(slot + t, __ATOMIC_RELAXED, __HIP_MEMORY_SCOPE_AGENT); mt[t] = __uint_as_float((unsigned)w); m2[t] = __uint_as_float((unsigned)(w >> 32)); } else { mt[t] = 0.f; m2[t] = 0.f; } ms += mt[t]; }
            const float mean = ms / (float)ntn; float q = 0.f;
#pragma unroll
            for (int t = 0; t < 4; ++t) if (t < ntn) { const float dm = mt[t] - mean; q += m2[t] + 256.0f * dm * dm; }
            S[row] = (f32x2v){mean, 1.0f / sqrtf(q / (256.0f * (float)ntn) + eps)};
        }
        asm volatile("s_waitcnt lgkmcnt(0)" ::: "memory"); __builtin_amdgcn_s_barrier(); asm volatile("" ::: "memory");
        return bad;
    }
};
struct EpiLnRes {
    static constexpr bool PERM = false, AFTER_DRAIN = true;
    const float* base; float* out; int ldc; const float* bias; PanelStats st; unsigned poison;
    __device__ __forceinline__ void fused(f32x4 (&acc)[2][2][4][2], const Unit& u, int wr, int wc, int fr, int fq, PG8_LAS unsigned char* lds, int wid, int lane) const {
        typedef float f32x2v __attribute__((ext_vector_type(2)));
        const PG8_LAS f32x2v* S = (const PG8_LAS f32x2v*)(lds + 8192);
        const int col0 = u.pn * BM + wc * 32 + 4 * fq;
#pragma unroll
        for (int bj = 0; bj < 2; ++bj)
#pragma unroll
            for (int n = 0; n < 2; ++n) { const f32x4 bv = bias ? *(const f32x4*)(bias + col0 + bj * HALF + n * 16) : (f32x4){0.f, 0.f, 0.f, 0.f};
#pragma unroll
                for (int ai = 0; ai < 2; ++ai)
#pragma unroll
                    for (int m = 0; m < 4; ++m) acc[ai][bj][m][n] += bv; }
        f32x4 pre[4][2][2];
#pragma unroll
        for (int m = 0; m < 4; ++m) { const size_t off = (size_t)(u.pm * BM + wr * 64 + m * 16 + fr) * ldc + col0;
#pragma unroll
            for (int bj = 0; bj < 2; ++bj)
#pragma unroll
                for (int n = 0; n < 2; ++n) pre[m][bj][n] = *(const f32x4*)(base + off + bj * HALF + n * 16); }
        const bool bad = st.run(acc, u, wr, wc, fr, fq, lds, wid, lane) || poison != 0u;
        const float qnan = __builtin_nanf("");
#pragma unroll
        for (int ai = 0; ai < 2; ++ai)
#pragma unroll
            for (int m = 0; m < 4; ++m) { const int r = ai * HALF + wr * 64 + m * 16 + fr; const f32x2v sr = S[r]; const size_t off = (size_t)(u.pm * BM + r) * ldc + col0;
#pragma unroll
                for (int bj = 0; bj < 2; ++bj)
#pragma unroll
                    for (int n = 0; n < 2; ++n) { const f32x4 bs = ai == 0 ? pre[m][bj][n] : *(const f32x4*)(base + off + bj * HALF + n * 16); f32x4 o = bs + (acc[ai][bj][m][n] - sr.x) * sr.y;
                        if (bad) o = (f32x4){qnan, qnan, qnan, qnan}; *(f32x4*)(out + off + bj * HALF + n * 16) = o; }
                if (m & 1) asm volatile("" ::: "memory"); }
    }
};
struct EpiLnResLn {
    static constexpr bool PERM = false, AFTER_DRAIN = true;
    const float* base; float* out; bf16_t* xn; int ldc; const float* bias; PanelStats st1, st2; unsigned poison;
    __device__ __forceinline__ void fused(f32x4 (&acc)[2][2][4][2], const Unit& u, int wr, int wc, int fr, int fq, PG8_LAS unsigned char* lds, int wid, int lane) const {
        typedef float f32x2v __attribute__((ext_vector_type(2))); typedef unsigned u32x2v __attribute__((ext_vector_type(2)));
        const PG8_LAS f32x2v* S = (const PG8_LAS f32x2v*)(lds + 8192);
        const int col0 = u.pn * BM + wc * 32 + 4 * fq;
#pragma unroll
        for (int bj = 0; bj < 2; ++bj)
#pragma unroll
            for (int n = 0; n < 2; ++n) { const f32x4 bv = bias ? *(const f32x4*)(bias + col0 + bj * HALF + n * 16) : (f32x4){0.f, 0.f, 0.f, 0.f};
#pragma unroll
                for (int ai = 0; ai < 2; ++ai)
#pragma unroll
                    for (int m = 0; m < 4; ++m) acc[ai][bj][m][n] += bv; }
        bool bad = st1.run(acc, u, wr, wc, fr, fq, lds, wid, lane) || poison != 0u;
        const float qnan = __builtin_nanf("");
#pragma unroll
        for (int ai = 0; ai < 2; ++ai)
#pragma unroll
            for (int m = 0; m < 4; ++m) { const int r = ai * HALF + wr * 64 + m * 16 + fr; const f32x2v sr = S[r]; const size_t off = (size_t)(u.pm * BM + r) * ldc + col0;
#pragma unroll
                for (int bj = 0; bj < 2; ++bj)
#pragma unroll
                    for (int n = 0; n < 2; ++n) { const f32x4 bs = *(const f32x4*)(base + off + bj * HALF + n * 16); acc[ai][bj][m][n] = bs + (acc[ai][bj][m][n] - sr.x) * sr.y; }
                asm volatile("" : "+v"(acc[ai][0][m][0]), "+v"(acc[ai][0][m][1]), "+v"(acc[ai][1][m][0]), "+v"(acc[ai][1][m][1]));
                if (m & 1) asm volatile("" ::: "memory"); }
        const bool bad1 = bad;
        bad = st2.run(acc, u, wr, wc, fr, fq, lds, wid, lane) || bad;
#pragma unroll
        for (int ai = 0; ai < 2; ++ai)
#pragma unroll
            for (int m = 0; m < 4; ++m) { const int r = ai * HALF + wr * 64 + m * 16 + fr; const f32x2v sr = S[r]; const size_t off = (size_t)(u.pm * BM + r) * ldc + col0;
#pragma unroll
                for (int bj = 0; bj < 2; ++bj)
#pragma unroll
                    for (int n = 0; n < 2; ++n) { const f32x4 x1 = acc[ai][bj][m][n]; *(f32x4*)(out + off + bj * HALF + n * 16) = bad1 ? (f32x4){qnan, qnan, qnan, qnan} : x1;
                        const f32x4 o = (x1 - sr.x) * sr.y; u32x2v w; w.x = cvt_pk_bf16(o[0], o[1]); w.y = cvt_pk_bf16(o[2], o[3]);
                        if (bad) { w.x = 0x7fc07fc0u; w.y = 0x7fc07fc0u; } *(u32x2v*)(xn + off + bj * HALF + n * 16) = w; }
                asm volatile("" ::: "memory"); }
    }
};

template <class Epi, class Sched, bool ALIGN_EPI = false, bool SP2 = false>
__device__ __forceinline__ void gemm_phase(PG8_LAS unsigned char* lds, const Gemm g, const Sched& S, const Epi& E) {
    const int tid = opaque_tid(), wid = __builtin_amdgcn_readfirstlane(tid >> 6), lane = tid & 63, wr = wid >> 2, wc = wid & 3, fr = lane & 15, fq = lane >> 4;
    const int K = g.K, nt = K / BK;
    unsigned voffA[2], voffB[2];
#pragma unroll
    for (int i = 0; i < 2; ++i) { int R, C; stage_rc(tid * 16 + i * 8192, R, C); const int Rb = Epi::PERM ? ((R & ~31) + perm32(R & 31)) : R;
        voffA[i] = (unsigned)(R * K + C) * 2u; voffB[i] = (unsigned)(Rb * K + C) * 2u; }
    const size_t kstep = (size_t)(BK * 2);
    const size_t hstep = (size_t)HALF * K * 2;
    const size_t tstep = 2 * hstep;
    const unsigned ldsw = (unsigned)wid * 1024u;
    const int aoff = lds_byte(wr * 64 + fr, fq * 8), boff = lds_byte(wc * 32 + fr, fq * 8);
#define PG8_SA(b, h) (((b) * 2 + (h)) * HTB)
#define PG8_SB(b, h) ((4 + (b) * 2 + (h)) * HTB)
#define PG8_STAGE(bufoff, gbase, voff) do { _Pragma("unroll") for (int _i = 0; _i < 2; ++_i) \
        __builtin_amdgcn_global_load_lds((const unsigned*)((const char*)(gbase) + (voff)[_i]), (PG8_LAS unsigned*)(lds + (bufoff) + ldsw + _i * 8192), 16, 0, 0); } while (0)
#define PG8_LDA(dst, b, h) do { _Pragma("unroll") for (int m = 0; m < 4; ++m) _Pragma("unroll") for (int k = 0; k < 2; ++k) dst[m][k] = *(const PG8_LAS bf16x8*)(lds + PG8_SA(b, h) + aoff + m * 2048 + k * 1024); } while (0)
#define PG8_LDB(dst, b, h) do { _Pragma("unroll") for (int n = 0; n < 2; ++n) _Pragma("unroll") for (int k = 0; k < 2; ++k) dst[n][k] = *(const PG8_LAS bf16x8*)(lds + PG8_SB(b, h) + boff + n * 2048 + k * 1024); } while (0)
#define PG8_MMA(ai, bj, At, Bt) do { __builtin_amdgcn_s_setprio(1); _Pragma("unroll") for (int m = 0; m < 4; ++m) _Pragma("unroll") for (int n = 0; n < 2; ++n) _Pragma("unroll") for (int k = 0; k < 2; ++k) \
        acc[ai][bj][m][n] = __builtin_amdgcn_mfma_f32_16x16x32_bf16(Bt[n][k], At[m][k], acc[ai][bj][m][n], 0, 0, 0); __builtin_amdgcn_s_setprio(0); } while (0)
#define PG8_WAIT_V(n) asm volatile("s_waitcnt vmcnt(" #n ")" ::: "memory")
#define PG8_WAIT_L(n) asm volatile("s_waitcnt lgkmcnt(" #n ")" ::: "memory")
#define PG8_BAR __builtin_amdgcn_s_barrier()
#define PG8_SCHED __builtin_amdgcn_sched_barrier(0)
    Unit cur, nxt; int ui = 0;
    if (!S.next(0, cur)) return;
    f32x4 acc[2][2][4][2];
#pragma unroll
    for (int a = 0; a < 2; ++a)
#pragma unroll
        for (int b = 0; b < 2; ++b)
#pragma unroll
            for (int m = 0; m < 4; ++m)
#pragma unroll
                for (int n = 0; n < 2; ++n) acc[a][b][m][n] = (f32x4){0.f, 0.f, 0.f, 0.f};
    bf16x8 At[4][2], B0[2][2], B1[2][2];
    const char* cA = (const char*)g.A + (size_t)cur.pm * tstep; const char* cB = (const char*)g.Bt + (size_t)cur.pn * tstep;
    S.a_ready(cur);
    if constexpr (SP2) {
        PG8_STAGE(PG8_SB(0, 0), cB, voffB); PG8_STAGE(PG8_SB(0, 1), cB + hstep, voffB); PG8_STAGE(PG8_SA(0, 0), cA, voffA); PG8_STAGE(PG8_SA(0, 1), cA + hstep, voffA);
        if (wr == 1) PG8_BAR;
        PG8_WAIT_V(2); PG8_BAR;
        PG8_STAGE(PG8_SB(1, 0), cB + kstep, voffB); PG8_STAGE(PG8_SA(1, 0), cA + kstep, voffA); PG8_STAGE(PG8_SB(1, 1), cB + hstep + kstep, voffB);
        PG8_WAIT_V(6); PG8_BAR;
    } else {
        PG8_STAGE(PG8_SB(0, 0), cB, voffB); PG8_STAGE(PG8_SA(0, 0), cA, voffA); PG8_STAGE(PG8_SB(0, 1), cB + hstep, voffB); PG8_STAGE(PG8_SA(0, 1), cA + hstep, voffA);
        if (wr == 1) PG8_BAR;
        PG8_WAIT_V(4); PG8_BAR;
        PG8_STAGE(PG8_SB(1, 0), cB + kstep, voffB); PG8_STAGE(PG8_SA(1, 0), cA + kstep, voffA); PG8_STAGE(PG8_SB(1, 1), cB + hstep + kstep, voffB);
        PG8_WAIT_V(6); PG8_BAR;
    }
    for (;;) {
        const bool has_next = S.next(ui + 1, nxt);
        const char* nA = has_next ? (const char*)g.A + (size_t)nxt.pm * tstep : cA; const char* nB = has_next ? (const char*)g.Bt + (size_t)nxt.pn * tstep : cB;
        for (int t = 0; t < nt; t += 2) {
            const bool last = (t == nt - 2);
            const char* a1 = cA + (size_t)(t + 1) * kstep;
            const char* a2 = last ? nA : cA + (size_t)(t + 2) * kstep; const char* b2 = last ? nB : cB + (size_t)(t + 2) * kstep;
            const char* a3 = a2 + kstep; const char* b3 = b2 + kstep;
            if (last && has_next) S.a_ready(nxt);
            if constexpr (SP2) {
            PG8_LDB(B0, 0, 0); PG8_LDB(B1, 0, 1); PG8_SCHED; PG8_LDA(At, 0, 0); PG8_STAGE(PG8_SA(1, 1), a1 + hstep, voffA);
            PG8_WAIT_V(8); PG8_WAIT_L(0); PG8_BAR; PG8_MMA(0, 0, At, B0); PG8_MMA(0, 1, At, B1); PG8_BAR; PG8_SCHED;
            PG8_LDA(At, 0, 1); PG8_STAGE(PG8_SB(0, 0), b2, voffB); PG8_STAGE(PG8_SB(0, 1), b2 + hstep, voffB); PG8_STAGE(PG8_SA(0, 0), a2, voffA);
            PG8_WAIT_V(8); PG8_WAIT_L(0); PG8_BAR; PG8_MMA(1, 0, At, B0); PG8_MMA(1, 1, At, B1); PG8_BAR; PG8_SCHED;
            PG8_LDB(B0, 1, 0); PG8_LDB(B1, 1, 1); PG8_SCHED; PG8_LDA(At, 1, 0); PG8_STAGE(PG8_SA(0, 1), a2 + hstep, voffA);
            PG8_WAIT_V(8); PG8_WAIT_L(0); PG8_BAR; PG8_MMA(0, 0, At, B0); PG8_MMA(0, 1, At, B1); PG8_BAR; PG8_SCHED;
            PG8_LDA(At, 1, 1); PG8_STAGE(PG8_SB(1, 0), b3, voffB); PG8_STAGE(PG8_SB(1, 1), b3 + hstep, voffB); PG8_STAGE(PG8_SA(1, 0), a3, voffA);
            PG8_WAIT_V(8); PG8_WAIT_L(0); PG8_BAR; PG8_MMA(1, 0, At, B0); PG8_MMA(1, 1, At, B1); PG8_BAR; PG8_SCHED;
            } else {
            PG8_LDB(B0, 0, 0); PG8_SCHED; PG8_LDA(At, 0, 0); PG8_STAGE(PG8_SA(1, 1), a1 + hstep, voffA);
            PG8_WAIT_L(8); PG8_BAR; PG8_WAIT_L(0); PG8_MMA(0, 0, At, B0); PG8_BAR; PG8_SCHED;
            PG8_LDB(B1, 0, 1); PG8_STAGE(PG8_SB(0, 0), b2, voffB);
            PG8_BAR; PG8_WAIT_L(0); PG8_MMA(0, 1, At, B1); PG8_BAR;
            PG8_LDA(At, 0, 1); PG8_STAGE(PG8_SA(0, 0), a2, voffA);
            PG8_BAR; PG8_WAIT_L(0); PG8_MMA(1, 0, At, B0); PG8_BAR; PG8_SCHED;
            PG8_STAGE(PG8_SB(0, 1), b2 + hstep, voffB);
            PG8_WAIT_V(6); PG8_BAR; PG8_MMA(1, 1, At, B1); PG8_BAR;
            PG8_LDB(B0, 1, 0); PG8_SCHED; PG8_LDA(At, 1, 0); PG8_STAGE(PG8_SA(0, 1), a2 + hstep, voffA);
            PG8_WAIT_L(8); PG8_BAR; PG8_WAIT_L(0); PG8_MMA(0, 0, At, B0); PG8_BAR; PG8_SCHED;
            PG8_LDB(B1, 1, 1); PG8_STAGE(PG8_SB(1, 0), b3, voffB);
            PG8_BAR; PG8_WAIT_L(0); PG8_MMA(0, 1, At, B1); PG8_BAR;
            PG8_LDA(At, 1, 1); PG8_STAGE(PG8_SA(1, 0), a3, voffA);
            PG8_BAR; PG8_WAIT_L(0); PG8_MMA(1, 0, At, B0); PG8_BAR; PG8_SCHED;
            PG8_STAGE(PG8_SB(1, 1), b3 + hstep, voffB);
            PG8_WAIT_V(6); PG8_BAR; PG8_MMA(1, 1, At, B1); PG8_BAR;
            }
        }
        if constexpr (ALIGN_EPI) { if (wr == 0) PG8_BAR; }
        if constexpr (!Epi::AFTER_DRAIN) { E(acc, cur, wr, wc, fr, fq); S.done(cur); }
        if (!has_next) break;
#pragma unroll
        for (int a = 0; a < 2; ++a)
#pragma unroll
            for (int b = 0; b < 2; ++b)
#pragma unroll
                for (int m = 0; m < 4; ++m)
#pragma unroll
                    for (int n = 0; n < 2; ++n) acc[a][b][m][n] = (f32x4){0.f, 0.f, 0.f, 0.f};
        cur = nxt; cA = nA; cB = nB; ++ui;
        if constexpr (ALIGN_EPI) { if (wr == 1) PG8_BAR; }
    }
    PG8_WAIT_V(0);
    if constexpr (!ALIGN_EPI) { if (wr == 0) PG8_BAR; }
    PG8_BAR;
    if constexpr (Epi::AFTER_DRAIN) { E.fused(acc, cur, wr, wc, fr, fq, lds, wid, lane); S.done(cur); }
#undef PG8_SA
#undef PG8_SB
#undef PG8_STAGE
#undef PG8_LDA
#undef PG8_LDB
#undef PG8_MMA
#undef PG8_WAIT_V
#undef PG8_WAIT_L
#undef PG8_BAR
#undef PG8_SCHED
}
}

#ifndef PG8_SP2
#define PG8_SP2 true
#endif
#ifndef PG8_ALIGN
#define PG8_ALIGN true
#endif
namespace pg8 {
constexpr int OUT_KP = 17301504, OUT_VP = 34078720, OUT_KS = 51122176, OUT_VS = 51646464;
typedef unsigned u32x2 __attribute__((ext_vector_type(2)));
constexpr int NSSQ = 32;
__device__ __forceinline__ float row_rstd(const float* ssq, int row) {
    const f32x4* p = (const f32x4*)(ssq + (size_t)row * NSSQ); float s = 0.f;
#pragma unroll
    for (int i = 0; i < NSSQ / 4; ++i) { const f32x4 a = p[i]; s += (a[0] + a[1]) + (a[2] + a[3]); }
    return __builtin_amdgcn_rsqf(s * (1.0f / 1024.0f) + 1e-6f);
}
template <int ACT, bool KVF32> struct EpiAct {
    static constexpr bool PERM = true, AFTER_DRAIN = false;
    bf16_t* O; int ldc; const float* ssq; int split_cols; size_t split_stride; float* fout;
    template <int NA, int NB> __device__ __forceinline__ void run(const f32x4 (&acc)[NA][NB][4][2], int rowt, int colt, bool sample, int wr, int wc, int fr, int fq) const {
        const int row0 = rowt + wr * 64 + fr; bf16_t* base = O; int t = 0;
        if (split_cols) { t = colt / split_cols; base += (size_t)t * split_stride; colt -= t * split_cols; }
        const int col0 = colt + wc * 32 + 8 * fq;
        float* fb = nullptr;
        if (KVF32) { if (t < 2) fb = fout + (!sample ? (size_t)(t == 0 ? OUT_KP : OUT_VP) : (size_t)(t == 0 ? OUT_KS : OUT_VS) - (size_t)16384 * 1024) + col0; }
        f32x4 pq[NA][4][2];
#pragma unroll
        for (int ai = 0; ai < NA; ++ai)
#pragma unroll
            for (int m = 0; m < 4; ++m) { const f32x4* p = (const f32x4*)(ssq + (size_t)(row0 + ai * HALF + m * 16) * NSSQ + 8 * fq); pq[ai][m][0] = p[0]; pq[ai][m][1] = p[1]; }
        float rsv[NA][4];
#pragma unroll
        for (int ai = 0; ai < NA; ++ai)
#pragma unroll
            for (int m = 0; m < 4; ++m) { const f32x4 a = pq[ai][m][0], b = pq[ai][m][1]; float sq = ((a[0] + a[1]) + (a[2] + a[3])) + ((b[0] + b[1]) + (b[2] + b[3]));
                sq += __shfl_xor(sq, 16); sq += __shfl_xor(sq, 32); rsv[ai][m] = __builtin_amdgcn_rsqf(sq * (1.0f / 1024.0f) + 1e-6f); }
#pragma unroll
        for (int ai = 0; ai < NA; ++ai)
#pragma unroll
            for (int m = 0; m < 4; ++m) { const int row = row0 + ai * HALF + m * 16; const float rs = rsv[ai][m];
                bf16_t* rowp = base + (size_t)row * ldc + col0;
#pragma unroll
                for (int bj = 0; bj < NB; ++bj) { f32x4 v0 = acc[ai][bj][m][0] * rs, v1 = acc[ai][bj][m][1] * rs;
                    if (ACT == 1) {
#pragma unroll
                        for (int e = 0; e < 4; ++e) { const float a = fmaxf(v0[e], 0.f), b = fmaxf(v1[e], 0.f); v0[e] = a * a; v1[e] = b * b; } }
                    if (KVF32) { if (fb) { float* fr_ = fb + (size_t)row * 1024 + bj * HALF; *(f32x4*)fr_ = v0; *(f32x4*)(fr_ + 4) = v1; } }
                    u32x4 w; w.x = cvt_pk_bf16(v0[0], v0[1]); w.y = cvt_pk_bf16(v0[2], v0[3]); w.z = cvt_pk_bf16(v1[0], v1[1]); w.w = cvt_pk_bf16(v1[2], v1[3]);
                    *(u32x4*)(rowp + bj * HALF) = w; } }
    }
    __device__ __forceinline__ void operator()(const f32x4 (&acc)[2][2][4][2], const Unit& u, int wr, int wc, int fr, int fq) const { run<2, 2>(acc, u.pm * BM, u.pn * BM, u.pm >= 64, wr, wc, fr, fq); }
};
struct EpiResid {
    static constexpr bool PERM = true, AFTER_DRAIN = false;
    float* X; bf16_t* XB; float* ssq; const float* Xp; const float* Xs;
    template <int NA, int NB> __device__ __forceinline__ void run(const f32x4 (&acc)[NA][NB][4][2], int rowt, int colt, bool sample, int wr, int wc, int fr, int fq) const {
        const int row0 = rowt + wr * 64 + fr; const int col0 = colt + wc * 32 + 8 * fq;
#pragma unroll
        for (int ai = 0; ai < NA; ++ai) {
            f32x4 xr[4][NB][2];
#pragma unroll
            for (int m = 0; m < 4; ++m) { const float* xp = (Xp ? (sample ? Xs - (size_t)16384 * 1024 : Xp) : (const float*)X) + (size_t)(row0 + ai * HALF + m * 16) * 1024 + col0;
#pragma unroll
                for (int bj = 0; bj < NB; ++bj) { xr[m][bj][0] = *(const f32x4*)(xp + bj * HALF); xr[m][bj][1] = *(const f32x4*)(xp + bj * HALF + 4); } }
#pragma unroll
            for (int m = 0; m < 4; ++m) { const int row = row0 + ai * HALF + m * 16; float* xp = X + (size_t)row * 1024 + col0; bf16_t* bp = XB + (size_t)row * 1024 + col0;
#pragma unroll
                for (int bj = 0; bj < NB; ++bj) { const f32x4 a0 = xr[m][bj][0] + acc[ai][bj][m][0], a1 = xr[m][bj][1] + acc[ai][bj][m][1];
                    *(f32x4*)(xp + bj * HALF) = a0; *(f32x4*)(xp + bj * HALF + 4) = a1;
                    float q = ((a0[0] * a0[0] + a0[1] * a0[1]) + (a0[2] * a0[2] + a0[3] * a0[3])) + ((a1[0] * a1[0] + a1[1] * a1[1]) + (a1[2] * a1[2] + a1[3] * a1[3]));
                    u32x4 w; w.x = cvt_pk_bf16(a0[0], a0[1]); w.y = cvt_pk_bf16(a0[2], a0[3]); w.z = cvt_pk_bf16(a1[0], a1[1]); w.w = cvt_pk_bf16(a1[2], a1[3]);
                    *(u32x4*)(bp + bj * HALF) = w;
                    q += __shfl_xor(q, 16); q += __shfl_xor(q, 32);
                    if (fq == 0) ssq[(size_t)row * NSSQ + ((colt + bj * HALF) >> 7) * 4 + wc] = q; } }
            asm volatile("" ::: "memory"); }
    }
    __device__ __forceinline__ void operator()(const f32x4 (&acc)[2][2][4][2], const Unit& u, int wr, int wc, int fr, int fq) const { run<2, 2>(acc, u.pm * BM, u.pn * BM, u.pm >= 64, wr, wc, fr, fq); }
};
__device__ __forceinline__ void glds16(const void* gsrc, unsigned lds_dst) { unsigned keep;
    asm volatile("s_mov_b32 %0, m0\n\ts_mov_b32 m0, %2\n\ts_nop 0\n\tglobal_load_lds_dwordx4 %1, off\n\ts_mov_b32 m0, %0" : "=&s"(keep) : "v"(gsrc), "s"(lds_dst) : "memory"); }
template <class Epi>
__device__ __forceinline__ void gemm128_tile(PG8_LAS unsigned char* lds, const bf16_t* A, const bf16_t* Bt, int K, const Epi& E, int rowt, int colt) {
    const int tid = opaque_tid(), wid = __builtin_amdgcn_readfirstlane(tid >> 6), lane = tid & 63, wr = wid >> 2, wc = wid & 3, fr = lane & 15, fq = lane >> 4;
    const int nt = K / BK;
    const char* gA[2]; const char* gB[2];
#pragma unroll
    for (int i = 0; i < 2; ++i) { int R, C; stage_rc(tid * 16 + i * 8192, R, C); const int Rb = (R & ~31) + perm32(R & 31);
        gA[i] = (const char*)A + (size_t)(R * K + C) * 2; gB[i] = (const char*)Bt + (size_t)(Rb * K + C) * 2; }
    const unsigned lds0 = (unsigned)(uintptr_t)lds + (unsigned)wid * 1024u;
    const int aoff = lds_byte(wr * 64 + fr, fq * 8), boff = lds_byte(wc * 32 + fr, fq * 8);
#define G128_STAGE(s, kt) do { _Pragma("unroll") for (int _i = 0; _i < 2; ++_i) { \
        glds16(gA[_i] + (size_t)(kt) * (BK * 2), (unsigned)__builtin_amdgcn_readfirstlane(lds0 + (unsigned)((s) * 2 * HTB + _i * 8192))); \
        glds16(gB[_i] + (size_t)(kt) * (BK * 2), (unsigned)__builtin_amdgcn_readfirstlane(lds0 + (unsigned)((s) * 2 * HTB + HTB + _i * 8192))); } } while (0)
    f32x4 acc[1][1][4][2];
#pragma unroll
    for (int m = 0; m < 4; ++m)
#pragma unroll
        for (int n = 0; n < 2; ++n) acc[0][0][m][n] = (f32x4){0.f, 0.f, 0.f, 0.f};
    G128_STAGE(0, 0); G128_STAGE(1, 1); G128_STAGE(2, 2);
    for (int t = 0; t < nt; ++t) {
        const int rem = nt - 1 - t;
        if (rem >= 2) asm volatile("s_waitcnt vmcnt(8)" ::: "memory"); else if (rem == 1) asm volatile("s_waitcnt vmcnt(4)" ::: "memory"); else asm volatile("s_waitcnt vmcnt(0)" ::: "memory");
        __builtin_amdgcn_s_barrier(); asm volatile("" ::: "memory");
        if (t + 3 < nt) G128_STAGE((t + 3) & 3, t + 3);
        const PG8_LAS unsigned char* sb = lds + (t & 3) * 2 * HTB;
        bf16x8 At[4][2], Bf[2][2];
#pragma unroll
        for (int m = 0; m < 4; ++m)
#pragma unroll
            for (int k = 0; k < 2; ++k) At[m][k] = *(const PG8_LAS bf16x8*)(sb + aoff + m * 2048 + k * 1024);
#pragma unroll
        for (int n = 0; n < 2; ++n)
#pragma unroll
            for (int k = 0; k < 2; ++k) Bf[n][k] = *(const PG8_LAS bf16x8*)(sb + HTB + boff + n * 2048 + k * 1024);
        asm volatile("s_waitcnt lgkmcnt(0)" ::: "memory");
#pragma unroll
        for (int m = 0; m < 4; ++m)
#pragma unroll
            for (int n = 0; n < 2; ++n)
#pragma unroll
                for (int k = 0; k < 2; ++k) acc[0][0][m][n] = __builtin_amdgcn_mfma_f32_16x16x32_bf16(Bf[n][k], At[m][k], acc[0][0][m][n], 0, 0, 0);
    }
#undef G128_STAGE
    E.template run<1, 1>(acc, rowt, colt, true, wr, wc, fr, fq);
    asm volatile("s_waitcnt lgkmcnt(0)" ::: "memory"); __builtin_amdgcn_s_barrier(); asm volatile("" ::: "memory");
}
__device__ __forceinline__ void gemm64_resid_tile(PG8_LAS unsigned char* lds, const bf16_t* A, const bf16_t* Bt, int K, const EpiResid& E, int rowt, int colt) {
    const int tid = opaque_tid(), wid = __builtin_amdgcn_readfirstlane(tid >> 6), lane = tid & 63, wr = wid >> 2, wc = wid & 3, fr = lane & 15, fq = lane >> 4;
    const int nt = K / BK;
    const char* gA; const char* gB;
    { int R, C; stage_rc(tid * 16, R, C); gA = (const char*)A + (size_t)(R * K + C) * 2; gB = (const char*)Bt + (size_t)(R * K + C) * 2; }
    const unsigned lds0 = (unsigned)(uintptr_t)lds + (unsigned)wid * 1024u;
    const int aoff = lds_byte(wr * 32 + fr, fq * 8), boff = lds_byte(wc * 16 + fr, fq * 8);
#define G64_STAGE(s, kt) do { glds16(gA + (size_t)(kt) * (BK * 2), (unsigned)__builtin_amdgcn_readfirstlane(lds0 + (unsigned)((s) * 16384))); \
        glds16(gB + (size_t)(kt) * (BK * 2), (unsigned)__builtin_amdgcn_readfirstlane(lds0 + (unsigned)((s) * 16384 + 8192))); } while (0)
    f32x4 acc[2];
    acc[0] = (f32x4){0.f, 0.f, 0.f, 0.f}; acc[1] = (f32x4){0.f, 0.f, 0.f, 0.f};
#pragma unroll
    for (int s = 0; s < 6; ++s) G64_STAGE(s, s);
    for (int t = 0; t < nt; ++t) {
        const int rem = nt - 1 - t;
        if (rem >= 5) asm volatile("s_waitcnt vmcnt(10)" ::: "memory"); else if (rem == 4) asm volatile("s_waitcnt vmcnt(8)" ::: "memory"); else if (rem == 3) asm volatile("s_waitcnt vmcnt(6)" ::: "memory");
        else if (rem == 2) asm volatile("s_waitcnt vmcnt(4)" ::: "memory"); else if (rem == 1) asm volatile("s_waitcnt vmcnt(2)" ::: "memory"); else asm volatile("s_waitcnt vmcnt(0)" ::: "memory");
        __builtin_amdgcn_s_barrier(); asm volatile("" ::: "memory");
        if (t + 6 < nt) G64_STAGE((t + 6) & 7, t + 6);
        const PG8_LAS unsigned char* sb = lds + (t & 7) * 16384;
        bf16x8 At[2][2], Bf[2];
#pragma unroll
        for (int m = 0; m < 2; ++m)
#pragma unroll
            for (int k = 0; k < 2; ++k) At[m][k] = *(const PG8_LAS bf16x8*)(sb + aoff + m * 2048 + k * 1024);
#pragma unroll
        for (int k = 0; k < 2; ++k) Bf[k] = *(const PG8_LAS bf16x8*)(sb + 8192 + boff + k * 1024);
        asm volatile("s_waitcnt lgkmcnt(0)" ::: "memory");
#pragma unroll
        for (int m = 0; m < 2; ++m)
#pragma unroll
            for (int k = 0; k < 2; ++k) acc[m] = __builtin_amdgcn_mfma_f32_16x16x32_bf16(Bf[k], At[m][k], acc[m], 0, 0, 0);
    }
#undef G64_STAGE
    asm volatile("s_waitcnt lgkmcnt(0)" ::: "memory"); __builtin_amdgcn_s_barrier(); asm volatile("" ::: "memory");
    PG8_LAS float* part = (PG8_LAS float*)lds;
    const int col0 = colt + wc * 16 + 4 * fq;
    const float* xsrc = E.Xp ? E.Xs - (size_t)16384 * 1024 : (const float*)E.X;
#pragma unroll
    for (int m = 0; m < 2; ++m) { const int rl = wr * 32 + m * 16 + fr, row = rowt + rl;
        const f32x4 a0 = *(const f32x4*)(xsrc + (size_t)row * 1024 + col0) + acc[m];
        *(f32x4*)(E.X + (size_t)row * 1024 + col0) = a0;
        u32x2 w; w.x = cvt_pk_bf16(a0[0], a0[1]); w.y = cvt_pk_bf16(a0[2], a0[3]);
        *(u32x2*)(E.XB + (size_t)row * 1024 + col0) = w;
        float q = (a0[0] * a0[0] + a0[1] * a0[1]) + (a0[2] * a0[2] + a0[3] * a0[3]);
        q += __shfl_xor(q, 16); q += __shfl_xor(q, 32);
        if (fq == 0) part[rl * 4 + wc] = q; }
    asm volatile("s_waitcnt lgkmcnt(0)" ::: "memory"); __builtin_amdgcn_s_barrier(); asm volatile("" ::: "memory");
    if (tid < 128) { const int rl = tid >> 1, pr = tid & 1; E.ssq[(size_t)(rowt + rl) * NSSQ + (colt >> 5) + pr] = part[rl * 4 + 2 * pr] + part[rl * 4 + 2 * pr + 1]; }
    asm volatile("s_waitcnt lgkmcnt(0)" ::: "memory"); __builtin_amdgcn_s_barrier(); asm volatile("" ::: "memory");
}
}
#include <hip/hip_bf16.h>
#include <cmath>
namespace attn_body {
using bf16=__hip_bfloat16;
using bf16x8=__attribute__((ext_vector_type(8)))short;
using s16x4=__attribute__((ext_vector_type(4)))short;
using f32x16=__attribute__((ext_vector_type(16)))float;
using u32x4=__attribute__((ext_vector_type(4)))unsigned;
constexpr int BATCH=1,NHEAD=16,SEQ=16384,D=64,DM=NHEAD*D;
constexpr int NW=8,QBLK=32,QB=QBLK*NW,KVBLK=64,NQB=SEQ/QB;
constexpr int ATTN_PITCH=DM, ATTN_UNIT_ROWS=QB;
__device__ __forceinline__ int crow(int r,int hi){return (r&3)+8*(r>>2)+4*hi;}
#define SBAR() __builtin_amdgcn_sched_barrier(0)
__device__ __forceinline__ void cmask(f32x16&p0,f32x16&p1,int jb,int qrel,int hi){
  const float NEG=-INFINITY; int kb=64*jb+4*hi;
  #pragma unroll
  for(int r=0;r<16;++r){int kv=kb+(r&3)+8*(r>>2); if(kv>qrel)p0[r]=NEG; if(kv+32>qrel)p1[r]=NEG;}
}

constexpr int NSLOT=3, SLOTB=8192;
constexpr int LDS_K=0, LDS_V=NSLOT*SLOTB, LDS_WS=2*NSLOT*SLOTB, LDS_OST=LDS_WS+NW*64*4, LDS_CK=LDS_OST+NW*4096, LDS_BYTES=LDS_CK+SEQ*4;
constexpr float C2=0.125f*1.4426950408889634f;
__device__ __forceinline__ void glds16(const void*gsrc,unsigned lds_dst){unsigned keep;
  asm volatile("s_mov_b32 %0, m0\n\ts_mov_b32 m0, %2\n\ts_nop 0\n\tglobal_load_lds_dwordx4 %1, off\n\ts_mov_b32 m0, %0":"=&s"(keep):"v"(gsrc),"s"(lds_dst):"memory");}
__device__ __forceinline__ void glds16s(const void*sbase,unsigned voff,unsigned lds_dst){unsigned keep;
  asm volatile("s_mov_b32 %0, m0\n\ts_mov_b32 m0, %3\n\ts_nop 0\n\tglobal_load_lds_dwordx4 %1, %2\n\ts_mov_b32 m0, %0":"=&s"(keep):"v"(voff),"s"(sbase),"s"(lds_dst):"memory");}
__device__ __forceinline__ float max3f(float a,float b,float c){float r;asm("v_max3_f32 %0, %1, %2, %3":"=v"(r):"v"(a),"v"(b),"v"(c));return r;}
__device__ __forceinline__ float max2f(float a,float b){float r;asm("v_max_f32_e32 %0, %1, %2":"=v"(r):"v"(a),"v"(b));return r;}
__device__ __forceinline__ float fadd_s(float a,float b){float r;asm("v_add_f32_e32 %0, %1, %2":"=v"(r):"v"(a),"v"(b));return r;}
__device__ __forceinline__ float fsub_s(float a,float b){float r;asm("v_sub_f32_e32 %0, %1, %2":"=v"(r):"v"(a),"v"(b));return r;}
typedef float f32x2_t __attribute__((ext_vector_type(2))); typedef __bf16 bf16x2_t __attribute__((ext_vector_type(2)));
__device__ __forceinline__ unsigned cvtpk_s(float lo,float hi){f32x2_t v={lo,hi};bf16x2_t b=__builtin_convertvector(v,bf16x2_t);return __builtin_bit_cast(unsigned,b);}
#define WAIT_BAR(N) asm volatile("s_waitcnt vmcnt(" #N ") lgkmcnt(0)\n\ts_barrier":::"memory")

__device__ __forceinline__ void qkt(f32x16&p0,f32x16&p1,const char*Kslot,const bf16x8*qr,const f32x16&negm,int r32,int hi){
  const char*kb=Kslot+hi*1024+r32*16;
  #pragma unroll
  for(int d0=0;d0<4;++d0){
    const bf16x8 b0=*reinterpret_cast<const bf16x8*>(kb+d0*2048);
    const bf16x8 b1=*reinterpret_cast<const bf16x8*>(kb+d0*2048+512);
    if(d0==0){p0=__builtin_amdgcn_mfma_f32_32x32x16_bf16(b0,qr[0],negm,0,0,0);p1=__builtin_amdgcn_mfma_f32_32x32x16_bf16(b1,qr[0],negm,0,0,0);}
    else{p0=__builtin_amdgcn_mfma_f32_32x32x16_bf16(b0,qr[d0],p0,0,0,0);p1=__builtin_amdgcn_mfma_f32_32x32x16_bf16(b1,qr[d0],p1,0,0,0);}}
}
typedef __attribute__((address_space(3))) const char* lds_cptr;
typedef short v4i16_t __attribute__((ext_vector_type(4)));
__device__ __forceinline__ void kload8(bf16x8*kf,lds_cptr kp){
  kf[0]=*(const __attribute__((address_space(3))) bf16x8*)(kp);      kf[1]=*(const __attribute__((address_space(3))) bf16x8*)(kp+512);
  kf[2]=*(const __attribute__((address_space(3))) bf16x8*)(kp+2048); kf[3]=*(const __attribute__((address_space(3))) bf16x8*)(kp+2560);
  kf[4]=*(const __attribute__((address_space(3))) bf16x8*)(kp+4096); kf[5]=*(const __attribute__((address_space(3))) bf16x8*)(kp+4608);
  kf[6]=*(const __attribute__((address_space(3))) bf16x8*)(kp+6144); kf[7]=*(const __attribute__((address_space(3))) bf16x8*)(kp+6656);
}
__device__ __forceinline__ void kload2(bf16x8*kf,lds_cptr kp,int j){ kf[2*j]=*(const __attribute__((address_space(3))) bf16x8*)(kp+j*2048); kf[2*j+1]=*(const __attribute__((address_space(3))) bf16x8*)(kp+j*2048+512); }
__device__ __forceinline__ s16x4 vtr(lds_cptr p){ return __builtin_bit_cast(s16x4,__builtin_amdgcn_ds_read_tr16_b64_v4i16((__attribute__((address_space(3))) v4i16_t*)p)); }
__device__ __forceinline__ float rowmax(const f32x16&p0,const f32x16&p1){
  float a=max3f(p0[0],p0[1],p1[0]),b=max3f(p0[2],p0[3],p1[1]);a=max3f(a,p1[2],p1[3]);
  #pragma unroll
  for(int r=4;r<16;r+=4){a=max3f(a,p0[r],p0[r+1]);b=max3f(b,p0[r+2],p0[r+3]);a=max3f(a,p1[r],p1[r+1]);b=max3f(b,p1[r+2],p1[r+3]);}
  const float m=max2f(a,b);
  auto rr=__builtin_amdgcn_permlane32_swap(__float_as_uint(m),__float_as_uint(m),false,false);
  return max2f(__uint_as_float(rr[0]),__uint_as_float(rr[1]));
}
__device__ __forceinline__ void pv(f32x16*o,int vb,bf16x8 pa0,bf16x8 pa1,bf16x8 pa2,bf16x8 pa3){
  #pragma unroll
  for(int d0=0;d0<2;++d0){s16x4 lo[4],hi[4];
    #pragma unroll
    for(int ks=0;ks<4;++ks){
      asm volatile("ds_read_b64_tr_b16 %0,%1 offset:%c2":"=&v"(lo[ks]):"v"(vb),"i"(d0*4096+ks*1024):"memory");
      asm volatile("ds_read_b64_tr_b16 %0,%1 offset:%c2":"=&v"(hi[ks]):"v"(vb),"i"(d0*4096+ks*1024+512):"memory");}
    asm volatile("s_waitcnt lgkmcnt(0)":::"memory");SBAR();
    #define PK(k) (bf16x8){lo[k][0],lo[k][1],lo[k][2],lo[k][3],hi[k][0],hi[k][1],hi[k][2],hi[k][3]}
    o[d0]=__builtin_amdgcn_mfma_f32_32x32x16_bf16(pa0,PK(0),o[d0],0,0,0);
    o[d0]=__builtin_amdgcn_mfma_f32_32x32x16_bf16(pa1,PK(1),o[d0],0,0,0);
    o[d0]=__builtin_amdgcn_mfma_f32_32x32x16_bf16(pa2,PK(2),o[d0],0,0,0);
    o[d0]=__builtin_amdgcn_mfma_f32_32x32x16_bf16(pa3,PK(3),o[d0],0,0,0);
    #undef PK
  }
}

#ifndef ATTN_STORE16
#define ATTN_STORE16(p,v) (*(u32x4*)(p)=(v))
#endif
typedef float f32x4_t __attribute__((ext_vector_type(4)));
#define CKSUB(C0,C1,t) do{ const __attribute__((address_space(3))) f32x4_t* ck_=(const __attribute__((address_space(3))) f32x4_t*)(ckl+(t)*64+4*hi); \
   _Pragma("unroll") for(int g_=0;g_<4;++g_){ const f32x4_t a_=ck_[2*g_], b_=ck_[8+2*g_]; \
     _Pragma("unroll") for(int i_=0;i_<4;++i_){ C0[4*g_+i_]-=a_[i_]; C1[4*g_+i_]-=b_[i_]; } } }while(0)
template<int THRL> __device__ __forceinline__ void attn_unit(int b,int h,int qb,const bf16*Q,const bf16*__restrict__ K,const bf16*__restrict__ V,bf16*O,char*shm,const float*ckg,const float kmax2,const float lfmax){
  const int tid=opaque_tid(),lane=tid&63,r32=lane&31,hi=lane>>5; const int wid=__builtin_amdgcn_readfirstlane(tid>>6);
  const long rowbase=(long)b*SEQ; const int q0=qb*QB;
  const bf16*Qw=Q+(rowbase+q0+wid*QBLK)*DM+h*D;
  const unsigned lds0=(unsigned)(uintptr_t)shm;
  float*wsf=(float*)(shm+LDS_WS)+wid*64;
  __attribute__((address_space(3))) float* ckl=(__attribute__((address_space(3))) float*)((__attribute__((address_space(3))) char*)shm+LDS_CK);
  const float cqv=ckg[q0+wid*QBLK+r32];
  bf16x8 qr[4];
  #pragma unroll
  for(int d0=0;d0<4;++d0)qr[d0]=*reinterpret_cast<const bf16x8*>(&Qw[(long)r32*DM+d0*16+hi*8]);
  int t0=0;
  if(qb>0){
    float*wsa=(float*)(shm+LDS_WS);
    float qs=0.f;
    #pragma unroll
    for(int d0=0;d0<4;++d0){
      #pragma unroll
      for(int e=0;e<8;++e){ const float v_=__builtin_bit_cast(float,((unsigned)(unsigned short)qr[d0][e])<<16); qs+=v_*v_; } }
    qs+=__shfl_xor(qs,32);
    #pragma unroll
    for(int o_=1;o_<32;o_<<=1) qs=fmaxf(qs,__shfl_xor(qs,o_));
    float dg=0.f;
    { const bf16*Kq=K+(rowbase+q0+wid*QBLK)*DM+h*D;
      #pragma unroll
      for(int d0=0;d0<4;++d0){ const bf16x8 kd_=*reinterpret_cast<const bf16x8*>(&Kq[(long)r32*DM+d0*16+hi*8]);
        #pragma unroll
        for(int e=0;e<8;++e){ dg+=__builtin_bit_cast(float,((unsigned)(unsigned short)qr[d0][e])<<16)*__builtin_bit_cast(float,((unsigned)(unsigned short)kd_[e])<<16); } } }
    dg+=__shfl_xor(dg,32);
    #pragma unroll
    for(int o_=1;o_<32;o_<<=1) dg=fminf(dg,__shfl_xor(dg,o_));
    const int ncand=q0/KVBLK;
    float cend=0.f; if(tid<ncand) cend=ckg[tid*KVBLK+KVBLK-1];
    const float cq0=ckg[q0];
    if(lane==0){ wsa[wid]=qs; wsa[16+wid]=dg; }
    __syncthreads();
    float qm=wsa[0];
    #pragma unroll
    for(int w_=1;w_<NW;++w_) qm=fmaxf(qm,wsa[w_]);
    float dmn=wsa[16];
    #pragma unroll
    for(int w_=1;w_<NW;++w_) dmn=fminf(dmn,wsa[16+w_]);
    const float lb_=-__log2f(fmaxf(-expm1f(lfmax),1e-30f));
    const float thr=dmn-26.05f-lb_-sqrtf(qm*kmax2)*1.0001f;
    const bool skip_=(tid<ncand)&&((cq0-cend)<thr);
    const unsigned long long bal_=__ballot(skip_);
    if(lane==0) wsa[8+wid]=(float)__popcll(bal_);
    __syncthreads();
    float cnt_=0.f;
    #pragma unroll
    for(int w_=0;w_<NW;++w_) cnt_+=wsa[8+w_];
    t0=__builtin_amdgcn_readfirstlane(((int)cnt_)&~1);
    __syncthreads();
  }
  const bf16*Kh=K+(rowbase+(long)t0*KVBLK)*DM+h*D,*Vh=V+(rowbase+(long)t0*KVBLK)*DM+h*D;
  { const int nf4=(q0+QB-t0*KVBLK)>>2; const f32x4_t* src_=(const f32x4_t*)(ckg+t0*KVBLK); __attribute__((address_space(3))) f32x4_t* dst_=(__attribute__((address_space(3))) f32x4_t*)ckl;
    for(int i_=tid;i_<nf4;i_+=NW*64) dst_[i_]=src_[i_]; }
  const unsigned kvoff=(unsigned)((lane*DM+wid*8)*2);
  const unsigned vvoff=(unsigned)(((16*(wid&3)+(lane>>2))*DM+(wid>>2)*32+(lane&3)*8)*2);
  const unsigned kdst=lds0+LDS_K+wid*1024, vdst=lds0+LDS_V+wid*1024;
  #define DMA_K(t,slot) glds16s(Kh+(long)(t)*KVBLK*DM,kvoff,(unsigned)__builtin_amdgcn_readfirstlane(kdst+(slot)))
  #define DMA_V(t,slot) glds16s(Vh+(long)(t)*KVBLK*DM,vvoff,(unsigned)__builtin_amdgcn_readfirstlane(vdst+(slot)))
  const int vb0=(int)(lds0+LDS_V)+((lane>>4)&1)*32+(lane&3)*8+(4*hi+((lane&15)>>2))*64;
  const char*Kbase=shm+LDS_K; bf16x8 kf[8];
  const lds_cptr shm3=(lds_cptr)shm; const lds_cptr kp0=shm3+LDS_K+hi*1024+r32*16; const lds_cptr vp0=shm3+LDS_V+((lane>>4)&1)*32+(lane&3)*8+(4*hi+((lane&15)>>2))*64;
  const int NT=(q0+QB)/KVBLK-t0;
  DMA_K(0,0);DMA_V(0,0);DMA_K(1,SLOTB);
  float mhat=-cqv,l_reg=0.f;    f32x16 o[2];o[0]=f32x16{};o[1]=f32x16{};f32x16 negm;
  #pragma unroll
  for(int r=0;r<16;++r)negm[r]=cqv;
  asm volatile("":"+v"(negm));
  const int qrel=wid*QBLK+r32;
  #define CMASK(P0,P1,t) do{int jb_=(t)-(NT-4); if(jb_>=0)cmask(P0,P1,jb_,qrel,hi);}while(0)
  bool resc=false;
  #define START(P0,P1) do{ const float rm=rowmax(P0,P1); resc=false; \
    { const float dl=rm; mhat=fadd_s(mhat,dl); \
      _Pragma("unroll") for(int r=0;r<16;++r){P0[r]=fsub_s(P0[r],dl);P1[r]=fsub_s(P1[r],dl);} \
      _Pragma("unroll") for(int r=0;r<16;++r)negm[r]=-mhat; asm volatile("":"+v"(negm)); } \
    _Pragma("unroll") for(int r=0;r<16;++r)P0[r]=__builtin_amdgcn_exp2f(P0[r]); }while(0)
  #define RESC() do{ if(resc){ asm volatile("s_waitcnt lgkmcnt(0)":::"memory"); \
      _Pragma("unroll") for(int d_=0;d_<2;++d_) _Pragma("unroll") for(int r=0;r<16;++r)o[d_][r]*=wsf[crow(r,hi)]; } }while(0)
  f32x16 pA0,pA1,pB0,pB1;
  int sl_prev=0,sl_cur=0,sl_next=SLOTB;
  #define ROT() do{sl_prev=sl_cur;sl_cur=sl_next;sl_next=(sl_next==(NSLOT-1)*SLOTB)?0:sl_next+SLOTB;}while(0)
  DMA_K(2,2*SLOTB);
  WAIT_BAR(3);
  qkt(pA0,pA1,Kbase,qr,negm,r32,hi);asm volatile("s_nop 15\n\ts_nop 7":"+v"(pA0),"+v"(pA1));CKSUB(pA0,pA1,0);CMASK(pA0,pA1,0);
  START(pA0,pA1);
  _Pragma("unroll") for(int r=0;r<16;++r)pA1[r]=__builtin_amdgcn_exp2f(pA1[r]);
  WAIT_BAR(0);
  DMA_K(3,0);DMA_V(1,SLOTB);
  ROT();
  kload8(kf,kp0+sl_cur);
  WAIT_BAR(2);
  s16x4 vlo[8],vhi[8]; u32x4 pw0,pw1,pw2,pw3;
  #define PKW(P,B) cvtpk_s(P[B],P[B+1])
  #define PAF(k) __builtin_bit_cast(bf16x8,pw##k)
  #define VFR(i) (bf16x8){vlo[i][0],vlo[i][1],vlo[i][2],vlo[i][3],vhi[i][0],vhi[i][1],vhi[i][2],vhi[i][3]}
  #define PIN(x) asm volatile("":"+v"(x))
  #define MX3(a,b,c) __builtin_fmaxf(__builtin_fmaxf((a),(b)),(c))
  #define GAPA(MF,A0,A1,A2,A3,W0,W1,PW) do{ MF; sacc+=A0; sacc+=A1; sacc+=A2; sacc+=A3; PIN(sacc); W0; W1; PIN(PW); SBAR(); }while(0)
  #define EX(v) __builtin_amdgcn_exp2f(v)
  #define GAPB(MF,X,B) do{ MF; X[B]=EX(X[B]); X[B+1]=EX(X[B+1]); X[B+2]=EX(X[B+2]); X[B+3]=EX(X[B+3]); PIN(X); SBAR(); }while(0)
  #define VRD(i) do{ vlo[i]=vtr(vp_+(((i)>>2)*4096+((i)&3)*1024)); vhi[i]=vtr(vp_+(((i)>>2)*4096+((i)&3)*1024+512)); }while(0)
  #define KRD(G,j) do{ if(G){ kload2(kf,kp0+sl_next,j); SBAR(); } }while(0)
  #define STEP(C0,C1,P0,P1,t,GK,GV,GL) do{ SBAR(); \
    const lds_cptr vp_=vp0+sl_prev; \
    VRD(0); SBAR(); float sacc=(P0[0]+P0[1]); \
    GAPA(C0=__builtin_amdgcn_mfma_f32_32x32x16_bf16(kf[0],qr[0],negm,0,0,0), P0[2],P0[3],P0[4],P0[5],     pw0[0]=PKW(P0,0), pw0[1]=PKW(P0,2), pw0); \
    VRD(4); SBAR(); GAPA(C1=__builtin_amdgcn_mfma_f32_32x32x16_bf16(kf[1],qr[0],negm,0,0,0), P0[6],P0[7],P0[8],P0[9],     pw0[2]=PKW(P0,4), pw0[3]=PKW(P0,6), pw0); \
    VRD(1); SBAR(); GAPA(C0=__builtin_amdgcn_mfma_f32_32x32x16_bf16(kf[2],qr[1],C0,0,0,0),   P0[10],P0[11],P0[12],P0[13], pw1[0]=PKW(P0,8), pw1[1]=PKW(P0,10), pw1); \
    VRD(5); SBAR(); GAPA(C1=__builtin_amdgcn_mfma_f32_32x32x16_bf16(kf[3],qr[1],C1,0,0,0),   P0[14],P0[15],P1[0],P1[1],   pw1[2]=PKW(P0,12),pw1[3]=PKW(P0,14), pw1); \
    VRD(2); SBAR(); GAPA(C0=__builtin_amdgcn_mfma_f32_32x32x16_bf16(kf[4],qr[2],C0,0,0,0),   P1[2],P1[3],P1[4],P1[5],     pw2[0]=PKW(P1,0), pw2[1]=PKW(P1,2), pw2); \
    VRD(6); SBAR(); GAPA(C1=__builtin_amdgcn_mfma_f32_32x32x16_bf16(kf[5],qr[2],C1,0,0,0),   P1[6],P1[7],P1[8],P1[9],     pw2[2]=PKW(P1,4), pw2[3]=PKW(P1,6), pw2); \
    VRD(3); SBAR(); GAPA(C0=__builtin_amdgcn_mfma_f32_32x32x16_bf16(kf[6],qr[3],C0,0,0,0),   P1[10],P1[11],P1[12],P1[13], pw3[0]=PKW(P1,8), pw3[1]=PKW(P1,10), pw3); \
    VRD(7); SBAR(); GAPA(C1=__builtin_amdgcn_mfma_f32_32x32x16_bf16(kf[7],qr[3],C1,0,0,0),   P1[14],P1[15],0.f,0.f,       pw3[2]=PKW(P1,12),pw3[3]=PKW(P1,14), pw3); \
    l_reg+=sacc; \
    if(GK){DMA_K((t)+3,sl_cur);} if(GV){DMA_V((t)+1,sl_next);} \
    CKSUB(C0,C1,t); CMASK(C0,C1,t); \
    { float a=MX3(C0[0],C0[1],C1[0]),b=MX3(C0[2],C0[3],C1[1]); a=MX3(a,C1[2],C1[3]); \
      _Pragma("unroll") for(int r=4;r<16;r+=4){a=MX3(a,C0[r],C0[r+1]);b=MX3(b,C0[r+2],C0[r+3]);a=MX3(a,C1[r],C1[r+1]);b=MX3(b,C1[r+2],C1[r+3]);} \
      float rm=__builtin_fmaxf(a,b); { auto rr=__builtin_amdgcn_permlane32_swap(__float_as_uint(rm),__float_as_uint(rm),false,false); rm=__builtin_fmaxf(__uint_as_float(rr[0]),__uint_as_float(rr[1])); } \
      resc=false; \
      if(__builtin_expect(__any(rm>(float)THRL),0)){ const float dl=__builtin_fmaxf(rm,0.f); mhat+=dl; \
        _Pragma("unroll") for(int r=0;r<16;++r){C0[r]-=dl;C1[r]-=dl;} \
        _Pragma("unroll") for(int r=0;r<16;++r)negm[r]=-mhat; asm volatile("":"+v"(negm)); \
        const float f=__builtin_amdgcn_exp2f(-dl); l_reg*=f; if(hi==0)wsf[r32]=f; resc=true; } } \
    SBAR(); \
    GAPB(o[0]=__builtin_amdgcn_mfma_f32_32x32x16_bf16(PAF(0),VFR(0),o[0],0,0,0), C0,0); \
    GAPB(o[1]=__builtin_amdgcn_mfma_f32_32x32x16_bf16(PAF(0),VFR(4),o[1],0,0,0), C0,4); \
    KRD(GL,0); GAPB(o[0]=__builtin_amdgcn_mfma_f32_32x32x16_bf16(PAF(1),VFR(1),o[0],0,0,0), C0,8); \
    KRD(GL,1); GAPB(o[1]=__builtin_amdgcn_mfma_f32_32x32x16_bf16(PAF(1),VFR(5),o[1],0,0,0), C0,12); \
    KRD(GL,2); GAPB(o[0]=__builtin_amdgcn_mfma_f32_32x32x16_bf16(PAF(2),VFR(2),o[0],0,0,0), C1,0); \
    KRD(GL,3); GAPB(o[1]=__builtin_amdgcn_mfma_f32_32x32x16_bf16(PAF(2),VFR(6),o[1],0,0,0), C1,4); \
    GAPB(o[0]=__builtin_amdgcn_mfma_f32_32x32x16_bf16(PAF(3),VFR(3),o[0],0,0,0), C1,8); \
    GAPB(o[1]=__builtin_amdgcn_mfma_f32_32x32x16_bf16(PAF(3),VFR(7),o[1],0,0,0), C1,12); \
    }while(0)
  int t=1;
  #undef CMASK
  #define CMASK(P0,P1,t) do{}while(0)
  for(;t+5<NT;t+=2){
    STEP(pB0,pB1,pA0,pA1,t,true,true,true);     WAIT_BAR(2); RESC(); ROT();
    STEP(pA0,pA1,pB0,pB1,t+1,true,true,true);   WAIT_BAR(2); RESC(); ROT();
  }
  #undef CMASK
  #define CMASK(P0,P1,t) do{int jb_=(t)-(NT-4); if(jb_>=0)cmask(P0,P1,jb_,qrel,hi);}while(0)
  #define ENDW(tt) do{ if((tt)+3<NT){WAIT_BAR(2);} else if((tt)+2<NT){WAIT_BAR(1);} else {WAIT_BAR(0);} }while(0)
  for(;t+1<NT;t+=2){
    STEP(pB0,pB1,pA0,pA1,t,(t+3<NT),(t+1<NT),(t+1<NT));       ENDW(t);   RESC(); ROT();
    STEP(pA0,pA1,pB0,pB1,t+1,(t+4<NT),(t+2<NT),(t+2<NT));     ENDW(t+1); RESC(); ROT();
  }
  STEP(pB0,pB1,pA0,pA1,NT-1,false,false,false); RESC();
  { float sacc=pB0[0]+pB0[1]; _Pragma("unroll") for(int r=2;r<16;++r)sacc+=pB0[r]; _Pragma("unroll") for(int r=0;r<16;++r)sacc+=pB1[r]; l_reg+=sacc;
    pw0=(u32x4){PKW(pB0,0),PKW(pB0,2),PKW(pB0,4),PKW(pB0,6)};pw1=(u32x4){PKW(pB0,8),PKW(pB0,10),PKW(pB0,12),PKW(pB0,14)};pw2=(u32x4){PKW(pB1,0),PKW(pB1,2),PKW(pB1,4),PKW(pB1,6)};pw3=(u32x4){PKW(pB1,8),PKW(pB1,10),PKW(pB1,12),PKW(pB1,14)};
    SBAR(); pv(o,vb0+sl_cur,PAF(0),PAF(1),PAF(2),PAF(3)); }
  #undef PKW
  #undef PAF
  #undef VFR
  #undef PIN
  #undef MX3
  #undef GAPA
  #undef GAPB
  #undef EX
  #undef VRD
  #undef KRD
  #undef STEP
  #undef ENDW
  {auto rr=__builtin_amdgcn_permlane32_swap(__float_as_uint(l_reg),__float_as_uint(l_reg),false,false);l_reg=__uint_as_float(rr[0])+__uint_as_float(rr[1]);}
  if(hi==0)wsf[32+r32]=l_reg;asm volatile("s_waitcnt lgkmcnt(0)":::"memory");
  float rli[16];
  #pragma unroll
  for(int r=0;r<16;++r)rli[r]=__builtin_amdgcn_rcpf(wsf[32+crow(r,hi)]);
  bf16*Ow=O+(rowbase+q0+wid*QBLK)*DM+h*D;
  { bf16*stg=(bf16*)(shm+LDS_OST)+wid*2048;
    #pragma unroll
    for(int r=0;r<16;++r){const int orow=crow(r,hi);
      #pragma unroll
      for(int d0=0;d0<2;++d0)stg[orow*64+d0*32+r32]=__float2bfloat16(o[d0][r]*rli[r]);}
    asm volatile("s_waitcnt lgkmcnt(0)":::"memory");
    #pragma unroll
    for(int i=0;i<4;++i){const int row=i*8+(lane>>3),ch=lane&7; const u32x4 v=*(const u32x4*)(stg+row*64+ch*8); ATTN_STORE16(Ow+(long)row*DM+ch*8,v);} }
  asm volatile("s_waitcnt lgkmcnt(0)\n\ts_barrier":::"memory");
  #undef DMA_K
  #undef DMA_V
  #undef CMASK
  #undef START
  #undef RESC
  #undef ROT
}
constexpr int ATTN_LDS_BYTES=LDS_BYTES;
struct AttnTensors { const bf16* Q; const bf16* K; const bf16* V; bf16* O; const float* CL; const unsigned* KMAX; const float* FMX; };
struct AttnUnit { int bh; int qb; };
#undef SBAR
#undef WAIT_BAR
}
namespace sattn {
#define SLAS __attribute__((address_space(3)))
typedef short bf16x8 __attribute__((ext_vector_type(8)));
typedef float f32x4 __attribute__((ext_vector_type(4)));
typedef unsigned u32x4 __attribute__((ext_vector_type(4)));
typedef unsigned u32x2 __attribute__((ext_vector_type(2)));
typedef float f32x2_t __attribute__((ext_vector_type(2))); typedef __bf16 bf16x2_t __attribute__((ext_vector_type(2)));
__device__ __forceinline__ unsigned pk(float lo, float hi) { f32x2_t v = {lo, hi}; bf16x2_t b = __builtin_convertvector(v, bf16x2_t); return __builtin_bit_cast(unsigned, b); }
__device__ __forceinline__ bf16x8 cvt8(f32x4 a, f32x4 b) { u32x4 w; w.x = pk(a[0], a[1]); w.y = pk(a[2], a[3]); w.z = pk(b[0], b[1]); w.w = pk(b[2], b[3]); return __builtin_bit_cast(bf16x8, w); }
constexpr int PAST = 2048, NEWK = 16, LKEYS = PAST + NEWK, VT_STRIDE = 80, VT_BYTES = 64 * VT_STRIDE;
constexpr int L_VT = 0, L_CO = 8 * VT_BYTES, L_CM = L_CO + 8 * 16 * 64 * 4, L_CL = L_CM + 8 * 16 * 4, L_END = L_CL + 8 * 16 * 4;
constexpr float NEG = -1.0e30f;
struct Tensors { const float* ck; const float* cv; const unsigned short* QB; const unsigned short* KB; const unsigned short* VB; unsigned short* O; const float* CLS; };
__device__ __forceinline__ void tile_tail(f32x4 (&s)[2], const bf16x8 (&vw)[4], float& m, float& l, f32x4 (&o)[4], SLAS char* vt, int r, int g) {
    float mx = fmaxf(fmaxf(fmaxf(s[0][0], s[0][1]), fmaxf(s[0][2], s[0][3])), fmaxf(fmaxf(s[1][0], s[1][1]), fmaxf(s[1][2], s[1][3])));
    mx = fmaxf(mx, __shfl_xor(mx, 16)); mx = fmaxf(mx, __shfl_xor(mx, 32));
    const float mn = fmaxf(m, mx), alpha = __builtin_amdgcn_exp2f(m - mn); m = mn;
    float ps = 0.f;
#pragma unroll
    for (int j = 0; j < 2; ++j)
#pragma unroll
        for (int e = 0; e < 4; ++e) { s[j][e] = __builtin_amdgcn_exp2f(s[j][e] - mn); ps += s[j][e]; }
    l = l * alpha + ps;
#pragma unroll
    for (int db = 0; db < 4; ++db) o[db] *= alpha;
    const bf16x8 pb = cvt8(s[0], s[1]);
#pragma unroll
    for (int dd = 0; dd < 4; ++dd) *(SLAS bf16x8*)(vt + (4 * r + dd) * VT_STRIDE + g * 16) = vw[dd];
#pragma unroll
    for (int db = 0; db < 4; ++db) { const bf16x8 va = *(const SLAS bf16x8*)(vt + (16 * db + r) * VT_STRIDE + g * 16); o[db] = __builtin_amdgcn_mfma_f32_16x16x32_bf16(va, pb, o[db], 0, 0, 0); }
}
__device__ __forceinline__ void unit(int b, int h, const Tensors& T, SLAS char* lds) {
    const int tid = opaque_tid(), lane = tid & 63, r = lane & 15, g = lane >> 4; const int wid = __builtin_amdgcn_readfirstlane(tid >> 6);
    SLAS char* vt = lds + L_VT + wid * VT_BYTES;
    const size_t srow = (size_t)16384 + (size_t)b * 16;
    const float* cls = T.CLS + (size_t)(b * 16 + h) * LKEYS;
    const unsigned short* qp = T.QB + (srow + r) * 1024 + h * 64 + 8 * g;
    const bf16x8 qf0 = *(const bf16x8*)qp, qf1 = *(const bf16x8*)(qp + 32);
    const float cq = cls[PAST + r];
    float m = NEG, l = 0.f; f32x4 o[4];
#pragma unroll
    for (int db = 0; db < 4; ++db) o[db] = (f32x4){0.f, 0.f, 0.f, 0.f};
    const float* kc = T.ck + ((size_t)b * PAST * 16 + h) * 64; const float* vc = T.cv + ((size_t)b * PAST * 16 + h) * 64;
    for (int tI = 0; tI < 8; ++tI) {
        const int k0 = wid * 256 + tI * 32;
        bf16x8 ka[2][2];
#pragma unroll
        for (int j = 0; j < 2; ++j)
#pragma unroll
            for (int dh = 0; dh < 2; ++dh) { const float* p = kc + (size_t)(k0 + 16 * j + r) * 1024 + dh * 32 + 8 * g; ka[j][dh] = cvt8(*(const f32x4*)p, *(const f32x4*)(p + 4)); }
        f32x4 vv[2][4];
#pragma unroll
        for (int j = 0; j < 2; ++j)
#pragma unroll
            for (int e = 0; e < 4; ++e) vv[j][e] = *(const f32x4*)(vc + (size_t)(k0 + 16 * j + 4 * g + e) * 1024 + 4 * r);
        f32x4 ckv[2];
#pragma unroll
        for (int j = 0; j < 2; ++j) ckv[j] = *(const f32x4*)(cls + k0 + 16 * j + 4 * g);
        f32x4 s[2];
#pragma unroll
        for (int j = 0; j < 2; ++j) { s[j] = __builtin_amdgcn_mfma_f32_16x16x32_bf16(ka[j][0], qf0, (f32x4){0.f, 0.f, 0.f, 0.f}, 0, 0, 0); s[j] = __builtin_amdgcn_mfma_f32_16x16x32_bf16(ka[j][1], qf1, s[j], 0, 0, 0); }
#pragma unroll
        for (int j = 0; j < 2; ++j)
#pragma unroll
            for (int e = 0; e < 4; ++e) s[j][e] += cq - ckv[j][e];
        bf16x8 vw[4];
#pragma unroll
        for (int dd = 0; dd < 4; ++dd) { u32x4 w; w.x = pk(vv[0][0][dd], vv[0][1][dd]); w.y = pk(vv[0][2][dd], vv[0][3][dd]); w.z = pk(vv[1][0][dd], vv[1][1][dd]); w.w = pk(vv[1][2][dd], vv[1][3][dd]); vw[dd] = __builtin_bit_cast(bf16x8, w); }
        tile_tail(s, vw, m, l, o, vt, r, g);
    }
    if (wid == 0) {
        bf16x8 ka[2]; { const unsigned short* p = T.KB + (srow + r) * 1024 + h * 64 + 8 * g; ka[0] = *(const bf16x8*)p; ka[1] = *(const bf16x8*)(p + 32); }
        const f32x4 ckv = *(const f32x4*)(cls + PAST + 4 * g);
        f32x4 s[2];
        s[0] = __builtin_amdgcn_mfma_f32_16x16x32_bf16(ka[0], qf0, (f32x4){0.f, 0.f, 0.f, 0.f}, 0, 0, 0); s[0] = __builtin_amdgcn_mfma_f32_16x16x32_bf16(ka[1], qf1, s[0], 0, 0, 0);
#pragma unroll
        for (int e = 0; e < 4; ++e) { s[0][e] += cq - ckv[e]; if (4 * g + e > r) s[0][e] = NEG; s[1][e] = NEG; }
        unsigned short ve[4][4];
#pragma unroll
        for (int e = 0; e < 4; ++e) { const u32x2 w = *(const u32x2*)(T.VB + (srow + 4 * g + e) * 1024 + h * 64 + 4 * r); ve[e][0] = (unsigned short)(w.x & 0xffffu); ve[e][1] = (unsigned short)(w.x >> 16); ve[e][2] = (unsigned short)(w.y & 0xffffu); ve[e][3] = (unsigned short)(w.y >> 16); }
        bf16x8 vw[4];
#pragma unroll
        for (int dd = 0; dd < 4; ++dd) { u32x4 w; w.x = (unsigned)ve[0][dd] | ((unsigned)ve[1][dd] << 16); w.y = (unsigned)ve[2][dd] | ((unsigned)ve[3][dd] << 16); w.z = 0u; w.w = 0u; vw[dd] = __builtin_bit_cast(bf16x8, w); }
        tile_tail(s, vw, m, l, o, vt, r, g);
    }
    l += __shfl_xor(l, 16); l += __shfl_xor(l, 32);
    SLAS float* co = (SLAS float*)(lds + L_CO) + (wid * 16 + r) * 64; SLAS float* cm = (SLAS float*)(lds + L_CM); SLAS float* cl = (SLAS float*)(lds + L_CL);
#pragma unroll
    for (int db = 0; db < 4; ++db) *(SLAS f32x4*)(co + 16 * db + 4 * g) = o[db];
    if (g == 0) { cm[wid * 16 + r] = m; cl[wid * 16 + r] = l; }
    __syncthreads();
    { const int q = tid >> 5, d2 = (tid & 31) * 2; float mm = NEG;
#pragma unroll
      for (int w = 0; w < 8; ++w) mm = fmaxf(mm, cm[w * 16 + q]);
      float den = 0.f, n0 = 0.f, n1 = 0.f;
#pragma unroll
      for (int w = 0; w < 8; ++w) { const float f = __builtin_amdgcn_exp2f(cm[w * 16 + q] - mm); den += f * cl[w * 16 + q]; const SLAS float* c = (const SLAS float*)(lds + L_CO) + (w * 16 + q) * 64 + d2; n0 += f * c[0]; n1 += f * c[1]; }
      const float inv = 1.0f / den;
      *(unsigned*)(T.O + (srow + q) * 1024 + h * 64 + d2) = pk(n0 * inv, n1 * inv); }
    __syncthreads();
}
#undef SLAS
}
namespace cg = cooperative_groups;
constexpr int NWAVES = 8;
constexpr int D = 1024, H = 16, FF = 4096, MP = 16384, MS = 512, M = MP + MS, PAST = 2048, DBATCH = 32, DSEQ = 16, LKEYS = PAST + DSEQ;
constexpr float RMS_EPS = 1e-6f, L2E = 1.4426950408889634f, QSCALE = 0.125f * 1.4426950408889634f;
constexpr size_t OUT_Y = 0, OUT_KP = 17301504, OUT_VP = 34078720, OUT_LP = 50855936, OUT_CP = 51118080, OUT_KS = 51122176, OUT_VS = 51646464, OUT_LS = 52170752, OUT_CS = 52178944, OUT_END = 52310016;
static_assert(OUT_KP == (size_t)pg8::OUT_KP && OUT_VP == (size_t)pg8::OUT_VP && OUT_KS == (size_t)pg8::OUT_KS && OUT_VS == (size_t)pg8::OUT_VS, "d_out map");
constexpr size_t MiB = 1u << 20;
constexpr size_t WS_CTL = 0, CTL_ZERO_BYTES = 1 * MiB;
constexpr size_t WS_WIN = 2 * MiB, WS_WOUT = 14 * MiB, WS_WKVQ = 18 * MiB, WS_WQ1 = 24 * MiB, WS_WO = 26 * MiB, WS_WUP = 30 * MiB, WS_WDN = 62 * MiB, WS_WF = 94 * MiB;
constexpr size_t WS_X = 96 * MiB, WS_XB = 162 * MiB, WS_G = 195 * MiB, WS_KB = 228 * MiB, WS_VB = 261 * MiB, WS_QB = 294 * MiB, WS_HB = 327 * MiB, WS_SSQ = 459 * MiB, WS_CLP = 462 * MiB, WS_CLS = 463 * MiB, WS_END = 468 * MiB;
static_assert((size_t)M * D * 4 == 66 * MiB && (size_t)M * FF * 2 == 132 * MiB && (size_t)512 * LKEYS * 4 <= 5 * MiB && (size_t)M * pg8::NSSQ * 4 <= 3 * MiB, "d_ws map");
constexpr int CW_BAR = 4096, CW_KMAX = 2048, CW_FMX = 2080, CW_ATQ = 2304  ;
constexpr int RING_OFF = 0, RING_BYTES = 131072;
constexpr int ATT_LDS = attn_body::LDS_BYTES;
constexpr int LDSCTL_OFF = (ATT_LDS > RING_BYTES ? ATT_LDS : RING_BYTES), MISC_OFF = LDSCTL_OFF + 320;
constexpr int LDS_BYTES = LDSCTL_OFF + 1024;
static_assert(LDS_BYTES <= 163840 && sattn::L_END <= RING_BYTES, "LDS map");

#define GAS __attribute__((address_space(1)))
#define LAS __attribute__((address_space(3)))
typedef unsigned short bf16;
typedef unsigned v4u __attribute__((ext_vector_type(4)));
typedef unsigned v2u __attribute__((ext_vector_type(2)));
typedef float f32x4 __attribute__((ext_vector_type(4)));
typedef short bf16x8 __attribute__((ext_vector_type(8)));
typedef GAS unsigned gu32;
#define RLX_AGENT __ATOMIC_RELAXED, __HIP_MEMORY_SCOPE_AGENT
#define LDS_WAIT() asm volatile("s_waitcnt lgkmcnt(0)" ::: "memory")
#define VM_WAIT() asm volatile("s_waitcnt vmcnt(0)" ::: "memory")
__device__ __forceinline__ unsigned pk2(float lo, float hi) { return sattn::pk(lo, hi); }
__device__ __forceinline__ float bflo(unsigned w) { return __builtin_bit_cast(float, w << 16); }
__device__ __forceinline__ float bfhi(unsigned w) { return __builtin_bit_cast(float, w & 0xffff0000u); }
#define XB_TMO      128
#define XB_XCNT(j)  (256  + 64 * (j))
#define XB_XSUB(j)  (1280 + 64 * (j))
#define XB_XGEN(j)  (2304 + 64 * (j))
#define XB_TOP      3328
#define XB_TOPGEN   3392
#define XCD_BAR_WORDS 3456
#define XB_SPIN_CAP (1u << 18)

__device__ __forceinline__ unsigned xb_ld(unsigned* p)              { return __hip_atomic_load(p, __ATOMIC_RELAXED, __HIP_MEMORY_SCOPE_AGENT); }
__device__ __forceinline__ unsigned xb_add(unsigned* p, unsigned v) { return __hip_atomic_fetch_add(p, v, __ATOMIC_RELAXED, __HIP_MEMORY_SCOPE_AGENT); }
__device__ __forceinline__ unsigned xb_xcc_id() { return (unsigned)__builtin_amdgcn_s_getreg((3 << 11) | 20) & 0xFu; }
#define XB_SPIN(cond, bar) do { unsigned _sp = 0; while (cond) { __builtin_amdgcn_s_sleep(1); \
    if ((++_sp & 255u) == 0u) { if (xb_ld(&(bar)[XB_TMO])) break; if (_sp > XB_SPIN_CAP) { atomicAdd(&(bar)[XB_TMO], 1u); break; } } } } while (0)

struct XcdBarrier {
    unsigned* bar; unsigned x;
    volatile LAS unsigned* st;
};

__device__ __forceinline__ XcdBarrier xcd_barrier_post(unsigned* bar, volatile LAS unsigned* st) {
    XcdBarrier b; b.bar = bar; b.x = xb_xcc_id(); b.st = st;
    if (threadIdx.x == 0) (void)xb_add(&bar[XB_XCNT(b.x)], 1u);
    return b;
}
__device__ __forceinline__ void xcd_barrier_complete(unsigned* bar, unsigned x, unsigned& nloc, unsigned& nx) {
    const unsigned G = gridDim.x * gridDim.y * gridDim.z;
    unsigned sum, cnt, mine, sp = 0u;
    for (;;) {
        sum = 0u; cnt = 0u; mine = 0u;
#pragma unroll
        for (unsigned j = 0; j < 16; ++j) { const unsigned c = xb_ld(&bar[XB_XCNT(j)]); sum += c; cnt += (c > 0u) ? 1u : 0u; mine = (j == x) ? c : mine; }
        if (sum == G) break;
        __builtin_amdgcn_s_sleep(1);
        if ((++sp & 255u) == 0u) { if (xb_ld(&bar[XB_TMO])) break; if (sp > XB_SPIN_CAP) { atomicAdd(&bar[XB_TMO], 1u); break; } }
    }
    nloc = mine > 0u ? mine : 1u; nx = cnt > 0u ? cnt : 1u;
}

__device__ __forceinline__ void xcd_barrier(const XcdBarrier& b) {
    asm volatile("s_waitcnt vmcnt(0)" ::: "memory");
    __syncthreads();
    if (threadIdx.x == 0) {
        unsigned* bar = b.bar;
        __builtin_amdgcn_s_waitcnt(0);
        unsigned nloc = b.st[0], nx = b.st[1];
        if (nloc == 0u) { xcd_barrier_complete(bar, b.x, nloc, nx); b.st[0] = nloc; b.st[1] = nx; }
        const unsigned old = xb_add(&bar[XB_XSUB(b.x)], 1u);
        const unsigned gen = old / nloc;
        if (old + 1u == (gen + 1u) * nloc) {
            __builtin_amdgcn_fence(__ATOMIC_RELEASE, "agent");
            asm volatile("s_waitcnt vmcnt(0)" ::: "memory");
            const unsigned og = xb_add(&bar[XB_TOP], 1u);
            const unsigned tg = og / nx;
            if (og + 1u == (tg + 1u) * nx) xb_add(&bar[XB_TOPGEN], 1u);
            else XB_SPIN(xb_ld(&bar[XB_TOPGEN]) == tg, bar);
            __builtin_amdgcn_fence(__ATOMIC_ACQUIRE, "agent");
            xb_add(&bar[XB_XGEN(b.x)], 1u);
            asm volatile("s_waitcnt vmcnt(0)" ::: "memory");
        } else {
            XB_SPIN(xb_ld(&bar[XB_XGEN(b.x)]) == gen, bar);
            __builtin_amdgcn_fence(__ATOMIC_ACQUIRE, "agent");
            asm volatile("s_waitcnt vmcnt(0)" ::: "memory");
        }
    }
    __syncthreads();
}
struct Args { const float* in[21]; float* out; unsigned char* ws; };
typedef const __attribute__((address_space(4))) Args* KArgs;
__device__ __forceinline__ KArgs kargs() { KArgs p = (KArgs)__builtin_amdgcn_kernarg_segment_ptr(); asm volatile("" : "+s"(p)); return p; }
struct Frame {
    LAS unsigned char* lds; volatile LAS unsigned* MISC; gu32* ctl;
    int tid, lane, wave, vcu, G;
};
__device__ __forceinline__ float wave_sum(float v) {
#pragma unroll
    for (int o = 1; o < 64; o <<= 1) v += __shfl_xor(v, o);
    return v;
}
constexpr int P0_TILE_FLOATS = 64 * 65;
__device__ __forceinline__ void p0_transpose_item(const float* W, int K, int N, bf16* WT, int row_off, LAS float* scr, int item, int lane, const float* gain, float scale) {
    const int nblk = N / 64, kb = item / nblk, nb = item % nblk, k0 = 64 * kb, n0 = 64 * nb;
    const int c4 = lane & 15, kr = lane >> 4;
    f32x4 v[16];
#pragma unroll
    for (int i = 0; i < 16; ++i) v[i] = *(const GAS f32x4*)(W + (size_t)(k0 + 4 * i + kr) * N + n0 + 4 * c4);
#pragma unroll
    for (int i = 0; i < 16; ++i) { const int kk = 4 * i + kr; const float gsc = gain ? gain[k0 + kk] * scale : scale; LAS float* d = scr + kk * 65 + 4 * c4;
        d[0] = v[i].x * gsc; d[1] = v[i].y * gsc; d[2] = v[i].z * gsc; d[3] = v[i].w * gsc; }
    LDS_WAIT(); asm volatile("" ::: "memory");
    const int c = lane & 7;
#pragma unroll
    for (int j = 0; j < 8; ++j) { const int n = (lane >> 3) + 8 * j; const LAS float* s = scr + (8 * c) * 65 + n;
        v4u o; o.x = pk2(s[0 * 65], s[1 * 65]); o.y = pk2(s[2 * 65], s[3 * 65]); o.z = pk2(s[4 * 65], s[5 * 65]); o.w = pk2(s[6 * 65], s[7 * 65]);
        *(GAS v4u*)(WT + (size_t)(row_off + n0 + n) * K + k0 + 8 * c) = o; }
    LDS_WAIT(); asm volatile("" ::: "memory");
}
enum { I_XP = 0, I_XS, I_CK, I_CV, I_CLF, I_SC, I_NMIX, I_NMLP, I_CIN, I_CW, I_COUT, I_NKV, I_WK, I_WV, I_WF, I_BF, I_WQ, I_WO, I_UP, I_DN, I_NF };

__device__ __forceinline__ void p0_prologue(const Frame& F, KArgs a, unsigned char* ws) {
    const int T_tid = opaque_tid(), T_lane = T_tid & 63, T_wave = __builtin_amdgcn_readfirstlane(T_tid >> 6);
    LAS float* scr = (LAS float*)(F.lds + RING_OFF) + T_wave * P0_TILE_FLOATS;
    const int gw = F.vcu * NWAVES + T_wave, NGW = F.G * NWAVES;
    constexpr int NCHUNK = 46;
    for (int it = gw; it < NCHUNK * 256; it += NGW) {
        int c = it >> 8, base = 0; const float* src = nullptr; const float* gain = nullptr; bf16* dst = nullptr; int roff = 0, K = D, N = D; float sc = 1.f;
        if (c < 6) { const int l = c / 3; src = a->in[I_CIN] + (size_t)l * D * 3 * D; gain = a->in[I_NMIX] + l * D; dst = (bf16*)(ws + WS_WIN) + (size_t)l * 3 * D * D; N = 3 * D; base = l * 3; }
        else if (c < 8) { const int l = c - 6; src = a->in[I_COUT] + (size_t)l * D * D; dst = (bf16*)(ws + WS_WOUT) + (size_t)l * D * D; base = c; }
        else if (c < 9) { src = a->in[I_WK]; gain = a->in[I_NKV]; dst = (bf16*)(ws + WS_WKVQ); base = c; }
        else if (c < 10) { src = a->in[I_WV]; gain = a->in[I_NKV]; dst = (bf16*)(ws + WS_WKVQ); roff = D; base = c; }
        else if (c < 11) { src = a->in[I_WQ]; gain = a->in[I_NMIX] + 2 * D; dst = (bf16*)(ws + WS_WKVQ); roff = 2 * D; sc = QSCALE; base = c; }
        else if (c < 12) { src = a->in[I_WQ] + (size_t)D * D; gain = a->in[I_NMIX] + 3 * D; dst = (bf16*)(ws + WS_WQ1); sc = QSCALE; base = c; }
        else if (c < 14) { const int j = c - 12; src = a->in[I_WO] + (size_t)j * D * D; dst = (bf16*)(ws + WS_WO) + (size_t)j * D * D; base = c; }
        else if (c < 30) { const int l = (c - 14) >> 2; src = a->in[I_UP] + (size_t)l * D * FF; gain = a->in[I_NMLP] + l * D; dst = (bf16*)(ws + WS_WUP) + (size_t)l * D * FF; N = FF; base = 14 + 4 * l; }
        else { const int l = (c - 30) >> 2; src = a->in[I_DN] + (size_t)l * D * FF; dst = (bf16*)(ws + WS_WDN) + (size_t)l * D * FF; K = FF; base = 30 + 4 * l; }
        p0_transpose_item(src, K, N, dst, roff, scr, it - base * 256, T_lane, gain, sc);
    }
    for (int i = (F.vcu * NWAVES + T_wave) * 64 + T_lane; i < D * H; i += NGW * 64) { const int k = i >> 4, h = i & 15; ((bf16*)(ws + WS_WF))[h * D + k] = (bf16)(pk2(a->in[I_NKV][k] * a->in[I_WF][i], 0.f) & 0xffffu); }
    bf16* XB = (bf16*)(ws + WS_XB); float* SSQ = (float*)(ws + WS_SSQ);
    for (int m = gw; m < M; m += NGW) {
        const float* xr = (m < MP) ? a->in[I_XP] + (size_t)m * D : a->in[I_XS] + (size_t)(m - MP) * D;
        const GAS f32x4* xp = (const GAS f32x4*)xr + T_lane; f32x4 v[4]; float s = 0.f;
#pragma unroll
        for (int j = 0; j < 4; ++j) { v[j] = xp[64 * j]; s += (v[j].x * v[j].x + v[j].y * v[j].y) + (v[j].z * v[j].z + v[j].w * v[j].w); }
        s = wave_sum(s);
        GAS v2u* bo = (GAS v2u*)(XB + (size_t)m * D) + T_lane;
#pragma unroll
        for (int j = 0; j < 4; ++j) { v2u w; w.x = pk2(v[j].x, v[j].y); w.y = pk2(v[j].z, v[j].w); bo[64 * j] = w; }
        if (T_lane < pg8::NSSQ) SSQ[(size_t)m * pg8::NSSQ + T_lane] = (T_lane == 0) ? s : 0.f;
    }
}
__device__ __forceinline__ void conv_gate_phase(const Frame& F, KArgs a, unsigned char* ws, int l) {
    const int T_tid = opaque_tid(), T_lane = T_tid & 63, T_wave = __builtin_amdgcn_readfirstlane(T_tid >> 6);
    const int gw = F.vcu * NWAVES + T_wave, NGW = F.G * NWAVES;
    const bf16* BCX = (const bf16*)(ws + WS_HB); bf16* Gm = (bf16*)(ws + WS_G);
    const float* cw = a->in[I_CW] + (size_t)l * 3 * D;
    for (int it = gw; it < (M / 4) * 2; it += NGW) {
        const int half = it & 1, row0 = (it >> 1) * 4, c0 = half * 512 + T_lane * 8;
        float w0[8], w1[8], w2[8], um2[8], um1[8];
        { const f32x4 a0 = *(const f32x4*)(cw + c0), a1 = *(const f32x4*)(cw + c0 + 4), b0 = *(const f32x4*)(cw + D + c0), b1 = *(const f32x4*)(cw + D + c0 + 4), d0 = *(const f32x4*)(cw + 2 * D + c0), d1 = *(const f32x4*)(cw + 2 * D + c0 + 4);
#pragma unroll
          for (int e = 0; e < 4; ++e) { w0[e] = a0[e]; w0[4 + e] = a1[e]; w1[e] = b0[e]; w1[4 + e] = b1[e]; w2[e] = d0[e]; w2[4 + e] = d1[e]; } }
        const bool sample = row0 >= MP; const int sb = sample ? (row0 - MP) >> 4 : 0; const int t0 = sample ? (row0 - MP) & 15 : row0;
        if (t0 == 0) {
            if (sample) { const float* st = a->in[I_SC] + ((size_t)(l * DBATCH + sb) * 2) * D + c0;
                const f32x4 p0 = *(const f32x4*)st, p1 = *(const f32x4*)(st + 4), q0 = *(const f32x4*)(st + D), q1 = *(const f32x4*)(st + D + 4);
#pragma unroll
                for (int e = 0; e < 4; ++e) { um2[e] = p0[e]; um2[4 + e] = p1[e]; um1[e] = q0[e]; um1[4 + e] = q1[e]; } }
            else {
#pragma unroll
                for (int e = 0; e < 8; ++e) { um2[e] = 0.f; um1[e] = 0.f; } }
        } else {
#pragma unroll
            for (int k = 0; k < 2; ++k) { const bf16* rp = BCX + (size_t)(row0 - 2 + k) * 3072 + c0; const v4u gc = *(const v4u*)(rp + D), xv = *(const v4u*)(rp + 2 * D);
#pragma unroll
                for (int e = 0; e < 4; ++e) { const float u0 = bflo(gc[e]) * bflo(xv[e]), u1 = bfhi(gc[e]) * bfhi(xv[e]); if (k == 0) { um2[2 * e] = u0; um2[2 * e + 1] = u1; } else { um1[2 * e] = u0; um1[2 * e + 1] = u1; } } }
        }
#pragma unroll
        for (int i = 0; i < 4; ++i) { const bf16* rp = BCX + (size_t)(row0 + i) * 3072 + c0; const v4u gb = *(const v4u*)rp, gc = *(const v4u*)(rp + D), xv = *(const v4u*)(rp + 2 * D);
            float u[8], o[8];
#pragma unroll
            for (int e = 0; e < 4; ++e) { u[2 * e] = bflo(gc[e]) * bflo(xv[e]); u[2 * e + 1] = bfhi(gc[e]) * bfhi(xv[e]); }
#pragma unroll
            for (int e = 0; e < 8; ++e) o[e] = w0[e] * um2[e] + w1[e] * um1[e] + w2[e] * u[e];
            v4u w;
#pragma unroll
            for (int e = 0; e < 4; ++e) w[e] = pk2(bflo(gb[e]) * o[2 * e], bfhi(gb[e]) * o[2 * e + 1]);
            *(v4u*)(Gm + (size_t)(row0 + i) * D + c0) = w;
#pragma unroll
            for (int e = 0; e < 8; ++e) { um2[e] = um1[e]; um1[e] = u[e]; } }
        const bool last = sample ? (t0 == 12) : (row0 + 4 == MP);
        if (last) { float* o = a->out + (sample ? OUT_CS + ((size_t)(l * DBATCH + sb) * 2) * D : OUT_CP + (size_t)l * 2 * D) + c0;
            *(f32x4*)o = (f32x4){um2[0], um2[1], um2[2], um2[3]}; *(f32x4*)(o + 4) = (f32x4){um2[4], um2[5], um2[6], um2[7]};
            *(f32x4*)(o + D) = (f32x4){um1[0], um1[1], um1[2], um1[3]}; *(f32x4*)(o + D + 4) = (f32x4){um1[4], um1[5], um1[6], um1[7]}; }
    }
}
__device__ __forceinline__ void logf_phase(const Frame& F, KArgs a, unsigned char* ws) {
    const int T_tid = opaque_tid(), T_lane = T_tid & 63, T_wave = __builtin_amdgcn_readfirstlane(T_tid >> 6);
    const int gw = F.vcu * NWAVES + T_wave, NGW = F.G * NWAVES; const int r = T_lane & 15, g = T_lane >> 4;
    const bf16* WF = (const bf16*)(ws + WS_WF); const bf16* XB = (const bf16*)(ws + WS_XB); const float* SSQ = (const float*)(ws + WS_SSQ);
    for (int blk = gw; blk < M / 16; blk += NGW) {
        const int row = blk * 16 + r; f32x4 acc = (f32x4){0.f, 0.f, 0.f, 0.f};
        const bf16* ap = WF + (size_t)r * D + 8 * g; const bf16* bp = XB + (size_t)row * D + 8 * g;
#pragma unroll 8
        for (int s = 0; s < 32; ++s) acc = __builtin_amdgcn_mfma_f32_16x16x32_bf16(*(const bf16x8*)(ap + 32 * s), *(const bf16x8*)(bp + 32 * s), acc, 0, 0, 0);
        const float rs = pg8::row_rstd(SSQ, row); const f32x4 bfv = *(const f32x4*)(a->in[I_BF] + 4 * g); f32x4 o;
#pragma unroll
        for (int e = 0; e < 4; ++e) { const float z = acc[e] * rs + bfv[e]; o[e] = fminf(z, 0.f) - log1pf(expf(-fabsf(z))); }
        float* op = a->out + ((row < MP) ? OUT_LP + (size_t)row * 16 : OUT_LS + (size_t)(row - MP) * 16) + 4 * g;
        *(f32x4*)op = o;
    }
}
__device__ __forceinline__ double wave_scan_incl(double v, int lane) {
#pragma unroll
    for (int o = 1; o < 64; o <<= 1) { const double t = __shfl_up(v, o); if (lane >= o) v += t; }
    return v;
}
__device__ __forceinline__ void scan_phase(const Frame& F, KArgs a, unsigned char* ws) {
    const int T_tid = opaque_tid(), T_lane = T_tid & 63, T_wave = __builtin_amdgcn_readfirstlane(T_tid >> 6);
    float* CLP = (float*)(ws + WS_CLP); float* CLS = (float*)(ws + WS_CLS);
    const int blk = blockIdx.x;
    if (blk < 16) {
        const int h = blk; const float* lf = a->out + OUT_LP; const int t0 = T_tid * 32; double s = 0.0; float lv[32];
#pragma unroll
        for (int i = 0; i < 32; ++i) lv[i] = lf[(size_t)(t0 + i) * 16 + h];
#pragma unroll
        for (int i = 0; i < 32; ++i) s += (double)lv[i];
        float lmx = lv[0];
#pragma unroll
        for (int i = 1; i < 32; ++i) lmx = fmaxf(lmx, lv[i]);
#pragma unroll
        for (int o = 1; o < 64; o <<= 1) lmx = fmaxf(lmx, __shfl_xor(lmx, o));
        const double inc = wave_scan_incl(s, T_lane);
        LAS double* wt = (LAS double*)(F.lds + RING_OFF); LAS float* wm = (LAS float*)(F.lds + RING_OFF + 128);
        if (T_lane == 63) { wt[T_wave] = inc; wm[T_wave] = lmx; }
        __syncthreads();
        if (T_tid == 0) { float m8 = wm[0];
#pragma unroll
            for (int w = 1; w < NWAVES; ++w) m8 = fmaxf(m8, wm[w]);
            ((float*)(ws + WS_CTL))[CW_FMX + h] = m8; }
        double run = inc - s;
        for (int w = 0; w < T_wave; ++w) run += wt[w];
#pragma unroll
        for (int i = 0; i < 32; ++i) { run += (double)lv[i]; lv[i] = (float)(run * (double)L2E); }
#pragma unroll
        for (int i = 0; i < 8; ++i) *(f32x4*)(CLP + (size_t)h * MP + t0 + 4 * i) = (f32x4){lv[4 * i], lv[4 * i + 1], lv[4 * i + 2], lv[4 * i + 3]};
        __syncthreads();
    } else {
        const int nws = (F.G - 16) * NWAVES;
        for (int seq = (blk - 16) * NWAVES + T_wave; seq < DBATCH * H; seq += nws) {
            const int b = seq >> 4, h = seq & 15; const float* clf = a->in[I_CLF] + (size_t)b * PAST * 16 + h; const float* nlf = a->out + OUT_LS + (size_t)b * DSEQ * 16 + h;
            const int s0 = T_lane * 33; double s = 0.0; float lv[33];
#pragma unroll
            for (int i = 0; i < 33; ++i) { const int k = s0 + i; const int kc = k < LKEYS ? k : LKEYS - 1; const float* p = kc < PAST ? clf + (size_t)kc * 16 : nlf + (size_t)(kc - PAST) * 16; const float v = *p; lv[i] = (k < LKEYS) ? v : 0.f; }
#pragma unroll
            for (int i = 0; i < 33; ++i) s += (double)lv[i];
            double run = wave_scan_incl(s, T_lane) - s;
#pragma unroll
            for (int i = 0; i < 33; ++i) { const int k = s0 + i; run += (double)lv[i]; if (k < LKEYS) CLS[(size_t)seq * LKEYS + k] = (float)(run * (double)L2E); }
        }
    }
    { const int gw = F.vcu * NWAVES + T_wave, NGW = F.G * NWAVES; const bf16* KB = (const bf16*)(ws + WS_KB); float mx = 0.f;
      for (int row = gw; row < MP; row += NGW) { const v4u p = *(const v4u*)(KB + (size_t)row * D + T_lane * 16), q = *(const v4u*)(KB + (size_t)row * D + T_lane * 16 + 8); float sq = 0.f;
#pragma unroll
          for (int e = 0; e < 4; ++e) { const float a0 = bflo(p[e]), a1 = bfhi(p[e]), b0 = bflo(q[e]), b1 = bfhi(q[e]); sq += (a0 * a0 + a1 * a1) + (b0 * b0 + b1 * b1); }
          sq += __shfl_xor(sq, 1); sq += __shfl_xor(sq, 2); mx = fmaxf(mx, sq); }
      __syncthreads();
      LAS float* km = (LAS float*)(F.lds + RING_OFF) + 64;
      if ((T_lane & 3) == 0) km[T_wave * 16 + (T_lane >> 2)] = mx;
      __syncthreads();
      if (T_tid < 16) { float m = km[T_tid];
#pragma unroll
          for (int w = 1; w < NWAVES; ++w) m = fmaxf(m, km[w * 16 + T_tid]);
          atomicMax((unsigned*)(ws + WS_CTL) + CW_KMAX + T_tid, __builtin_bit_cast(unsigned, m)); }
      __syncthreads(); }
}
__device__ __forceinline__ void final_norm_phase(const Frame& F, KArgs a, unsigned char* ws) {
    const int T_tid = opaque_tid(), T_lane = T_tid & 63, T_wave = __builtin_amdgcn_readfirstlane(T_tid >> 6);
    const int gw = F.vcu * NWAVES + T_wave, NGW = F.G * NWAVES; const float* X = (const float*)(ws + WS_X);
    const GAS f32x4* gp = (const GAS f32x4*)a->in[I_NF] + T_lane; f32x4 gn[4];
#pragma unroll
    for (int j = 0; j < 4; ++j) gn[j] = gp[64 * j];
    for (int m = gw; m < M; m += NGW) {
        const GAS f32x4* xp = (const GAS f32x4*)(X + (size_t)m * D) + T_lane; f32x4 v[4]; float s = 0.f;
#pragma unroll
        for (int j = 0; j < 4; ++j) { v[j] = xp[64 * j]; s += (v[j].x * v[j].x + v[j].y * v[j].y) + (v[j].z * v[j].z + v[j].w * v[j].w); }
        const float rs = 1.0f / sqrtf(wave_sum(s) * (1.0f / D) + RMS_EPS);
        GAS f32x4* op = (GAS f32x4*)(a->out + OUT_Y + (size_t)m * D) + T_lane;
#pragma unroll
        for (int j = 0; j < 4; ++j) op[64 * j] = v[j] * rs * gn[j];
    }
}

__device__ __forceinline__ void attention_phase(char* lds, const attn_body::AttnTensors& T, const sattn::Tensors& ST, unsigned* qctr, int block) {
    volatile LAS int* tk = (volatile LAS int*)((LAS char*)lds + attn_body::LDS_WS);
    for (;;) {
        if (threadIdx.x == 0) { int v = -1, q = block & 7; for (int tried = 0; tried < 8; ++tried) { const unsigned i_ = __hip_atomic_fetch_add(qctr + 64 * q, 1u, __ATOMIC_RELAXED, __HIP_MEMORY_SCOPE_AGENT); if (i_ < 192u) { v = (int)(q * 192u + i_); break; } q = (q + 1) & 7; } tk[0] = v; }
        __syncthreads();
        const int u = __builtin_amdgcn_readfirstlane(tk[0]);
        __syncthreads();
        if (u < 0) break;
        const int qq = u / 192, i_ = u - qq * 192, grp = i_ / 3, rem = i_ - grp * 3;
        if (rem == 2) { const int su = qq * 64 + grp; sattn::unit(su >> 4, su & 15, ST, (LAS char*)lds); }
        else { const int pi = grp * 2 + rem, h = 2 * qq + (pi & 1), qb = 63 - (pi >> 1);
            attn_body::attn_unit<24>(0, h, qb, T.Q, T.K, T.V, T.O, lds, T.CL + (size_t)h * attn_body::SEQ, __builtin_bit_cast(float, T.KMAX[h]), T.FMX[h]); }
    }
}

__global__ void __launch_bounds__(NWAVES * 64, 2) yoco_fwd(Args args) {
    extern __shared__ __attribute__((aligned(16))) unsigned char lds[];
    Frame F;
    F.lds = (LAS unsigned char*)lds;
    F.MISC = (volatile LAS unsigned*)(F.lds + MISC_OFF);
    F.tid = threadIdx.x; F.lane = F.tid & 63; F.wave = __builtin_amdgcn_readfirstlane(F.tid >> 6);
    F.G = gridDim.x; { const int bx = blockIdx.x; F.vcu = (F.G % 8 == 0) ? (bx % 8) * (F.G / 8) + bx / 8 : bx; }
    F.ctl = (gu32*)(kargs()->ws + WS_CTL);
    for (int u = F.tid; u < (LDS_BYTES - LDSCTL_OFF) / 4; u += NWAVES * 64) ((LAS unsigned*)(F.lds + LDSCTL_OFF))[u] = 0u;
    __syncthreads();
    XcdBarrier bar = xcd_barrier_post((unsigned*)(F.ctl + CW_BAR), F.MISC + 8);
#define GRID_BAR() xcd_barrier(bar)
#define WSP(T, off) ((T*)(kargs()->ws + (off)))

    p0_prologue(F, kargs(), kargs()->ws);
    if (kargs()->ws == nullptr) cg::this_grid().sync();
    GRID_BAR();

#define SAMPLE_TILES(g, E) do { const int id_ = opaque_bid(); if (id_ < 4 * ((g).N / 128)) { const int mi_ = id_ & 3, ni_ = id_ >> 2; \
        pg8::gemm128_tile(F.lds + RING_OFF, (g).A + (size_t)(MP + 128 * mi_) * (g).K, (g).Bt + (size_t)(128 * ni_) * (g).K, (g).K, E, MP + 128 * mi_, 128 * ni_); } } while (0)
#define SAMPLE_TILES64(g, E) do { const int id_ = opaque_bid(); if (id_ < 8 * ((g).N / 64)) { const int mi_ = id_ & 7, ni_ = id_ >> 3; \
        pg8::gemm64_resid_tile(F.lds + RING_OFF, (g).A + (size_t)(MP + 64 * mi_) * (g).K, (g).Bt + (size_t)(64 * ni_) * (g).K, (g).K, E, MP + 64 * mi_, 64 * ni_); } } while (0)
#define LAYER(l) do { \
        if ((l) != 2) { \
            constexpr bool cv = (l) < 2; unsigned char* ws = kargs()->ws; \
            pg8::Gemm g{(const bf16*)(ws + WS_XB), cv ? (const bf16*)(ws + WS_WIN) + (size_t)(l) * 3 * D * D : (const bf16*)(ws + WS_WQ1), M, cv ? 3 * D : D, D}; \
            pg8::StaticOrder S; S.init(MP, cv ? 3 * D : D, F.G, opaque_bid()); \
            pg8::EpiAct<0, false> E{cv ? (bf16*)(ws + WS_HB) : (bf16*)(ws + WS_QB), cv ? 3 * D : D, (const float*)(ws + WS_SSQ), 0, 0, nullptr}; \
            pg8::gemm_phase<pg8::EpiAct<0, false>, pg8::StaticOrder, PG8_ALIGN, PG8_SP2>(F.lds + RING_OFF, g, S, E); \
            SAMPLE_TILES(g, E); \
            GRID_BAR(); \
        } \
        if ((l) < 2) { conv_gate_phase(F, kargs(), kargs()->ws, (l)); } \
        else { \
            { KArgs ka = kargs(); unsigned char* ws = ka->ws; \
            const attn_body::AttnTensors AT{(const attn_body::bf16*)(ws + WS_QB), (const attn_body::bf16*)(ws + WS_KB), (const attn_body::bf16*)(ws + WS_VB), (attn_body::bf16*)(ws + WS_G), (const float*)(ws + WS_CLP), (const unsigned*)(ws + WS_CTL) + CW_KMAX, (const float*)(ws + WS_CTL) + CW_FMX}; \
            const sattn::Tensors ST{ka->in[I_CK], ka->in[I_CV], (const bf16*)(ws + WS_QB), (const bf16*)(ws + WS_KB), (const bf16*)(ws + WS_VB), (bf16*)(ws + WS_G), (const float*)(ws + WS_CLS)}; \
            attention_phase((char*)lds + RING_OFF, AT, ST, (unsigned*)(ws + WS_CTL) + CW_ATQ + ((l) - 2) * 512, opaque_bid()); } \
        } \
        GRID_BAR(); \
        { unsigned char* ws = kargs()->ws; \
            pg8::Gemm g{(const bf16*)(ws + WS_G), ((l) < 2) ? (const bf16*)(ws + WS_WOUT) + (size_t)(l) * D * D : (const bf16*)(ws + WS_WO) + (size_t)((l) - 2) * D * D, M, D, D}; \
            pg8::StaticOrder S; S.init(MP, D, F.G, opaque_bid()); \
            pg8::EpiResid E{(float*)(ws + WS_X), (bf16*)(ws + WS_XB), (float*)(ws + WS_SSQ), ((l) == 0) ? kargs()->in[I_XP] : nullptr, ((l) == 0) ? kargs()->in[I_XS] : nullptr}; \
            pg8::gemm_phase<pg8::EpiResid, pg8::StaticOrder, PG8_ALIGN, PG8_SP2>(F.lds + RING_OFF, g, S, E); \
            SAMPLE_TILES64(g, E); \
            GRID_BAR(); } \
        { unsigned char* ws = kargs()->ws; \
            pg8::Gemm g{(const bf16*)(ws + WS_XB), (const bf16*)(ws + WS_WUP) + (size_t)(l) * D * FF, M, FF, D}; \
            pg8::StaticOrder S; S.init(MP, FF, F.G, opaque_bid()); \
            pg8::EpiAct<1, false> E{(bf16*)(ws + WS_HB), FF, (const float*)(ws + WS_SSQ), 0, 0, nullptr}; \
            pg8::gemm_phase<pg8::EpiAct<1, false>, pg8::StaticOrder, PG8_ALIGN, PG8_SP2>(F.lds + RING_OFF, g, S, E); \
            SAMPLE_TILES(g, E); \
            GRID_BAR(); } \
        { unsigned char* ws = kargs()->ws; \
            pg8::Gemm g{(const bf16*)(ws + WS_HB), (const bf16*)(ws + WS_WDN) + (size_t)(l) * D * FF, M, D, FF}; \
            pg8::StaticOrder S; S.init(MP, D, F.G, opaque_bid()); \
            pg8::EpiResid E{(float*)(ws + WS_X), (bf16*)(ws + WS_XB), (float*)(ws + WS_SSQ), nullptr, nullptr}; \
            pg8::gemm_phase<pg8::EpiResid, pg8::StaticOrder, PG8_ALIGN, PG8_SP2>(F.lds + RING_OFF, g, S, E); \
            SAMPLE_TILES64(g, E); \
            GRID_BAR(); } \
        if ((l) == 1) { \
            KArgs ka = kargs(); unsigned char* ws = ka->ws; \
            pg8::Gemm g{(const bf16*)(ws + WS_XB), (const bf16*)(ws + WS_WKVQ), M, 3 * D, D}; \
            pg8::StaticOrder S; S.init(MP, 3 * D, F.G, opaque_bid()); \
            pg8::EpiAct<0, true> E{(bf16*)(ws + WS_KB), D, (const float*)(ws + WS_SSQ), D, (size_t)(WS_VB - WS_KB) / 2, ka->out}; \
            pg8::gemm_phase<pg8::EpiAct<0, true>, pg8::StaticOrder, PG8_ALIGN, PG8_SP2>(F.lds + RING_OFF, g, S, E); \
            SAMPLE_TILES(g, E); \
            logf_phase(F, kargs(), kargs()->ws); \
            GRID_BAR(); \
            scan_phase(F, kargs(), kargs()->ws); \
            GRID_BAR(); \
        } } while (0)
    LAYER(0); LAYER(1); LAYER(2); LAYER(3);
    final_norm_phase(F, kargs(), kargs()->ws);
}

extern "C" void kernel_launch(void* const* d_in, const int* in_sizes, int n_in, void* d_out, int out_size, void* d_ws, size_t ws_size, hipStream_t stream) {
    static int grid = 0;
    if (grid == 0) {
        if (n_in != 21 || out_size != (int)OUT_END || ws_size < WS_END) { fprintf(stderr, "kernel_launch: unexpected sizes (n_in %d, out %d, ws %zu); nothing launched\n", n_in, out_size, ws_size); grid = -1; return; }
        int dev = 0, cus = 0, per_cu = 0;
        if (hipGetDevice(&dev) != hipSuccess || hipDeviceGetAttribute(&cus, hipDeviceAttributeMultiprocessorCount, dev) != hipSuccess) { grid = -1; return; }
        if (hipFuncSetAttribute((const void*)yoco_fwd, hipFuncAttributeMaxDynamicSharedMemorySize, LDS_BYTES) != hipSuccess) { fprintf(stderr, "kernel_launch: hipFuncSetAttribute failed\n"); grid = -1; return; }
        if (hipOccupancyMaxActiveBlocksPerMultiprocessor(&per_cu, (const void*)yoco_fwd, NWAVES * 64, LDS_BYTES) != hipSuccess || per_cu < 1) { fprintf(stderr, "kernel_launch: occupancy query says %d\n", per_cu); per_cu = 1; }
        (void)hipGetLastError();
        grid = cus;
    }
    if (grid < 0) return;
    if (hipMemsetAsync((char*)d_ws + WS_CTL, 0, CTL_ZERO_BYTES, stream) != hipSuccess) { fprintf(stderr, "kernel_launch: memset failed\n"); return; }
    Args a{};
    for (int i = 0; i < 21; ++i) a.in[i] = (const float*)d_in[i];
    a.out = (float*)d_out; a.ws = (unsigned char*)d_ws;
    void* kargv[] = {&a};
    const hipError_t e = hipLaunchCooperativeKernel((const void*)yoco_fwd, dim3(grid), dim3(NWAVES * 64), kargv, LDS_BYTES, stream);
    if (e != hipSuccess) fprintf(stderr, "kernel_launch: cooperative launch failed: %s (grid %d)\n", hipGetErrorString(e), grid);
}
```
